# Optimizing an MI355X kernel written in HIP

```python
import math
import jax, jax.numpy as jnp
from jax import lax
import numpy as np

D_MODEL = 1024
BATCH = 32
SEQ = 2048
DEPTH = 2

HEAD_DIM = D_MODEL // 16
A_HEADS = 4
IDX_HEADS = 4
IDX_DIM = HEAD_DIM
TOPK_MAX = 256
B_HEADS = 4
DIFF_DH = HEAD_DIM // 2
C_HEADS = 8
C_CONFIGS = ((128, 1), (512, 4), (2048, 16))
C_BLOCK = 128
Q_BLOCK = 128
MIX_WIDTH = (A_HEADS + B_HEADS + C_HEADS) * HEAD_DIM
FF_DIM = -(-8 * D_MODEL // (3 * 256)) * 256
DEEPNORM_ALPHA = (2 * DEPTH) ** 0.25
DEEPNORM_BETA = (8 * DEPTH) ** -0.25
LN_EPS = 1e-5
IN_SIZES = (A_HEADS * HEAD_DIM, HEAD_DIM, HEAD_DIM,
            IDX_HEADS * IDX_DIM, IDX_DIM, IDX_HEADS,
            B_HEADS * 2 * DIFF_DH, B_HEADS * 2 * DIFF_DH, B_HEADS * HEAD_DIM,
            C_HEADS * HEAD_DIM, C_HEADS * HEAD_DIM, C_HEADS * HEAD_DIM)
IN_COLS = sum(IN_SIZES)

kernel_name = 'hybrid_dsa_diff_dilated_deepnorm'


def layer_norm(x, g, b):
    xf = x.astype(jnp.float32)
    mu = jnp.mean(xf, axis=-1, keepdims=True)
    var = jnp.mean(jnp.square(xf - mu), axis=-1, keepdims=True)
    y = (xf - mu) * lax.rsqrt(var + LN_EPS) * g.astype(jnp.float32) + b.astype(jnp.float32)
    return y.astype(x.dtype)


def alibi_slopes(n):
    return jnp.asarray([2.0 ** (-8.0 * (i + 1) / n) for i in range(n)], dtype=jnp.float32)


def to_blocks(a):
    b, s = a.shape[:2]
    a = a.reshape((b, s // Q_BLOCK, Q_BLOCK) + a.shape[2:])
    return jnp.moveaxis(a, 1, 0)


def from_blocks(a):
    nb, b, q = a.shape[:3]
    return jnp.moveaxis(a, 0, 1).reshape((b, nb * q) + a.shape[3:])


def split_columns(z):
    parts, start = [], 0
    for size in IN_SIZES:
        parts.append(z[..., start:start + size])
        start += size
    return parts


def dsa_attention(q, k, v, qi, ki, wi):
    s = q.shape[1]
    topk = min(TOPK_MAX, s // 4)
    slopes = alibi_slopes(A_HEADS)
    key_pos = jnp.arange(s)
    wi = wi.astype(jnp.float32) * IDX_HEADS ** -0.5

    def block(args):
        blk, q_b, qi_b, wi_b = args
        t = blk * Q_BLOCK + jnp.arange(Q_BLOCK)
        rel = jax.nn.relu(jnp.einsum('bqhd,bsd->bqhs', qi_b, ki).astype(jnp.float32) * IDX_DIM ** -0.5)
        score = jnp.einsum('bqhs,bqh->bqs', rel, wi_b)
        score = jnp.where(key_pos[None, None, :] <= t[None, :, None], score, -jnp.inf)
        _, sel = lax.top_k(score, topk)
        k_sel = jax.vmap(lambda kk, ii: kk[ii])(k, sel)
        v_sel = jax.vmap(lambda vv, ii: vv[ii])(v, sel)
        dist = (t[None, :, None] - sel).astype(jnp.float32)
        logits = jnp.einsum('bqhd,bqkd->bqhk', q_b, k_sel).astype(jnp.float32) * HEAD_DIM ** -0.5
        logits = logits - slopes[None, None, :, None] * dist[:, :, None, :]
        logits = jnp.where((dist >= 0)[:, :, None, :], logits, -jnp.inf)
        p = jax.nn.softmax(logits, axis=-1)
        return jnp.einsum('bqhk,bqkd->bqhd', p, v_sel.astype(jnp.float32)).astype(v.dtype)

    nb = s // Q_BLOCK
    out = lax.map(block, (jnp.arange(nb), to_blocks(q), to_blocks(qi), to_blocks(wi)))
    return from_blocks(out)


def diff_attention(q, k, v, lam, subln_g, lambda_init):
    s = q.shape[1]
    slopes = alibi_slopes(B_HEADS)
    lam = lam.astype(jnp.float32)
    lam_full = jnp.exp(jnp.sum(lam[0] * lam[1])) - jnp.exp(jnp.sum(lam[2] * lam[3])) + lambda_init
    key_pos = jnp.arange(s)
    vf = v.astype(jnp.float32)

    def block(args):
        blk, q_b = args
        t = blk * Q_BLOCK + jnp.arange(Q_BLOCK)
        dist = (t[:, None] - key_pos[None, :]).astype(jnp.float32)
        logits = jnp.einsum('bqhmd,bshmd->bhmqs', q_b, k).astype(jnp.float32) * DIFF_DH ** -0.5
        logits = logits - slopes[None, :, None, None, None] * dist
        logits = jnp.where(dist >= 0, logits, -jnp.inf)
        p = jax.nn.softmax(logits, axis=-1)
        w = p[:, :, 0] - lam_full * p[:, :, 1]
        return jnp.einsum('bhqs,bshd->bqhd', w, vf)

    nb = s // Q_BLOCK
    o = from_blocks(lax.map(block, (jnp.arange(nb), to_blocks(q))))
    o = o * lax.rsqrt(jnp.mean(o * o, axis=-1, keepdims=True) + LN_EPS) * subln_g.astype(jnp.float32)
    return (o * (1.0 - lambda_init)).astype(v.dtype)


def dilated_branch(q, k, v, dilation, steps, slopes):
    b, s, h, d = q.shape
    ls = s // dilation
    nb = -(-ls // C_BLOCK)
    lp = nb * C_BLOCK

    def sub(a):
        a = a.reshape(b, ls, dilation, h, d).transpose(0, 2, 1, 3, 4)
        a = jnp.pad(a, ((0, 0), (0, 0), (0, lp - ls), (0, 0), (0, 0)))
        return a.reshape(b, dilation, nb, C_BLOCK, h, d)

    def band(a):
        prev = jnp.pad(a, ((0, 0), (0, 0), (1, 0), (0, 0), (0, 0), (0, 0)))[:, :, :-1]
        return jnp.concatenate([prev, a], axis=3)

    qs = sub(q)
    kb, vb = band(sub(k)), band(sub(v))
    qi = jnp.arange(C_BLOCK) + C_BLOCK
    kj = jnp.arange(2 * C_BLOCK)
    delta = qi[:, None] - kj[None, :]
    key_idx = jnp.arange(nb)[:, None] * C_BLOCK + kj[None, :] - C_BLOCK
    valid = (delta >= 0)[None] & (delta <= steps)[None] & (key_idx >= 0)[:, None, :]
    dist = (delta * dilation).astype(jnp.float32)
    logits = jnp.einsum('bonqhd,bonkhd->bonhqk', qs, kb).astype(jnp.float32) * HEAD_DIM ** -0.5
    logits = logits - slopes[:, None, None] * dist
    logits = jnp.where(valid[:, None], logits, -jnp.inf)
    lse = jax.nn.logsumexp(logits, axis=-1)
    p = jnp.exp(logits - lse[..., None])
    o = jnp.einsum('bonhqk,bonkhd->bonqhd', p, vb.astype(jnp.float32))
    o = o.reshape(b, dilation, lp, h, d)[:, :, :ls].transpose(0, 2, 1, 3, 4).reshape(b, s, h, d)
    lse = lse.transpose(0, 1, 2, 4, 3).reshape(b, dilation, lp, h)[:, :, :ls]
    lse = lse.transpose(0, 2, 1, 3).reshape(b, s, h)
    return o, lse


def dilated_attention(q, k, v):
    slopes = alibi_slopes(C_HEADS)
    outs, lses = [], []
    for window, dil in C_CONFIGS:
        o, l = dilated_branch(q, k, v, dil, window // dil, slopes)
        outs.append(o)
        lses.append(l)
    wts = jax.nn.softmax(jnp.stack(lses), axis=0)
    o = jnp.sum(wts[..., None] * jnp.stack(outs), axis=0)
    return o.astype(v.dtype)


def hybrid_mixer(h, w_in, w_o, lam, subln_g, lambda_init):
    b, s, _ = h.shape
    p = split_columns(h @ w_in)
    qa = p[0].reshape(b, s, A_HEADS, HEAD_DIM)
    qi = p[3].reshape(b, s, IDX_HEADS, IDX_DIM)
    oa = dsa_attention(qa, p[1], p[2], qi, p[4], p[5]).reshape(b, s, -1)
    qb = p[6].reshape(b, s, B_HEADS, 2, DIFF_DH)
    kb = p[7].reshape(b, s, B_HEADS, 2, DIFF_DH)
    vb = p[8].reshape(b, s, B_HEADS, HEAD_DIM)
    ob = diff_attention(qb, kb, vb, lam, subln_g, lambda_init).reshape(b, s, -1)
    qc = p[9].reshape(b, s, C_HEADS, HEAD_DIM)
    kc = p[10].reshape(b, s, C_HEADS, HEAD_DIM)
    vc = p[11].reshape(b, s, C_HEADS, HEAD_DIM)
    oc = dilated_attention(qc, kc, vc).reshape(b, s, -1)
    return jnp.concatenate([oa, ob, oc], axis=-1) @ w_o


def setup_inputs(seed: int = 0) -> dict:
    key = jax.random.key(seed)
    ks = jax.random.split(key, 12)
    nrm = jax.random.normal
    x = nrm(ks[0], (BATCH, SEQ, D_MODEL), jnp.float32)
    w_in = nrm(ks[1], (DEPTH, D_MODEL, IN_COLS), jnp.float32) * D_MODEL ** -0.5
    w_o = nrm(ks[2], (DEPTH, MIX_WIDTH, D_MODEL), jnp.float32) * (MIX_WIDTH ** -0.5 * DEEPNORM_BETA)
    lam = 0.1 * nrm(ks[3], (DEPTH, 4, DIFF_DH), jnp.float32)
    subln_g = 1.0 + 0.01 * nrm(ks[4], (DEPTH, HEAD_DIM), jnp.float32)
    ln1_g = 1.0 + 0.01 * nrm(ks[5], (DEPTH, D_MODEL), jnp.float32)
    ln1_b = 0.01 * nrm(ks[6], (DEPTH, D_MODEL), jnp.float32)
    w_gate = nrm(ks[7], (DEPTH, D_MODEL, FF_DIM), jnp.float32) * D_MODEL ** -0.5
    w_up = nrm(ks[8], (DEPTH, D_MODEL, FF_DIM), jnp.float32) * D_MODEL ** -0.5
    w_down = nrm(ks[9], (DEPTH, FF_DIM, D_MODEL), jnp.float32) * (FF_DIM ** -0.5 * DEEPNORM_BETA)
    ln2_g = 1.0 + 0.01 * nrm(ks[10], (DEPTH, D_MODEL), jnp.float32)
    ln2_b = 0.01 * nrm(ks[11], (DEPTH, D_MODEL), jnp.float32)
    return {'x': x, 'w_in': w_in, 'w_o': w_o, 'lam': lam, 'subln_g': subln_g,
            'ln1_g': ln1_g, 'ln1_b': ln1_b, 'w_gate': w_gate, 'w_up': w_up,
            'w_down': w_down, 'ln2_g': ln2_g, 'ln2_b': ln2_b}


def reference(x, w_in, w_o, lam, subln_g, ln1_g, ln1_b, w_gate, w_up, w_down, ln2_g, ln2_b):
    for l in range(DEPTH):
        lambda_init = 0.8 - 0.6 * math.exp(-0.3 * l)
        mix = hybrid_mixer(x, w_in[l], w_o[l], lam[l], subln_g[l], lambda_init)
        x = layer_norm(DEEPNORM_ALPHA * x + mix, ln1_g[l], ln1_b[l])
        f = (jax.nn.silu(x @ w_gate[l]) * (x @ w_up[l])) @ w_down[l]
        x = layer_norm(DEEPNORM_ALPHA * x + f, ln2_g[l], ln2_b[l])
    return x
```

```cpp
#include <hip/hip_runtime.h>
#include <cstdio>
#include <cstdint>
#include <cmath>
#define FL_CLASS 0
#define FLASH2 0
namespace pg8 {
#define PG8_LAS __attribute__((address_space(3)))
typedef unsigned short bf16_t;
typedef short bf16x8 __attribute__((ext_vector_type(8)));
typedef float f32x4 __attribute__((ext_vector_type(4)));
typedef unsigned u32x4 __attribute__((ext_vector_type(4)));
constexpr int BM = 256, BK = 64, HALF = 128, HTB = HALF * BK * 2  , STAGE_BYTES = 8 * HTB, NXCD = 8, WGM = 8;

__host__ __device__ __forceinline__ int lds_byte(int r, int c) { const int st = (r >> 4) * 2 + (c >> 5), rr = r & 15, cc = c & 31, ob = rr * 64 + cc * 2; return st * 1024 + (ob ^ (((ob >> 9) & 1) << 5)); }
__host__ __device__ __forceinline__ void stage_rc(int b, int& R, int& C) { const int st = b / 1024, sb = b % 1024, swz = sb ^ (((sb >> 9) & 1) << 5); R = (st >> 1) * 16 + swz / 64; C = (st & 1) * 32 + (swz % 64) / 2; }
__host__ __device__ __forceinline__ int perm32(int rho) { const int n = rho >> 4, i = rho & 15; return 8 * (i >> 2) + 4 * n + (i & 3); }

struct Unit { int pm, pn; };
struct Gemm { const bf16_t* A; const bf16_t* Bt; int M, N, K; };

struct StaticOrder {
    int nM, nN, nwg, G, c;
    __host__ __device__ void init(int M, int N, int G_, int c_) { nM = M / BM; nN = N / BM; nwg = nM * nN; G = G_; c = c_; }
    __host__ __device__ bool next(int i, Unit& u) const {
        const long L = (long)i * G + c; if (L >= nwg) return false;
        int wgid = (int)L; { const int q = nwg / NXCD, r = nwg % NXCD, xcd = wgid % NXCD, off = wgid / NXCD; wgid = (xcd < r ? xcd * (q + 1) : r * (q + 1) + (xcd - r) * q) + off; }
        const int nig = WGM * nN, gid = wgid / nig, fm = gid * WGM, gsz = (nM - fm) < WGM ? (nM - fm) : WGM;
        u.pm = fm + ((wgid % nig) % gsz); u.pn = (wgid % nig) / gsz; return true;
    }
    __device__ __forceinline__ void a_ready(const Unit&) const {}
    __device__ __forceinline__ void done(const Unit&) const {}
};
__device__ __forceinline__ unsigned cvt_pk_bf16(float lo, float hi) { unsigned r; asm volatile("v_cvt_pk_bf16_f32 %0, %1, %2" : "=v"(r) : "v"(lo), "v"(hi)); return r; }
typedef float f32x2 __attribute__((ext_vector_type(2)));
typedef unsigned u32x2 __attribute__((ext_vector_type(2)));
struct EpiStore {
    static constexpr bool PERM = true, AFTER_DRAIN = false;
    bf16_t* O; int ldc;
    __device__ __forceinline__ void operator()(const f32x4 (&acc)[2][2][4][2], const Unit& u, int wr, int wc, int fr, int fq) const {
        const int row0 = u.pm * BM + wr * 64 + fr, col0 = u.pn * BM + wc * 32 + 8 * fq;
#pragma unroll
        for (int ai = 0; ai < 2; ++ai)
#pragma unroll
            for (int m = 0; m < 4; ++m) { bf16_t* rowp = O + (size_t)(row0 + ai * HALF + m * 16) * ldc + col0;
#pragma unroll
                for (int bj = 0; bj < 2; ++bj) { const f32x4 v0 = acc[ai][bj][m][0], v1 = acc[ai][bj][m][1];
                    u32x4 w; w.x = cvt_pk_bf16(v0[0], v0[1]); w.y = cvt_pk_bf16(v0[2], v0[3]); w.z = cvt_pk_bf16(v1[0], v1[1]); w.w = cvt_pk_bf16(v1[2], v1[3]);
                    *(u32x4*)(rowp + bj * HALF) = w; } }
    }
};
struct EpiSwiglu {
    static constexpr bool PERM = true, AFTER_DRAIN = false;
    bf16_t* O; int ldc;
    __device__ __forceinline__ float act(float g, float u) const { const float e = __builtin_amdgcn_exp2f(g * -1.4426950408889634f); return g * __builtin_amdgcn_rcpf(1.0f + e) * u; }
    __device__ __forceinline__ void operator()(const f32x4 (&acc)[2][2][4][2], const Unit& u, int wr, int wc, int fr, int fq) const {
        const int row0 = u.pm * BM + wr * 64 + fr, col0 = u.pn * HALF + wc * 32 + 8 * fq;
#pragma unroll
        for (int ai = 0; ai < 2; ++ai)
#pragma unroll
            for (int m = 0; m < 4; ++m) { bf16_t* rowp = O + (size_t)(row0 + ai * HALF + m * 16) * ldc + col0;
                const f32x4 g0 = acc[ai][0][m][0], g1 = acc[ai][0][m][1], u0 = acc[ai][1][m][0], u1 = acc[ai][1][m][1];
                u32x4 w; w.x = cvt_pk_bf16(act(g0[0], u0[0]), act(g0[1], u0[1])); w.y = cvt_pk_bf16(act(g0[2], u0[2]), act(g0[3], u0[3]));
                w.z = cvt_pk_bf16(act(g1[0], u1[0]), act(g1[1], u1[1])); w.w = cvt_pk_bf16(act(g1[2], u1[2]), act(g1[3], u1[3]));
                *(u32x4*)rowp = w; }
    }
};
struct EpiRes {
    static constexpr bool PERM = false, AFTER_DRAIN = false;
    const bf16_t* X; float* H; int ldc; float alpha;
    __device__ __forceinline__ void operator()(const f32x4 (&acc)[2][2][4][2], const Unit& u, int wr, int wc, int fr, int fq) const {
        const int row0 = u.pm * BM + wr * 64 + fr, col0 = u.pn * BM + wc * 32 + 4 * fq;
#pragma unroll
        for (int ai = 0; ai < 2; ++ai)
#pragma unroll
            for (int m = 0; m < 4; ++m) { const size_t off = (size_t)(row0 + ai * HALF + m * 16) * ldc + col0;
#pragma unroll
                for (int bj = 0; bj < 2; ++bj)
#pragma unroll
                    for (int n = 0; n < 2; ++n) { const size_t c = off + bj * HALF + n * 16; const u32x2 xb = *(const u32x2*)(X + c);
                        f32x4 x; x[0] = __uint_as_float(xb.x << 16); x[1] = __uint_as_float(xb.x & 0xffff0000u); x[2] = __uint_as_float(xb.y << 16); x[3] = __uint_as_float(xb.y & 0xffff0000u);
                        *(f32x4*)(H + c) = acc[ai][bj][m][n] + x * alpha; } }
    }
};

__device__ __forceinline__ float sum16x(float v) { auto rr = __builtin_amdgcn_permlane16_swap(__float_as_uint(v), __float_as_uint(v), false, false); return __uint_as_float(rr[0]) + __uint_as_float(rr[1]); }
__device__ __forceinline__ float sum32x(float v) { auto rr = __builtin_amdgcn_permlane32_swap(__float_as_uint(v), __float_as_uint(v), false, false); return __uint_as_float(rr[0]) + __uint_as_float(rr[1]); }
__device__ __forceinline__ void row_stats(const float* ssum, const float* ssq, int row, float& mu, float& rs) {
    mu = 0.f; rs = 1.f;
    if (ssum) { const float s = ssum[row], q = ssq[row]; mu = s * (1.f / 1024.f); rs = 1.f / sqrtf(fmaxf(q * (1.f / 1024.f) - mu * mu, 0.f) + 1e-5f); }
}
struct EpiStoreLN {
    static constexpr bool PERM = true, AFTER_DRAIN = false;
    bf16_t* O; int ldc; const float* ssum; const float* ssq; const float* c1; const float* c0;
    __device__ __forceinline__ void operator()(const f32x4 (&acc)[2][2][4][2], const Unit& u, int wr, int wc, int fr, int fq) const {
        const int row0 = u.pm * BM + wr * 64 + fr, col0 = u.pn * BM + wc * 32 + 8 * fq;
        f32x4 c1v[2][2], c0v[2][2]; float z_ = 0.f; asm volatile("" : "+v"(z_));
#pragma unroll
        for (int bj = 0; bj < 2; ++bj)
#pragma unroll
            for (int n = 0; n < 2; ++n) { c1v[bj][n] = ssum ? *(const f32x4*)(c1 + col0 + bj * HALF + 4 * n) : (f32x4){z_, z_, z_, z_}; c0v[bj][n] = ssum ? *(const f32x4*)(c0 + col0 + bj * HALF + 4 * n) : (f32x4){z_, z_, z_, z_}; }
#pragma unroll
        for (int ai = 0; ai < 2; ++ai)
#pragma unroll
            for (int m = 0; m < 4; ++m) { const int row = row0 + ai * HALF + m * 16; float mu, rs; row_stats(ssum, ssq, row, mu, rs);
                bf16_t* rowp = O + (size_t)row * ldc + col0;
#pragma unroll
                for (int bj = 0; bj < 2; ++bj) { const f32x4 v0 = (acc[ai][bj][m][0] - c1v[bj][0] * mu) * rs + c0v[bj][0], v1 = (acc[ai][bj][m][1] - c1v[bj][1] * mu) * rs + c0v[bj][1];
                    u32x4 w; w.x = cvt_pk_bf16(v0[0], v0[1]); w.y = cvt_pk_bf16(v0[2], v0[3]); w.z = cvt_pk_bf16(v1[0], v1[1]); w.w = cvt_pk_bf16(v1[2], v1[3]);
                    *(u32x4*)(rowp + bj * HALF) = w; } }
    }
};
struct EpiSwigluLN {
    static constexpr bool PERM = true, AFTER_DRAIN = false;
    bf16_t* O; int ldc; const float* ssum; const float* ssq; const float* c1; const float* c0;
    __device__ __forceinline__ float act(float g, float u) const { const float e = __builtin_amdgcn_exp2f(g * -1.4426950408889634f); return g * __builtin_amdgcn_rcpf(1.0f + e) * u; }
    __device__ __forceinline__ void operator()(const f32x4 (&acc)[2][2][4][2], const Unit& u, int wr, int wc, int fr, int fq) const {
        const int row0 = u.pm * BM + wr * 64 + fr, col0 = u.pn * HALF + wc * 32 + 8 * fq, wrow0 = u.pn * BM + wc * 32 + 8 * fq;
        f32x4 c1v[2][2], c0v[2][2];
#pragma unroll
        for (int bj = 0; bj < 2; ++bj)
#pragma unroll
            for (int n = 0; n < 2; ++n) { c1v[bj][n] = *(const f32x4*)(c1 + wrow0 + bj * HALF + 4 * n); c0v[bj][n] = *(const f32x4*)(c0 + wrow0 + bj * HALF + 4 * n); }
#pragma unroll
        for (int ai = 0; ai < 2; ++ai)
#pragma unroll
            for (int m = 0; m < 4; ++m) { const int row = row0 + ai * HALF + m * 16; float mu, rs; row_stats(ssum, ssq, row, mu, rs);
                bf16_t* rowp = O + (size_t)row * ldc + col0;
                const f32x4 g0 = (acc[ai][0][m][0] - c1v[0][0] * mu) * rs + c0v[0][0], g1 = (acc[ai][0][m][1] - c1v[0][1] * mu) * rs + c0v[0][1];
                const f32x4 u0 = (acc[ai][1][m][0] - c1v[1][0] * mu) * rs + c0v[1][0], u1 = (acc[ai][1][m][1] - c1v[1][1] * mu) * rs + c0v[1][1];
                u32x4 w; w.x = cvt_pk_bf16(act(g0[0], u0[0]), act(g0[1], u0[1])); w.y = cvt_pk_bf16(act(g0[2], u0[2]), act(g0[3], u0[3]));
                w.z = cvt_pk_bf16(act(g1[0], u1[0]), act(g1[1], u1[1])); w.w = cvt_pk_bf16(act(g1[2], u1[2]), act(g1[3], u1[3]));
                *(u32x4*)rowp = w; }
    }
};
struct EpiResStat {
    static constexpr bool PERM = false, AFTER_DRAIN = false;
    const bf16_t* R; const float* rsum; const float* rsq; const float* g; const float* b; bf16_t* Hb; float* Hf; float* osum; float* osq; int ldc; float alpha;
    __device__ __forceinline__ void operator()(const f32x4 (&acc)[2][2][4][2], const Unit& u, int wr, int wc, int fr, int fq) const {
        const int row0 = u.pm * BM + wr * 64 + fr, col0 = u.pn * BM + wc * 32 + 4 * fq;
        f32x4 gv[2][2], bv[2][2];
#pragma unroll
        for (int bj = 0; bj < 2; ++bj)
#pragma unroll
            for (int n = 0; n < 2; ++n) { float z_ = 0.f, o_ = 1.f; asm volatile("" : "+v"(z_), "+v"(o_)); gv[bj][n] = rsum ? *(const f32x4*)(g + col0 + bj * HALF + n * 16) : (f32x4){o_, o_, o_, o_}; bv[bj][n] = rsum ? *(const f32x4*)(b + col0 + bj * HALF + n * 16) : (f32x4){z_, z_, z_, z_}; }
        float ss[2][4], qq[2][4];
#pragma unroll
        for (int ai = 0; ai < 2; ++ai)
#pragma unroll
            for (int m = 0; m < 4; ++m) { const int row = row0 + ai * HALF + m * 16; float mu, rs; row_stats(rsum, rsq, row, mu, rs);
                const size_t off = (size_t)row * ldc + col0; float s = 0.f, q = 0.f;
#pragma unroll
                for (int bj = 0; bj < 2; ++bj)
#pragma unroll
                    for (int n = 0; n < 2; ++n) { const size_t c = off + bj * HALF + n * 16; const u32x2 xb = *(const u32x2*)(R + c);
                        f32x4 x; x[0] = __uint_as_float(xb.x << 16); x[1] = __uint_as_float(xb.x & 0xffff0000u); x[2] = __uint_as_float(xb.y << 16); x[3] = __uint_as_float(xb.y & 0xffff0000u);
                        x = (x - mu) * rs * gv[bj][n] + bv[bj][n];
                        const f32x4 v = acc[ai][bj][m][n] + x * alpha;
                        if (Hf) *(f32x4*)(Hf + c) = v;
                        else { u32x2 w; w.x = cvt_pk_bf16(v[0], v[1]); w.y = cvt_pk_bf16(v[2], v[3]); *(u32x2*)(Hb + c) = w; s += (v[0] + v[1]) + (v[2] + v[3]); q += (v[0] * v[0] + v[1] * v[1]) + (v[2] * v[2] + v[3] * v[3]); } }
                ss[ai][m] = sum32x(sum16x(s)); qq[ai][m] = sum32x(sum16x(q)); }
        if (!Hf && osum) {
#pragma unroll
            for (int ai = 0; ai < 2; ++ai) { const float sv = fq == 0 ? ss[ai][0] : (fq == 1 ? ss[ai][1] : (fq == 2 ? ss[ai][2] : ss[ai][3])), qv = fq == 0 ? qq[ai][0] : (fq == 1 ? qq[ai][1] : (fq == 2 ? qq[ai][2] : qq[ai][3]));
                const int row = row0 + ai * HALF + fq * 16;
                __hip_atomic_fetch_add(osum + row, sv, __ATOMIC_RELAXED, __HIP_MEMORY_SCOPE_AGENT); __hip_atomic_fetch_add(osq + row, qv, __ATOMIC_RELAXED, __HIP_MEMORY_SCOPE_AGENT); } }
    }
};
template <class Epi, class Sched, bool ALIGN_EPI = false, bool SP2 = false>
__device__ __forceinline__ void gemm_phase(PG8_LAS unsigned char* lds, const Gemm g, const Sched& S, const Epi& E, int wave_in) {
    int lane_; asm volatile("v_mbcnt_lo_u32_b32 %0, -1, 0\n\tv_mbcnt_hi_u32_b32 %0, -1, %0" : "=v"(lane_)); const int tid_ = wave_in * 64 + lane_;
    const int tid = tid_, wid = __builtin_amdgcn_readfirstlane(tid >> 6), lane = tid & 63, wr = wid >> 2, wc = wid & 3, fr = lane & 15, fq = lane >> 4;
    const int K = g.K, nt = K / BK;
    unsigned voffA[2], voffB[2];
#pragma unroll
    for (int i = 0; i < 2; ++i) { int R, C; stage_rc(tid * 16 + i * 8192, R, C); const int Rb = Epi::PERM ? ((R & ~31) + perm32(R & 31)) : R;
        voffA[i] = (unsigned)(R * K + C) * 2u; voffB[i] = (unsigned)(Rb * K + C) * 2u; }
    const size_t kstep = (size_t)(BK * 2);
    const size_t hstep = (size_t)HALF * K * 2;
    const size_t tstep = 2 * hstep;
    const unsigned ldsw = (unsigned)wid * 1024u;
    const int aoff = lds_byte(wr * 64 + fr, fq * 8), boff = lds_byte(wc * 32 + fr, fq * 8);
#define PG8_SA(b, h) (((b) * 2 + (h)) * HTB)
#define PG8_SB(b, h) ((4 + (b) * 2 + (h)) * HTB)
#define PG8_STAGE(bufoff, gbase, voff) do { _Pragma("unroll") for (int _i = 0; _i < 2; ++_i) \
        __builtin_amdgcn_global_load_lds((const unsigned*)((const char*)(gbase) + (voff)[_i]), (PG8_LAS unsigned*)(lds + (bufoff) + ldsw + _i * 8192), 16, 0, 0); } while (0)
#define PG8_LDA(dst, b, h) do { _Pragma("unroll") for (int m = 0; m < 4; ++m) _Pragma("unroll") for (int k = 0; k < 2; ++k) dst[m][k] = *(const PG8_LAS bf16x8*)(lds + PG8_SA(b, h) + aoff + m * 2048 + k * 1024); } while (0)
#define PG8_LDB(dst, b, h) do { _Pragma("unroll") for (int n = 0; n < 2; ++n) _Pragma("unroll") for (int k = 0; k < 2; ++k) dst[n][k] = *(const PG8_LAS bf16x8*)(lds + PG8_SB(b, h) + boff + n * 2048 + k * 1024); } while (0)
#define PG8_MMA(ai, bj, At, Bt) do { __builtin_amdgcn_s_setprio(1); _Pragma("unroll") for (int m = 0; m < 4; ++m) _Pragma("unroll") for (int n = 0; n < 2; ++n) _Pragma("unroll") for (int k = 0; k < 2; ++k) \
        acc[ai][bj][m][n] = __builtin_amdgcn_mfma_f32_16x16x32_bf16(Bt[n][k], At[m][k], acc[ai][bj][m][n], 0, 0, 0); __builtin_amdgcn_s_setprio(0); } while (0)
#define PG8_WAIT_V(n) asm volatile("s_waitcnt vmcnt(" #n ")" ::: "memory")
#define PG8_WAIT_L(n) asm volatile("s_waitcnt lgkmcnt(" #n ")" ::: "memory")
#define PG8_BAR __builtin_amdgcn_s_barrier()
#define PG8_SCHED __builtin_amdgcn_sched_barrier(0)
    Unit cur, nxt; int ui = 0;
    if (!S.next(0, cur)) return;
    f32x4 acc[2][2][4][2];
#pragma unroll
    for (int a = 0; a < 2; ++a)
#pragma unroll
        for (int b = 0; b < 2; ++b)
#pragma unroll
            for (int m = 0; m < 4; ++m)
#pragma unroll
                for (int n = 0; n < 2; ++n) acc[a][b][m][n] = (f32x4){0.f, 0.f, 0.f, 0.f};
    bf16x8 At[4][2], B0[2][2], B1[2][2];
    const char* cA = (const char*)g.A + (size_t)cur.pm * tstep; const char* cB = (const char*)g.Bt + (size_t)cur.pn * tstep;
    S.a_ready(cur);
    if constexpr (SP2) {
        PG8_STAGE(PG8_SB(0, 0), cB, voffB); PG8_STAGE(PG8_SB(0, 1), cB + hstep, voffB); PG8_STAGE(PG8_SA(0, 0), cA, voffA); PG8_STAGE(PG8_SA(0, 1), cA + hstep, voffA);
        if (wr == 1) PG8_BAR;
        PG8_WAIT_V(2); PG8_BAR;
        PG8_STAGE(PG8_SB(1, 0), cB + kstep, voffB); PG8_STAGE(PG8_SA(1, 0), cA + kstep, voffA); PG8_STAGE(PG8_SB(1, 1), cB + hstep + kstep, voffB);
        PG8_WAIT_V(6); PG8_BAR;
    } else {
        PG8_STAGE(PG8_SB(0, 0), cB, voffB); PG8_STAGE(PG8_SA(0, 0), cA, voffA); PG8_STAGE(PG8_SB(0, 1), cB + hstep, voffB); PG8_STAGE(PG8_SA(0, 1), cA + hstep, voffA);
        if (wr == 1) PG8_BAR;
        PG8_WAIT_V(4); PG8_BAR;
        PG8_STAGE(PG8_SB(1, 0), cB + kstep, voffB); PG8_STAGE(PG8_SA(1, 0), cA + kstep, voffA); PG8_STAGE(PG8_SB(1, 1), cB + hstep + kstep, voffB);
        PG8_WAIT_V(6); PG8_BAR;
    }
    for (;;) {
        const bool has_next = S.next(ui + 1, nxt);
        const char* nA = has_next ? (const char*)g.A + (size_t)nxt.pm * tstep : cA; const char* nB = has_next ? (const char*)g.Bt + (size_t)nxt.pn * tstep : cB;
        for (int t = 0; t < nt; t += 2) {
            const bool last = (t == nt - 2);
            const char* a1 = cA + (size_t)(t + 1) * kstep;
            const char* a2 = last ? nA : cA + (size_t)(t + 2) * kstep; const char* b2 = last ? nB : cB + (size_t)(t + 2) * kstep;
            const char* a3 = a2 + kstep; const char* b3 = b2 + kstep;
            if (last && has_next) S.a_ready(nxt);
            if constexpr (SP2) {
            PG8_LDB(B0, 0, 0); PG8_LDB(B1, 0, 1); PG8_SCHED; PG8_LDA(At, 0, 0); PG8_STAGE(PG8_SA(1, 1), a1 + hstep, voffA);
            PG8_WAIT_V(8); PG8_WAIT_L(0); PG8_BAR; PG8_MMA(0, 0, At, B0); PG8_MMA(0, 1, At, B1); PG8_BAR; PG8_SCHED;
            PG8_LDA(At, 0, 1); PG8_STAGE(PG8_SB(0, 0), b2, voffB); PG8_STAGE(PG8_SB(0, 1), b2 + hstep, voffB); PG8_STAGE(PG8_SA(0, 0), a2, voffA);
            PG8_WAIT_V(8); PG8_WAIT_L(0); PG8_BAR; PG8_MMA(1, 0, At, B0); PG8_MMA(1, 1, At, B1); PG8_BAR; PG8_SCHED;
            PG8_LDB(B0, 1, 0); PG8_LDB(B1, 1, 1); PG8_SCHED; PG8_LDA(At, 1, 0); PG8_STAGE(PG8_SA(0, 1), a2 + hstep, voffA);
            PG8_WAIT_V(8); PG8_WAIT_L(0); PG8_BAR; PG8_MMA(0, 0, At, B0); PG8_MMA(0, 1, At, B1); PG8_BAR; PG8_SCHED;
            PG8_LDA(At, 1, 1); PG8_STAGE(PG8_SB(1, 0), b3, voffB); PG8_STAGE(PG8_SB(1, 1), b3 + hstep, voffB); PG8_STAGE(PG8_SA(1, 0), a3, voffA);
            PG8_WAIT_V(8); PG8_WAIT_L(0); PG8_BAR; PG8_MMA(1, 0, At, B0); PG8_MMA(1, 1, At, B1); PG8_BAR; PG8_SCHED;
            } else {
            PG8_LDB(B0, 0, 0); PG8_SCHED; PG8_LDA(At, 0, 0); PG8_STAGE(PG8_SA(1, 1), a1 + hstep, voffA);
            PG8_WAIT_L(8); PG8_BAR; PG8_WAIT_L(0); PG8_MMA(0, 0, At, B0); PG8_BAR; PG8_SCHED;
            PG8_LDB(B1, 0, 1); PG8_STAGE(PG8_SB(0, 0), b2, voffB);
            PG8_BAR; PG8_WAIT_L(0); PG8_MMA(0, 1, At, B1); PG8_BAR;
            PG8_LDA(At, 0, 1); PG8_STAGE(PG8_SA(0, 0), a2, voffA);
            PG8_BAR; PG8_WAIT_L(0); PG8_MMA(1, 0, At, B0); PG8_BAR; PG8_SCHED;
            PG8_STAGE(PG8_SB(0, 1), b2 + hstep, voffB);
            PG8_WAIT_V(6); PG8_BAR; PG8_MMA(1, 1, At, B1); PG8_BAR;
            PG8_LDB(B0, 1, 0); PG8_SCHED; PG8_LDA(At, 1, 0); PG8_STAGE(PG8_SA(0, 1), a2 + hstep, voffA);
            PG8_WAIT_L(8); PG8_BAR; PG8_WAIT_L(0); PG8_MMA(0, 0, At, B0); PG8_BAR; PG8_SCHED;
            PG8_LDB(B1, 1, 1); PG8_STAGE(PG8_SB(1, 0), b3, voffB);
            PG8_BAR; PG8_WAIT_L(0); PG8_MMA(0, 1, At, B1); PG8_BAR;
            PG8_LDA(At, 1, 1); PG8_STAGE(PG8_SA(1, 0), a3, voffA);
            PG8_BAR; PG8_WAIT_L(0); PG8_MMA(1, 0, At, B0); PG8_BAR; PG8_SCHED;
            PG8_STAGE(PG8_SB(1, 1), b3 + hstep, voffB);
            PG8_WAIT_V(6); PG8_BAR; PG8_MMA(1, 1, At, B1); PG8_BAR;
            }
        }
        if constexpr (ALIGN_EPI) { if (wr == 0) PG8_BAR; }
        if constexpr (!Epi::AFTER_DRAIN) { E(acc, cur, wr, wc, fr, fq); S.done(cur); }
        if (!has_next) break;
#pragma unroll
        for (int a = 0; a < 2; ++a)
#pragma unroll
            for (int b = 0; b < 2; ++b)
#pragma unroll
                for (int m = 0; m < 4; ++m)
#pragma unroll
                    for (int n = 0; n < 2; ++n) acc[a][b][m][n] = (f32x4){0.f, 0.f, 0.f, 0.f};
        cur = nxt; cA = nA; cB = nB; ++ui;
        if constexpr (ALIGN_EPI) { if (wr == 1) PG8_BAR; }
    }
    PG8_WAIT_V(0);
    if constexpr (!ALIGN_EPI) { if (wr == 0) PG8_BAR; }
    PG8_BAR;
    if constexpr (Epi::AFTER_DRAIN) { E.fused(acc, cur, wr, wc, fr, fq, lds, wid, lane); S.done(cur); }
#undef PG8_SA
#undef PG8_SB
#undef PG8_STAGE
#undef PG8_LDA
#undef PG8_LDB
#undef PG8_MMA
#undef PG8_WAIT_V
#undef PG8_WAIT_L
#undef PG8_BAR
#undef PG8_SCHED
}
}
constexpr int NWAVES = 8;
constexpr int BATCH = 32, SEQ = 2048, DM = 1024, M = BATCH * SEQ, ZC = 3072, FF = 2816, GU = 2 * FF, DEPTH = 2, INC = 3012;
constexpr float LN_EPS = 1e-5f, LOG2E = 1.4426950408889634f, ALPHA = 1.4142135623730951f;
constexpr int ZC_QA = 0, ZC_KA = 256, ZC_VA = 320, ZC_QI = 384, ZC_KI = 640, ZC_WI = 704, ZC_QB = 768, ZC_KB = 1024, ZC_VB = 1280, ZC_QC = 1536, ZC_KC = 2048, ZC_VC = 2560;
constexpr size_t MiB = 1u << 20;
constexpr size_t WS_CTL = 0, CTL_ZERO_BYTES = 4 * MiB;
constexpr size_t WS_STAT = 1 * MiB;
constexpr size_t WS_CV = 3 * MiB;
constexpr size_t CV_LAYER = 2 * (3072 + 5632);
constexpr size_t WS_W = 4 * MiB;
constexpr size_t W_IN_B = (size_t)ZC * DM * 2, W_O_B = (size_t)DM * DM * 2, W_GU_B = (size_t)GU * DM * 2, W_D_B = (size_t)DM * FF * 2;
constexpr size_t W_LAYER_B = W_IN_B + W_O_B + W_GU_B + W_D_B;
constexpr size_t WS_R0 = 64 * MiB, WS_R1 = 192 * MiB, WS_R2 = 320 * MiB, WS_BIG = 448 * MiB, WS_END = 832 * MiB;
static_assert(WS_W + DEPTH * W_LAYER_B <= WS_R0, "weights fit below R0");
static_assert((size_t)M * ZC * 2 <= WS_END - WS_BIG && (size_t)M * DM * 4 <= WS_END - WS_BIG && (size_t)M * DM * 2 <= WS_R1 - WS_R0, "activation map");
constexpr int CW_TMO = 0, CW_BAR = 4096;
constexpr int RING_OFF = 0, RING_BYTES = 131072;
constexpr int LDSCTL_OFF = RING_BYTES, MISC_OFF = LDSCTL_OFF + 320;
constexpr int LDS_BYTES = 147456;

typedef unsigned short bf16;
typedef unsigned v4u __attribute__((ext_vector_type(4)));
typedef unsigned v2u __attribute__((ext_vector_type(2)));
typedef float f32x4 __attribute__((ext_vector_type(4)));
#define LDS_WAIT() asm volatile("s_waitcnt lgkmcnt(0)" ::: "memory")
__device__ __forceinline__ unsigned f2bf(float f) { unsigned u = __builtin_bit_cast(unsigned, f); return (u + 0x7fffu + ((u >> 16) & 1u)) >> 16; }
__device__ __forceinline__ unsigned pk2(float lo, float hi) { return f2bf(lo) | (f2bf(hi) << 16); }
__device__ __forceinline__ float bflo(unsigned w) { return __uint_as_float(w << 16); }
__device__ __forceinline__ float bfhi(unsigned w) { return __uint_as_float(w & 0xffff0000u); }
__device__ __forceinline__ float bf1(bf16 b) { return __uint_as_float((unsigned)b << 16); }
__device__ __forceinline__ void unpack8(const v4u w, float (&f)[8]) { f[0] = bflo(w.x); f[1] = bfhi(w.x); f[2] = bflo(w.y); f[3] = bfhi(w.y); f[4] = bflo(w.z); f[5] = bfhi(w.z); f[6] = bflo(w.w); f[7] = bfhi(w.w); }
__device__ __forceinline__ float wave_sum(float v, int lane) {
#pragma unroll
    for (int o = 1; o < 64; o <<= 1) v += __int_as_float(__builtin_amdgcn_ds_bpermute((lane ^ o) << 2, __float_as_int(v)));
    return v;
}
__device__ __forceinline__ int mbcnt64(unsigned long long m) { return (int)__builtin_amdgcn_mbcnt_hi((unsigned)(m >> 32), __builtin_amdgcn_mbcnt_lo((unsigned)m, 0u)); }
#define GAS __attribute__((address_space(1)))
#define LAS __attribute__((address_space(3)))
typedef GAS unsigned gu32;
#define RLX_AGENT __ATOMIC_RELAXED, __HIP_MEMORY_SCOPE_AGENT
#define VM_WAIT() asm volatile("s_waitcnt vmcnt(0)" ::: "memory")
__device__ __forceinline__ int lane_now() { int l; asm volatile("v_mbcnt_lo_u32_b32 %0, -1, 0\n\tv_mbcnt_hi_u32_b32 %0, -1, %0" : "=v"(l)); return l; }
#define XB_TMO      128
#define XB_XCNT(j)  (256  + 64 * (j))
#define XB_XSUB(j)  (1280 + 64 * (j))
#define XB_XGEN(j)  (2304 + 64 * (j))
#define XB_TOP      3328
#define XB_TOPGEN   3392
#define XCD_BAR_WORDS 3456
#define XB_SPIN_CAP (1u << 24)

__device__ __forceinline__ unsigned xb_ld(unsigned* p)              { return __hip_atomic_load(p, __ATOMIC_RELAXED, __HIP_MEMORY_SCOPE_AGENT); }
__device__ __forceinline__ unsigned xb_add(unsigned* p, unsigned v) { return __hip_atomic_fetch_add(p, v, __ATOMIC_RELAXED, __HIP_MEMORY_SCOPE_AGENT); }
__device__ __forceinline__ unsigned xb_xcc_id() { return (unsigned)__builtin_amdgcn_s_getreg((3 << 11) | 20) & 0xFu; }
#define XB_SPIN(cond, bar) do { unsigned _sp = 0; while (cond) { __builtin_amdgcn_s_sleep(1); \
    if ((++_sp & 255u) == 0u) { if (xb_ld(&(bar)[XB_TMO])) break; if (_sp > XB_SPIN_CAP) { atomicAdd(&(bar)[XB_TMO], 1u); break; } } } } while (0)

struct XcdBarrier {
    unsigned* bar; unsigned x;
    volatile LAS unsigned* st;
};

__device__ __forceinline__ XcdBarrier xcd_barrier_post(unsigned* bar, volatile LAS unsigned* st) {
    XcdBarrier b; b.bar = bar; b.x = (unsigned)__builtin_amdgcn_readfirstlane((int)xb_xcc_id()); b.st = st;
    if (threadIdx.x == 0) (void)xb_add(&bar[XB_XCNT(b.x)], 1u);
    return b;
}
__device__ __forceinline__ void xcd_barrier_complete(unsigned* bar, unsigned x, unsigned& nloc, unsigned& nx) {
    const unsigned G = gridDim.x * gridDim.y * gridDim.z;
    unsigned sum, cnt, mine, sp = 0u;
    for (;;) {
        sum = 0u; cnt = 0u; mine = 0u;
#pragma unroll
        for (unsigned j = 0; j < 16; ++j) { const unsigned c = xb_ld(&bar[XB_XCNT(j)]); sum += c; cnt += (c > 0u) ? 1u : 0u; mine = (j == x) ? c : mine; }
        if (sum == G) break;
        __builtin_amdgcn_s_sleep(1);
        if ((++sp & 255u) == 0u) { if (xb_ld(&bar[XB_TMO])) break; if (sp > XB_SPIN_CAP) { atomicAdd(&bar[XB_TMO], 1u); break; } }
    }
    nloc = mine > 0u ? mine : 1u; nx = cnt > 0u ? cnt : 1u;
}

__device__ __forceinline__ void xcd_barrier(const XcdBarrier& b) {
    asm volatile("s_waitcnt vmcnt(0)" ::: "memory");
    __syncthreads();
    if (threadIdx.x == 0) {
        unsigned* bar = b.bar; asm volatile("" : "+s"(bar));
        const unsigned bx_ = (unsigned)__builtin_amdgcn_readfirstlane((int)xb_xcc_id());
        __builtin_amdgcn_s_waitcnt(0);
        unsigned nloc = b.st[0], nx = b.st[1];
        if (nloc == 0u) { xcd_barrier_complete(bar, bx_, nloc, nx); b.st[0] = nloc; b.st[1] = nx; }
        const unsigned old = xb_add(&bar[XB_XSUB(bx_)], 1u);
        const unsigned gen = old / nloc;
        if (old + 1u == (gen + 1u) * nloc) {
            __builtin_amdgcn_fence(__ATOMIC_RELEASE, "agent");
            asm volatile("s_waitcnt vmcnt(0)" ::: "memory");
            const unsigned og = xb_add(&bar[XB_TOP], 1u);
            const unsigned tg = og / nx;
            if (og + 1u == (tg + 1u) * nx) xb_add(&bar[XB_TOPGEN], 1u);
            else XB_SPIN(xb_ld(&bar[XB_TOPGEN]) == tg, bar);
            __builtin_amdgcn_fence(__ATOMIC_ACQUIRE, "agent");
            xb_add(&bar[XB_XGEN(bx_)], 1u);
            asm volatile("s_waitcnt vmcnt(0)" ::: "memory");
        } else {
            XB_SPIN(xb_ld(&bar[XB_XGEN(bx_)]) == gen, bar);
            __builtin_amdgcn_fence(__ATOMIC_ACQUIRE, "agent");
            asm volatile("s_waitcnt vmcnt(0)" ::: "memory");
        }
    }
    __syncthreads();
}
template <int TYPE> __device__ __forceinline__ void transpose_item(const float* W0, const float* W1, const float* gk, const float* bk, float* c1o, float* c0o, int K, int Nsrc, int Ndst, bf16* WT, LAS float* scr, int item, int lane) {
    const int nblk = Ndst / 32, kb = item / nblk, nb = item % nblk, k0 = 64 * kb, n0 = 32 * nb;
    const int nd = n0 + (lane & 31);
    const float* src = W0; int c = nd; float sc = 1.f; bool pad = false;
    if (TYPE == 0) {
        if (nd < 708) c = nd; else if (nd < 768) { pad = true; c = 0; } else c = nd - 60;
        if (nd < 256) sc = 0.125f * LOG2E; else if (nd >= ZC_QB && nd < ZC_KB) sc = 0.17677669529663687f * LOG2E; else if (nd >= ZC_QC && nd < ZC_KC) sc = 0.125f * LOG2E;
    } else if (TYPE == 2) {
        const int tile = nd >> 8, w = nd & 255;
        if (w < 128) { src = W0; c = tile * 128 + w; } else { src = W1; c = tile * 128 + (w - 128); }
    }
    float s1 = 0.f, s0 = 0.f;
#pragma unroll
    for (int i = 0; i < 32; ++i) { const int kk = 2 * i + (lane >> 5); float v = pad ? 0.f : src[(size_t)(k0 + kk) * Nsrc + c] * sc;
        if (gk) { s0 += bk[k0 + kk] * v; v *= gk[k0 + kk]; s1 += __uint_as_float(f2bf(v) << 16); }
        scr[kk * 33 + (lane & 31)] = v; }
    if (gk) { s1 += __int_as_float(__builtin_amdgcn_ds_bpermute((lane ^ 32) << 2, __float_as_int(s1))); s0 += __int_as_float(__builtin_amdgcn_ds_bpermute((lane ^ 32) << 2, __float_as_int(s0)));
        if (lane < 32 && c1o) { __hip_atomic_fetch_add(c1o + nd, s1, __ATOMIC_RELAXED, __HIP_MEMORY_SCOPE_AGENT); __hip_atomic_fetch_add(c0o + nd, s0, __ATOMIC_RELAXED, __HIP_MEMORY_SCOPE_AGENT); } }
    LDS_WAIT();
    const int c8 = lane & 7;
#pragma unroll
    for (int j = 0; j < 4; ++j) { const int n = (lane >> 3) + 8 * j; const LAS float* s = scr + (8 * c8) * 33 + n;
        v4u o; o.x = pk2(s[0 * 33], s[1 * 33]); o.y = pk2(s[2 * 33], s[3 * 33]); o.z = pk2(s[4 * 33], s[5 * 33]); o.w = pk2(s[6 * 33], s[7 * 33]);
        *(v4u*)(WT + (size_t)(n0 + n) * K + k0 + 8 * c8) = o; }
    LDS_WAIT();
}

template <bool OUT_F32> __device__ __forceinline__ void ln_phase(const float* H, const float* g, const float* b, bf16* ob, float* of, int gw, int NGW, int lane) {
    asm volatile("" : "+v"(lane));
    f32x4 gv[4], bv[4];
#pragma unroll
    for (int j = 0; j < 4; ++j) { gv[j] = ((const f32x4*)g)[lane + 64 * j]; bv[j] = ((const f32x4*)b)[lane + 64 * j]; }
    for (int m = gw; m < M; m += NGW) {
        const f32x4* xr = (const f32x4*)(H + (size_t)m * DM) + lane;
        f32x4 v[4]; float s = 0.f;
#pragma unroll
        for (int j = 0; j < 4; ++j) { v[j] = xr[64 * j]; s += (v[j].x + v[j].y) + (v[j].z + v[j].w); }
        const float mean = wave_sum(s, lane) * (1.f / DM); float s2 = 0.f;
#pragma unroll
        for (int j = 0; j < 4; ++j) { v[j] = v[j] - mean; s2 += (v[j].x * v[j].x + v[j].y * v[j].y) + (v[j].z * v[j].z + v[j].w * v[j].w); }
        const float rstd = 1.f / sqrtf(wave_sum(s2, lane) * (1.f / DM) + LN_EPS);
#pragma unroll
        for (int j = 0; j < 4; ++j) { const f32x4 y = v[j] * rstd * gv[j] + bv[j];
            if (OUT_F32) ((f32x4*)(of + (size_t)m * DM))[lane + 64 * j] = y;
            else { v2u o; o.x = pk2(y.x, y.y); o.y = pk2(y.z, y.w); ((v2u*)(ob + (size_t)m * DM))[lane + 64 * j] = o; } }
    }
}

typedef short bf16x8v __attribute__((ext_vector_type(8)));
typedef float f32x16 __attribute__((ext_vector_type(16)));
typedef short s16x4 __attribute__((ext_vector_type(4)));
typedef short v4i16_t __attribute__((ext_vector_type(4)));
typedef float f32x2_t __attribute__((ext_vector_type(2)));
typedef __bf16 bf16x2_t __attribute__((ext_vector_type(2)));
__device__ __forceinline__ unsigned cvtpk(float lo, float hi) { f32x2_t v = {lo, hi}; bf16x2_t b = __builtin_convertvector(v, bf16x2_t); return __builtin_bit_cast(unsigned, b); }
__device__ __forceinline__ s16x4 lds_tr(LAS const unsigned char* p) { return __builtin_bit_cast(s16x4, __builtin_amdgcn_ds_read_tr16_b64_v4i16((LAS v4i16_t*)p)); }
__device__ __forceinline__ float swap_max(float v) { auto rr = __builtin_amdgcn_permlane32_swap(__float_as_uint(v), __float_as_uint(v), false, false); return fmaxf(__uint_as_float(rr[0]), __uint_as_float(rr[1])); }
__device__ __forceinline__ float swap_sum(float v) { auto rr = __builtin_amdgcn_permlane32_swap(__float_as_uint(v), __float_as_uint(v), false, false); return __uint_as_float(rr[0]) + __uint_as_float(rr[1]); }
#ifndef FL_MFMA_SUM
#define FL_MFMA_SUM 1
#endif
#ifndef FL_CLASS
#define FL_CLASS 1
#endif
constexpr float FL_THR = 4.0f;
constexpr int FL_K = 0, FL_V = 16384, FL_TAB = 32768, FL_TABN = 2112;

__device__ __forceinline__ void fl_softmax(f32x16& p, float& m, float& l, f32x16 (&o)[2], bf16x8v (&pa)[2]) {
    const bool first = m < -1e29f;
    const float mref = first ? 0.f : m;
#pragma unroll
    for (int r = 0; r < 16; ++r) p[r] -= mref;
    float rm = fmaxf(fmaxf(p[0], p[1]), fmaxf(p[2], p[3]));
#pragma unroll
    for (int r = 4; r < 16; r += 4) rm = fmaxf(rm, fmaxf(fmaxf(p[r], p[r + 1]), fmaxf(p[r + 2], p[r + 3])));
    rm = swap_max(rm);
    const float dl = first ? ((rm > -1e29f) ? rm : 0.f) : ((rm > FL_THR) ? rm : 0.f);
    if (__any(dl != 0.f)) { const float al = first ? 1.f : __builtin_amdgcn_exp2f(-dl); l *= al;     o[0] *= al; o[1] *= al;
#pragma unroll
        for (int r = 0; r < 16; ++r) p[r] -= dl; }
    m = first ? ((rm > -1e29f) ? rm : m) : m + dl;
    float ls = 0.f;
#pragma unroll
    for (int r = 0; r < 16; ++r) { p[r] = __builtin_amdgcn_exp2f(p[r]); ls += p[r]; }
    l += ls;
    typedef unsigned u4 __attribute__((ext_vector_type(4)));
    u4 w0, w1; w0.x = cvtpk(p[0], p[1]); w0.y = cvtpk(p[2], p[3]); w0.z = cvtpk(p[4], p[5]); w0.w = cvtpk(p[6], p[7]);
    w1.x = cvtpk(p[8], p[9]); w1.y = cvtpk(p[10], p[11]); w1.z = cvtpk(p[12], p[13]); w1.w = cvtpk(p[14], p[15]);
    pa[0] = __builtin_bit_cast(bf16x8v, w0); pa[1] = __builtin_bit_cast(bf16x8v, w1);
}

__device__ __forceinline__ void fl_softmax2(f32x16& pa_, f32x16& pb_, float& m, float& l, f32x16 (&o)[2], bf16x8v (&pf)[4]) {
    const bool first = m < -1e29f;
    const float mref = first ? 0.f : m;
#pragma unroll
    for (int r = 0; r < 16; ++r) { pa_[r] -= mref; pb_[r] -= mref; }
    float rm = fmaxf(fmaxf(pa_[0], pa_[1]), fmaxf(pb_[0], pb_[1]));
#pragma unroll
    for (int r = 2; r < 16; r += 2) rm = fmaxf(rm, fmaxf(fmaxf(pa_[r], pa_[r + 1]), fmaxf(pb_[r], pb_[r + 1])));
    rm = swap_max(rm);
    const float dl = first ? ((rm > -1e29f) ? rm : 0.f) : ((rm > FL_THR) ? rm : 0.f);
    if (__any(dl != 0.f)) { const float al = first ? 1.f : __builtin_amdgcn_exp2f(-dl); l *= al; o[0] *= al; o[1] *= al;
#pragma unroll
        for (int r = 0; r < 16; ++r) { pa_[r] -= dl; pb_[r] -= dl; } }
    m = first ? ((rm > -1e29f) ? rm : m) : m + dl;
    float ls0 = 0.f, ls1 = 0.f;
#pragma unroll
    for (int r = 0; r < 16; ++r) { pa_[r] = __builtin_amdgcn_exp2f(pa_[r]); ls0 += pa_[r]; pb_[r] = __builtin_amdgcn_exp2f(pb_[r]); ls1 += pb_[r]; }
    l += ls0 + ls1;
    typedef unsigned u4 __attribute__((ext_vector_type(4)));
    u4 w;
    w.x = cvtpk(pa_[0], pa_[1]); w.y = cvtpk(pa_[2], pa_[3]); w.z = cvtpk(pa_[4], pa_[5]); w.w = cvtpk(pa_[6], pa_[7]); pf[0] = __builtin_bit_cast(bf16x8v, w);
    w.x = cvtpk(pa_[8], pa_[9]); w.y = cvtpk(pa_[10], pa_[11]); w.z = cvtpk(pa_[12], pa_[13]); w.w = cvtpk(pa_[14], pa_[15]); pf[1] = __builtin_bit_cast(bf16x8v, w);
    w.x = cvtpk(pb_[0], pb_[1]); w.y = cvtpk(pb_[2], pb_[3]); w.z = cvtpk(pb_[4], pb_[5]); w.w = cvtpk(pb_[6], pb_[7]); pf[2] = __builtin_bit_cast(bf16x8v, w);
    w.x = cvtpk(pb_[8], pb_[9]); w.y = cvtpk(pb_[10], pb_[11]); w.z = cvtpk(pb_[12], pb_[13]); w.w = cvtpk(pb_[14], pb_[15]); pf[3] = __builtin_bit_cast(bf16x8v, w);
}

__device__ __forceinline__ void fl_softmax3(f32x16& pa_, f32x16& pb_, float sha, float shb, float& m, float& l, f32x16 (&o)[2], bf16x8v (&pf)[4]) {
    const bool first = m < -1e29f;
    const float mref = first ? 0.f : m, ca = sha - mref, cb = shb - mref;
#pragma unroll
    for (int r = 0; r < 16; ++r) { pa_[r] += ca; pb_[r] += cb; }
    float rm = fmaxf(fmaxf(pa_[0], pa_[1]), fmaxf(pb_[0], pb_[1]));
#pragma unroll
    for (int r = 2; r < 16; r += 2) rm = fmaxf(rm, fmaxf(fmaxf(pa_[r], pa_[r + 1]), fmaxf(pb_[r], pb_[r + 1])));
    rm = swap_max(rm);
    const float dl = first ? ((rm > -1e29f) ? rm : 0.f) : ((rm > FL_THR) ? rm : 0.f);
    if (__any(dl != 0.f)) { const float al = first ? 1.f : __builtin_amdgcn_exp2f(-dl); l *= al; o[0] *= al; o[1] *= al;
#pragma unroll
        for (int r = 0; r < 16; ++r) { pa_[r] -= dl; pb_[r] -= dl; } }
    m = first ? ((rm > -1e29f) ? rm : m) : m + dl;
    float ls0 = 0.f, ls1 = 0.f;
#pragma unroll
    for (int r = 0; r < 16; ++r) { pa_[r] = __builtin_amdgcn_exp2f(pa_[r]); ls0 += pa_[r]; pb_[r] = __builtin_amdgcn_exp2f(pb_[r]); ls1 += pb_[r]; }
    l += ls0 + ls1;
    typedef unsigned u4 __attribute__((ext_vector_type(4)));
    u4 w;
    w.x = cvtpk(pa_[0], pa_[1]); w.y = cvtpk(pa_[2], pa_[3]); w.z = cvtpk(pa_[4], pa_[5]); w.w = cvtpk(pa_[6], pa_[7]); pf[0] = __builtin_bit_cast(bf16x8v, w);
    w.x = cvtpk(pa_[8], pa_[9]); w.y = cvtpk(pa_[10], pa_[11]); w.z = cvtpk(pa_[12], pa_[13]); w.w = cvtpk(pa_[14], pa_[15]); pf[1] = __builtin_bit_cast(bf16x8v, w);
    w.x = cvtpk(pb_[0], pb_[1]); w.y = cvtpk(pb_[2], pb_[3]); w.z = cvtpk(pb_[4], pb_[5]); w.w = cvtpk(pb_[6], pb_[7]); pf[2] = __builtin_bit_cast(bf16x8v, w);
    w.x = cvtpk(pb_[8], pb_[9]); w.y = cvtpk(pb_[10], pb_[11]); w.z = cvtpk(pb_[12], pb_[13]); w.w = cvtpk(pb_[14], pb_[15]); pf[3] = __builtin_bit_cast(bf16x8v, w);
}
__device__ __forceinline__ float fl_rowsum(const bf16x8v (&pf)[4]) {
    const bf16x8v ones = (bf16x8v){0x3f80, 0x3f80, 0x3f80, 0x3f80, 0x3f80, 0x3f80, 0x3f80, 0x3f80};
    f32x16 z;
#pragma unroll
    for (int r = 0; r < 16; ++r) z[r] = 0.f;
    z = __builtin_amdgcn_mfma_f32_32x32x16_bf16(ones, pf[0], z, 0, 0, 0); z = __builtin_amdgcn_mfma_f32_32x32x16_bf16(ones, pf[1], z, 0, 0, 0);
    z = __builtin_amdgcn_mfma_f32_32x32x16_bf16(ones, pf[2], z, 0, 0, 0); z = __builtin_amdgcn_mfma_f32_32x32x16_bf16(ones, pf[3], z, 0, 0, 0);
    return z[0];
}

template <int MODE> __device__ __forceinline__ void flash_unit(const bf16* Z, bf16* MIX, LAS unsigned char* L, int b, int h, int qb, float lam_full, float lambda_init, const float* subg, int tid, int wave, int lane) {
    lane = lane_now(); tid = wave * 64 + lane;
    constexpr int NMAP = MODE == 0 ? 2 : 1, KS = 4 / NMAP;
    constexpr int CQ = MODE == 0 ? ZC_QB : ZC_QC, CK = MODE == 0 ? ZC_KB : ZC_KC, CV = MODE == 0 ? ZC_VB : ZC_VC;
    const int r32 = lane & 31, hi = lane >> 5;
    LAS unsigned char* Kb = L + FL_K; LAS unsigned char* Vb = L + FL_V; LAS float* tab = (LAS float*)(L + FL_TAB);
    const int Q0 = qb * 256, tq0 = Q0 + wave * 32, t = tq0 + r32;
    const bf16* zb = Z + (size_t)(b * SEQ) * ZC;
    const float sl = (MODE == 0 ? __builtin_amdgcn_exp2f(-2.f * (float)(h + 1)) : __builtin_amdgcn_exp2f(-(float)(h + 1))) * LOG2E;
    for (int j = tid; j < FL_TABN; j += NWAVES * 64) { const int d = 2047 - j; float v;
        if (MODE == 0) v = d < 0 ? -INFINITY : -sl * (float)d;
        else { const int mult = (d <= 128 ? 1 : 0) + (((d & 3) == 0 && d <= 512) ? 1 : 0) + ((d & 15) == 0 ? 1 : 0);
               v = (d < 0 || mult == 0) ? -INFINITY : -sl * (float)d + (mult == 1 ? 0.f : (mult == 2 ? 1.f : 1.5849625007211562f)); }
        tab[j] = v; }
    bf16x8v qf[NMAP][KS];
#pragma unroll
    for (int mp = 0; mp < NMAP; ++mp)
#pragma unroll
        for (int ks = 0; ks < KS; ++ks) qf[mp][ks] = *(const bf16x8v*)(zb + (size_t)t * ZC + CQ + h * 64 + (mp * KS + ks) * 16 + hi * 8);
    constexpr int NCLS = MODE == 0 ? 1 : 3;
    f32x16 cin[NCLS];
#pragma unroll
    for (int r = 0; r < 16; ++r) { const int cr = (r & 3) + 8 * (r >> 2) + 4 * hi; const float a = sl * (float)cr;
        if (MODE == 0) cin[0][r] = a;
        else { const bool m4 = ((t - cr) & 3) == 0, m16 = ((t - cr) & 15) == 0;
            cin[0][r] = a + (m16 ? 1.5849625007211562f : (m4 ? 1.f : 0.f)); cin[NCLS - 2][r] = m4 ? a + (m16 ? 1.f : 0.f) : -INFINITY; cin[NCLS - 1][r] = m16 ? a : -INFINITY; } }
    float m[NMAP], l[NMAP]; f32x16 o[NMAP][2];
#pragma unroll
    for (int mp = 0; mp < NMAP; ++mp) { m[mp] = -1e30f; l[mp] = 0.f;
#pragma unroll
        for (int r = 0; r < 16; ++r) { o[mp][0][r] = 0.f; o[mp][1][r] = 0.f; } }
    const int skey = tid >> 3, sc = tid & 7;
    const bf16* ksrc = zb + (size_t)skey * ZC + CK + h * 64 + sc * 8;
    const bf16* vsrc = zb + (size_t)skey * ZC + CV + h * 64 + sc * 8;
    const int kdst = (sc >> 1) * 2048 + (sc & 1) * 1024 + (skey >> 5) * 512 + (skey & 31) * 16;
    const int vdst = (sc >> 2) * 4096 + (skey >> 3) * 512 + (skey & 7) * 64 + (sc & 3) * 16;
    const int krd = hi * 1024 + r32 * 16;
    const int vrd = ((lane >> 4) & 1) * 32 + (lane & 3) * 8 + (4 * hi + ((lane & 15) >> 2)) * 64;
    int jt = Q0 / 64 + 3;
    v4u kA = *(const v4u*)(ksrc + (size_t)jt * 64 * ZC), vA = *(const v4u*)(vsrc + (size_t)jt * 64 * ZC);
    v4u kB = *(const v4u*)(ksrc + (size_t)(jt - 1) * 64 * ZC), vB = *(const v4u*)(vsrc + (size_t)(jt - 1) * 64 * ZC);
    *(LAS v4u*)(Kb + (jt & 1) * 8192 + kdst) = kA; *(LAS v4u*)(Vb + (jt & 1) * 8192 + vdst) = vA;
    __syncthreads();
#define FL_TILE(JT, KW, VW, KL, VL) do { const int jt_ = (JT); \
        if (jt_ >= 2) { KL = *(const v4u*)(ksrc + (size_t)(jt_ - 2) * 64 * ZC); VL = *(const v4u*)(vsrc + (size_t)(jt_ - 2) * 64 * ZC); } \
        const LAS unsigned char* Kc = Kb + (jt_ & 1) * 8192; const LAS unsigned char* Vc = Vb + (jt_ & 1) * 8192; \
        if (jt_ * 64 <= tq0) {                                            \
              \
            const LAS float* tp = tab + (2047 - t + jt_ * 64 + 4 * hi); \
            f32x16 bias0, bias1; bf16x8v kf[NMAP][KS][2]; s16x4 vlo[4][2], vhh[4][2]; \
            _Pragma("unroll") for (int r = 0; r < 16; ++r) { bias0[r] = tp[(r & 3) + 8 * (r >> 2)]; bias1[r] = tp[32 + (r & 3) + 8 * (r >> 2)]; } \
            _Pragma("unroll") for (int mp = 0; mp < NMAP; ++mp) _Pragma("unroll") for (int ks = 0; ks < KS; ++ks) _Pragma("unroll") for (int u = 0; u < 2; ++u) kf[mp][ks][u] = *(const LAS bf16x8v*)(Kc + (mp * KS + ks) * 2048 + u * 512 + krd); \
            _Pragma("unroll") for (int s4 = 0; s4 < 4; ++s4) _Pragma("unroll") for (int db = 0; db < 2; ++db) { const LAS unsigned char* vp = Vc + db * 4096 + s4 * 1024 + vrd; vlo[s4][db] = lds_tr(vp); vhh[s4][db] = lds_tr(vp + 512); } \
            __builtin_amdgcn_sched_barrier(0); \
            _Pragma("unroll") for (int mp = 0; mp < NMAP; ++mp) { \
                f32x16 p0 = bias0, p1 = bias1; \
                _Pragma("unroll") for (int ks = 0; ks < KS; ++ks) { p0 = __builtin_amdgcn_mfma_f32_32x32x16_bf16(kf[mp][ks][0], qf[mp][ks], p0, 0, 0, 0); p1 = __builtin_amdgcn_mfma_f32_32x32x16_bf16(kf[mp][ks][1], qf[mp][ks], p1, 0, 0, 0); } \
                __builtin_amdgcn_sched_barrier(0); \
                bf16x8v pf[4]; \
                fl_softmax3(p0, p1, 0.f, 0.f, m[mp], l[mp], o[mp], pf); \
                __builtin_amdgcn_sched_barrier(0); \
                _Pragma("unroll") for (int s4 = 0; s4 < 4; ++s4) _Pragma("unroll") for (int db = 0; db < 2; ++db) { \
                        const bf16x8v vf = (bf16x8v){vlo[s4][db][0], vlo[s4][db][1], vlo[s4][db][2], vlo[s4][db][3], vhh[s4][db][0], vhh[s4][db][1], vhh[s4][db][2], vhh[s4][db][3]}; \
                        o[mp][db] = __builtin_amdgcn_mfma_f32_32x32x16_bf16(vf, pf[s4], o[mp][db], 0, 0, 0); } \
                __builtin_amdgcn_sched_barrier(0); } \
        } \
        if (jt_ >= 1) { *(LAS v4u*)(Kb + ((jt_ - 1) & 1) * 8192 + kdst) = KW; *(LAS v4u*)(Vb + ((jt_ - 1) & 1) * 8192 + vdst) = VW; } \
        __syncthreads(); } while (0)
    for (; jt >= 0; jt -= 2) { FL_TILE(jt, kB, vB, kA, vA); FL_TILE(jt - 1, kA, vA, kB, vB); }
#undef FL_TILE
    bf16* orow = MIX + (size_t)(b * SEQ + t) * DM + (MODE == 0 ? 256 : 512) + h * 64 + 4 * hi;
    if (MODE == 0) {
        const float i0 = 1.f / swap_sum(l[0]), i1 = lam_full / swap_sum(l[NMAP - 1]); float ss = 0.f;
#pragma unroll
        for (int db = 0; db < 2; ++db)
#pragma unroll
            for (int r = 0; r < 16; ++r) { const float v = o[0][db][r] * i0 - o[NMAP - 1][db][r] * i1; o[0][db][r] = v; ss += v * v; }
        const float rs = (1.f / sqrtf(swap_sum(ss) * (1.f / 64.f) + LN_EPS)) * (1.f - lambda_init);
#pragma unroll
        for (int db = 0; db < 2; ++db)
#pragma unroll
            for (int rg = 0; rg < 4; ++rg) { const f32x4 g = *(const f32x4*)(subg + 32 * db + 8 * rg + 4 * hi);
                v2u w; w.x = cvtpk(o[0][db][4 * rg + 0] * rs * g.x, o[0][db][4 * rg + 1] * rs * g.y); w.y = cvtpk(o[0][db][4 * rg + 2] * rs * g.z, o[0][db][4 * rg + 3] * rs * g.w);
                *(v2u*)(orow + 32 * db + 8 * rg) = w; }
    } else {
        const float i0 = 1.f / swap_sum(l[0]);
#pragma unroll
        for (int db = 0; db < 2; ++db)
#pragma unroll
            for (int rg = 0; rg < 4; ++rg) { v2u w; w.x = cvtpk(o[0][db][4 * rg + 0] * i0, o[0][db][4 * rg + 1] * i0); w.y = cvtpk(o[0][db][4 * rg + 2] * i0, o[0][db][4 * rg + 3] * i0);
                *(v2u*)(orow + 32 * db + 8 * rg) = w; }
    }
}
template <int MODE> __device__ __forceinline__ void flash_phase(const bf16* Z, bf16* MIX, LAS unsigned char* L, const float* lam, const float* subg, float lambda_init, int vcu, int G, int tid, int wave, int lane) {
    asm volatile("" : "+v"(tid), "+v"(lane));
    constexpr int NH = MODE == 0 ? 4 : 8, NPAIR = BATCH * NH * 4;
    float lam_full = 0.f;
    if (MODE == 0) { const int li = lane & 31; const float s01 = wave_sum(lam[li] * lam[32 + li], lane) * 0.5f, s23 = wave_sum(lam[64 + li] * lam[96 + li], lane) * 0.5f; lam_full = __int_as_float(__builtin_amdgcn_readfirstlane(__float_as_int(expf(s01) - expf(s23) + lambda_init))); }
    lambda_init = __int_as_float(__builtin_amdgcn_readfirstlane(__float_as_int(lambda_init)));
    for (int p = vcu; p < NPAIR; p += G) {
        const int b = p / (NH * 4), h = (p >> 2) % NH, x = p & 3;
#pragma unroll 1
        for (int k = 0; k < 2; ++k) { flash_unit<MODE>(Z, MIX, L, b, h, k == 0 ? 7 - x : x, lam_full, lambda_init, subg, tid, wave, lane); __syncthreads(); }
    }
}
constexpr int F2_K = 0, F2_V = 24576, F2_TAB = 40960;
#define F2_QK(S, KSLOT, MP, JT) do { const LAS float* tp_ = tab + (2047 - t + (JT) * 64 + 4 * hi); const LAS unsigned char* kc_ = Kb + (KSLOT) * 8192; \
        _Pragma("unroll") for (int r = 0; r < 16; ++r) { S[0][r] = tp_[(r & 3) + 8 * (r >> 2)]; S[1][r] = tp_[32 + (r & 3) + 8 * (r >> 2)]; } \
        _Pragma("unroll") for (int ks = 0; ks < KS; ++ks) { const bf16x8v k0_ = *(const LAS bf16x8v*)(kc_ + ((MP) * KS + ks) * 2048 + krd), k1_ = *(const LAS bf16x8v*)(kc_ + ((MP) * KS + ks) * 2048 + 512 + krd); \
            S[0] = __builtin_amdgcn_mfma_f32_32x32x16_bf16(k0_, qf[MP][ks], S[0], 0, 0, 0); S[1] = __builtin_amdgcn_mfma_f32_32x32x16_bf16(k1_, qf[MP][ks], S[1], 0, 0, 0); } } while (0)
#define F2_BD(S, MP) do { float rm_ = fmaxf(fmaxf(S[0][0], S[0][1]), fmaxf(S[1][0], S[1][1])); \
        _Pragma("unroll") for (int r = 2; r < 16; r += 2) rm_ = fmaxf(rm_, fmaxf(fmaxf(S[0][r], S[0][r + 1]), fmaxf(S[1][r], S[1][r + 1]))); \
        rm_ = swap_max(rm_); const bool first_ = m[MP] < -1e29f; \
        const bool up_ = first_ ? (rm_ > -1e29f) : (rm_ > m[MP] + FL_THR); \
        if (__any(up_)) { const float nm_ = up_ ? rm_ : m[MP], al_ = (first_ || !up_) ? 1.f : __builtin_amdgcn_exp2f(m[MP] - nm_); l[MP] *= al_; o[MP][0] *= al_; o[MP][1] *= al_; m[MP] = nm_; } } while (0)
#define F2_SM(S, MP, PF) do { const float nm_ = -m[MP]; float ls0_ = 0.f, ls1_ = 0.f; \
        _Pragma("unroll") for (int r = 0; r < 16; ++r) { S[0][r] = __builtin_amdgcn_exp2f(S[0][r] + nm_); ls0_ += S[0][r]; S[1][r] = __builtin_amdgcn_exp2f(S[1][r] + nm_); ls1_ += S[1][r]; } \
        l[MP] += ls0_ + ls1_; \
        { typedef unsigned u4_ __attribute__((ext_vector_type(4))); u4_ w_; \
          w_.x = cvtpk(S[0][0], S[0][1]); w_.y = cvtpk(S[0][2], S[0][3]); w_.z = cvtpk(S[0][4], S[0][5]); w_.w = cvtpk(S[0][6], S[0][7]); PF[0] = __builtin_bit_cast(bf16x8v, w_); \
          w_.x = cvtpk(S[0][8], S[0][9]); w_.y = cvtpk(S[0][10], S[0][11]); w_.z = cvtpk(S[0][12], S[0][13]); w_.w = cvtpk(S[0][14], S[0][15]); PF[1] = __builtin_bit_cast(bf16x8v, w_); \
          w_.x = cvtpk(S[1][0], S[1][1]); w_.y = cvtpk(S[1][2], S[1][3]); w_.z = cvtpk(S[1][4], S[1][5]); w_.w = cvtpk(S[1][6], S[1][7]); PF[2] = __builtin_bit_cast(bf16x8v, w_); \
          w_.x = cvtpk(S[1][8], S[1][9]); w_.y = cvtpk(S[1][10], S[1][11]); w_.z = cvtpk(S[1][12], S[1][13]); w_.w = cvtpk(S[1][14], S[1][15]); PF[3] = __builtin_bit_cast(bf16x8v, w_); } } while (0)
#define F2_PV(MP, VSLOT, PF) do { const LAS unsigned char* vc_ = Vb + (VSLOT) * 8192; \
        _Pragma("unroll") for (int s4 = 0; s4 < 4; ++s4) _Pragma("unroll") for (int db = 0; db < 2; ++db) { const LAS unsigned char* vp_ = vc_ + db * 4096 + s4 * 1024 + vrd; \
            const s16x4 lo_ = lds_tr(vp_), hh_ = lds_tr(vp_ + 512); const bf16x8v vf_ = (bf16x8v){lo_[0], lo_[1], lo_[2], lo_[3], hh_[0], hh_[1], hh_[2], hh_[3]}; \
            o[MP][db] = __builtin_amdgcn_mfma_f32_32x32x16_bf16(vf_, PF[s4], o[MP][db], 0, 0, 0); } } while (0)

template <int MODE> __device__ __forceinline__ void flash_unit2(const bf16* Z, bf16* MIX, LAS unsigned char* L, int b, int h, int qb, float lam_full, float lambda_init, const float* subg, int wave) {
    const int lane = lane_now(), tid = wave * 64 + lane;
    constexpr int NMAP = MODE == 0 ? 2 : 1, KS = 4 / NMAP;
    constexpr int CQ = MODE == 0 ? ZC_QB : ZC_QC, CK = MODE == 0 ? ZC_KB : ZC_KC, CV = MODE == 0 ? ZC_VB : ZC_VC;
    const int r32 = lane & 31, hi = lane >> 5;
    LAS unsigned char* Kb = L + F2_K; LAS unsigned char* Vb = L + F2_V; LAS float* tab = (LAS float*)(L + F2_TAB);
    const int Q0 = qb * 256, tq0 = Q0 + wave * 32, t = tq0 + r32, Jw = tq0 >> 6;
    const bf16* zb = Z + (size_t)(b * SEQ) * ZC;
    const float sl = (MODE == 0 ? __builtin_amdgcn_exp2f(-2.f * (float)(h + 1)) : __builtin_amdgcn_exp2f(-(float)(h + 1))) * LOG2E;
    for (int j = tid; j < FL_TABN; j += NWAVES * 64) { const int d = 2047 - j; float v;
        if (MODE == 0) v = d < 0 ? -INFINITY : -sl * (float)d;
        else { const int mult = (d <= 128 ? 1 : 0) + (((d & 3) == 0 && d <= 512) ? 1 : 0) + ((d & 15) == 0 ? 1 : 0);
               v = (d < 0 || mult == 0) ? -INFINITY : -sl * (float)d + (mult == 1 ? 0.f : (mult == 2 ? 1.f : 1.5849625007211562f)); }
        tab[j] = v; }
    bf16x8v qf[NMAP][KS];
#pragma unroll
    for (int mp = 0; mp < NMAP; ++mp)
#pragma unroll
        for (int ks = 0; ks < KS; ++ks) qf[mp][ks] = *(const bf16x8v*)(zb + (size_t)t * ZC + CQ + h * 64 + (mp * KS + ks) * 16 + hi * 8);
    float m[NMAP], l[NMAP]; f32x16 o[NMAP][2];
#pragma unroll
    for (int mp = 0; mp < NMAP; ++mp) { m[mp] = -1e30f; l[mp] = 0.f;
#pragma unroll
        for (int r = 0; r < 16; ++r) { o[mp][0][r] = 0.f; o[mp][1][r] = 0.f; } }
    const int skey = tid >> 3, sc = tid & 7;
    const bf16* ksrc = zb + (size_t)skey * ZC + CK + h * 64 + sc * 8;
    const bf16* vsrc = zb + (size_t)skey * ZC + CV + h * 64 + sc * 8;
    const int kdst = (sc >> 1) * 2048 + (sc & 1) * 1024 + (skey >> 5) * 512 + (skey & 31) * 16;
    const int vdst = (sc >> 2) * 4096 + (skey >> 3) * 512 + (skey & 7) * 64 + (sc & 3) * 16;
    const int krd = hi * 1024 + r32 * 16;
    const int vrd = ((lane >> 4) & 1) * 32 + (lane & 3) * 8 + (4 * hi + ((lane & 15) >> 2)) * 64;
    const size_t til = (size_t)64 * ZC;
    const int J = Q0 / 64 + 3;
    int k0s = J % 3, k1s = (J + 2) % 3, k2s = (J + 1) % 3;
    { const v4u a = *(const v4u*)(ksrc + J * til), bq = *(const v4u*)(ksrc + (J - 1) * til), c = *(const v4u*)(vsrc + J * til);
      *(LAS v4u*)(Kb + k0s * 8192 + kdst) = a; *(LAS v4u*)(Kb + k1s * 8192 + kdst) = bq; *(LAS v4u*)(Vb + (J & 1) * 8192 + vdst) = c; }
    v4u kA = *(const v4u*)(ksrc + (J - 2) * til), vA = *(const v4u*)(vsrc + (J - 1) * til);
    v4u kB = kA, vB = vA;
    __syncthreads();
    f32x16 Sa[2], Sb[2];
    if (J <= Jw) { F2_QK(Sa, k0s, 0, J); F2_BD(Sa, 0); }
#define F2_TILE(JT, KW, VW, KL, VL, SC, SN) do { const int jt_ = (JT); \
        if (jt_ >= 3) KL = *(const v4u*)(ksrc + (jt_ - 3) * til); if (jt_ >= 2) VL = *(const v4u*)(vsrc + (jt_ - 2) * til); \
        if (MODE == 1) { \
            if (jt_ <= Jw && jt_ >= 1) { bf16x8v pf_[4]; if (wave >= 4) { F2_SM(SC, 0, pf_); F2_PV(0, jt_ & 1, pf_); F2_QK(SN, k1s, 0, jt_ - 1); F2_BD(SN, 0); } else { F2_QK(SN, k1s, 0, jt_ - 1); F2_SM(SC, 0, pf_); F2_PV(0, jt_ & 1, pf_); F2_BD(SN, 0); } } \
            else if (jt_ == Jw + 1) { F2_QK(SN, k1s, 0, jt_ - 1); F2_BD(SN, 0); } \
            else if (jt_ <= Jw) { bf16x8v pf_[4]; F2_SM(SC, 0, pf_); F2_PV(0, jt_ & 1, pf_); } \
        } else { \
            if (jt_ <= Jw) { bf16x8v pf_[4]; F2_QK(Sb, k0s, NMAP - 1, jt_); F2_SM(Sa, 0, pf_); F2_PV(0, jt_ & 1, pf_); F2_BD(Sb, NMAP - 1); } \
            if (jt_ <= Jw + 1 && jt_ >= 1) { F2_QK(Sa, k1s, 0, jt_ - 1); } \
            if (jt_ <= Jw) { bf16x8v pf_[4]; F2_SM(Sb, NMAP - 1, pf_); F2_PV(NMAP - 1, jt_ & 1, pf_); } \
            if (jt_ <= Jw + 1 && jt_ >= 1) { F2_BD(Sa, 0); } \
        } \
        if (jt_ >= 2) *(LAS v4u*)(Kb + k2s * 8192 + kdst) = KW; if (jt_ >= 1) *(LAS v4u*)(Vb + ((jt_ - 1) & 1) * 8192 + vdst) = VW; \
        { const int t_ = k0s; k0s = k1s; k1s = k2s; k2s = t_; } \
        __syncthreads(); } while (0)
    for (int jt = J; jt >= 0; jt -= 2) { F2_TILE(jt, kA, vA, kB, vB, Sa, Sb); F2_TILE(jt - 1, kB, vB, kA, vA, Sb, Sa); }
#undef F2_TILE
    bf16* orow = MIX + (size_t)(b * SEQ + t) * DM + (MODE == 0 ? 256 : 512) + h * 64 + 4 * hi;
    if (MODE == 0) {
        const float i0 = 1.f / swap_sum(l[0]), i1 = lam_full / swap_sum(l[NMAP - 1]); float ss = 0.f;
#pragma unroll
        for (int db = 0; db < 2; ++db)
#pragma unroll
            for (int r = 0; r < 16; ++r) { const float v = o[0][db][r] * i0 - o[NMAP - 1][db][r] * i1; o[0][db][r] = v; ss += v * v; }
        const float rs = (1.f / sqrtf(swap_sum(ss) * (1.f / 64.f) + LN_EPS)) * (1.f - lambda_init);
#pragma unroll
        for (int db = 0; db < 2; ++db)
#pragma unroll
            for (int rg = 0; rg < 4; ++rg) { const f32x4 g = *(const f32x4*)(subg + 32 * db + 8 * rg + 4 * hi);
                v2u w; w.x = cvtpk(o[0][db][4 * rg + 0] * rs * g.x, o[0][db][4 * rg + 1] * rs * g.y); w.y = cvtpk(o[0][db][4 * rg + 2] * rs * g.z, o[0][db][4 * rg + 3] * rs * g.w);
                *(v2u*)(orow + 32 * db + 8 * rg) = w; }
    } else {
        const float i0 = 1.f / swap_sum(l[0]);
#pragma unroll
        for (int db = 0; db < 2; ++db)
#pragma unroll
            for (int rg = 0; rg < 4; ++rg) { v2u w; w.x = cvtpk(o[0][db][4 * rg + 0] * i0, o[0][db][4 * rg + 1] * i0); w.y = cvtpk(o[0][db][4 * rg + 2] * i0, o[0][db][4 * rg + 3] * i0);
                *(v2u*)(orow + 32 * db + 8 * rg) = w; }
    }
}
template <int MODE> __device__ __forceinline__ void flash_phase2(const bf16* Z, bf16* MIX, LAS unsigned char* L, const float* lam, const float* subg, float lambda_init, int vcu, int G, int tid, int wave, int lane) {
    constexpr int NH = MODE == 0 ? 4 : 8, NPAIR = BATCH * NH * 4;
    float lam_full = 0.f;
    if (MODE == 0) { const int li = lane & 31; const float s01 = wave_sum(lam[li] * lam[32 + li], lane) * 0.5f, s23 = wave_sum(lam[64 + li] * lam[96 + li], lane) * 0.5f; lam_full = expf(s01) - expf(s23) + lambda_init; }
    for (int p = vcu; p < NPAIR; p += G) {
        const int b = p / (NH * 4), h = (p >> 2) % NH, x = p & 3;
#pragma unroll 1
        for (int k = 0; k < 2; ++k) { flash_unit2<MODE>(Z, MIX, L, b, h, k == 0 ? 7 - x : x, lam_full, lambda_init, subg, wave); __syncthreads(); }
    }
}
constexpr int MA_K = 0, MA_V = 32768, MA_BM = 65536, MA_BMS = 68  , MA_WQ = MA_BM + 32 * MA_BMS * 4, MA_MG = MA_WQ + 512, MA_SEL = MA_MG + 4 * 34 * 64 * 4, MA_END = MA_SEL + NWAVES * 2560;
static_assert(MA_END <= RING_BYTES, "mixer A LDS map");

__device__ __forceinline__ unsigned ordkey(float f) { const unsigned u = __float_as_uint(f); return u ^ ((unsigned)((int)u >> 31) | 0x80000000u); }
#define DPP_I(v, ctrl) __builtin_amdgcn_update_dpp(0, (v), (ctrl), 0xf, 0xf, false)
__device__ __forceinline__ float wave_max_dpp(float v) {
    v = fmaxf(v, __int_as_float(DPP_I(__float_as_int(v), 0xB1))); v = fmaxf(v, __int_as_float(DPP_I(__float_as_int(v), 0x4E)));
    v = fmaxf(v, __int_as_float(DPP_I(__float_as_int(v), 0x141))); v = fmaxf(v, __int_as_float(DPP_I(__float_as_int(v), 0x140)));
    const int i = __float_as_int(v);
    return fmaxf(fmaxf(__int_as_float(__builtin_amdgcn_readlane(i, 0)), __int_as_float(__builtin_amdgcn_readlane(i, 16))), fmaxf(__int_as_float(__builtin_amdgcn_readlane(i, 32)), __int_as_float(__builtin_amdgcn_readlane(i, 48))));
}
__device__ __forceinline__ float wave_min_dpp(float v) {
    v = fminf(v, __int_as_float(DPP_I(__float_as_int(v), 0xB1))); v = fminf(v, __int_as_float(DPP_I(__float_as_int(v), 0x4E)));
    v = fminf(v, __int_as_float(DPP_I(__float_as_int(v), 0x141))); v = fminf(v, __int_as_float(DPP_I(__float_as_int(v), 0x140)));
    const int i = __float_as_int(v);
    return fminf(fminf(__int_as_float(__builtin_amdgcn_readlane(i, 0)), __int_as_float(__builtin_amdgcn_readlane(i, 16))), fminf(__int_as_float(__builtin_amdgcn_readlane(i, 32)), __int_as_float(__builtin_amdgcn_readlane(i, 48))));
}
__device__ __forceinline__ int wave_prefix_dpp(int x, int lane) {
    x += DPP_I(x, 0x111); x += DPP_I(x, 0x112); x += DPP_I(x, 0x114); x += DPP_I(x, 0x118);
    const int t0 = __builtin_amdgcn_readlane(x, 15), t1 = __builtin_amdgcn_readlane(x, 31), t2 = __builtin_amdgcn_readlane(x, 47);
    return x + (lane >= 16 ? t0 : 0) + (lane >= 32 ? t1 : 0) + (lane >= 48 ? t2 : 0);
}
template <int NJ> __device__ __forceinline__ void select_load(const float* srow, int t, int lane, float (&raw)[NJ]) {
#pragma unroll
    for (int j = 0; j < NJ; ++j) { const int kx = 64 * j + lane; raw[j] = srow[kx < t ? kx : t]; }
}
template <int NJ> __device__ __forceinline__ unsigned select_row_t(const float (&raw)[NJ], int t, LAS unsigned* hist, LAS unsigned* clist, int lane) {
    float f[NJ]; int bn[NJ];
    float vmax = -INFINITY, vmin = INFINITY;
#pragma unroll
    for (int j = 0; j < NJ; ++j) { const int kx = 64 * j + lane; const float v = raw[j] + 0.0f; const bool ok = kx <= t; f[j] = ok ? v : -INFINITY; vmax = fmaxf(vmax, f[j]); vmin = fminf(vmin, ok ? v : INFINITY); }
    vmax = wave_max_dpp(vmax); vmin = wave_min_dpp(vmin);
    const float scale = 255.99f / (vmax - vmin);
    { unsigned z_ = 0u; asm volatile("" : "+v"(z_)); ((LAS v4u*)hist)[lane] = (v4u){z_, z_, z_, z_}; }
#pragma unroll
    for (int j = 0; j < NJ; ++j) { int bi = (int)((f[j] - vmin) * scale); bi = bi > 255 ? 255 : bi; bi = bi < 0 ? 0 : bi; bn[j] = (64 * j + lane <= t) ? bi : -1;
        if (bn[j] >= 0) __hip_atomic_fetch_add(hist + bn[j], 1u, __ATOMIC_RELAXED, __HIP_MEMORY_SCOPE_WAVEFRONT); }
    LDS_WAIT();
    const v4u hv = ((const LAS v4u*)hist)[63 - lane];
    const int ssum = (int)(hv.x + hv.y + hv.z + hv.w);
    const int x = wave_prefix_dpp(ssum, lane);
    const int above = x - ssum; const bool found = above < 256 && x >= 256;
    int bsel, cab;
    { const int c3 = above + (int)hv.w, c2 = c3 + (int)hv.z, c1 = c2 + (int)hv.y; const int b0 = 4 * (63 - lane);
      if (c3 >= 256) { bsel = b0 + 3; cab = above; } else if (c2 >= 256) { bsel = b0 + 2; cab = c3; } else if (c1 >= 256) { bsel = b0 + 1; cab = c2; } else { bsel = b0; cab = c1; } }
    const unsigned long long fm = __ballot(found);
    const int src = (int)__builtin_ctzll(fm);
    const int bstar = __builtin_amdgcn_readlane(bsel, src), c_above = __builtin_amdgcn_readlane(cab, src);
    unsigned key[NJ];
#pragma unroll
    for (int j = 0; j < NJ; ++j) key[j] = ordkey(f[j]);
    int base = 0;
#pragma unroll
    for (int j = 0; j < NJ; ++j) { const bool isc = bn[j] == bstar; const unsigned long long cm = __ballot(isc); const int pos = base + mbcnt64(cm);
        clist[(isc && pos < 256) ? pos : 256 + lane] = key[j]; base += __popcll(cm); }
    LDS_WAIT();
    const int ncand = base, need = 256 - c_above;
    unsigned T = 0u; int cge;
    if (ncand <= 64) {
        const unsigned ck = lane < ncand ? clist[lane] : 0u;
        int g = 0, e = 0;
#pragma unroll 1
        for (int i = 0; i < ncand; ++i) { const unsigned sk = (unsigned)__builtin_amdgcn_readlane((int)ck, i); g += (sk > ck) ? 1 : 0; e += (sk == ck) ? 1 : 0; }
        const unsigned long long hit = __ballot(lane < ncand && g < need && need <= g + e);
        const int src2 = (int)__builtin_ctzll(hit);
        T = (unsigned)__builtin_amdgcn_readlane((int)ck, src2);
        cge = c_above + __builtin_amdgcn_readlane(g, src2) + __builtin_amdgcn_readlane(e, src2);
    } else if (ncand <= 256) {
        unsigned ck[4];
#pragma unroll
        for (int r = 0; r < 4; ++r) ck[r] = (r * 64 + lane < ncand) ? clist[r * 64 + lane] : 0u;
#pragma unroll 1
        for (int bit = 31; bit >= 0; --bit) { const unsigned cand = T | (1u << bit);
            const int cnt = __popcll(__ballot(ck[0] >= cand)) + __popcll(__ballot(ck[1] >= cand)) + __popcll(__ballot(ck[2] >= cand)) + __popcll(__ballot(ck[3] >= cand));
            if (cnt >= need) T = cand; }
        cge = c_above + __popcll(__ballot(ck[0] >= T)) + __popcll(__ballot(ck[1] >= T)) + __popcll(__ballot(ck[2] >= T)) + __popcll(__ballot(ck[3] >= T));
    } else {
#pragma unroll 1
        for (int bit = 31; bit >= 0; --bit) { const unsigned cand = T | (1u << bit); int cnt = 0;
#pragma unroll
            for (int j = 0; j < NJ; ++j) cnt += __popcll(__ballot(key[j] >= cand));
            if (cnt >= 256) T = cand; }
        cge = 0;
#pragma unroll
        for (int j = 0; j < NJ; ++j) cge += __popcll(__ballot(key[j] >= T));
    }
    unsigned w = 0u;
    if (cge == 256) {
#pragma unroll
        for (int j = NJ - 1; j >= 0; --j) w = w + w + (key[j] >= T ? 1u : 0u);
    } else {
        int cgt = 0;
#pragma unroll
        for (int j = 0; j < NJ; ++j) cgt += __popcll(__ballot(key[j] > T));
        const int need2 = 256 - cgt; int eqseen = 0;
#pragma unroll
        for (int j = 0; j < NJ; ++j) { const bool gt = key[j] > T, eq = key[j] == T; const unsigned long long em = __ballot(eq); const int er = eqseen + mbcnt64(em);
            w |= (gt || (eq && er < need2)) ? (1u << j) : 0u; eqseen += __popcll(em); }
    }
    return w;
}
constexpr int MB_K = 0, MB_V = 32768, MB_BM = 65536, MB_WQ = MB_BM + 64 * MA_BMS * 4, MB_SEL = MB_WQ + 1024, MB_END = MB_SEL + NWAVES * 2560;
static_assert(MB_END <= RING_BYTES, "mixer A (64-query units) LDS map");
template <int NJ> __device__ __forceinline__ void select8_t(const float* scr0, int t0, LAS unsigned* hist, LAS unsigned* clist, LAS unsigned* bmrow0, int lane) {
    float cur[NJ], nxt[NJ];
    select_load<NJ>(scr0, t0, lane, cur);
#pragma unroll 1
    for (int i = 0; i < 8; ++i) {
        const int t = t0 + i;
        if (i < 7) select_load<NJ>(scr0 + (size_t)(i + 1) * 2048, t + 1, lane, nxt);
        unsigned w;
        if (t < 256) { const int n = t + 1, nf = n >> 6; w = ((1u << nf) - 1u) | ((lane < (n & 63)) ? (1u << nf) : 0u); }
        else w = select_row_t<NJ>(cur, t, hist, clist, lane);
        bmrow0[i * MA_BMS + lane] = w;
#pragma unroll
        for (int j = 0; j < NJ; ++j) cur[j] = nxt[j];
    }
}
__device__ __forceinline__ void mixa_unit64(const bf16* Z, bf16* MIX, float* SCR, LAS unsigned char* L, int b, int qt64, int wave) {
    int lane = lane_now(), tid = wave * 64 + lane;
    int r32 = lane & 31, hi = lane >> 5; const int T0 = qt64 * 64;
    const bf16* zb = Z + (size_t)(b * SEQ) * ZC;
    LAS unsigned* bm = (LAS unsigned*)(L + MB_BM); LAS float* wq = (LAS float*)(L + MB_WQ);
    if (tid < 256) wq[tid] = bf1(zb[(size_t)(T0 + (tid >> 2)) * ZC + ZC_WI + (tid & 3)]);
    __syncthreads();
#pragma unroll 1
    for (int half = 0; half < 2; ++half) {
        const int Th = T0 + 32 * half;
        bf16x8v qi[4][4];
#pragma unroll
        for (int mt = 0; mt < 4; ++mt)
#pragma unroll
            for (int ks = 0; ks < 4; ++ks) qi[mt][ks] = *(const bf16x8v*)(zb + (size_t)(Th + 8 * mt + (r32 >> 2)) * ZC + ZC_QI + (r32 & 3) * 64 + ks * 16 + hi * 8);
        const int nkt = (Th >> 5) + 1;
        bf16x8v kn[4];
        if (wave < nkt) { const bf16* kr0 = zb + (size_t)(wave * 32 + r32) * ZC + ZC_KI + hi * 8;
#pragma unroll
            for (int ks = 0; ks < 4; ++ks) kn[ks] = *(const bf16x8v*)(kr0 + ks * 16); }
        for (int kt = wave; kt < nkt; kt += NWAVES) {
            const int key = kt * 32 + r32;
            bf16x8v kf[4];
#pragma unroll
            for (int ks = 0; ks < 4; ++ks) kf[ks] = kn[ks];
            if (kt + NWAVES < nkt) { const bf16* kr1 = zb + (size_t)((kt + NWAVES) * 32 + r32) * ZC + ZC_KI + hi * 8;
#pragma unroll
                for (int ks = 0; ks < 4; ++ks) kn[ks] = *(const bf16x8v*)(kr1 + ks * 16); }
#pragma unroll
            for (int mt = 0; mt < 4; ++mt) {
                f32x16 d;
#pragma unroll
                for (int r = 0; r < 16; ++r) d[r] = 0.f;
#pragma unroll
                for (int ks = 0; ks < 4; ++ks) d = __builtin_amdgcn_mfma_f32_32x32x16_bf16(qi[mt][ks], kf[ks], d, 0, 0, 0);
#pragma unroll
                for (int g = 0; g < 4; ++g) { const int q = 32 * half + 8 * mt + 2 * g + hi; const f32x4 w = *(const LAS f32x4*)(wq + 4 * q);
                    float s = fmaxf(d[4 * g + 0], 0.f) * w.x + fmaxf(d[4 * g + 1], 0.f) * w.y + fmaxf(d[4 * g + 2], 0.f) * w.z + fmaxf(d[4 * g + 3], 0.f) * w.w;
                    if (key > T0 + q) s = -INFINITY;
                    SCR[(size_t)q * 2048 + key] = s; }
            }
        }
    }
    asm volatile("s_waitcnt vmcnt(0)" ::: "memory");
    __syncthreads();
    {
        lane = lane_now();
        const int q0 = wave * 8, tl = __builtin_amdgcn_readfirstlane(T0 + q0 + 7);
        LAS unsigned* hs = (LAS unsigned*)(L + MB_SEL + wave * 2560);
        if (tl + 1 <= 512) select8_t<8>(SCR + (size_t)q0 * 2048, T0 + q0, hs, hs + 256, bm + q0 * MA_BMS, lane);
        else if (tl + 1 <= 1024) select8_t<16>(SCR + (size_t)q0 * 2048, T0 + q0, hs, hs + 256, bm + q0 * MA_BMS, lane);
        else if (tl + 1 <= 1536) select8_t<24>(SCR + (size_t)q0 * 2048, T0 + q0, hs, hs + 256, bm + q0 * MA_BMS, lane);
        else select8_t<32>(SCR + (size_t)q0 * 2048, T0 + q0, hs, hs + 256, bm + q0 * MA_BMS, lane);
    }
    lane = lane_now(); tid = wave * 64 + lane; r32 = lane & 31; hi = lane >> 5;
    int wv = wave; asm volatile("" : "+s"(wv));
    const int h = wv & 3, qh = wv >> 2, tq0 = T0 + 32 * qh, t = tq0 + r32;
    const float sl = __builtin_amdgcn_exp2f(-2.f * (float)(h + 1)) * LOG2E;
    bf16x8v qf[4];
#pragma unroll
    for (int ks = 0; ks < 4; ++ks) qf[ks] = *(const bf16x8v*)(zb + (size_t)t * ZC + ZC_QA + h * 64 + ks * 16 + hi * 8);
    float m = -1e30f, l = 0.f; f32x16 o[2];
    f32x16 cinA;
#pragma unroll
    for (int r = 0; r < 16; ++r) cinA[r] = sl * (float)((r & 3) + 8 * (r >> 2) + 4 * hi);
#pragma unroll
    for (int r = 0; r < 16; ++r) { o[0][r] = 0.f; o[1][r] = 0.f; }
    LAS unsigned char* Kb = L + MB_K; LAS unsigned char* Vb = L + MB_V;
    const int skey = tid >> 3, sc = tid & 7;
    const bf16* ksrc = zb + (size_t)skey * ZC + ZC_KA + sc * 8;
    const bf16* vsrc = zb + (size_t)skey * ZC + ZC_VA + sc * 8;
    const int kdst = (sc >> 1) * 2048 + (sc & 1) * 1024 + (skey >> 5) * 512 + (skey & 31) * 16;
    const int vdst = (sc >> 2) * 4096 + (skey >> 3) * 512 + (skey & 7) * 64 + (sc & 3) * 16;
    const int krd = hi * 1024 + r32 * 16;
    const int vrd = ((lane >> 4) & 1) * 32 + (lane & 3) * 8 + (4 * hi + ((lane & 15) >> 2)) * 64;
    const LAS v4u* wrow = (const LAS v4u*)(bm + (32 * qh + r32) * MA_BMS + 4 * hi);
    int jp = (T0 + 63) >> 7;
    const size_t stg = (size_t)128 * ZC, til = (size_t)64 * ZC;
    v4u kA0 = *(const v4u*)(ksrc + jp * stg), vA0 = *(const v4u*)(vsrc + jp * stg), kA1 = *(const v4u*)(ksrc + jp * stg + til), vA1 = *(const v4u*)(vsrc + jp * stg + til);
    { LAS unsigned char* kb = Kb + (jp & 1) * 16384; LAS unsigned char* vb = Vb + (jp & 1) * 16384;
      *(LAS v4u*)(kb + kdst) = kA0; *(LAS v4u*)(vb + vdst) = vA0; *(LAS v4u*)(kb + 8192 + kdst) = kA1; *(LAS v4u*)(vb + 8192 + vdst) = vA1; }
    v4u kB0 = kA0, vB0 = vA0, kB1 = kA1, vB1 = vA1;
    if (jp >= 1) { kB0 = *(const v4u*)(ksrc + (jp - 1) * stg); vB0 = *(const v4u*)(vsrc + (jp - 1) * stg); kB1 = *(const v4u*)(ksrc + (jp - 1) * stg + til); vB1 = *(const v4u*)(vsrc + (jp - 1) * stg + til); }
    __syncthreads();
#define MB_STAGE(JP, KW0, VW0, KW1, VW1, KL0, VL0, KL1, VL1) do { const int jp_ = (JP); \
        if (jp_ >= 2) { KL0 = *(const v4u*)(ksrc + (jp_ - 2) * stg); VL0 = *(const v4u*)(vsrc + (jp_ - 2) * stg); KL1 = *(const v4u*)(ksrc + (jp_ - 2) * stg + til); VL1 = *(const v4u*)(vsrc + (jp_ - 2) * stg + til); } \
        _Pragma("unroll") for (int kp = 1; kp >= 0; --kp) { \
            const int tile = 2 * jp_ + kp, s0 = 64 * tile; \
            if (s0 <= tq0 + 31) {                                          \
                const LAS unsigned char* Kc = Kb + (jp_ & 1) * 16384 + kp * 8192; const LAS unsigned char* Vc = Vb + (jp_ & 1) * 16384 + kp * 8192; \
                const float sha = sl * (float)(s0 - t), shb = sha + 32.f * sl; \
                f32x16 p0 = cinA, p1 = cinA; \
                _Pragma("unroll") for (int ks = 0; ks < 4; ++ks) { const bf16x8v kf0 = *(const LAS bf16x8v*)(Kc + ks * 2048 + krd), kf1 = *(const LAS bf16x8v*)(Kc + ks * 2048 + 512 + krd); \
                    p0 = __builtin_amdgcn_mfma_f32_32x32x16_bf16(kf0, qf[ks], p0, 0, 0, 0); p1 = __builtin_amdgcn_mfma_f32_32x32x16_bf16(kf1, qf[ks], p1, 0, 0, 0); } \
                const unsigned sbit = (unsigned)tile; \
                _Pragma("unroll") for (int g = 0; g < 4; ++g) { const v4u wa = wrow[2 * g], wb = wrow[8 + 2 * g]; \
                    _Pragma("unroll") for (int e = 0; e < 4; ++e) { const int r = 4 * g + e; \
                        const unsigned ma = (unsigned)(-(int)((wa[e] >> sbit) & 1u)), mb = (unsigned)(-(int)((wb[e] >> sbit) & 1u)); \
                        p0[r] = __uint_as_float((__float_as_uint(p0[r]) & ma) | (~ma & 0xff800000u)); p1[r] = __uint_as_float((__float_as_uint(p1[r]) & mb) | (~mb & 0xff800000u)); } } \
                bf16x8v pf[4]; \
                fl_softmax3(p0, p1, sha, shb, m, l, o, pf); \
                _Pragma("unroll") for (int s4 = 0; s4 < 4; ++s4) _Pragma("unroll") for (int db = 0; db < 2; ++db) { const LAS unsigned char* vp = Vc + db * 4096 + s4 * 1024 + vrd; \
                        const s16x4 lo = lds_tr(vp), hh = lds_tr(vp + 512); \
                        const bf16x8v vf = (bf16x8v){lo[0], lo[1], lo[2], lo[3], hh[0], hh[1], hh[2], hh[3]}; \
                        o[db] = __builtin_amdgcn_mfma_f32_32x32x16_bf16(vf, pf[s4], o[db], 0, 0, 0); } \
            } } \
        if (jp_ >= 1) { LAS unsigned char* kb = Kb + ((jp_ - 1) & 1) * 16384; LAS unsigned char* vb = Vb + ((jp_ - 1) & 1) * 16384; \
            *(LAS v4u*)(kb + kdst) = KW0; *(LAS v4u*)(vb + vdst) = VW0; *(LAS v4u*)(kb + 8192 + kdst) = KW1; *(LAS v4u*)(vb + 8192 + vdst) = VW1; } \
        __syncthreads(); } while (0)
    for (; jp >= 0; jp -= 2) { MB_STAGE(jp, kB0, vB0, kB1, vB1, kA0, vA0, kA1, vA1); if (jp >= 1) MB_STAGE(jp - 1, kA0, vA0, kA1, vA1, kB0, vB0, kB1, vB1); }
#undef MB_STAGE
    { const float inv = 1.f / swap_sum(l);
      bf16* orow = MIX + (size_t)(b * SEQ + t) * DM + h * 64 + 4 * hi;
#pragma unroll
      for (int db = 0; db < 2; ++db)
#pragma unroll
          for (int rg = 0; rg < 4; ++rg) { v2u w; w.x = cvtpk(o[db][4 * rg + 0] * inv, o[db][4 * rg + 1] * inv); w.y = cvtpk(o[db][4 * rg + 2] * inv, o[db][4 * rg + 3] * inv); *(v2u*)(orow + 32 * db + 8 * rg) = w; } }
}
__device__ __forceinline__ void mixa_phase64(const bf16* Z, bf16* MIX, float* SCR, LAS unsigned char* L, int vcu, int G, int wave) {
    float* scr = SCR + (size_t)blockIdx.x * (64 * 2048);
    for (int p = vcu; p < BATCH * 16; p += G) {
        const int b = p >> 4, x = p & 15;
#pragma unroll 1
        for (int k = 0; k < 2; ++k) { mixa_unit64(Z, MIX, scr, L, b, k == 0 ? 31 - x : x, wave); __syncthreads(); }
    }
}
#ifndef REP_A
#define REP_A 1
#endif
#ifndef REP_B
#define REP_B 1
#endif
#ifndef REP_C
#define REP_C 1
#endif
#ifndef REP_G
#define REP_G 1
#endif
#ifndef REP_BAR
#define REP_BAR 1
#endif
#ifndef FLASH2
#define FLASH2 1
#endif
#if FLASH2
#define FLASHP flash_phase2
#else
#define FLASHP flash_phase
#endif
#ifndef GM_ALIGN
#define GM_ALIGN true
#endif
#ifndef GM_ALIGN_RES
#define GM_ALIGN_RES true
#endif
#ifndef GM_SP2
#define GM_SP2 true
#endif
#ifndef MIXA64
#define MIXA64 1
#endif
struct Args { const float* in[12]; float* out; unsigned char* ws; };
__global__ void __launch_bounds__(NWAVES * 64, 2) hybrid_fwd(Args args) {
    extern __shared__ __attribute__((aligned(16))) unsigned char lds[];
    LAS unsigned char* L = (LAS unsigned char*)lds;
    volatile LAS unsigned* MISC = (volatile LAS unsigned*)(L + MISC_OFF);
    const int wave = __builtin_amdgcn_readfirstlane((int)threadIdx.x >> 6);
#define LANE_NOW lane_now()
#define TID_NOW (wave * 64 + lane_now())
    const int G = gridDim.x, bx = blockIdx.x;
    const int vcu = (G % 8 == 0) ? (bx % 8) * (G / 8) + bx / 8 : bx;
    const int gw = vcu * NWAVES + wave, NGW = G * NWAVES;
    unsigned char* ws = args.ws;
    gu32* ctl = (gu32*)(ws + WS_CTL);
    for (int u = TID_NOW; u < (LDS_BYTES - LDSCTL_OFF) / 4; u += NWAVES * 64) ((LAS unsigned*)(L + LDSCTL_OFF))[u] = 0u;
    __syncthreads();
    XcdBarrier bar = xcd_barrier_post((unsigned*)(ctl + CW_BAR), MISC + 8);
    const float* x = args.in[0];
    bf16* R0 = (bf16*)(ws + WS_R0); bf16* R1 = (bf16*)(ws + WS_R1); bf16* R2 = (bf16*)(ws + WS_R2); bf16* BIG = (bf16*)(ws + WS_BIG);

    {
        const int tid_ = TID_NOW;
        const size_t n8 = (size_t)M * DM / 8; const size_t gt = (size_t)bx * (NWAVES * 64) + tid_, nth = (size_t)G * NWAVES * 64;
#ifndef REP_X
#define REP_X 1
#endif
#ifndef REP_T
#define REP_T 1
#endif
        for (int rx_ = 0; rx_ < REP_X; ++rx_)
        for (size_t i = gt; i < n8; i += 4 * nth) {
            f32x4 a[4], b[4];
#pragma unroll
            for (int u = 0; u < 4; ++u) { size_t j = i + u * nth; j = j < n8 ? j : n8 - 1; a[u] = ((const f32x4*)x)[2 * j]; b[u] = ((const f32x4*)x)[2 * j + 1]; }
#pragma unroll
            for (int u = 0; u < 4; ++u) { const size_t j = i + u * nth; if (j < n8) { v4u o; o.x = pk2(a[u].x, a[u].y); o.y = pk2(a[u].z, a[u].w); o.z = pk2(b[u].x, b[u].y); o.w = pk2(b[u].z, b[u].w); ((v4u*)R0)[j] = o; } }
        }
        LAS float* scr = (LAS float*)(L + RING_OFF + wave * 16384);
        constexpr int I_IN = (DM / 64) * (ZC / 32), I_O = (DM / 64) * (DM / 32), I_GU = (DM / 64) * (GU / 32), I_D = (FF / 64) * (DM / 32), I_L = I_IN + I_O + I_GU + I_D;
        for (int rt_ = 0; rt_ < REP_T; ++rt_)
        for (int it = gw; it < DEPTH * I_L; it += NGW) {
            const int l = it / I_L; int r = it % I_L;
            unsigned char* wl = ws + WS_W + (size_t)l * W_LAYER_B;
            float* cv = (float*)(ws + WS_CV) + (size_t)l * CV_LAYER; const bool acc_ = rt_ == 0;
            const float* g2p = l > 0 ? args.in[10] + (l - 1) * DM : nullptr; const float* b2p = l > 0 ? args.in[11] + (l - 1) * DM : nullptr;
            const float* g1 = args.in[5] + l * DM; const float* b1 = args.in[6] + l * DM;
            if (r < I_IN) { transpose_item<0>(args.in[1] + (size_t)l * DM * INC, nullptr, g2p, b2p, acc_ ? cv : nullptr, cv + ZC, DM, INC, ZC, (bf16*)wl, scr, r, LANE_NOW); continue; } r -= I_IN;
            if (r < I_O) { transpose_item<1>(args.in[2] + (size_t)l * DM * DM, nullptr, nullptr, nullptr, nullptr, nullptr, DM, DM, DM, (bf16*)(wl + W_IN_B), scr, r, LANE_NOW); continue; } r -= I_O;
            if (r < I_GU) { transpose_item<2>(args.in[7] + (size_t)l * DM * FF, args.in[8] + (size_t)l * DM * FF, g1, b1, acc_ ? cv + 2 * ZC : nullptr, cv + 2 * ZC + GU, DM, FF, GU, (bf16*)(wl + W_IN_B + W_O_B), scr, r, LANE_NOW); continue; } r -= I_GU;
            transpose_item<1>(args.in[9] + (size_t)l * FF * DM, nullptr, nullptr, nullptr, nullptr, nullptr, FF, DM, DM, (bf16*)(wl + W_IN_B + W_O_B + W_GU_B), scr, r, LANE_NOW);
        }
    }
    xcd_barrier(bar);

#pragma unroll
    for (int l = 0; l < DEPTH; ++l) {
#define WS_NOW ({ unsigned char* w_ = args.ws; asm volatile("" : "+s"(w_)); w_; })
#define P_WL(w) ((w) + WS_W + (size_t)l * W_LAYER_B)
#define P_ST(w, ll, which) ((float*)((w) + WS_STAT) + (size_t)(((ll) * 2 + (which)) * 2) * M)
#define P_CV(w) ((const float*)((w) + WS_CV) + (size_t)l * CV_LAYER)
        const float lambda_init = (l == 0) ? 0.2f : 0.35550906759f;
        const bool last = (l + 1 == DEPTH);

        { unsigned char* w = WS_NOW; const float* sP = l > 0 ? P_ST(w, l - 1, 1) : nullptr; const float* cv = P_CV(w);
          pg8::Gemm g{(const pg8::bf16_t*)(w + WS_R0), (const pg8::bf16_t*)P_WL(w), M, ZC, DM}; pg8::StaticOrder S; S.init(M, ZC, G, bx);
          pg8::EpiStoreLN E{(pg8::bf16_t*)(w + WS_BIG), ZC, sP, sP ? sP + M : nullptr, cv, cv + ZC};
          for (int rep = 0; rep < REP_G; ++rep) {
          pg8::gemm_phase<pg8::EpiStoreLN, pg8::StaticOrder, GM_ALIGN, GM_SP2>(L + RING_OFF, g, S, E, wave); } }
        for (int rb_ = 0; rb_ < REP_BAR; ++rb_) xcd_barrier(bar);
        { unsigned char* w = WS_NOW; for (int rep = 0; rep < REP_A; ++rep) mixa_phase64((const bf16*)(w + WS_BIG), (bf16*)(w + WS_R1), (float*)(w + WS_R2), L + RING_OFF, vcu, G, wave); }
        { unsigned char* w = WS_NOW; for (int rep = 0; rep < REP_B; ++rep) FLASHP<0>((const bf16*)(w + WS_BIG), (bf16*)(w + WS_R1), L + RING_OFF, args.in[3] + l * 128, args.in[4] + l * 64, lambda_init, vcu, G, TID_NOW, wave, LANE_NOW); }
        { unsigned char* w = WS_NOW; for (int rep = 0; rep < REP_C; ++rep) FLASHP<1>((const bf16*)(w + WS_BIG), (bf16*)(w + WS_R1), L + RING_OFF, nullptr, nullptr, 0.f, vcu, G, TID_NOW, wave, LANE_NOW); }
        for (int rb_ = 0; rb_ < REP_BAR; ++rb_) xcd_barrier(bar);
        { unsigned char* w = WS_NOW; const float* sP = l > 0 ? P_ST(w, l - 1, 1) : nullptr; float* sA = P_ST(w, l, 0);
          pg8::Gemm g{(const pg8::bf16_t*)(w + WS_R1), (const pg8::bf16_t*)(P_WL(w) + W_IN_B), M, DM, DM}; pg8::StaticOrder S; S.init(M, DM, G, bx);
          pg8::EpiResStat E{(const pg8::bf16_t*)(w + WS_R0), sP, sP ? sP + M : nullptr, l > 0 ? args.in[10] + (l - 1) * DM : nullptr, l > 0 ? args.in[11] + (l - 1) * DM : nullptr, (pg8::bf16_t*)(w + WS_R2), nullptr, sA, sA + M, DM, ALPHA};
          for (int rep = 0; rep < REP_G; ++rep) { if (rep > 0) { E.osum = nullptr; }
          pg8::gemm_phase<pg8::EpiResStat, pg8::StaticOrder, GM_ALIGN_RES, GM_SP2>(L + RING_OFF, g, S, E, wave); } }
        for (int rb_ = 0; rb_ < REP_BAR; ++rb_) xcd_barrier(bar);
        { unsigned char* w = WS_NOW; float* sA = P_ST(w, l, 0); const float* cv = P_CV(w);
          pg8::Gemm g{(const pg8::bf16_t*)(w + WS_R2), (const pg8::bf16_t*)(P_WL(w) + W_IN_B + W_O_B), M, GU, DM}; pg8::StaticOrder S; S.init(M, GU, G, bx);
          pg8::EpiSwigluLN E{(pg8::bf16_t*)(w + WS_BIG), FF, sA, sA + M, cv + 2 * ZC, cv + 2 * ZC + GU};
          for (int rep = 0; rep < REP_G; ++rep) {
          pg8::gemm_phase<pg8::EpiSwigluLN, pg8::StaticOrder, GM_ALIGN, GM_SP2>(L + RING_OFF, g, S, E, wave); } }
        for (int rb_ = 0; rb_ < REP_BAR; ++rb_) xcd_barrier(bar);
        { unsigned char* w = WS_NOW; float* sA = P_ST(w, l, 0); float* sB = P_ST(w, l, 1);
          pg8::Gemm g{(const pg8::bf16_t*)(w + WS_BIG), (const pg8::bf16_t*)(P_WL(w) + W_IN_B + W_O_B + W_GU_B), M, DM, FF}; pg8::StaticOrder S; S.init(M, DM, G, bx);
          pg8::EpiResStat E{(const pg8::bf16_t*)(w + WS_R2), sA, sA + M, args.in[5] + l * DM, args.in[6] + l * DM, (pg8::bf16_t*)(w + WS_R0), nullptr, sB, sB + M, DM, ALPHA};
          for (int rep = 0; rep < REP_G; ++rep) { if (rep > 0) { E.osum = nullptr; }
          pg8::gemm_phase<pg8::EpiResStat, pg8::StaticOrder, GM_ALIGN_RES, GM_SP2>(L + RING_OFF, g, S, E, wave); } }
        for (int rb_ = 0; rb_ < REP_BAR; ++rb_) xcd_barrier(bar);
        if (last) {
            unsigned char* w = WS_NOW; const bf16* R0 = (const bf16*)(w + WS_R0); const float* sB = P_ST(w, l, 1);
            const int tid_ = TID_NOW;
            const size_t gt = (size_t)bx * (NWAVES * 64) + tid_, nth = (size_t)G * NWAVES * 64;
            if (nth % 128 == 0) {
                const int cc = (int)(gt & 127) * 8; const float* g2 = args.in[10] + l * DM + cc; const float* b2 = args.in[11] + l * DM + cc;
                const f32x4 ga = *(const f32x4*)g2, gb = *(const f32x4*)(g2 + 4), ba = *(const f32x4*)b2, bb = *(const f32x4*)(b2 + 4);
                const size_t rstep = nth / 128;
                for (size_t row = gt >> 7; row < (size_t)M; row += 4 * rstep) {
                    v4u hv[4]; float mu[4], rs[4];
#pragma unroll
                    for (int u = 0; u < 4; ++u) { size_t r = row + u * rstep; r = r < (size_t)M ? r : (size_t)M - 1; hv[u] = *(const v4u*)(R0 + r * DM + cc); const float s = sB[r], q = sB[M + r]; mu[u] = s * (1.f / DM); rs[u] = __builtin_amdgcn_rsqf(fmaxf(q * (1.f / DM) - mu[u] * mu[u], 0.f) + LN_EPS); }
#pragma unroll
                    for (int u = 0; u < 4; ++u) { const size_t r = row + u * rstep; if (r < (size_t)M) {
                        f32x4 ya, yb; ya.x = bflo(hv[u].x); ya.y = bfhi(hv[u].x); ya.z = bflo(hv[u].y); ya.w = bfhi(hv[u].y); yb.x = bflo(hv[u].z); yb.y = bfhi(hv[u].z); yb.z = bflo(hv[u].w); yb.w = bfhi(hv[u].w);
                        ya = (ya - mu[u]) * rs[u] * ga + ba; yb = (yb - mu[u]) * rs[u] * gb + bb;
                        float* op = args.out + r * DM + cc; *(f32x4*)op = ya; *(f32x4*)(op + 4) = yb; } }
                }
            }
        }
    }
}

extern "C" void kernel_launch(void* const* d_in, const int* in_sizes, int n_in, void* d_out, int out_size, void* d_ws, size_t ws_size, hipStream_t stream) {
    static int grid = 0;
    if (grid == 0) {
        if (n_in != 12 || in_sizes[0] != M * DM || out_size != M * DM || ws_size < WS_END) { fprintf(stderr, "kernel_launch: unexpected shapes / workspace (n_in %d, in0 %d, out %d, ws %zu < %zu)\n", n_in, n_in > 0 ? in_sizes[0] : -1, out_size, ws_size, (size_t)WS_END); grid = -1; return; }
        int dev = 0, cus = 0, per_cu = 0;
        if (hipGetDevice(&dev) != hipSuccess || hipDeviceGetAttribute(&cus, hipDeviceAttributeMultiprocessorCount, dev) != hipSuccess) { grid = -1; return; }
        if (hipFuncSetAttribute((const void*)hybrid_fwd, hipFuncAttributeMaxDynamicSharedMemorySize, LDS_BYTES) != hipSuccess) { fprintf(stderr, "kernel_launch: hipFuncSetAttribute failed\n"); grid = -1; return; }
        if (hipOccupancyMaxActiveBlocksPerMultiprocessor(&per_cu, (const void*)hybrid_fwd, NWAVES * 64, LDS_BYTES) != hipSuccess || per_cu < 1) { fprintf(stderr, "kernel_launch: occupancy query reports %d\n", per_cu); }
        (void)hipGetLastError();
        grid = cus < 256 ? cus : 256;
    }
    if (grid < 0) return;
    if (hipMemsetAsync((char*)d_ws + WS_CTL, 0, CTL_ZERO_BYTES, stream) != hipSuccess) return;
    Args a{};
    for (int i = 0; i < 12; ++i) a.in[i] = (const float*)d_in[i];
    a.out = (float*)d_out; a.ws = (unsigned char*)d_ws;
    hipLaunchKernelGGL(hybrid_fwd, dim3(grid), dim3(NWAVES * 64), LDS_BYTES, stream, a);
}
```

```cpp
#include <hip/hip_runtime.h>
#include <cstdio>
#include <cstdint>
#include <cmath>
#define FL_CLASS 0
#define FLASH2 0
#define FFN_FP8_P5 0
namespace pg8 {
#define PG8_LAS __attribute__((address_space(3)))
typedef unsigned short bf16_t;
typedef short bf16x8 __attribute__((ext_vector_type(8)));
typedef float f32x4 __attribute__((ext_vector_type(4)));
typedef unsigned u32x4 __attribute__((ext_vector_type(4)));
constexpr int BM = 256, BK = 64, HALF = 128, HTB = HALF * BK * 2  , STAGE_BYTES = 8 * HTB, NXCD = 8, WGM = 8;

__host__ __device__ __forceinline__ int lds_byte(int r, int c) { const int st = (r >> 4) * 2 + (c >> 5), rr = r & 15, cc = c & 31, ob = rr * 64 + cc * 2; return st * 1024 + (ob ^ (((ob >> 9) & 1) << 5)); }
__host__ __device__ __forceinline__ void stage_rc(int b, int& R, int& C) { const int st = b / 1024, sb = b % 1024, swz = sb ^ (((sb >> 9) & 1) << 5); R = (st >> 1) * 16 + swz / 64; C = (st & 1) * 32 + (swz % 64) / 2; }
__host__ __device__ __forceinline__ int perm32(int rho) { const int n = rho >> 4, i = rho & 15; return 8 * (i >> 2) + 4 * n + (i & 3); }

struct Unit { int pm, pn; };
struct Gemm { const bf16_t* A; const bf16_t* Bt; int M, N, K; int scale_w; };
typedef int v4i_t __attribute__((ext_vector_type(4)));
typedef int v8i_t __attribute__((ext_vector_type(8)));

struct StaticOrder {
    int nM, nN, nwg, G, c;
    __host__ __device__ void init(int M, int N, int G_, int c_) { nM = M / BM; nN = N / BM; nwg = nM * nN; G = G_; c = c_; }
    __host__ __device__ bool next(int i, Unit& u) const {
        const long L = (long)i * G + c; if (L >= nwg) return false;
        int wgid = (int)L; { const int q = nwg / NXCD, r = nwg % NXCD, xcd = wgid % NXCD, off = wgid / NXCD; wgid = (xcd < r ? xcd * (q + 1) : r * (q + 1) + (xcd - r) * q) + off; }
        const int nig = WGM * nN, gid = wgid / nig, fm = gid * WGM, gsz = (nM - fm) < WGM ? (nM - fm) : WGM;
        u.pm = fm + ((wgid % nig) % gsz); u.pn = (wgid % nig) / gsz; return true;
    }
    __device__ __forceinline__ void a_ready(const Unit&) const {}
    __device__ __forceinline__ void done(const Unit&) const {}
};
__device__ __forceinline__ unsigned cvt_pk_bf16(float lo, float hi) { unsigned r; asm volatile("v_cvt_pk_bf16_f32 %0, %1, %2" : "=v"(r) : "v"(lo), "v"(hi)); return r; }
typedef float f32x2 __attribute__((ext_vector_type(2)));
typedef unsigned u32x2 __attribute__((ext_vector_type(2)));
struct EpiStore {
    static constexpr bool PERM = true, AFTER_DRAIN = false;
    bf16_t* O; int ldc;
    __device__ __forceinline__ void operator()(const f32x4 (&acc)[2][2][4][2], const Unit& u, int wr, int wc, int fr, int fq) const {
        const int row0 = u.pm * BM + wr * 64 + fr, col0 = u.pn * BM + wc * 32 + 8 * fq;
#pragma unroll
        for (int ai = 0; ai < 2; ++ai)
#pragma unroll
            for (int m = 0; m < 4; ++m) { bf16_t* rowp = O + (size_t)(row0 + ai * HALF + m * 16) * ldc + col0;
#pragma unroll
                for (int bj = 0; bj < 2; ++bj) { const f32x4 v0 = acc[ai][bj][m][0], v1 = acc[ai][bj][m][1];
                    u32x4 w; w.x = cvt_pk_bf16(v0[0], v0[1]); w.y = cvt_pk_bf16(v0[2], v0[3]); w.z = cvt_pk_bf16(v1[0], v1[1]); w.w = cvt_pk_bf16(v1[2], v1[3]);
                    *(u32x4*)(rowp + bj * HALF) = w; } }
    }
};
struct EpiSwiglu {
    static constexpr bool PERM = true, AFTER_DRAIN = false;
    bf16_t* O; int ldc;
    __device__ __forceinline__ float act(float g, float u) const { const float e = __builtin_amdgcn_exp2f(g * -1.4426950408889634f); return g * __builtin_amdgcn_rcpf(1.0f + e) * u; }
    __device__ __forceinline__ void operator()(const f32x4 (&acc)[2][2][4][2], const Unit& u, int wr, int wc, int fr, int fq) const {
        const int row0 = u.pm * BM + wr * 64 + fr, col0 = u.pn * HALF + wc * 32 + 8 * fq;
#pragma unroll
        for (int ai = 0; ai < 2; ++ai)
#pragma unroll
            for (int m = 0; m < 4; ++m) { bf16_t* rowp = O + (size_t)(row0 + ai * HALF + m * 16) * ldc + col0;
                const f32x4 g0 = acc[ai][0][m][0], g1 = acc[ai][0][m][1], u0 = acc[ai][1][m][0], u1 = acc[ai][1][m][1];
                u32x4 w; w.x = cvt_pk_bf16(act(g0[0], u0[0]), act(g0[1], u0[1])); w.y = cvt_pk_bf16(act(g0[2], u0[2]), act(g0[3], u0[3]));
                w.z = cvt_pk_bf16(act(g1[0], u1[0]), act(g1[1], u1[1])); w.w = cvt_pk_bf16(act(g1[2], u1[2]), act(g1[3], u1[3]));
                *(u32x4*)rowp = w; }
    }
};
struct EpiRes {
    static constexpr bool PERM = false, AFTER_DRAIN = false;
    const bf16_t* X; float* H; int ldc; float alpha;
    __device__ __forceinline__ void operator()(const f32x4 (&acc)[2][2][4][2], const Unit& u, int wr, int wc, int fr, int fq) const {
        const int row0 = u.pm * BM + wr * 64 + fr, col0 = u.pn * BM + wc * 32 + 4 * fq;
#pragma unroll
        for (int ai = 0; ai < 2; ++ai)
#pragma unroll
            for (int m = 0; m < 4; ++m) { const size_t off = (size_t)(row0 + ai * HALF + m * 16) * ldc + col0;
#pragma unroll
                for (int bj = 0; bj < 2; ++bj)
#pragma unroll
                    for (int n = 0; n < 2; ++n) { const size_t c = off + bj * HALF + n * 16; const u32x2 xb = *(const u32x2*)(X + c);
                        f32x4 x; x[0] = __uint_as_float(xb.x << 16); x[1] = __uint_as_float(xb.x & 0xffff0000u); x[2] = __uint_as_float(xb.y << 16); x[3] = __uint_as_float(xb.y & 0xffff0000u);
                        *(f32x4*)(H + c) = acc[ai][bj][m][n] + x * alpha; } }
    }
};

__device__ __forceinline__ float sum16x(float v) { auto rr = __builtin_amdgcn_permlane16_swap(__float_as_uint(v), __float_as_uint(v), false, false); return __uint_as_float(rr[0]) + __uint_as_float(rr[1]); }
__device__ __forceinline__ float sum32x(float v) { auto rr = __builtin_amdgcn_permlane32_swap(__float_as_uint(v), __float_as_uint(v), false, false); return __uint_as_float(rr[0]) + __uint_as_float(rr[1]); }
__device__ __forceinline__ void row_stats(const float* ssum, const float* ssq, int row, float& mu, float& rs) {
    mu = 0.f; rs = 1.f;
    if (ssum) { const float s = ssum[row], q = ssq[row]; mu = s * (1.f / 1024.f); rs = 1.f / sqrtf(fmaxf(q * (1.f / 1024.f) - mu * mu, 0.f) + 1e-5f); }
}
struct EpiStoreLN {
    static constexpr bool PERM = true, AFTER_DRAIN = false;
    bf16_t* O; int ldc; const float* ssum; const float* ssq; const float* c1; const float* c0;
    __device__ __forceinline__ void operator()(const f32x4 (&acc)[2][2][4][2], const Unit& u, int wr, int wc, int fr, int fq) const {
        const int row0 = u.pm * BM + wr * 64 + fr, col0 = u.pn * BM + wc * 32 + 8 * fq;
        f32x4 c1v[2][2], c0v[2][2]; float z_ = 0.f; asm volatile("" : "+v"(z_));
#pragma unroll
        for (int bj = 0; bj < 2; ++bj)
#pragma unroll
            for (int n = 0; n < 2; ++n) { c1v[bj][n] = ssum ? *(const f32x4*)(c1 + col0 + bj * HALF + 4 * n) : (f32x4){z_, z_, z_, z_}; c0v[bj][n] = ssum ? *(const f32x4*)(c0 + col0 + bj * HALF + 4 * n) : (f32x4){z_, z_, z_, z_}; }
#pragma unroll
        for (int ai = 0; ai < 2; ++ai)
#pragma unroll
            for (int m = 0; m < 4; ++m) { const int row = row0 + ai * HALF + m * 16; float mu, rs; row_stats(ssum, ssq, row, mu, rs);
                bf16_t* rowp = O + (size_t)row * ldc + col0;
#pragma unroll
                for (int bj = 0; bj < 2; ++bj) { const f32x4 v0 = (acc[ai][bj][m][0] - c1v[bj][0] * mu) * rs + c0v[bj][0], v1 = (acc[ai][bj][m][1] - c1v[bj][1] * mu) * rs + c0v[bj][1];
                    u32x4 w; w.x = cvt_pk_bf16(v0[0], v0[1]); w.y = cvt_pk_bf16(v0[2], v0[3]); w.z = cvt_pk_bf16(v1[0], v1[1]); w.w = cvt_pk_bf16(v1[2], v1[3]);
                    *(u32x4*)(rowp + bj * HALF) = w; } }
    }
};
struct EpiSwigluLN {
    static constexpr bool PERM = true, AFTER_DRAIN = false;
    bf16_t* O; int ldc; const float* ssum; const float* ssq; const float* c1; const float* c0; float ascale;
    __device__ __forceinline__ float act(float g, float u) const { const float e = __builtin_amdgcn_exp2f(g * -1.4426950408889634f); return g * __builtin_amdgcn_rcpf(1.0f + e) * u; }
    __device__ __forceinline__ void operator()(const f32x4 (&acc)[2][2][4][2], const Unit& u, int wr, int wc, int fr, int fq) const {
        const int row0 = u.pm * BM + wr * 64 + fr, col0 = u.pn * HALF + wc * 32 + 8 * fq, wrow0 = u.pn * BM + wc * 32 + 8 * fq;
        f32x4 c1v[2][2], c0v[2][2];
#pragma unroll
        for (int bj = 0; bj < 2; ++bj)
#pragma unroll
            for (int n = 0; n < 2; ++n) { c1v[bj][n] = *(const f32x4*)(c1 + wrow0 + bj * HALF + 4 * n); c0v[bj][n] = *(const f32x4*)(c0 + wrow0 + bj * HALF + 4 * n); }
#pragma unroll
        for (int ai = 0; ai < 2; ++ai)
#pragma unroll
            for (int m = 0; m < 4; ++m) { const int row = row0 + ai * HALF + m * 16; float mu, rs; row_stats(ssum, ssq, row, mu, rs);
                bf16_t* rowp = O + (size_t)row * ldc + col0;
                const f32x4 g0 = (acc[ai][0][m][0] * ascale - c1v[0][0] * mu) * rs + c0v[0][0], g1 = (acc[ai][0][m][1] * ascale - c1v[0][1] * mu) * rs + c0v[0][1];
                const f32x4 u0 = (acc[ai][1][m][0] * ascale - c1v[1][0] * mu) * rs + c0v[1][0], u1 = (acc[ai][1][m][1] * ascale - c1v[1][1] * mu) * rs + c0v[1][1];
                u32x4 w; w.x = cvt_pk_bf16(act(g0[0], u0[0]), act(g0[1], u0[1])); w.y = cvt_pk_bf16(act(g0[2], u0[2]), act(g0[3], u0[3]));
                w.z = cvt_pk_bf16(act(g1[0], u1[0]), act(g1[1], u1[1])); w.w = cvt_pk_bf16(act(g1[2], u1[2]), act(g1[3], u1[3]));
                *(u32x4*)rowp = w; }
    }
};
struct EpiSwigluLN8 {
    static constexpr bool PERM = true, AFTER_DRAIN = false;
    unsigned char* O; int ldc; const float* ssum; const float* ssq; const float* c1; const float* c0; float ascale;
    __device__ __forceinline__ float act(float g, float u) const { const float e = __builtin_amdgcn_exp2f(g * -1.4426950408889634f); return g * __builtin_amdgcn_rcpf(1.0f + e) * u; }
    __device__ __forceinline__ void operator()(const f32x4 (&acc)[2][2][4][2], const Unit& u, int wr, int wc, int fr, int fq) const {
        const int row0 = u.pm * BM + wr * 64 + fr, col0 = u.pn * HALF + wc * 32 + 8 * fq, wrow0 = u.pn * BM + wc * 32 + 8 * fq;
        f32x4 c1v[2][2], c0v[2][2];
#pragma unroll
        for (int bj = 0; bj < 2; ++bj)
#pragma unroll
            for (int n = 0; n < 2; ++n) { c1v[bj][n] = *(const f32x4*)(c1 + wrow0 + bj * HALF + 4 * n); c0v[bj][n] = *(const f32x4*)(c0 + wrow0 + bj * HALF + 4 * n); }
#pragma unroll
        for (int ai = 0; ai < 2; ++ai)
#pragma unroll
            for (int m = 0; m < 4; ++m) { const int row = row0 + ai * HALF + m * 16; float mu, rs; row_stats(ssum, ssq, row, mu, rs);
                unsigned char* rowp = O + (size_t)row * ldc + col0;
                const f32x4 g0 = (acc[ai][0][m][0] * ascale - c1v[0][0] * mu) * rs + c0v[0][0], g1 = (acc[ai][0][m][1] * ascale - c1v[0][1] * mu) * rs + c0v[0][1];
                const f32x4 u0 = (acc[ai][1][m][0] * ascale - c1v[1][0] * mu) * rs + c0v[1][0], u1 = (acc[ai][1][m][1] * ascale - c1v[1][1] * mu) * rs + c0v[1][1];
                int w0 = __builtin_amdgcn_cvt_pk_fp8_f32(act(g0[0], u0[0]), act(g0[1], u0[1]), 0, false); w0 = __builtin_amdgcn_cvt_pk_fp8_f32(act(g0[2], u0[2]), act(g0[3], u0[3]), w0, true);
                int w1 = __builtin_amdgcn_cvt_pk_fp8_f32(act(g1[0], u1[0]), act(g1[1], u1[1]), 0, false); w1 = __builtin_amdgcn_cvt_pk_fp8_f32(act(g1[2], u1[2]), act(g1[3], u1[3]), w1, true);
                u32x2 w; w.x = (unsigned)w0; w.y = (unsigned)w1; *(u32x2*)rowp = w; }
    }
};
struct EpiResStat {
    static constexpr bool PERM = false, AFTER_DRAIN = false;
    const bf16_t* R; const float* rsum; const float* rsq; const float* g; const float* b; bf16_t* Hb; float* Hf; float* osum; float* osq; int ldc; float alpha; unsigned char* H8; float ascale;
    __device__ __forceinline__ void operator()(const f32x4 (&acc)[2][2][4][2], const Unit& u, int wr, int wc, int fr, int fq) const {
        const int row0 = u.pm * BM + wr * 64 + fr, col0 = u.pn * BM + wc * 32 + 4 * fq;
        f32x4 gv[2][2], bv[2][2];
#pragma unroll
        for (int bj = 0; bj < 2; ++bj)
#pragma unroll
            for (int n = 0; n < 2; ++n) { float z_ = 0.f, o_ = 1.f; asm volatile("" : "+v"(z_), "+v"(o_)); gv[bj][n] = rsum ? *(const f32x4*)(g + col0 + bj * HALF + n * 16) : (f32x4){o_, o_, o_, o_}; bv[bj][n] = rsum ? *(const f32x4*)(b + col0 + bj * HALF + n * 16) : (f32x4){z_, z_, z_, z_}; }
        float ss[2][4], qq[2][4];
#pragma unroll
        for (int ai = 0; ai < 2; ++ai)
#pragma unroll
            for (int m = 0; m < 4; ++m) { const int row = row0 + ai * HALF + m * 16; float mu, rs; row_stats(rsum, rsq, row, mu, rs);
                const size_t off = (size_t)row * ldc + col0; float s = 0.f, q = 0.f;
#pragma unroll
                for (int bj = 0; bj < 2; ++bj)
#pragma unroll
                    for (int n = 0; n < 2; ++n) { const size_t c = off + bj * HALF + n * 16; const u32x2 xb = *(const u32x2*)(R + c);
                        f32x4 x; x[0] = __uint_as_float(xb.x << 16); x[1] = __uint_as_float(xb.x & 0xffff0000u); x[2] = __uint_as_float(xb.y << 16); x[3] = __uint_as_float(xb.y & 0xffff0000u);
                        x = (x - mu) * rs * gv[bj][n] + bv[bj][n];
                        const f32x4 v = acc[ai][bj][m][n] * ascale + x * alpha;
                        if (Hf) *(f32x4*)(Hf + c) = v;
                        else { u32x2 w; w.x = cvt_pk_bf16(v[0], v[1]); w.y = cvt_pk_bf16(v[2], v[3]); *(u32x2*)(Hb + c) = w; s += (v[0] + v[1]) + (v[2] + v[3]); q += (v[0] * v[0] + v[1] * v[1]) + (v[2] * v[2] + v[3] * v[3]);
                            if (H8) { int w8 = __builtin_amdgcn_cvt_pk_fp8_f32(v[0], v[1], 0, false); w8 = __builtin_amdgcn_cvt_pk_fp8_f32(v[2], v[3], w8, true); *(int*)(H8 + c) = w8; } } }
                ss[ai][m] = sum32x(sum16x(s)); qq[ai][m] = sum32x(sum16x(q)); }
        if (!Hf && osum) {
#pragma unroll
            for (int ai = 0; ai < 2; ++ai) { const float sv = fq == 0 ? ss[ai][0] : (fq == 1 ? ss[ai][1] : (fq == 2 ? ss[ai][2] : ss[ai][3])), qv = fq == 0 ? qq[ai][0] : (fq == 1 ? qq[ai][1] : (fq == 2 ? qq[ai][2] : qq[ai][3]));
                const int row = row0 + ai * HALF + fq * 16;
                __hip_atomic_fetch_add(osum + row, sv, __ATOMIC_RELAXED, __HIP_MEMORY_SCOPE_AGENT); __hip_atomic_fetch_add(osq + row, qv, __ATOMIC_RELAXED, __HIP_MEMORY_SCOPE_AGENT); } }
    }
};
template <class Epi, class Sched, bool ALIGN_EPI = false, bool SP2 = false, bool FP8 = false>
__device__ __forceinline__ void gemm_phase(PG8_LAS unsigned char* lds, const Gemm g, const Sched& S, const Epi& E, int wave_in) {
    int lane_; asm volatile("v_mbcnt_lo_u32_b32 %0, -1, 0\n\tv_mbcnt_hi_u32_b32 %0, -1, %0" : "=v"(lane_)); const int tid_ = wave_in * 64 + lane_;
    const int tid = tid_, wid = __builtin_amdgcn_readfirstlane(tid >> 6), lane = tid & 63, wr = wid >> 2, wc = wid & 3, fr = lane & 15, fq = lane >> 4;
    const int K = g.K, nt = K / BK;
    unsigned voffA[2], voffB[2];
#pragma unroll
    for (int i = 0; i < 2; ++i) { int R, C; stage_rc(tid * 16 + i * 8192, R, C); const int Rb = Epi::PERM ? ((R & ~31) + perm32(R & 31)) : R;
        voffA[i] = (unsigned)(R * K + C) * 2u; voffB[i] = (unsigned)(Rb * K + C) * 2u; }
    const size_t kstep = (size_t)(BK * 2);
    const size_t hstep = (size_t)HALF * K * 2;
    const size_t tstep = 2 * hstep;
    const unsigned ldsw = (unsigned)wid * 1024u;
    const int aoff = lds_byte(wr * 64 + fr, fq * 8), boff = lds_byte(wc * 32 + fr, fq * 8);
#define PG8_SA(b, h) (((b) * 2 + (h)) * HTB)
#define PG8_SB(b, h) ((4 + (b) * 2 + (h)) * HTB)
#define PG8_STAGE(bufoff, gbase, voff) do { _Pragma("unroll") for (int _i = 0; _i < 2; ++_i) \
        __builtin_amdgcn_global_load_lds((const unsigned*)((const char*)(gbase) + (voff)[_i]), (PG8_LAS unsigned*)(lds + (bufoff) + ldsw + _i * 8192), 16, 0, 0); } while (0)
#define PG8_LDA16(dst, b, h) do { _Pragma("unroll") for (int m = 0; m < 4; ++m) _Pragma("unroll") for (int k = 0; k < 2; ++k) dst[m][k] = *(const PG8_LAS bf16x8*)(lds + PG8_SA(b, h) + aoff + m * 2048 + k * 1024); } while (0)
#define PG8_LDA8(dst, b, h) do { _Pragma("unroll") for (int m = 0; m < 4; ++m) { const v4i_t lo_ = *(const PG8_LAS v4i_t*)(lds + PG8_SA(b, h) + aoff + m * 2048), hi_ = *(const PG8_LAS v4i_t*)(lds + PG8_SA(b, h) + aoff + m * 2048 + 1024); dst[m] = __builtin_shufflevector(lo_, hi_, 0, 1, 2, 3, 4, 5, 6, 7); } } while (0)
#define PG8_LDA(dst, b, h) do { if constexpr (FP8) PG8_LDA8(dst##8, b, h); else PG8_LDA16(dst, b, h); } while (0)
#define PG8_LDB16(dst, b, h) do { _Pragma("unroll") for (int n = 0; n < 2; ++n) _Pragma("unroll") for (int k = 0; k < 2; ++k) dst[n][k] = *(const PG8_LAS bf16x8*)(lds + PG8_SB(b, h) + boff + n * 2048 + k * 1024); } while (0)
#define PG8_LDB8(dst, b, h) do { _Pragma("unroll") for (int n = 0; n < 2; ++n) { const v4i_t lo_ = *(const PG8_LAS v4i_t*)(lds + PG8_SB(b, h) + boff + n * 2048), hi_ = *(const PG8_LAS v4i_t*)(lds + PG8_SB(b, h) + boff + n * 2048 + 1024); dst[n] = __builtin_shufflevector(lo_, hi_, 0, 1, 2, 3, 4, 5, 6, 7); } } while (0)
#define PG8_LDB(dst, b, h) do { if constexpr (FP8) PG8_LDB8(dst##8, b, h); else PG8_LDB16(dst, b, h); } while (0)
#define PG8_MMA(ai, bj, At, Bt) do { __builtin_amdgcn_s_setprio(1); _Pragma("unroll") for (int m = 0; m < 4; ++m) _Pragma("unroll") for (int n = 0; n < 2; ++n) _Pragma("unroll") for (int k = 0; k < 2; ++k) \
        acc[ai][bj][m][n] = __builtin_amdgcn_mfma_f32_16x16x32_bf16(Bt[n][k], At[m][k], acc[ai][bj][m][n], 0, 0, 0); __builtin_amdgcn_s_setprio(0); } while (0)
#define PG8_MMA8(ai, bj, At, Bt) do { __builtin_amdgcn_s_setprio(1); _Pragma("unroll") for (int m = 0; m < 4; ++m) _Pragma("unroll") for (int n = 0; n < 2; ++n) \
        acc[ai][bj][m][n] = __builtin_amdgcn_mfma_scale_f32_16x16x128_f8f6f4(Bt[n], At[m], acc[ai][bj][m][n], 0, 0, 0, 0, 0, 0);     __builtin_amdgcn_s_setprio(0); } while (0)
#define PG8_MM(ai, bj, At, Bt) do { if constexpr (FP8) PG8_MMA8(ai, bj, At##8, Bt##8); else PG8_MMA(ai, bj, At, Bt); } while (0)
#define PG8_WAIT_V(n) asm volatile("s_waitcnt vmcnt(" #n ")" ::: "memory")
#define PG8_WAIT_L(n) asm volatile("s_waitcnt lgkmcnt(" #n ")" ::: "memory")
#define PG8_BAR __builtin_amdgcn_s_barrier()
#define PG8_SCHED __builtin_amdgcn_sched_barrier(0)
    Unit cur, nxt; int ui = 0;
    if (!S.next(0, cur)) return;
    f32x4 acc[2][2][4][2];
#pragma unroll
    for (int a = 0; a < 2; ++a)
#pragma unroll
        for (int b = 0; b < 2; ++b)
#pragma unroll
            for (int m = 0; m < 4; ++m)
#pragma unroll
                for (int n = 0; n < 2; ++n) acc[a][b][m][n] = (f32x4){0.f, 0.f, 0.f, 0.f};
    bf16x8 At[4][2], B0[2][2], B1[2][2]; v8i_t At8[4], B08[2], B18[2];
    const char* cA = (const char*)g.A + (size_t)cur.pm * tstep; const char* cB = (const char*)g.Bt + (size_t)cur.pn * tstep;
    S.a_ready(cur);
    if constexpr (SP2) {
        PG8_STAGE(PG8_SB(0, 0), cB, voffB); PG8_STAGE(PG8_SB(0, 1), cB + hstep, voffB); PG8_STAGE(PG8_SA(0, 0), cA, voffA); PG8_STAGE(PG8_SA(0, 1), cA + hstep, voffA);
        if (wr == 1) PG8_BAR;
        PG8_WAIT_V(2); PG8_BAR;
        PG8_STAGE(PG8_SB(1, 0), cB + kstep, voffB); PG8_STAGE(PG8_SA(1, 0), cA + kstep, voffA); PG8_STAGE(PG8_SB(1, 1), cB + hstep + kstep, voffB);
        PG8_WAIT_V(6); PG8_BAR;
    } else {
        PG8_STAGE(PG8_SB(0, 0), cB, voffB); PG8_STAGE(PG8_SA(0, 0), cA, voffA); PG8_STAGE(PG8_SB(0, 1), cB + hstep, voffB); PG8_STAGE(PG8_SA(0, 1), cA + hstep, voffA);
        if (wr == 1) PG8_BAR;
        PG8_WAIT_V(4); PG8_BAR;
        PG8_STAGE(PG8_SB(1, 0), cB + kstep, voffB); PG8_STAGE(PG8_SA(1, 0), cA + kstep, voffA); PG8_STAGE(PG8_SB(1, 1), cB + hstep + kstep, voffB);
        PG8_WAIT_V(6); PG8_BAR;
    }
    for (;;) {
        const bool has_next = S.next(ui + 1, nxt);
        const char* nA = has_next ? (const char*)g.A + (size_t)nxt.pm * tstep : cA; const char* nB = has_next ? (const char*)g.Bt + (size_t)nxt.pn * tstep : cB;
#pragma unroll 1
        for (int t = 0; t < nt; t += 2) {
            const bool last = (t == nt - 2);
            const char* a1 = cA + (size_t)(t + 1) * kstep;
            const char* a2 = last ? nA : cA + (size_t)(t + 2) * kstep; const char* b2 = last ? nB : cB + (size_t)(t + 2) * kstep;
            const char* a3 = a2 + kstep; const char* b3 = b2 + kstep;
            if (last && has_next) S.a_ready(nxt);
            if constexpr (SP2) {
            PG8_LDB(B0, 0, 0); PG8_LDB(B1, 0, 1); PG8_SCHED; PG8_LDA(At, 0, 0); PG8_STAGE(PG8_SA(1, 1), a1 + hstep, voffA);
            PG8_WAIT_V(8); PG8_WAIT_L(0); PG8_BAR; PG8_MM(0, 0, At, B0); PG8_MM(0, 1, At, B1); PG8_BAR; PG8_SCHED;
            PG8_LDA(At, 0, 1); PG8_STAGE(PG8_SB(0, 0), b2, voffB); PG8_STAGE(PG8_SB(0, 1), b2 + hstep, voffB); PG8_STAGE(PG8_SA(0, 0), a2, voffA);
            PG8_WAIT_V(8); PG8_WAIT_L(0); PG8_BAR; PG8_MM(1, 0, At, B0); PG8_MM(1, 1, At, B1); PG8_BAR; PG8_SCHED;
            PG8_LDB(B0, 1, 0); PG8_LDB(B1, 1, 1); PG8_SCHED; PG8_LDA(At, 1, 0); PG8_STAGE(PG8_SA(0, 1), a2 + hstep, voffA);
            PG8_WAIT_V(8); PG8_WAIT_L(0); PG8_BAR; PG8_MM(0, 0, At, B0); PG8_MM(0, 1, At, B1); PG8_BAR; PG8_SCHED;
            PG8_LDA(At, 1, 1); PG8_STAGE(PG8_SB(1, 0), b3, voffB); PG8_STAGE(PG8_SB(1, 1), b3 + hstep, voffB); PG8_STAGE(PG8_SA(1, 0), a3, voffA);
            PG8_WAIT_V(8); PG8_WAIT_L(0); PG8_BAR; PG8_MM(1, 0, At, B0); PG8_MM(1, 1, At, B1); PG8_BAR; PG8_SCHED;
            } else {
            PG8_LDB(B0, 0, 0); PG8_SCHED; PG8_LDA(At, 0, 0); PG8_STAGE(PG8_SA(1, 1), a1 + hstep, voffA);
            PG8_WAIT_L(8); PG8_BAR; PG8_WAIT_L(0); PG8_MM(0, 0, At, B0); PG8_BAR; PG8_SCHED;
            PG8_LDB(B1, 0, 1); PG8_STAGE(PG8_SB(0, 0), b2, voffB);
            PG8_BAR; PG8_WAIT_L(0); PG8_MM(0, 1, At, B1); PG8_BAR;
            PG8_LDA(At, 0, 1); PG8_STAGE(PG8_SA(0, 0), a2, voffA);
            PG8_BAR; PG8_WAIT_L(0); PG8_MM(1, 0, At, B0); PG8_BAR; PG8_SCHED;
            PG8_STAGE(PG8_SB(0, 1), b2 + hstep, voffB);
            PG8_WAIT_V(6); PG8_BAR; PG8_MM(1, 1, At, B1); PG8_BAR;
            PG8_LDB(B0, 1, 0); PG8_SCHED; PG8_LDA(At, 1, 0); PG8_STAGE(PG8_SA(0, 1), a2 + hstep, voffA);
            PG8_WAIT_L(8); PG8_BAR; PG8_WAIT_L(0); PG8_MM(0, 0, At, B0); PG8_BAR; PG8_SCHED;
            PG8_LDB(B1, 1, 1); PG8_STAGE(PG8_SB(1, 0), b3, voffB);
            PG8_BAR; PG8_WAIT_L(0); PG8_MM(0, 1, At, B1); PG8_BAR;
            PG8_LDA(At, 1, 1); PG8_STAGE(PG8_SA(1, 0), a3, voffA);
            PG8_BAR; PG8_WAIT_L(0); PG8_MM(1, 0, At, B0); PG8_BAR; PG8_SCHED;
            PG8_STAGE(PG8_SB(1, 1), b3 + hstep, voffB);
            PG8_WAIT_V(6); PG8_BAR; PG8_MM(1, 1, At, B1); PG8_BAR;
            }
        }
        if constexpr (ALIGN_EPI) { if (wr == 0) PG8_BAR; }
        if constexpr (!Epi::AFTER_DRAIN) { int le_; asm volatile("v_mbcnt_lo_u32_b32 %0, -1, 0\n\tv_mbcnt_hi_u32_b32 %0, -1, %0" : "=v"(le_)); E(acc, cur, wr, wc, le_ & 15, le_ >> 4); S.done(cur); }
        if (!has_next) break;
#pragma unroll
        for (int a = 0; a < 2; ++a)
#pragma unroll
            for (int b = 0; b < 2; ++b)
#pragma unroll
                for (int m = 0; m < 4; ++m)
#pragma unroll
                    for (int n = 0; n < 2; ++n) acc[a][b][m][n] = (f32x4){0.f, 0.f, 0.f, 0.f};
        cur = nxt; cA = nA; cB = nB; ++ui;
        if constexpr (ALIGN_EPI) { if (wr == 1) PG8_BAR; }
    }
    PG8_WAIT_V(0);
    if constexpr (!ALIGN_EPI) { if (wr == 0) PG8_BAR; }
    PG8_BAR;
    if constexpr (Epi::AFTER_DRAIN) { E.fused(acc, cur, wr, wc, fr, fq, lds, wid, lane); S.done(cur); }
#undef PG8_SA
#undef PG8_SB
#undef PG8_STAGE
#undef PG8_LDA
#undef PG8_LDA8
#undef PG8_LDA16
#undef PG8_LDB
#undef PG8_LDB8
#undef PG8_LDB16
#undef PG8_MMA
#undef PG8_MMA8
#undef PG8_MM
#undef PG8_WAIT_V
#undef PG8_WAIT_L
#undef PG8_BAR
#undef PG8_SCHED
}
}
constexpr int NWAVES = 8;
constexpr int BATCH = 32, SEQ = 2048, DM = 1024, M = BATCH * SEQ, ZC = 3072, FF = 2816, GU = 2 * FF, DEPTH = 2, INC = 3012;
constexpr float LN_EPS = 1e-5f, LOG2E = 1.4426950408889634f, ALPHA = 1.4142135623730951f;
constexpr int ZC_QA = 0, ZC_KA = 256, ZC_VA = 320, ZC_QI = 384, ZC_KI = 640, ZC_WI = 704, ZC_QB = 768, ZC_KB = 1024, ZC_VB = 1280, ZC_QC = 1536, ZC_KC = 2048, ZC_VC = 2560;
constexpr size_t MiB = 1u << 20;
constexpr size_t WS_CTL = 0, CTL_ZERO_BYTES = 4 * MiB;
constexpr size_t WS_STAT = 1 * MiB;
constexpr size_t WS_CV = 3 * MiB;
constexpr size_t CV_LAYER = 2 * (3072 + 5632);
constexpr size_t WS_W = 4 * MiB;
constexpr size_t W_IN_B = (size_t)ZC * DM * 2, W_O_B = (size_t)DM * DM * 2, W_GU_B = (size_t)GU * DM * 2, W_D_B = (size_t)DM * FF * 2;
constexpr size_t W_LAYER_B = W_IN_B + W_O_B + W_GU_B + W_D_B;
constexpr size_t WS_R0 = 64 * MiB, WS_R1 = 192 * MiB, WS_R2 = 320 * MiB, WS_BIG = 448 * MiB, WS_END = 896 * MiB;
static_assert(WS_W + DEPTH * W_LAYER_B <= WS_R0, "weights fit below R0");
static_assert((size_t)M * ZC * 2 <= WS_END - WS_BIG && (size_t)M * DM * 4 <= WS_END - WS_BIG && (size_t)M * DM * 2 <= WS_R1 - WS_R0, "activation map");
constexpr int CW_TMO = 0, CW_BAR = 4096;
constexpr int RING_OFF = 0, RING_BYTES = 131072;
constexpr int LDSCTL_OFF = RING_BYTES, MISC_OFF = LDSCTL_OFF + 320;
constexpr int LDS_BYTES = 147456;

typedef unsigned short bf16;
typedef unsigned v4u __attribute__((ext_vector_type(4)));
typedef unsigned v2u __attribute__((ext_vector_type(2)));
typedef float f32x4 __attribute__((ext_vector_type(4)));
#define LDS_WAIT() asm volatile("s_waitcnt lgkmcnt(0)" ::: "memory")
__device__ __forceinline__ unsigned f2bf(float f) { unsigned u = __builtin_bit_cast(unsigned, f); return (u + 0x7fffu + ((u >> 16) & 1u)) >> 16; }
__device__ __forceinline__ unsigned pk2(float lo, float hi) { return f2bf(lo) | (f2bf(hi) << 16); }
__device__ __forceinline__ float bflo(unsigned w) { return __uint_as_float(w << 16); }
__device__ __forceinline__ float bfhi(unsigned w) { return __uint_as_float(w & 0xffff0000u); }
__device__ __forceinline__ float bf1(bf16 b) { return __uint_as_float((unsigned)b << 16); }
__device__ __forceinline__ void unpack8(const v4u w, float (&f)[8]) { f[0] = bflo(w.x); f[1] = bfhi(w.x); f[2] = bflo(w.y); f[3] = bfhi(w.y); f[4] = bflo(w.z); f[5] = bfhi(w.z); f[6] = bflo(w.w); f[7] = bfhi(w.w); }
__device__ __forceinline__ float wave_sum(float v, int lane) {
#pragma unroll
    for (int o = 1; o < 64; o <<= 1) v += __int_as_float(__builtin_amdgcn_ds_bpermute((lane ^ o) << 2, __float_as_int(v)));
    return v;
}
__device__ __forceinline__ int mbcnt64(unsigned long long m) { return (int)__builtin_amdgcn_mbcnt_hi((unsigned)(m >> 32), __builtin_amdgcn_mbcnt_lo((unsigned)m, 0u)); }
#define GAS __attribute__((address_space(1)))
#define LAS __attribute__((address_space(3)))
typedef GAS unsigned gu32;
#define RLX_AGENT __ATOMIC_RELAXED, __HIP_MEMORY_SCOPE_AGENT
#define VM_WAIT() asm volatile("s_waitcnt vmcnt(0)" ::: "memory")
__device__ __forceinline__ int lane_now() { int l; asm volatile("v_mbcnt_lo_u32_b32 %0, -1, 0\n\tv_mbcnt_hi_u32_b32 %0, -1, %0" : "=v"(l)); return l; }
#define XB_TMO      128
#define XB_XCNT(j)  (256  + 64 * (j))
#define XB_XSUB(j)  (1280 + 64 * (j))
#define XB_XGEN(j)  (2304 + 64 * (j))
#define XB_TOP      3328
#define XB_TOPGEN   3392
#define XCD_BAR_WORDS 3456
#define XB_SPIN_CAP (1u << 24)

__device__ __forceinline__ unsigned xb_ld(unsigned* p)              { return __hip_atomic_load(p, __ATOMIC_RELAXED, __HIP_MEMORY_SCOPE_AGENT); }
__device__ __forceinline__ unsigned xb_add(unsigned* p, unsigned v) { return __hip_atomic_fetch_add(p, v, __ATOMIC_RELAXED, __HIP_MEMORY_SCOPE_AGENT); }
__device__ __forceinline__ unsigned xb_xcc_id() { return (unsigned)__builtin_amdgcn_s_getreg((3 << 11) | 20) & 0xFu; }
#define XB_SPIN(cond, bar) do { unsigned _sp = 0; while (cond) { __builtin_amdgcn_s_sleep(1); \
    if ((++_sp & 255u) == 0u) { if (xb_ld(&(bar)[XB_TMO])) break; if (_sp > XB_SPIN_CAP) { atomicAdd(&(bar)[XB_TMO], 1u); break; } } } } while (0)

struct XcdBarrier {
    unsigned* bar; unsigned x;
    volatile LAS unsigned* st;
};

__device__ __forceinline__ XcdBarrier xcd_barrier_post(unsigned* bar, volatile LAS unsigned* st) {
    XcdBarrier b; b.bar = bar; b.x = (unsigned)__builtin_amdgcn_readfirstlane((int)xb_xcc_id()); b.st = st;
    if (threadIdx.x == 0) (void)xb_add(&bar[XB_XCNT(b.x)], 1u);
    return b;
}
__device__ __forceinline__ void xcd_barrier_complete(unsigned* bar, unsigned x, unsigned& nloc, unsigned& nx) {
    const unsigned G = gridDim.x * gridDim.y * gridDim.z;
    unsigned sum, cnt, mine, sp = 0u;
    for (;;) {
        sum = 0u; cnt = 0u; mine = 0u;
#pragma unroll
        for (unsigned j = 0; j < 16; ++j) { const unsigned c = xb_ld(&bar[XB_XCNT(j)]); sum += c; cnt += (c > 0u) ? 1u : 0u; mine = (j == x) ? c : mine; }
        if (sum == G) break;
        __builtin_amdgcn_s_sleep(1);
        if ((++sp & 255u) == 0u) { if (xb_ld(&bar[XB_TMO])) break; if (sp > XB_SPIN_CAP) { atomicAdd(&bar[XB_TMO], 1u); break; } }
    }
    nloc = mine > 0u ? mine : 1u; nx = cnt > 0u ? cnt : 1u;
}

__device__ __forceinline__ void xcd_barrier(const XcdBarrier& b) {
    asm volatile("s_waitcnt vmcnt(0)" ::: "memory");
    __syncthreads();
    if (threadIdx.x == 0) {
        unsigned* bar = b.bar; asm volatile("" : "+s"(bar));
        const unsigned bx_ = (unsigned)__builtin_amdgcn_readfirstlane((int)xb_xcc_id());
        __builtin_amdgcn_s_waitcnt(0);
        unsigned nloc = b.st[0], nx = b.st[1];
        if (nloc == 0u) { xcd_barrier_complete(bar, bx_, nloc, nx); b.st[0] = nloc; b.st[1] = nx; }
        const unsigned old = xb_add(&bar[XB_XSUB(bx_)], 1u);
        const unsigned gen = old / nloc;
        if (old + 1u == (gen + 1u) * nloc) {
            __builtin_amdgcn_fence(__ATOMIC_RELEASE, "agent");
            asm volatile("s_waitcnt vmcnt(0)" ::: "memory");
            const unsigned og = xb_add(&bar[XB_TOP], 1u);
            const unsigned tg = og / nx;
            if (og + 1u == (tg + 1u) * nx) xb_add(&bar[XB_TOPGEN], 1u);
            else XB_SPIN(xb_ld(&bar[XB_TOPGEN]) == tg, bar);
            __builtin_amdgcn_fence(__ATOMIC_ACQUIRE, "agent");
            xb_add(&bar[XB_XGEN(bx_)], 1u);
            asm volatile("s_waitcnt vmcnt(0)" ::: "memory");
        } else {
            XB_SPIN(xb_ld(&bar[XB_XGEN(bx_)]) == gen, bar);
            __builtin_amdgcn_fence(__ATOMIC_ACQUIRE, "agent");
            asm volatile("s_waitcnt vmcnt(0)" ::: "memory");
        }
    }
    __syncthreads();
}
template <int TYPE, int FP8S = 0> __device__ __forceinline__ void transpose_item(const float* W0, const float* W1, const float* gk, const float* bk, float* c1o, float* c0o, int K, int Nsrc, int Ndst, bf16* WT, LAS float* scr, int item, int lane) {
    const int nblk = Ndst / 32, kb = item / nblk, nb = item % nblk, k0 = 64 * kb, n0 = 32 * nb;
    const int nd = n0 + (lane & 31);
    const float* src = W0; int c = nd; float sc = 1.f; bool pad = false;
    if (TYPE == 0) {
        if (nd < 708) c = nd; else if (nd < 768) { pad = true; c = 0; } else c = nd - 60;
        if (nd < 256) sc = 0.125f * LOG2E; else if (nd >= ZC_QB && nd < ZC_KB) sc = 0.17677669529663687f * LOG2E; else if (nd >= ZC_QC && nd < ZC_KC) sc = 0.125f * LOG2E;
    } else if (TYPE == 2) {
        const int tile = nd >> 8, w = nd & 255;
        if (w < 128) { src = W0; c = tile * 128 + w; } else { src = W1; c = tile * 128 + (w - 128); }
    }
    float s1 = 0.f, s0 = 0.f;
#pragma unroll
    for (int i = 0; i < 32; ++i) { const int kk = 2 * i + (lane >> 5); float v = pad ? 0.f : src[(size_t)(k0 + kk) * Nsrc + c] * sc;
        if (gk) { s0 += bk[k0 + kk] * v; v *= gk[k0 + kk];
            if (FP8S) s1 += __builtin_amdgcn_cvt_f32_fp8(__builtin_amdgcn_cvt_pk_fp8_f32(v * (float)(1 << FP8S), 0.f, 0, false), 0) * (1.f / (float)(1 << FP8S));
            else s1 += __uint_as_float(f2bf(v) << 16); }
        scr[kk * 33 + (lane & 31)] = v; }
    if (gk) { s1 += __int_as_float(__builtin_amdgcn_ds_bpermute((lane ^ 32) << 2, __float_as_int(s1))); s0 += __int_as_float(__builtin_amdgcn_ds_bpermute((lane ^ 32) << 2, __float_as_int(s0)));
        if (lane < 32 && c1o) { __hip_atomic_fetch_add(c1o + nd, s1, __ATOMIC_RELAXED, __HIP_MEMORY_SCOPE_AGENT); __hip_atomic_fetch_add(c0o + nd, s0, __ATOMIC_RELAXED, __HIP_MEMORY_SCOPE_AGENT); } }
    LDS_WAIT();
    const int c8 = lane & 7;
#pragma unroll
    for (int j = 0; j < 4; ++j) { const int n = (lane >> 3) + 8 * j; const LAS float* s = scr + (8 * c8) * 33 + n;
        if (FP8S) {
            const float S = (float)(1 << FP8S);
            int w0 = __builtin_amdgcn_cvt_pk_fp8_f32(s[0 * 33] * S, s[1 * 33] * S, 0, false); w0 = __builtin_amdgcn_cvt_pk_fp8_f32(s[2 * 33] * S, s[3 * 33] * S, w0, true);
            int w1 = __builtin_amdgcn_cvt_pk_fp8_f32(s[4 * 33] * S, s[5 * 33] * S, 0, false); w1 = __builtin_amdgcn_cvt_pk_fp8_f32(s[6 * 33] * S, s[7 * 33] * S, w1, true);
            v2u o; o.x = (unsigned)w0; o.y = (unsigned)w1; *(v2u*)((unsigned char*)WT + (size_t)(n0 + n) * K + k0 + 8 * c8) = o;
        } else {
        v4u o; o.x = pk2(s[0 * 33], s[1 * 33]); o.y = pk2(s[2 * 33], s[3 * 33]); o.z = pk2(s[4 * 33], s[5 * 33]); o.w = pk2(s[6 * 33], s[7 * 33]);
        *(v4u*)(WT + (size_t)(n0 + n) * K + k0 + 8 * c8) = o; } }
    LDS_WAIT();
}

template <bool OUT_F32> __device__ __forceinline__ void ln_phase(const float* H, const float* g, const float* b, bf16* ob, float* of, int gw, int NGW, int lane) {
    asm volatile("" : "+v"(lane));
    f32x4 gv[4], bv[4];
#pragma unroll
    for (int j = 0; j < 4; ++j) { gv[j] = ((const f32x4*)g)[lane + 64 * j]; bv[j] = ((const f32x4*)b)[lane + 64 * j]; }
    for (int m = gw; m < M; m += NGW) {
        const f32x4* xr = (const f32x4*)(H + (size_t)m * DM) + lane;
        f32x4 v[4]; float s = 0.f;
#pragma unroll
        for (int j = 0; j < 4; ++j) { v[j] = xr[64 * j]; s += (v[j].x + v[j].y) + (v[j].z + v[j].w); }
        const float mean = wave_sum(s, lane) * (1.f / DM); float s2 = 0.f;
#pragma unroll
        for (int j = 0; j < 4; ++j) { v[j] = v[j] - mean; s2 += (v[j].x * v[j].x + v[j].y * v[j].y) + (v[j].z * v[j].z + v[j].w * v[j].w); }
        const float rstd = 1.f / sqrtf(wave_sum(s2, lane) * (1.f / DM) + LN_EPS);
#pragma unroll
        for (int j = 0; j < 4; ++j) { const f32x4 y = v[j] * rstd * gv[j] + bv[j];
            if (OUT_F32) ((f32x4*)(of + (size_t)m * DM))[lane + 64 * j] = y;
            else { v2u o; o.x = pk2(y.x, y.y); o.y = pk2(y.z, y.w); ((v2u*)(ob + (size_t)m * DM))[lane + 64 * j] = o; } }
    }
}

typedef short bf16x8v __attribute__((ext_vector_type(8)));
typedef float f32x16 __attribute__((ext_vector_type(16)));
typedef short s16x4 __attribute__((ext_vector_type(4)));
typedef short v4i16_t __attribute__((ext_vector_type(4)));
typedef float f32x2_t __attribute__((ext_vector_type(2)));
typedef __bf16 bf16x2_t __attribute__((ext_vector_type(2)));
__device__ __forceinline__ unsigned cvtpk(float lo, float hi) { f32x2_t v = {lo, hi}; bf16x2_t b = __builtin_convertvector(v, bf16x2_t); return __builtin_bit_cast(unsigned, b); }
__device__ __forceinline__ s16x4 lds_tr(LAS const unsigned char* p) { return __builtin_bit_cast(s16x4, __builtin_amdgcn_ds_read_tr16_b64_v4i16((LAS v4i16_t*)p)); }
__device__ __forceinline__ float swap_max(float v) { auto rr = __builtin_amdgcn_permlane32_swap(__float_as_uint(v), __float_as_uint(v), false, false); return fmaxf(__uint_as_float(rr[0]), __uint_as_float(rr[1])); }
__device__ __forceinline__ float swap_sum(float v) { auto rr = __builtin_amdgcn_permlane32_swap(__float_as_uint(v), __float_as_uint(v), false, false); return __uint_as_float(rr[0]) + __uint_as_float(rr[1]); }
#ifndef FL_MFMA_SUM
#define FL_MFMA_SUM 1
#endif
#ifndef FL_CLASS
#define FL_CLASS 1
#endif
constexpr float FL_THR = 4.0f;
constexpr int FL_K = 0, FL_V = 16384, FL_TAB = 32768, FL_TABN = 2112;

__device__ __forceinline__ void fl_softmax(f32x16& p, float& m, float& l, f32x16 (&o)[2], bf16x8v (&pa)[2]) {
    const bool first = m < -1e29f;
    const float mref = first ? 0.f : m;
#pragma unroll
    for (int r = 0; r < 16; ++r) p[r] -= mref;
    float rm = fmaxf(fmaxf(p[0], p[1]), fmaxf(p[2], p[3]));
#pragma unroll
    for (int r = 4; r < 16; r += 4) rm = fmaxf(rm, fmaxf(fmaxf(p[r], p[r + 1]), fmaxf(p[r + 2], p[r + 3])));
    rm = swap_max(rm);
    const float dl = first ? ((rm > -1e29f) ? rm : 0.f) : ((rm > FL_THR) ? rm : 0.f);
    if (__any(dl != 0.f)) { const float al = first ? 1.f : __builtin_amdgcn_exp2f(-dl); l *= al;     o[0] *= al; o[1] *= al;
#pragma unroll
        for (int r = 0; r < 16; ++r) p[r] -= dl; }
    m = first ? ((rm > -1e29f) ? rm : m) : m + dl;
    float ls = 0.f;
#pragma unroll
    for (int r = 0; r < 16; ++r) { p[r] = __builtin_amdgcn_exp2f(p[r]); ls += p[r]; }
    l += ls;
    typedef unsigned u4 __attribute__((ext_vector_type(4)));
    u4 w0, w1; w0.x = cvtpk(p[0], p[1]); w0.y = cvtpk(p[2], p[3]); w0.z = cvtpk(p[4], p[5]); w0.w = cvtpk(p[6], p[7]);
    w1.x = cvtpk(p[8], p[9]); w1.y = cvtpk(p[10], p[11]); w1.z = cvtpk(p[12], p[13]); w1.w = cvtpk(p[14], p[15]);
    pa[0] = __builtin_bit_cast(bf16x8v, w0); pa[1] = __builtin_bit_cast(bf16x8v, w1);
}

__device__ __forceinline__ void fl_softmax2(f32x16& pa_, f32x16& pb_, float& m, float& l, f32x16 (&o)[2], bf16x8v (&pf)[4]) {
    const bool first = m < -1e29f;
    const float mref = first ? 0.f : m;
#pragma unroll
    for (int r = 0; r < 16; ++r) { pa_[r] -= mref; pb_[r] -= mref; }
    float rm = fmaxf(fmaxf(pa_[0], pa_[1]), fmaxf(pb_[0], pb_[1]));
#pragma unroll
    for (int r = 2; r < 16; r += 2) rm = fmaxf(rm, fmaxf(fmaxf(pa_[r], pa_[r + 1]), fmaxf(pb_[r], pb_[r + 1])));
    rm = swap_max(rm);
    const float dl = first ? ((rm > -1e29f) ? rm : 0.f) : ((rm > FL_THR) ? rm : 0.f);
    if (__any(dl != 0.f)) { const float al = first ? 1.f : __builtin_amdgcn_exp2f(-dl); l *= al; o[0] *= al; o[1] *= al;
#pragma unroll
        for (int r = 0; r < 16; ++r) { pa_[r] -= dl; pb_[r] -= dl; } }
    m = first ? ((rm > -1e29f) ? rm : m) : m + dl;
    float ls0 = 0.f, ls1 = 0.f;
#pragma unroll
    for (int r = 0; r < 16; ++r) { pa_[r] = __builtin_amdgcn_exp2f(pa_[r]); ls0 += pa_[r]; pb_[r] = __builtin_amdgcn_exp2f(pb_[r]); ls1 += pb_[r]; }
    l += ls0 + ls1;
    typedef unsigned u4 __attribute__((ext_vector_type(4)));
    u4 w;
    w.x = cvtpk(pa_[0], pa_[1]); w.y = cvtpk(pa_[2], pa_[3]); w.z = cvtpk(pa_[4], pa_[5]); w.w = cvtpk(pa_[6], pa_[7]); pf[0] = __builtin_bit_cast(bf16x8v, w);
    w.x = cvtpk(pa_[8], pa_[9]); w.y = cvtpk(pa_[10], pa_[11]); w.z = cvtpk(pa_[12], pa_[13]); w.w = cvtpk(pa_[14], pa_[15]); pf[1] = __builtin_bit_cast(bf16x8v, w);
    w.x = cvtpk(pb_[0], pb_[1]); w.y = cvtpk(pb_[2], pb_[3]); w.z = cvtpk(pb_[4], pb_[5]); w.w = cvtpk(pb_[6], pb_[7]); pf[2] = __builtin_bit_cast(bf16x8v, w);
    w.x = cvtpk(pb_[8], pb_[9]); w.y = cvtpk(pb_[10], pb_[11]); w.z = cvtpk(pb_[12], pb_[13]); w.w = cvtpk(pb_[14], pb_[15]); pf[3] = __builtin_bit_cast(bf16x8v, w);
}

__device__ __forceinline__ void fl_softmax3(f32x16& pa_, f32x16& pb_, float sha, float shb, float& m, float& l, f32x16 (&o)[2], bf16x8v (&pf)[4]) {
    const bool first = m < -1e29f;
    const float mref = first ? 0.f : m, ca = sha - mref, cb = shb - mref;
#pragma unroll
    for (int r = 0; r < 16; ++r) { pa_[r] += ca; pb_[r] += cb; }
    float rm = fmaxf(fmaxf(pa_[0], pa_[1]), fmaxf(pb_[0], pb_[1]));
#pragma unroll
    for (int r = 2; r < 16; r += 2) rm = fmaxf(rm, fmaxf(fmaxf(pa_[r], pa_[r + 1]), fmaxf(pb_[r], pb_[r + 1])));
    rm = swap_max(rm);
    const float dl = first ? ((rm > -1e29f) ? rm : 0.f) : ((rm > FL_THR) ? rm : 0.f);
    if (__any(dl != 0.f)) { const float al = first ? 1.f : __builtin_amdgcn_exp2f(-dl); l *= al; o[0] *= al; o[1] *= al;
#pragma unroll
        for (int r = 0; r < 16; ++r) { pa_[r] -= dl; pb_[r] -= dl; } }
    m = first ? ((rm > -1e29f) ? rm : m) : m + dl;
    float ls0 = 0.f, ls1 = 0.f;
#pragma unroll
    for (int r = 0; r < 16; ++r) { pa_[r] = __builtin_amdgcn_exp2f(pa_[r]); ls0 += pa_[r]; pb_[r] = __builtin_amdgcn_exp2f(pb_[r]); ls1 += pb_[r]; }
    l += ls0 + ls1;
    typedef unsigned u4 __attribute__((ext_vector_type(4)));
    u4 w;
    w.x = cvtpk(pa_[0], pa_[1]); w.y = cvtpk(pa_[2], pa_[3]); w.z = cvtpk(pa_[4], pa_[5]); w.w = cvtpk(pa_[6], pa_[7]); pf[0] = __builtin_bit_cast(bf16x8v, w);
    w.x = cvtpk(pa_[8], pa_[9]); w.y = cvtpk(pa_[10], pa_[11]); w.z = cvtpk(pa_[12], pa_[13]); w.w = cvtpk(pa_[14], pa_[15]); pf[1] = __builtin_bit_cast(bf16x8v, w);
    w.x = cvtpk(pb_[0], pb_[1]); w.y = cvtpk(pb_[2], pb_[3]); w.z = cvtpk(pb_[4], pb_[5]); w.w = cvtpk(pb_[6], pb_[7]); pf[2] = __builtin_bit_cast(bf16x8v, w);
    w.x = cvtpk(pb_[8], pb_[9]); w.y = cvtpk(pb_[10], pb_[11]); w.z = cvtpk(pb_[12], pb_[13]); w.w = cvtpk(pb_[14], pb_[15]); pf[3] = __builtin_bit_cast(bf16x8v, w);
}
__device__ __forceinline__ float fl_rowsum(const bf16x8v (&pf)[4]) {
    const bf16x8v ones = (bf16x8v){0x3f80, 0x3f80, 0x3f80, 0x3f80, 0x3f80, 0x3f80, 0x3f80, 0x3f80};
    f32x16 z;
#pragma unroll
    for (int r = 0; r < 16; ++r) z[r] = 0.f;
    z = __builtin_amdgcn_mfma_f32_32x32x16_bf16(ones, pf[0], z, 0, 0, 0); z = __builtin_amdgcn_mfma_f32_32x32x16_bf16(ones, pf[1], z, 0, 0, 0);
    z = __builtin_amdgcn_mfma_f32_32x32x16_bf16(ones, pf[2], z, 0, 0, 0); z = __builtin_amdgcn_mfma_f32_32x32x16_bf16(ones, pf[3], z, 0, 0, 0);
    return z[0];
}

template <int MODE> __device__ __forceinline__ void flash_unit(const bf16* Z, bf16* MIX, LAS unsigned char* L, int b, int h, int qb, float lam_full, float lambda_init, const float* subg, int tid, int wave, int lane) {
    lane = lane_now(); tid = wave * 64 + lane;
    constexpr int NMAP = MODE == 0 ? 2 : 1, KS = 4 / NMAP;
    constexpr int CQ = MODE == 0 ? ZC_QB : ZC_QC, CK = MODE == 0 ? ZC_KB : ZC_KC, CV = MODE == 0 ? ZC_VB : ZC_VC;
    const int r32 = lane & 31, hi = lane >> 5;
    LAS unsigned char* Kb = L + FL_K; LAS unsigned char* Vb = L + FL_V; LAS float* tab = (LAS float*)(L + FL_TAB);
    const int Q0 = qb * 256, tq0 = Q0 + wave * 32, t = tq0 + r32;
    const bf16* zb = Z + (size_t)(b * SEQ) * ZC;
    const float sl = (MODE == 0 ? __builtin_amdgcn_exp2f(-2.f * (float)(h + 1)) : __builtin_amdgcn_exp2f(-(float)(h + 1))) * LOG2E;
    for (int j = tid; j < FL_TABN; j += NWAVES * 64) { const int d = 2047 - j; float v;
        if (MODE == 0) v = d < 0 ? -INFINITY : -sl * (float)d;
        else { const int mult = (d <= 128 ? 1 : 0) + (((d & 3) == 0 && d <= 512) ? 1 : 0) + ((d & 15) == 0 ? 1 : 0);
               v = (d < 0 || mult == 0) ? -INFINITY : -sl * (float)d + (mult == 1 ? 0.f : (mult == 2 ? 1.f : 1.5849625007211562f)); }
        tab[j] = v; }
    bf16x8v qf[NMAP][KS];
#pragma unroll
    for (int mp = 0; mp < NMAP; ++mp)
#pragma unroll
        for (int ks = 0; ks < KS; ++ks) qf[mp][ks] = *(const bf16x8v*)(zb + (size_t)t * ZC + CQ + h * 64 + (mp * KS + ks) * 16 + hi * 8);
    constexpr int NCLS = MODE == 0 ? 1 : 3;
    f32x16 cin[NCLS];
#pragma unroll
    for (int r = 0; r < 16; ++r) { const int cr = (r & 3) + 8 * (r >> 2) + 4 * hi; const float a = sl * (float)cr;
        if (MODE == 0) cin[0][r] = a;
        else { const bool m4 = ((t - cr) & 3) == 0, m16 = ((t - cr) & 15) == 0;
            cin[0][r] = a + (m16 ? 1.5849625007211562f : (m4 ? 1.f : 0.f)); cin[NCLS - 2][r] = m4 ? a + (m16 ? 1.f : 0.f) : -INFINITY; cin[NCLS - 1][r] = m16 ? a : -INFINITY; } }
    float m[NMAP], l[NMAP]; f32x16 o[NMAP][2];
#pragma unroll
    for (int mp = 0; mp < NMAP; ++mp) { m[mp] = -1e30f; l[mp] = 0.f;
#pragma unroll
        for (int r = 0; r < 16; ++r) { o[mp][0][r] = 0.f; o[mp][1][r] = 0.f; } }
    const int skey = tid >> 3, sc = tid & 7;
    const bf16* ksrc = zb + (size_t)skey * ZC + CK + h * 64 + sc * 8;
    const bf16* vsrc = zb + (size_t)skey * ZC + CV + h * 64 + sc * 8;
    const int kdst = (sc >> 1) * 2048 + (sc & 1) * 1024 + (skey >> 5) * 512 + (skey & 31) * 16;
    const int vdst = (sc >> 2) * 4096 + (skey >> 3) * 512 + (skey & 7) * 64 + (sc & 3) * 16;
    const int krd = hi * 1024 + r32 * 16;
    const int vrd = ((lane >> 4) & 1) * 32 + (lane & 3) * 8 + (4 * hi + ((lane & 15) >> 2)) * 64;
    int tilz = 64 * ZC; asm volatile("" : "+s"(tilz));
    int jt = Q0 / 64 + 3;
    v4u kA = *(const v4u*)(ksrc + (size_t)(jt * tilz)), vA = *(const v4u*)(vsrc + (size_t)(jt * tilz));
    v4u kB = *(const v4u*)(ksrc + (size_t)((jt - 1) * tilz)), vB = *(const v4u*)(vsrc + (size_t)((jt - 1) * tilz));
    *(LAS v4u*)(Kb + (jt & 1) * 8192 + kdst) = kA; *(LAS v4u*)(Vb + (jt & 1) * 8192 + vdst) = vA;
    __syncthreads();
#define FL_TILE(JT, KW, VW, KL, VL) do { const int jt_ = (JT); \
        if (jt_ >= 2) { KL = *(const v4u*)(ksrc + (size_t)((jt_ - 2) * tilz)); VL = *(const v4u*)(vsrc + (size_t)((jt_ - 2) * tilz)); } \
        const LAS unsigned char* Kc = Kb + (jt_ & 1) * 8192; const LAS unsigned char* Vc = Vb + (jt_ & 1) * 8192; \
        if (jt_ * 64 <= tq0) {                                            \
              \
            const LAS float* tp = tab + (2047 - t + jt_ * 64 + 4 * hi); \
            f32x16 bias0, bias1; \
            _Pragma("unroll") for (int r = 0; r < 16; ++r) { bias0[r] = tp[(r & 3) + 8 * (r >> 2)]; bias1[r] = tp[32 + (r & 3) + 8 * (r >> 2)]; } \
            _Pragma("unroll") for (int mp = 0; mp < NMAP; ++mp) { \
                f32x16 p0 = bias0, p1 = bias1; \
                _Pragma("unroll") for (int ks = 0; ks < KS; ++ks) { const bf16x8v kf0 = *(const LAS bf16x8v*)(Kc + (mp * KS + ks) * 2048 + krd), kf1 = *(const LAS bf16x8v*)(Kc + (mp * KS + ks) * 2048 + 512 + krd); \
                    p0 = __builtin_amdgcn_mfma_f32_32x32x16_bf16(kf0, qf[mp][ks], p0, 0, 0, 0); p1 = __builtin_amdgcn_mfma_f32_32x32x16_bf16(kf1, qf[mp][ks], p1, 0, 0, 0); } \
                bf16x8v pf[4]; \
                fl_softmax3(p0, p1, 0.f, 0.f, m[mp], l[mp], o[mp], pf); \
                _Pragma("unroll") for (int s4 = 0; s4 < 4; ++s4) _Pragma("unroll") for (int db = 0; db < 2; ++db) { const LAS unsigned char* vp = Vc + db * 4096 + s4 * 1024 + vrd; \
                        const s16x4 lo = lds_tr(vp), hh = lds_tr(vp + 512); \
                        const bf16x8v vf = (bf16x8v){lo[0], lo[1], lo[2], lo[3], hh[0], hh[1], hh[2], hh[3]}; \
                        o[mp][db] = __builtin_amdgcn_mfma_f32_32x32x16_bf16(vf, pf[s4], o[mp][db], 0, 0, 0); } } \
        } \
        if (jt_ >= 1) { *(LAS v4u*)(Kb + ((jt_ - 1) & 1) * 8192 + kdst) = KW; *(LAS v4u*)(Vb + ((jt_ - 1) & 1) * 8192 + vdst) = VW; } \
        __syncthreads(); } while (0)
    for (; jt >= 0; jt -= 2) { FL_TILE(jt, kB, vB, kA, vA); FL_TILE(jt - 1, kA, vA, kB, vB); }
#undef FL_TILE
    bf16* orow = MIX + (size_t)(b * SEQ + t) * DM + (MODE == 0 ? 256 : 512) + h * 64 + 4 * hi;
    if (MODE == 0) {
        const float i0 = 1.f / swap_sum(l[0]), i1 = lam_full / swap_sum(l[NMAP - 1]); float ss = 0.f;
#pragma unroll
        for (int db = 0; db < 2; ++db)
#pragma unroll
            for (int r = 0; r < 16; ++r) { const float v = o[0][db][r] * i0 - o[NMAP - 1][db][r] * i1; o[0][db][r] = v; ss += v * v; }
        const float rs = (1.f / sqrtf(swap_sum(ss) * (1.f / 64.f) + LN_EPS)) * lambda_init;
#pragma unroll
        for (int db = 0; db < 2; ++db)
#pragma unroll
            for (int rg = 0; rg < 4; ++rg) { const f32x4 g = *(const f32x4*)(subg + 32 * db + 8 * rg + 4 * hi);
                v2u w; w.x = cvtpk(o[0][db][4 * rg + 0] * rs * g.x, o[0][db][4 * rg + 1] * rs * g.y); w.y = cvtpk(o[0][db][4 * rg + 2] * rs * g.z, o[0][db][4 * rg + 3] * rs * g.w);
                *(v2u*)(orow + 32 * db + 8 * rg) = w; }
    } else {
        const float i0 = 1.f / swap_sum(l[0]);
#pragma unroll
        for (int db = 0; db < 2; ++db)
#pragma unroll
            for (int rg = 0; rg < 4; ++rg) { v2u w; w.x = cvtpk(o[0][db][4 * rg + 0] * i0, o[0][db][4 * rg + 1] * i0); w.y = cvtpk(o[0][db][4 * rg + 2] * i0, o[0][db][4 * rg + 3] * i0);
                *(v2u*)(orow + 32 * db + 8 * rg) = w; }
    }
}
template <int MODE> __device__ __forceinline__ void flash_phase(const bf16* Z, bf16* MIX, LAS unsigned char* L, const float* lam, const float* subg, float lambda_init, int vcu, int G, int tid, int wave, int lane) {
    asm volatile("" : "+v"(tid), "+v"(lane));
    constexpr int NH = MODE == 0 ? 4 : 8, NPAIR = BATCH * NH * 4;
    float lam_full = 0.f;
    if (MODE == 0) { const int li = lane & 31; const float s01 = wave_sum(lam[li] * lam[32 + li], lane) * 0.5f, s23 = wave_sum(lam[64 + li] * lam[96 + li], lane) * 0.5f; lam_full = __int_as_float(__builtin_amdgcn_readfirstlane(__float_as_int(expf(s01) - expf(s23) + lambda_init))); }
    const float oml = __int_as_float(__builtin_amdgcn_readfirstlane(__float_as_int(1.f - lambda_init)));
    for (int p = vcu; p < NPAIR; p += G) {
        const int b = p / (NH * 4), h = (p >> 2) % NH, x = p & 3;
#pragma unroll 1
        for (int k = 0; k < 2; ++k) { flash_unit<MODE>(Z, MIX, L, b, h, k == 0 ? 7 - x : x, lam_full, oml, subg, tid, wave, lane); __syncthreads(); }
    }
}
constexpr int F2_K = 0, F2_V = 24576, F2_TAB = 40960;
#define F2_QK(S, KSLOT, MP, JT) do { const LAS float* tp_ = tab + (2047 - t + (JT) * 64 + 4 * hi); const LAS unsigned char* kc_ = Kb + (KSLOT) * 8192; \
        _Pragma("unroll") for (int r = 0; r < 16; ++r) { S[0][r] = tp_[(r & 3) + 8 * (r >> 2)]; S[1][r] = tp_[32 + (r & 3) + 8 * (r >> 2)]; } \
        _Pragma("unroll") for (int ks = 0; ks < KS; ++ks) { const bf16x8v k0_ = *(const LAS bf16x8v*)(kc_ + ((MP) * KS + ks) * 2048 + krd), k1_ = *(const LAS bf16x8v*)(kc_ + ((MP) * KS + ks) * 2048 + 512 + krd); \
            S[0] = __builtin_amdgcn_mfma_f32_32x32x16_bf16(k0_, qf[MP][ks], S[0], 0, 0, 0); S[1] = __builtin_amdgcn_mfma_f32_32x32x16_bf16(k1_, qf[MP][ks], S[1], 0, 0, 0); } } while (0)
#define F2_BD(S, MP) do { float rm_ = fmaxf(fmaxf(S[0][0], S[0][1]), fmaxf(S[1][0], S[1][1])); \
        _Pragma("unroll") for (int r = 2; r < 16; r += 2) rm_ = fmaxf(rm_, fmaxf(fmaxf(S[0][r], S[0][r + 1]), fmaxf(S[1][r], S[1][r + 1]))); \
        rm_ = swap_max(rm_); const bool first_ = m[MP] < -1e29f; \
        const bool up_ = first_ ? (rm_ > -1e29f) : (rm_ > m[MP] + FL_THR); \
        if (__any(up_)) { const float nm_ = up_ ? rm_ : m[MP], al_ = (first_ || !up_) ? 1.f : __builtin_amdgcn_exp2f(m[MP] - nm_); l[MP] *= al_; o[MP][0] *= al_; o[MP][1] *= al_; m[MP] = nm_; } } while (0)
#define F2_SM(S, MP, PF) do { const float nm_ = -m[MP]; float ls0_ = 0.f, ls1_ = 0.f; \
        _Pragma("unroll") for (int r = 0; r < 16; ++r) { S[0][r] = __builtin_amdgcn_exp2f(S[0][r] + nm_); ls0_ += S[0][r]; S[1][r] = __builtin_amdgcn_exp2f(S[1][r] + nm_); ls1_ += S[1][r]; } \
        l[MP] += ls0_ + ls1_; \
        { typedef unsigned u4_ __attribute__((ext_vector_type(4))); u4_ w_; \
          w_.x = cvtpk(S[0][0], S[0][1]); w_.y = cvtpk(S[0][2], S[0][3]); w_.z = cvtpk(S[0][4], S[0][5]); w_.w = cvtpk(S[0][6], S[0][7]); PF[0] = __builtin_bit_cast(bf16x8v, w_); \
          w_.x = cvtpk(S[0][8], S[0][9]); w_.y = cvtpk(S[0][10], S[0][11]); w_.z = cvtpk(S[0][12], S[0][13]); w_.w = cvtpk(S[0][14], S[0][15]); PF[1] = __builtin_bit_cast(bf16x8v, w_); \
          w_.x = cvtpk(S[1][0], S[1][1]); w_.y = cvtpk(S[1][2], S[1][3]); w_.z = cvtpk(S[1][4], S[1][5]); w_.w = cvtpk(S[1][6], S[1][7]); PF[2] = __builtin_bit_cast(bf16x8v, w_); \
          w_.x = cvtpk(S[1][8], S[1][9]); w_.y = cvtpk(S[1][10], S[1][11]); w_.z = cvtpk(S[1][12], S[1][13]); w_.w = cvtpk(S[1][14], S[1][15]); PF[3] = __builtin_bit_cast(bf16x8v, w_); } } while (0)
#define F2_PV(MP, VSLOT, PF) do { const LAS unsigned char* vc_ = Vb + (VSLOT) * 8192; \
        _Pragma("unroll") for (int s4 = 0; s4 < 4; ++s4) _Pragma("unroll") for (int db = 0; db < 2; ++db) { const LAS unsigned char* vp_ = vc_ + db * 4096 + s4 * 1024 + vrd; \
            const s16x4 lo_ = lds_tr(vp_), hh_ = lds_tr(vp_ + 512); const bf16x8v vf_ = (bf16x8v){lo_[0], lo_[1], lo_[2], lo_[3], hh_[0], hh_[1], hh_[2], hh_[3]}; \
            o[MP][db] = __builtin_amdgcn_mfma_f32_32x32x16_bf16(vf_, PF[s4], o[MP][db], 0, 0, 0); } } while (0)

template <int MODE> __device__ __forceinline__ void flash_unit2(const bf16* Z, bf16* MIX, LAS unsigned char* L, int b, int h, int qb, float lam_full, float lambda_init, const float* subg, int wave) {
    const int lane = lane_now(), tid = wave * 64 + lane;
    constexpr int NMAP = MODE == 0 ? 2 : 1, KS = 4 / NMAP;
    constexpr int CQ = MODE == 0 ? ZC_QB : ZC_QC, CK = MODE == 0 ? ZC_KB : ZC_KC, CV = MODE == 0 ? ZC_VB : ZC_VC;
    const int r32 = lane & 31, hi = lane >> 5;
    LAS unsigned char* Kb = L + F2_K; LAS unsigned char* Vb = L + F2_V; LAS float* tab = (LAS float*)(L + F2_TAB);
    const int Q0 = qb * 256, tq0 = Q0 + wave * 32, t = tq0 + r32, Jw = tq0 >> 6;
    const bf16* zb = Z + (size_t)(b * SEQ) * ZC;
    const float sl = (MODE == 0 ? __builtin_amdgcn_exp2f(-2.f * (float)(h + 1)) : __builtin_amdgcn_exp2f(-(float)(h + 1))) * LOG2E;
    for (int j = tid; j < FL_TABN; j += NWAVES * 64) { const int d = 2047 - j; float v;
        if (MODE == 0) v = d < 0 ? -INFINITY : -sl * (float)d;
        else { const int mult = (d <= 128 ? 1 : 0) + (((d & 3) == 0 && d <= 512) ? 1 : 0) + ((d & 15) == 0 ? 1 : 0);
               v = (d < 0 || mult == 0) ? -INFINITY : -sl * (float)d + (mult == 1 ? 0.f : (mult == 2 ? 1.f : 1.5849625007211562f)); }
        tab[j] = v; }
    bf16x8v qf[NMAP][KS];
#pragma unroll
    for (int mp = 0; mp < NMAP; ++mp)
#pragma unroll
        for (int ks = 0; ks < KS; ++ks) qf[mp][ks] = *(const bf16x8v*)(zb + (size_t)t * ZC + CQ + h * 64 + (mp * KS + ks) * 16 + hi * 8);
    float m[NMAP], l[NMAP]; f32x16 o[NMAP][2];
#pragma unroll
    for (int mp = 0; mp < NMAP; ++mp) { m[mp] = -1e30f; l[mp] = 0.f;
#pragma unroll
        for (int r = 0; r < 16; ++r) { o[mp][0][r] = 0.f; o[mp][1][r] = 0.f; } }
    const int skey = tid >> 3, sc = tid & 7;
    const bf16* ksrc = zb + (size_t)skey * ZC + CK + h * 64 + sc * 8;
    const bf16* vsrc = zb + (size_t)skey * ZC + CV + h * 64 + sc * 8;
    const int kdst = (sc >> 1) * 2048 + (sc & 1) * 1024 + (skey >> 5) * 512 + (skey & 31) * 16;
    const int vdst = (sc >> 2) * 4096 + (skey >> 3) * 512 + (skey & 7) * 64 + (sc & 3) * 16;
    const int krd = hi * 1024 + r32 * 16;
    const int vrd = ((lane >> 4) & 1) * 32 + (lane & 3) * 8 + (4 * hi + ((lane & 15) >> 2)) * 64;
    const size_t til = (size_t)64 * ZC;
    const int J = Q0 / 64 + 3;
    int k0s = J % 3, k1s = (J + 2) % 3, k2s = (J + 1) % 3;
    { const v4u a = *(const v4u*)(ksrc + J * til), bq = *(const v4u*)(ksrc + (J - 1) * til), c = *(const v4u*)(vsrc + J * til);
      *(LAS v4u*)(Kb + k0s * 8192 + kdst) = a; *(LAS v4u*)(Kb + k1s * 8192 + kdst) = bq; *(LAS v4u*)(Vb + (J & 1) * 8192 + vdst) = c; }
    v4u kA = *(const v4u*)(ksrc + (J - 2) * til), vA = *(const v4u*)(vsrc + (J - 1) * til);
    v4u kB = kA, vB = vA;
    __syncthreads();
    f32x16 Sa[2], Sb[2];
    if (J <= Jw) { F2_QK(Sa, k0s, 0, J); F2_BD(Sa, 0); }
#define F2_TILE(JT, KW, VW, KL, VL, SC, SN) do { const int jt_ = (JT); \
        if (jt_ >= 3) KL = *(const v4u*)(ksrc + (jt_ - 3) * til); if (jt_ >= 2) VL = *(const v4u*)(vsrc + (jt_ - 2) * til); \
        if (MODE == 1) { \
            if (jt_ <= Jw && jt_ >= 1) { bf16x8v pf_[4]; if (wave >= 4) { F2_SM(SC, 0, pf_); F2_PV(0, jt_ & 1, pf_); F2_QK(SN, k1s, 0, jt_ - 1); F2_BD(SN, 0); } else { F2_QK(SN, k1s, 0, jt_ - 1); F2_SM(SC, 0, pf_); F2_PV(0, jt_ & 1, pf_); F2_BD(SN, 0); } } \
            else if (jt_ == Jw + 1) { F2_QK(SN, k1s, 0, jt_ - 1); F2_BD(SN, 0); } \
            else if (jt_ <= Jw) { bf16x8v pf_[4]; F2_SM(SC, 0, pf_); F2_PV(0, jt_ & 1, pf_); } \
        } else { \
            if (jt_ <= Jw) { bf16x8v pf_[4]; F2_QK(Sb, k0s, NMAP - 1, jt_); F2_SM(Sa, 0, pf_); F2_PV(0, jt_ & 1, pf_); F2_BD(Sb, NMAP - 1); } \
            if (jt_ <= Jw + 1 && jt_ >= 1) { F2_QK(Sa, k1s, 0, jt_ - 1); } \
            if (jt_ <= Jw) { bf16x8v pf_[4]; F2_SM(Sb, NMAP - 1, pf_); F2_PV(NMAP - 1, jt_ & 1, pf_); } \
            if (jt_ <= Jw + 1 && jt_ >= 1) { F2_BD(Sa, 0); } \
        } \
        if (jt_ >= 2) *(LAS v4u*)(Kb + k2s * 8192 + kdst) = KW; if (jt_ >= 1) *(LAS v4u*)(Vb + ((jt_ - 1) & 1) * 8192 + vdst) = VW; \
        { const int t_ = k0s; k0s = k1s; k1s = k2s; k2s = t_; } \
        __syncthreads(); } while (0)
    for (int jt = J; jt >= 0; jt -= 2) { F2_TILE(jt, kA, vA, kB, vB, Sa, Sb); F2_TILE(jt - 1, kB, vB, kA, vA, Sb, Sa); }
#undef F2_TILE
    bf16* orow = MIX + (size_t)(b * SEQ + t) * DM + (MODE == 0 ? 256 : 512) + h * 64 + 4 * hi;
    if (MODE == 0) {
        const float i0 = 1.f / swap_sum(l[0]), i1 = lam_full / swap_sum(l[NMAP - 1]); float ss = 0.f;
#pragma unroll
        for (int db = 0; db < 2; ++db)
#pragma unroll
            for (int r = 0; r < 16; ++r) { const float v = o[0][db][r] * i0 - o[NMAP - 1][db][r] * i1; o[0][db][r] = v; ss += v * v; }
        const float rs = (1.f / sqrtf(swap_sum(ss) * (1.f / 64.f) + LN_EPS)) * (1.f - lambda_init);
#pragma unroll
        for (int db = 0; db < 2; ++db)
#pragma unroll
            for (int rg = 0; rg < 4; ++rg) { const f32x4 g = *(const f32x4*)(subg + 32 * db + 8 * rg + 4 * hi);
                v2u w; w.x = cvtpk(o[0][db][4 * rg + 0] * rs * g.x, o[0][db][4 * rg + 1] * rs * g.y); w.y = cvtpk(o[0][db][4 * rg + 2] * rs * g.z, o[0][db][4 * rg + 3] * rs * g.w);
                *(v2u*)(orow + 32 * db + 8 * rg) = w; }
    } else {
        const float i0 = 1.f / swap_sum(l[0]);
#pragma unroll
        for (int db = 0; db < 2; ++db)
#pragma unroll
            for (int rg = 0; rg < 4; ++rg) { v2u w; w.x = cvtpk(o[0][db][4 * rg + 0] * i0, o[0][db][4 * rg + 1] * i0); w.y = cvtpk(o[0][db][4 * rg + 2] * i0, o[0][db][4 * rg + 3] * i0);
                *(v2u*)(orow + 32 * db + 8 * rg) = w; }
    }
}
template <int MODE> __device__ __forceinline__ void flash_phase2(const bf16* Z, bf16* MIX, LAS unsigned char* L, const float* lam, const float* subg, float lambda_init, int vcu, int G, int tid, int wave, int lane) {
    constexpr int NH = MODE == 0 ? 4 : 8, NPAIR = BATCH * NH * 4;
    float lam_full = 0.f;
    if (MODE == 0) { const int li = lane & 31; const float s01 = wave_sum(lam[li] * lam[32 + li], lane) * 0.5f, s23 = wave_sum(lam[64 + li] * lam[96 + li], lane) * 0.5f; lam_full = expf(s01) - expf(s23) + lambda_init; }
    for (int p = vcu; p < NPAIR; p += G) {
        const int b = p / (NH * 4), h = (p >> 2) % NH, x = p & 3;
#pragma unroll 1
        for (int k = 0; k < 2; ++k) { flash_unit2<MODE>(Z, MIX, L, b, h, k == 0 ? 7 - x : x, lam_full, lambda_init, subg, wave); __syncthreads(); }
    }
}
constexpr int MA_K = 0, MA_V = 32768, MA_BM = 65536, MA_BMS = 68  , MA_WQ = MA_BM + 32 * MA_BMS * 4, MA_MG = MA_WQ + 512, MA_SEL = MA_MG + 4 * 34 * 64 * 4, MA_END = MA_SEL + NWAVES * 2560;
static_assert(MA_END <= RING_BYTES, "mixer A LDS map");

__device__ __forceinline__ unsigned ordkey(float f) { const unsigned u = __float_as_uint(f); return u ^ ((unsigned)((int)u >> 31) | 0x80000000u); }
#define DPP_I(v, ctrl) __builtin_amdgcn_update_dpp(0, (v), (ctrl), 0xf, 0xf, false)
__device__ __forceinline__ float wave_max_dpp(float v) {
    v = fmaxf(v, __int_as_float(DPP_I(__float_as_int(v), 0xB1))); v = fmaxf(v, __int_as_float(DPP_I(__float_as_int(v), 0x4E)));
    v = fmaxf(v, __int_as_float(DPP_I(__float_as_int(v), 0x141))); v = fmaxf(v, __int_as_float(DPP_I(__float_as_int(v), 0x140)));
    const int i = __float_as_int(v);
    return fmaxf(fmaxf(__int_as_float(__builtin_amdgcn_readlane(i, 0)), __int_as_float(__builtin_amdgcn_readlane(i, 16))), fmaxf(__int_as_float(__builtin_amdgcn_readlane(i, 32)), __int_as_float(__builtin_amdgcn_readlane(i, 48))));
}
__device__ __forceinline__ float wave_min_dpp(float v) {
    v = fminf(v, __int_as_float(DPP_I(__float_as_int(v), 0xB1))); v = fminf(v, __int_as_float(DPP_I(__float_as_int(v), 0x4E)));
    v = fminf(v, __int_as_float(DPP_I(__float_as_int(v), 0x141))); v = fminf(v, __int_as_float(DPP_I(__float_as_int(v), 0x140)));
    const int i = __float_as_int(v);
    return fminf(fminf(__int_as_float(__builtin_amdgcn_readlane(i, 0)), __int_as_float(__builtin_amdgcn_readlane(i, 16))), fminf(__int_as_float(__builtin_amdgcn_readlane(i, 32)), __int_as_float(__builtin_amdgcn_readlane(i, 48))));
}
__device__ __forceinline__ int wave_prefix_dpp(int x, int lane) {
    x += DPP_I(x, 0x111); x += DPP_I(x, 0x112); x += DPP_I(x, 0x114); x += DPP_I(x, 0x118);
    const int t0 = __builtin_amdgcn_readlane(x, 15), t1 = __builtin_amdgcn_readlane(x, 31), t2 = __builtin_amdgcn_readlane(x, 47);
    return x + (lane >= 16 ? t0 : 0) + (lane >= 32 ? t1 : 0) + (lane >= 48 ? t2 : 0);
}
template <int NJ> __device__ __forceinline__ void select_load(const float* srow, int t, int lane, float (&raw)[NJ]) {
#pragma unroll
    for (int j = 0; j < NJ; ++j) { const int kx = 64 * j + lane; raw[j] = srow[kx < t ? kx : t]; }
}
template <int NJ> __device__ __forceinline__ unsigned select_row_t(const float (&raw)[NJ], int t, LAS unsigned* hist, LAS unsigned* clist, int lane) {
    float f[NJ]; int bn[NJ];
    float NINF = -INFINITY, PINF = INFINITY; int C255 = 255; asm volatile("" : "+v"(NINF), "+v"(PINF), "+v"(C255));
    float vmax = NINF, vmin = PINF;
#pragma unroll
    for (int j = 0; j < NJ; ++j) { const int kx = 64 * j + lane; const float v = raw[j] + 0.0f; const bool ok = kx <= t; f[j] = ok ? v : NINF; vmax = fmaxf(vmax, f[j]); vmin = fminf(vmin, ok ? v : PINF); }
    vmax = wave_max_dpp(vmax); vmin = wave_min_dpp(vmin);
    const float scale = 255.99f / (vmax - vmin);
    { unsigned z_ = 0u; asm volatile("" : "+v"(z_)); ((LAS v4u*)hist)[lane] = (v4u){z_, z_, z_, z_}; }
#pragma unroll
    for (int j = 0; j < NJ; ++j) { int bi = (int)((f[j] - vmin) * scale); bi = bi > C255 ? C255 : bi; bi = bi < 0 ? 0 : bi; bn[j] = (64 * j + lane <= t) ? bi : -1;
        if (bn[j] >= 0) __hip_atomic_fetch_add(hist + bn[j], 1u, __ATOMIC_RELAXED, __HIP_MEMORY_SCOPE_WAVEFRONT); }
    LDS_WAIT();
    const v4u hv = ((const LAS v4u*)hist)[63 - lane];
    const int ssum = (int)(hv.x + hv.y + hv.z + hv.w);
    const int x = wave_prefix_dpp(ssum, lane);
    const int above = x - ssum; const bool found = above < 256 && x >= 256;
    int bsel, cab;
    { const int c3 = above + (int)hv.w, c2 = c3 + (int)hv.z, c1 = c2 + (int)hv.y; const int b0 = 4 * (63 - lane);
      if (c3 >= 256) { bsel = b0 + 3; cab = above; } else if (c2 >= 256) { bsel = b0 + 2; cab = c3; } else if (c1 >= 256) { bsel = b0 + 1; cab = c2; } else { bsel = b0; cab = c1; } }
    const unsigned long long fm = __ballot(found);
    const int src = (int)__builtin_ctzll(fm);
    const int bstar = __builtin_amdgcn_readlane(bsel, src), c_above = __builtin_amdgcn_readlane(cab, src);
    unsigned key[NJ];
#pragma unroll
    for (int j = 0; j < NJ; ++j) key[j] = ordkey(f[j]);
    int base = 0;
#pragma unroll
    for (int j = 0; j < NJ; ++j) { const bool isc = bn[j] == bstar; const unsigned long long cm = __ballot(isc); const int pos = base + mbcnt64(cm);
        clist[(isc && pos < 256) ? pos : 256 + lane] = key[j]; base += __popcll(cm); }
    LDS_WAIT();
    const int ncand = base, need = 256 - c_above;
    unsigned T = 0u; int cge;
    if (ncand <= 64) {
        const unsigned ck = lane < ncand ? clist[lane] : 0u;
        int g = 0, e = 0;
#pragma unroll 1
        for (int i = 0; i < ncand; ++i) { const unsigned sk = (unsigned)__builtin_amdgcn_readlane((int)ck, i); g += (sk > ck) ? 1 : 0; e += (sk == ck) ? 1 : 0; }
        const unsigned long long hit = __ballot(lane < ncand && g < need && need <= g + e);
        const int src2 = (int)__builtin_ctzll(hit);
        T = (unsigned)__builtin_amdgcn_readlane((int)ck, src2);
        cge = c_above + __builtin_amdgcn_readlane(g, src2) + __builtin_amdgcn_readlane(e, src2);
    } else if (ncand <= 256) {
        unsigned ck[4];
#pragma unroll
        for (int r = 0; r < 4; ++r) ck[r] = (r * 64 + lane < ncand) ? clist[r * 64 + lane] : 0u;
#pragma unroll 1
        for (int bit = 31; bit >= 0; --bit) { const unsigned cand = T | (1u << bit);
            const int cnt = __popcll(__ballot(ck[0] >= cand)) + __popcll(__ballot(ck[1] >= cand)) + __popcll(__ballot(ck[2] >= cand)) + __popcll(__ballot(ck[3] >= cand));
            if (cnt >= need) T = cand; }
        cge = c_above + __popcll(__ballot(ck[0] >= T)) + __popcll(__ballot(ck[1] >= T)) + __popcll(__ballot(ck[2] >= T)) + __popcll(__ballot(ck[3] >= T));
    } else {
#pragma unroll 1
        for (int bit = 31; bit >= 0; --bit) { const unsigned cand = T | (1u << bit); int cnt = 0;
#pragma unroll
            for (int j = 0; j < NJ; ++j) cnt += __popcll(__ballot(key[j] >= cand));
            if (cnt >= 256) T = cand; }
        cge = 0;
#pragma unroll
        for (int j = 0; j < NJ; ++j) cge += __popcll(__ballot(key[j] >= T));
    }
    unsigned w = 0u;
    if (cge == 256) {
#pragma unroll
        for (int j = NJ - 1; j >= 0; --j) w = w + w + (key[j] >= T ? 1u : 0u);
    } else {
        int cgt = 0;
#pragma unroll
        for (int j = 0; j < NJ; ++j) cgt += __popcll(__ballot(key[j] > T));
        const int need2 = 256 - cgt; int eqseen = 0;
#pragma unroll
        for (int j = 0; j < NJ; ++j) { const bool gt = key[j] > T, eq = key[j] == T; const unsigned long long em = __ballot(eq); const int er = eqseen + mbcnt64(em);
            w |= (gt || (eq && er < need2)) ? (1u << j) : 0u; eqseen += __popcll(em); }
    }
    return w;
}
constexpr int MB_K = 0, MB_V = 32768, MB_BM = 65536, MB_WQ = MB_BM + 64 * MA_BMS * 4, MB_SEL = MB_WQ + 1024, MB_END = MB_SEL + NWAVES * 2560;
static_assert(MB_END <= RING_BYTES, "mixer A (64-query units) LDS map");
template <int NJ> __device__ __forceinline__ void select8_t(const float* scr0, int t0, LAS unsigned* hist, LAS unsigned* clist, LAS unsigned* bmrow0, int lane) {
    float cur[NJ], nxt[NJ];
    select_load<NJ>(scr0, t0, lane, cur);
#pragma unroll 1
    for (int i = 0; i < 8; ++i) {
        const int t = t0 + i;
        if (i < 7) select_load<NJ>(scr0 + (size_t)(i + 1) * 2048, t + 1, lane, nxt);
        unsigned w;
        if (t < 256) { const int n = t + 1, nf = n >> 6; w = ((1u << nf) - 1u) | ((lane < (n & 63)) ? (1u << nf) : 0u); }
        else w = select_row_t<NJ>(cur, t, hist, clist, lane);
        bmrow0[i * MA_BMS + lane] = w;
#pragma unroll
        for (int j = 0; j < NJ; ++j) cur[j] = nxt[j];
    }
}
__device__ __forceinline__ void mixa_unit64(const bf16* Z, bf16* MIX, float* SCR, LAS unsigned char* L, int b, int qt64, int wave) {
    int lane = lane_now(), tid = wave * 64 + lane;
    int r32 = lane & 31, hi = lane >> 5; const int T0 = qt64 * 64;
    const bf16* zb = Z + (size_t)(b * SEQ) * ZC;
    LAS unsigned* bm = (LAS unsigned*)(L + MB_BM); LAS float* wq = (LAS float*)(L + MB_WQ);
    if (tid < 256) wq[tid] = bf1(zb[(size_t)(T0 + (tid >> 2)) * ZC + ZC_WI + (tid & 3)]);
    __syncthreads();
#pragma unroll 1
    for (int half = 0; half < 2; ++half) {
        const int Th = T0 + 32 * half;
        bf16x8v qi[4][4];
#pragma unroll
        for (int mt = 0; mt < 4; ++mt)
#pragma unroll
            for (int ks = 0; ks < 4; ++ks) qi[mt][ks] = *(const bf16x8v*)(zb + (size_t)(Th + 8 * mt + (r32 >> 2)) * ZC + ZC_QI + (r32 & 3) * 64 + ks * 16 + hi * 8);
        const int nkt = (Th >> 5) + 1;
        bf16x8v kn[4];
        if (wave < nkt) { const bf16* kr0 = zb + (size_t)(wave * 32 + r32) * ZC + ZC_KI + hi * 8;
#pragma unroll
            for (int ks = 0; ks < 4; ++ks) kn[ks] = *(const bf16x8v*)(kr0 + ks * 16); }
        for (int kt = wave; kt < nkt; kt += NWAVES) {
            const int key = kt * 32 + r32;
            bf16x8v kf[4];
#pragma unroll
            for (int ks = 0; ks < 4; ++ks) kf[ks] = kn[ks];
            if (kt + NWAVES < nkt) { const bf16* kr1 = zb + (size_t)((kt + NWAVES) * 32 + r32) * ZC + ZC_KI + hi * 8;
#pragma unroll
                for (int ks = 0; ks < 4; ++ks) kn[ks] = *(const bf16x8v*)(kr1 + ks * 16); }
#pragma unroll
            for (int mt = 0; mt < 4; ++mt) {
                f32x16 d;
#pragma unroll
                for (int r = 0; r < 16; ++r) d[r] = 0.f;
#pragma unroll
                for (int ks = 0; ks < 4; ++ks) d = __builtin_amdgcn_mfma_f32_32x32x16_bf16(qi[mt][ks], kf[ks], d, 0, 0, 0);
#pragma unroll
                for (int g = 0; g < 4; ++g) { const int q = 32 * half + 8 * mt + 2 * g + hi; const f32x4 w = *(const LAS f32x4*)(wq + 4 * q);
                    float s = fmaxf(d[4 * g + 0], 0.f) * w.x + fmaxf(d[4 * g + 1], 0.f) * w.y + fmaxf(d[4 * g + 2], 0.f) * w.z + fmaxf(d[4 * g + 3], 0.f) * w.w;
                    if (key > T0 + q) s = -INFINITY;
                    SCR[(size_t)q * 2048 + key] = s; }
            }
        }
    }
    asm volatile("s_waitcnt vmcnt(0)" ::: "memory");
    __syncthreads();
    {
        lane = lane_now();
        const int q0 = wave * 8, tl = __builtin_amdgcn_readfirstlane(T0 + q0 + 7);
        LAS unsigned* hs = (LAS unsigned*)(L + MB_SEL + wave * 2560);
        if (tl + 1 <= 512) select8_t<8>(SCR + (size_t)q0 * 2048, T0 + q0, hs, hs + 256, bm + q0 * MA_BMS, lane);
        else if (tl + 1 <= 1024) select8_t<16>(SCR + (size_t)q0 * 2048, T0 + q0, hs, hs + 256, bm + q0 * MA_BMS, lane);
        else if (tl + 1 <= 1536) select8_t<24>(SCR + (size_t)q0 * 2048, T0 + q0, hs, hs + 256, bm + q0 * MA_BMS, lane);
        else select8_t<32>(SCR + (size_t)q0 * 2048, T0 + q0, hs, hs + 256, bm + q0 * MA_BMS, lane);
    }
    lane = lane_now(); tid = wave * 64 + lane; r32 = lane & 31; hi = lane >> 5;
    int wv = wave; asm volatile("" : "+s"(wv));
    const int h = wv & 3, qh = wv >> 2, tq0 = T0 + 32 * qh, t = tq0 + r32;
    const float sl = __builtin_amdgcn_exp2f(-2.f * (float)(h + 1)) * LOG2E;
    bf16x8v qf[4];
#pragma unroll
    for (int ks = 0; ks < 4; ++ks) qf[ks] = *(const bf16x8v*)(zb + (size_t)t * ZC + ZC_QA + h * 64 + ks * 16 + hi * 8);
    float m = -1e30f, l = 0.f; f32x16 o[2];
    f32x16 cinA;
#pragma unroll
    for (int r = 0; r < 16; ++r) cinA[r] = sl * (float)((r & 3) + 8 * (r >> 2) + 4 * hi);
#pragma unroll
    for (int r = 0; r < 16; ++r) { o[0][r] = 0.f; o[1][r] = 0.f; }
    LAS unsigned char* Kb = L + MB_K; LAS unsigned char* Vb = L + MB_V;
    const int skey = tid >> 3, sc = tid & 7;
    const bf16* ksrc = zb + (size_t)skey * ZC + ZC_KA + sc * 8;
    const bf16* vsrc = zb + (size_t)skey * ZC + ZC_VA + sc * 8;
    const int kdst = (sc >> 1) * 2048 + (sc & 1) * 1024 + (skey >> 5) * 512 + (skey & 31) * 16;
    const int vdst = (sc >> 2) * 4096 + (skey >> 3) * 512 + (skey & 7) * 64 + (sc & 3) * 16;
    const int krd = hi * 1024 + r32 * 16;
    const int vrd = ((lane >> 4) & 1) * 32 + (lane & 3) * 8 + (4 * hi + ((lane & 15) >> 2)) * 64;
    const LAS v4u* wrow = (const LAS v4u*)(bm + (32 * qh + r32) * MA_BMS + 4 * hi);
    int jp = (T0 + 63) >> 7;
    int stg_ = 128 * ZC, til_ = 64 * ZC; asm volatile("" : "+s"(stg_), "+s"(til_));
    const size_t stg = (size_t)stg_, til = (size_t)til_;
    v4u kA0 = *(const v4u*)(ksrc + jp * stg), vA0 = *(const v4u*)(vsrc + jp * stg), kA1 = *(const v4u*)(ksrc + jp * stg + til), vA1 = *(const v4u*)(vsrc + jp * stg + til);
    { LAS unsigned char* kb = Kb + (jp & 1) * 16384; LAS unsigned char* vb = Vb + (jp & 1) * 16384;
      *(LAS v4u*)(kb + kdst) = kA0; *(LAS v4u*)(vb + vdst) = vA0; *(LAS v4u*)(kb + 8192 + kdst) = kA1; *(LAS v4u*)(vb + 8192 + vdst) = vA1; }
    v4u kB0 = kA0, vB0 = vA0, kB1 = kA1, vB1 = vA1;
    if (jp >= 1) { kB0 = *(const v4u*)(ksrc + (jp - 1) * stg); vB0 = *(const v4u*)(vsrc + (jp - 1) * stg); kB1 = *(const v4u*)(ksrc + (jp - 1) * stg + til); vB1 = *(const v4u*)(vsrc + (jp - 1) * stg + til); }
    __syncthreads();
#define MB_STAGE(JP, KW0, VW0, KW1, VW1, KL0, VL0, KL1, VL1) do { const int jp_ = (JP); \
        if (jp_ >= 2) { KL0 = *(const v4u*)(ksrc + (jp_ - 2) * stg); VL0 = *(const v4u*)(vsrc + (jp_ - 2) * stg); KL1 = *(const v4u*)(ksrc + (jp_ - 2) * stg + til); VL1 = *(const v4u*)(vsrc + (jp_ - 2) * stg + til); } \
        _Pragma("unroll") for (int kp = 1; kp >= 0; --kp) { \
            const int tile = 2 * jp_ + kp, s0 = 64 * tile; \
            if (s0 <= tq0 + 31) {                                          \
                const LAS unsigned char* Kc = Kb + (jp_ & 1) * 16384 + kp * 8192; const LAS unsigned char* Vc = Vb + (jp_ & 1) * 16384 + kp * 8192; \
                const float sha = sl * (float)(s0 - t), shb = sha + 32.f * sl; \
                f32x16 p0 = cinA, p1 = cinA; \
                _Pragma("unroll") for (int ks = 0; ks < 4; ++ks) { const bf16x8v kf0 = *(const LAS bf16x8v*)(Kc + ks * 2048 + krd), kf1 = *(const LAS bf16x8v*)(Kc + ks * 2048 + 512 + krd); \
                    p0 = __builtin_amdgcn_mfma_f32_32x32x16_bf16(kf0, qf[ks], p0, 0, 0, 0); p1 = __builtin_amdgcn_mfma_f32_32x32x16_bf16(kf1, qf[ks], p1, 0, 0, 0); } \
                const unsigned sbit = (unsigned)tile; \
                _Pragma("unroll") for (int g = 0; g < 4; ++g) { const v4u wa = wrow[2 * g], wb = wrow[8 + 2 * g]; \
                    _Pragma("unroll") for (int e = 0; e < 4; ++e) { const int r = 4 * g + e; \
                        const unsigned ma = (unsigned)(-(int)((wa[e] >> sbit) & 1u)), mb = (unsigned)(-(int)((wb[e] >> sbit) & 1u)); \
                        p0[r] = __uint_as_float((__float_as_uint(p0[r]) & ma) | (~ma & 0xff800000u)); p1[r] = __uint_as_float((__float_as_uint(p1[r]) & mb) | (~mb & 0xff800000u)); } } \
                bf16x8v pf[4]; \
                fl_softmax3(p0, p1, sha, shb, m, l, o, pf); \
                _Pragma("unroll") for (int s4 = 0; s4 < 4; ++s4) _Pragma("unroll") for (int db = 0; db < 2; ++db) { const LAS unsigned char* vp = Vc + db * 4096 + s4 * 1024 + vrd; \
                        const s16x4 lo = lds_tr(vp), hh = lds_tr(vp + 512); \
                        const bf16x8v vf = (bf16x8v){lo[0], lo[1], lo[2], lo[3], hh[0], hh[1], hh[2], hh[3]}; \
                        o[db] = __builtin_amdgcn_mfma_f32_32x32x16_bf16(vf, pf[s4], o[db], 0, 0, 0); } \
            } } \
        if (jp_ >= 1) { LAS unsigned char* kb = Kb + ((jp_ - 1) & 1) * 16384; LAS unsigned char* vb = Vb + ((jp_ - 1) & 1) * 16384; \
            *(LAS v4u*)(kb + kdst) = KW0; *(LAS v4u*)(vb + vdst) = VW0; *(LAS v4u*)(kb + 8192 + kdst) = KW1; *(LAS v4u*)(vb + 8192 + vdst) = VW1; } \
        __syncthreads(); } while (0)
    for (; jp >= 0; jp -= 2) { MB_STAGE(jp, kB0, vB0, kB1, vB1, kA0, vA0, kA1, vA1); if (jp >= 1) MB_STAGE(jp - 1, kA0, vA0, kA1, vA1, kB0, vB0, kB1, vB1); }
#undef MB_STAGE
    { const float inv = 1.f / swap_sum(l);
      bf16* orow = MIX + (size_t)(b * SEQ + t) * DM + h * 64 + 4 * hi;
#pragma unroll
      for (int db = 0; db < 2; ++db)
#pragma unroll
          for (int rg = 0; rg < 4; ++rg) { v2u w; w.x = cvtpk(o[db][4 * rg + 0] * inv, o[db][4 * rg + 1] * inv); w.y = cvtpk(o[db][4 * rg + 2] * inv, o[db][4 * rg + 3] * inv); *(v2u*)(orow + 32 * db + 8 * rg) = w; } }
}
__device__ __forceinline__ void mixa_phase64(const bf16* Z, bf16* MIX, float* SCR, LAS unsigned char* L, int vcu, int G, int wave) {
    float* scr = SCR + (size_t)blockIdx.x * (64 * 2048);
    for (int p = vcu; p < BATCH * 16; p += G) {
        const int b = p >> 4, x = p & 15;
#pragma unroll 1
        for (int k = 0; k < 2; ++k) { mixa_unit64(Z, MIX, scr, L, b, k == 0 ? 31 - x : x, wave); __syncthreads(); }
    }
}
#ifndef REP_A
#define REP_A 1
#endif
#ifndef REP_B
#define REP_B 1
#endif
#ifndef REP_C
#define REP_C 1
#endif
#ifndef REP_G
#define REP_G 1
#endif
#ifndef REP_BAR
#define REP_BAR 1
#endif
#ifndef FLASH2
#define FLASH2 1
#endif
#if FLASH2
#define FLASHP flash_phase2
#else
#define FLASHP flash_phase
#endif
#ifndef GM_ALIGN
#define GM_ALIGN true
#endif
#ifndef GM_ALIGN_RES
#define GM_ALIGN_RES true
#endif
#ifndef GM_SP2
#define GM_SP2 true
#endif
#ifndef MIXA64
#define MIXA64 1
#endif
#ifndef FFN_FP8
#define FFN_FP8 1
#endif
#ifndef FFN_FP8_P5
#define FFN_FP8_P5 FFN_FP8
#endif
#define H8_OFF (FFN_FP8_P5 ? (size_t)0 : 352 * MiB)
#define ACT_OFF (FFN_FP8 && FFN_FP8_P5 ? 64 * MiB : (size_t)0)
struct Args { const float* in[12]; float* out; unsigned char* ws; };
__global__ void __launch_bounds__(NWAVES * 64, 2) hybrid_fwd(Args args) {
    extern __shared__ __attribute__((aligned(16))) unsigned char lds[];
    LAS unsigned char* L = (LAS unsigned char*)lds;
    volatile LAS unsigned* MISC = (volatile LAS unsigned*)(L + MISC_OFF);
    const int wave = __builtin_amdgcn_readfirstlane((int)threadIdx.x >> 6);
#define LANE_NOW lane_now()
#define TID_NOW (wave * 64 + lane_now())
    const int G = gridDim.x, bx = blockIdx.x;
    const int vcu = (G % 8 == 0) ? (bx % 8) * (G / 8) + bx / 8 : bx;
    const int gw = vcu * NWAVES + wave, NGW = G * NWAVES;
    unsigned char* ws = args.ws;
    gu32* ctl = (gu32*)(ws + WS_CTL);
    for (int u = TID_NOW; u < (LDS_BYTES - LDSCTL_OFF) / 4; u += NWAVES * 64) ((LAS unsigned*)(L + LDSCTL_OFF))[u] = 0u;
    __syncthreads();
    XcdBarrier bar = xcd_barrier_post((unsigned*)(ctl + CW_BAR), MISC + 8);
    const float* x = args.in[0];
    bf16* R0 = (bf16*)(ws + WS_R0); bf16* R1 = (bf16*)(ws + WS_R1); bf16* R2 = (bf16*)(ws + WS_R2); bf16* BIG = (bf16*)(ws + WS_BIG);

    {
        const int tid_ = TID_NOW;
        const size_t n8 = (size_t)M * DM / 8; const size_t gt = (size_t)bx * (NWAVES * 64) + tid_, nth = (size_t)G * NWAVES * 64;
#ifndef REP_X
#define REP_X 1
#endif
#ifndef REP_T
#define REP_T 1
#endif
        for (int rx_ = 0; rx_ < REP_X; ++rx_)
        for (size_t i = gt; i < n8; i += 4 * nth) {
            f32x4 a[4], b[4];
#pragma unroll
            for (int u = 0; u < 4; ++u) { size_t j = i + u * nth; j = j < n8 ? j : n8 - 1; a[u] = ((const f32x4*)x)[2 * j]; b[u] = ((const f32x4*)x)[2 * j + 1]; }
#pragma unroll
            for (int u = 0; u < 4; ++u) { const size_t j = i + u * nth; if (j < n8) { v4u o; o.x = pk2(a[u].x, a[u].y); o.y = pk2(a[u].z, a[u].w); o.z = pk2(b[u].x, b[u].y); o.w = pk2(b[u].z, b[u].w); ((v4u*)R0)[j] = o; } }
        }
        LAS float* scr = (LAS float*)(L + RING_OFF + wave * 16384);
        constexpr int I_IN = (DM / 64) * (ZC / 32), I_O = (DM / 64) * (DM / 32), I_GU = (DM / 64) * (GU / 32), I_D = (FF / 64) * (DM / 32), I_L = I_IN + I_O + I_GU + I_D;
        for (int rt_ = 0; rt_ < REP_T; ++rt_)
        for (int it = gw; it < DEPTH * I_L; it += NGW) {
            const int l = it / I_L; int r = it % I_L;
            unsigned char* wl = ws + WS_W + (size_t)l * W_LAYER_B;
            float* cv = (float*)(ws + WS_CV) + (size_t)l * CV_LAYER; const bool acc_ = rt_ == 0;
            const float* g2p = l > 0 ? args.in[10] + (l - 1) * DM : nullptr; const float* b2p = l > 0 ? args.in[11] + (l - 1) * DM : nullptr;
            const float* g1 = args.in[5] + l * DM; const float* b1 = args.in[6] + l * DM;
            if (r < I_IN) { transpose_item<0>(args.in[1] + (size_t)l * DM * INC, nullptr, g2p, b2p, acc_ ? cv : nullptr, cv + ZC, DM, INC, ZC, (bf16*)wl, scr, r, LANE_NOW); continue; } r -= I_IN;
            if (r < I_O) { transpose_item<1>(args.in[2] + (size_t)l * DM * DM, nullptr, nullptr, nullptr, nullptr, nullptr, DM, DM, DM, (bf16*)(wl + W_IN_B), scr, r, LANE_NOW); continue; } r -= I_O;
            if (r < I_GU) { transpose_item<2, FFN_FP8 ? 6 : 0>(args.in[7] + (size_t)l * DM * FF, args.in[8] + (size_t)l * DM * FF, g1, b1, acc_ ? cv + 2 * ZC : nullptr, cv + 2 * ZC + GU, DM, FF, GU, (bf16*)(wl + W_IN_B + W_O_B), scr, r, LANE_NOW); continue; } r -= I_GU;
            transpose_item<1, FFN_FP8_P5 ? 8 : 0>(args.in[9] + (size_t)l * FF * DM, nullptr, nullptr, nullptr, nullptr, nullptr, FF, DM, DM, (bf16*)(wl + W_IN_B + W_O_B + W_GU_B), scr, r, LANE_NOW);
        }
    }
    xcd_barrier(bar);

#pragma unroll
    for (int l = 0; l < DEPTH; ++l) {
#define WS_NOW ({ unsigned char* w_ = args.ws; asm volatile("" : "+s"(w_)); w_; })
#define OPQ_S(x) ({ int x_ = (x); asm volatile("" : "+s"(x_)); x_; })
#define P_WL(w) ((w) + WS_W + (size_t)l * W_LAYER_B)
#define P_ST(w, ll, which) ((float*)((w) + WS_STAT) + (size_t)(((ll) * 2 + (which)) * 2) * M)
#define P_CV(w) ((const float*)((w) + WS_CV) + (size_t)l * CV_LAYER)
        const float lambda_init = (l == 0) ? 0.2f : 0.35550906759f;
        const bool last = (l + 1 == DEPTH);

        { unsigned char* w = WS_NOW; const float* sP = l > 0 ? P_ST(w, l - 1, 1) : nullptr; const float* cv = P_CV(w);
          pg8::Gemm g{(const pg8::bf16_t*)(w + WS_R0), (const pg8::bf16_t*)P_WL(w), M, ZC, DM}; pg8::StaticOrder S; S.init(M, ZC, OPQ_S(G), OPQ_S(bx));
          pg8::EpiStoreLN E{(pg8::bf16_t*)(w + WS_BIG), ZC, sP, sP ? sP + M : nullptr, cv, cv + ZC};
          for (int rep = 0; rep < REP_G; ++rep) {
          pg8::gemm_phase<pg8::EpiStoreLN, pg8::StaticOrder, GM_ALIGN, GM_SP2>(L + RING_OFF, g, S, E, OPQ_S(wave)); } }
        for (int rb_ = 0; rb_ < REP_BAR; ++rb_) xcd_barrier(bar);
        { unsigned char* w = WS_NOW; for (int rep = 0; rep < REP_A; ++rep) mixa_phase64((const bf16*)(w + WS_BIG), (bf16*)(w + WS_R1), (float*)(w + WS_R2), L + RING_OFF, OPQ_S(vcu), OPQ_S(G), OPQ_S(wave)); }
        { unsigned char* w = WS_NOW; for (int rep = 0; rep < REP_B; ++rep) FLASHP<0>((const bf16*)(w + WS_BIG), (bf16*)(w + WS_R1), L + RING_OFF, args.in[3] + l * 128, args.in[4] + l * 64, lambda_init, OPQ_S(vcu), OPQ_S(G), TID_NOW, OPQ_S(wave), LANE_NOW); }
        { unsigned char* w = WS_NOW; for (int rep = 0; rep < REP_C; ++rep) FLASHP<1>((const bf16*)(w + WS_BIG), (bf16*)(w + WS_R1), L + RING_OFF, nullptr, nullptr, 0.f, OPQ_S(vcu), OPQ_S(G), TID_NOW, OPQ_S(wave), LANE_NOW); }
        for (int rb_ = 0; rb_ < REP_BAR; ++rb_) xcd_barrier(bar);
        { unsigned char* w = WS_NOW; const float* sP = l > 0 ? P_ST(w, l - 1, 1) : nullptr; float* sA = P_ST(w, l, 0);
          pg8::Gemm g{(const pg8::bf16_t*)(w + WS_R1), (const pg8::bf16_t*)(P_WL(w) + W_IN_B), M, DM, DM}; pg8::StaticOrder S; S.init(M, DM, OPQ_S(G), OPQ_S(bx));
          pg8::EpiResStat E{(const pg8::bf16_t*)(w + WS_R0), sP, sP ? sP + M : nullptr, l > 0 ? args.in[10] + (l - 1) * DM : nullptr, l > 0 ? args.in[11] + (l - 1) * DM : nullptr, (pg8::bf16_t*)(w + WS_R2), nullptr, sA, sA + M, DM, ALPHA, FFN_FP8 ? (unsigned char*)(w + WS_BIG + H8_OFF) : nullptr, 1.f};
          for (int rep = 0; rep < REP_G; ++rep) { if (rep > 0) { E.osum = nullptr; }
          pg8::gemm_phase<pg8::EpiResStat, pg8::StaticOrder, GM_ALIGN_RES, GM_SP2>(L + RING_OFF, g, S, E, OPQ_S(wave)); } }
        for (int rb_ = 0; rb_ < REP_BAR; ++rb_) xcd_barrier(bar);
        { unsigned char* w = WS_NOW; float* sA = P_ST(w, l, 0); const float* cv = P_CV(w);
          pg8::StaticOrder S; S.init(M, GU, OPQ_S(G), OPQ_S(bx));
#if FFN_FP8
          pg8::Gemm g{(const pg8::bf16_t*)(w + WS_BIG + H8_OFF), (const pg8::bf16_t*)(P_WL(w) + W_IN_B + W_O_B), M, GU, DM / 2, 0};
#if FFN_FP8_P5
          pg8::EpiSwigluLN8 E{w + WS_BIG + ACT_OFF, FF, sA, sA + M, cv + 2 * ZC, cv + 2 * ZC + GU, 1.f / 64.f};
          for (int rep = 0; rep < REP_G; ++rep) {
          pg8::gemm_phase<pg8::EpiSwigluLN8, pg8::StaticOrder, GM_ALIGN, GM_SP2, true>(L + RING_OFF, g, S, E, OPQ_S(wave)); }
#else
          pg8::EpiSwigluLN E{(pg8::bf16_t*)(w + WS_BIG + ACT_OFF), FF, sA, sA + M, cv + 2 * ZC, cv + 2 * ZC + GU, 1.f / 64.f};
          for (int rep = 0; rep < REP_G; ++rep) {
          pg8::gemm_phase<pg8::EpiSwigluLN, pg8::StaticOrder, GM_ALIGN, GM_SP2, true>(L + RING_OFF, g, S, E, OPQ_S(wave)); }
#endif
#else
          pg8::Gemm g{(const pg8::bf16_t*)(w + WS_R2), (const pg8::bf16_t*)(P_WL(w) + W_IN_B + W_O_B), M, GU, DM, 0};
          pg8::EpiSwigluLN E{(pg8::bf16_t*)(w + WS_BIG), FF, sA, sA + M, cv + 2 * ZC, cv + 2 * ZC + GU, 1.f};
          for (int rep = 0; rep < REP_G; ++rep) {
          pg8::gemm_phase<pg8::EpiSwigluLN, pg8::StaticOrder, GM_ALIGN, GM_SP2>(L + RING_OFF, g, S, E, OPQ_S(wave)); }
#endif
        }
        for (int rb_ = 0; rb_ < REP_BAR; ++rb_) xcd_barrier(bar);
        { unsigned char* w = WS_NOW; float* sA = P_ST(w, l, 0); float* sB = P_ST(w, l, 1);
#if FFN_FP8_P5
          pg8::Gemm g{(const pg8::bf16_t*)(w + WS_BIG + ACT_OFF), (const pg8::bf16_t*)(P_WL(w) + W_IN_B + W_O_B + W_GU_B), M, DM, FF / 2, 0};
#else
          pg8::Gemm g{(const pg8::bf16_t*)(w + WS_BIG + ACT_OFF), (const pg8::bf16_t*)(P_WL(w) + W_IN_B + W_O_B + W_GU_B), M, DM, FF, 0};
#endif
          pg8::StaticOrder S; S.init(M, DM, OPQ_S(G), OPQ_S(bx));
          pg8::EpiResStat E{(const pg8::bf16_t*)(w + WS_R2), sA, sA + M, args.in[5] + l * DM, args.in[6] + l * DM, (pg8::bf16_t*)(w + WS_R0), nullptr, sB, sB + M, DM, ALPHA, nullptr, FFN_FP8_P5 ? 1.f / 256.f : 1.f};
          for (int rep = 0; rep < REP_G; ++rep) { if (rep > 0) { E.osum = nullptr; }
          pg8::gemm_phase<pg8::EpiResStat, pg8::StaticOrder, GM_ALIGN_RES, GM_SP2, FFN_FP8_P5 != 0>(L + RING_OFF, g, S, E, OPQ_S(wave)); } }
        for (int rb_ = 0; rb_ < REP_BAR; ++rb_) xcd_barrier(bar);
        if (last) {
            unsigned char* w = WS_NOW; const bf16* R0 = (const bf16*)(w + WS_R0); const float* sB = P_ST(w, l, 1);
            const int tid_ = TID_NOW;
            const size_t gt = (size_t)bx * (NWAVES * 64) + tid_, nth = (size_t)G * NWAVES * 64;
            if (nth % 128 == 0) {
                const int cc = (int)(gt & 127) * 8; const float* g2 = args.in[10] + l * DM + cc; const float* b2 = args.in[11] + l * DM + cc;
                const f32x4 ga = *(const f32x4*)g2, gb = *(const f32x4*)(g2 + 4), ba = *(const f32x4*)b2, bb = *(const f32x4*)(b2 + 4);
                const size_t rstep = nth / 128;
                for (size_t row = gt >> 7; row < (size_t)M; row += 4 * rstep) {
                    v4u hv[4]; float mu[4], rs[4];
#pragma unroll
                    for (int u = 0; u < 4; ++u) { size_t r = row + u * rstep; r = r < (size_t)M ? r : (size_t)M - 1; hv[u] = *(const v4u*)(R0 + r * DM + cc); const float s = sB[r], q = sB[M + r]; mu[u] = s * (1.f / DM); rs[u] = __builtin_amdgcn_rsqf(fmaxf(q * (1.f / DM) - mu[u] * mu[u], 0.f) + LN_EPS); }
#pragma unroll
                    for (int u = 0; u < 4; ++u) { const size_t r = row + u * rstep; if (r < (size_t)M) {
                        f32x4 ya, yb; ya.x = bflo(hv[u].x); ya.y = bfhi(hv[u].x); ya.z = bflo(hv[u].y); ya.w = bfhi(hv[u].y); yb.x = bflo(hv[u].z); yb.y = bfhi(hv[u].z); yb.z = bflo(hv[u].w); yb.w = bfhi(hv[u].w);
                        ya = (ya - mu[u]) * rs[u] * ga + ba; yb = (yb - mu[u]) * rs[u] * gb + bb;
                        float* op = args.out + r * DM + cc; *(f32x4*)op = ya; *(f32x4*)(op + 4) = yb; } }
                }
            }
        }
    }
}

extern "C" void kernel_launch(void* const* d_in, const int* in_sizes, int n_in, void* d_out, int out_size, void* d_ws, size_t ws_size, hipStream_t stream) {
    static int grid = 0;
    if (grid == 0) {
        if (n_in != 12 || in_sizes[0] != M * DM || out_size != M * DM || ws_size < WS_END) { fprintf(stderr, "kernel_launch: unexpected shapes / workspace (n_in %d, in0 %d, out %d, ws %zu < %zu)\n", n_in, n_in > 0 ? in_sizes[0] : -1, out_size, ws_size, (size_t)WS_END); grid = -1; return; }
        int dev = 0, cus = 0, per_cu = 0;
        if (hipGetDevice(&dev) != hipSuccess || hipDeviceGetAttribute(&cus, hipDeviceAttributeMultiprocessorCount, dev) != hipSuccess) { grid = -1; return; }
        if (hipFuncSetAttribute((const void*)hybrid_fwd, hipFuncAttributeMaxDynamicSharedMemorySize, LDS_BYTES) != hipSuccess) { fprintf(stderr, "kernel_launch: hipFuncSetAttribute failed\n"); grid = -1; return; }
        if (hipOccupancyMaxActiveBlocksPerMultiprocessor(&per_cu, (const void*)hybrid_fwd, NWAVES * 64, LDS_BYTES) != hipSuccess || per_cu < 1) { fprintf(stderr, "kernel_launch: occupancy query reports %d\n", per_cu); }
        (void)hipGetLastError();
        grid = cus < 256 ? cus : 256;
    }
    if (grid < 0) return;
    if (hipMemsetAsync((char*)d_ws + WS_CTL, 0, CTL_ZERO_BYTES, stream) != hipSuccess) return;
    Args a{};
    for (int i = 0; i < 12; ++i) a.in[i] = (const float*)d_in[i];
    a.out = (float*)d_out; a.ws = (unsigned char*)d_ws;
    hipLaunchKernelGGL(hybrid_fwd, dim3(grid), dim3(NWAVES * 64), LDS_BYTES, stream, a);
}
```

```cpp
#include <hip/hip_runtime.h>
#include <cstdio>
#include <cstdint>
#include <cmath>
#define FL_CLASS 0
#define FLASH2 0
namespace pg8 {
#define PG8_LAS __attribute__((address_space(3)))
typedef unsigned short bf16_t;
typedef short bf16x8 __attribute__((ext_vector_type(8)));
typedef float f32x4 __attribute__((ext_vector_type(4)));
typedef unsigned u32x4 __attribute__((ext_vector_type(4)));
constexpr int BM = 256, BK = 64, HALF = 128, HTB = HALF * BK * 2  , STAGE_BYTES = 8 * HTB, NXCD = 8, WGM = 8;

__host__ __device__ __forceinline__ int lds_byte(int r, int c) { const int st = (r >> 4) * 2 + (c >> 5), rr = r & 15, cc = c & 31, ob = rr * 64 + cc * 2; return st * 1024 + (ob ^ (((ob >> 9) & 1) << 5)); }
__host__ __device__ __forceinline__ void stage_rc(int b, int& R, int& C) { const int st = b / 1024, sb = b % 1024, swz = sb ^ (((sb >> 9) & 1) << 5); R = (st >> 1) * 16 + swz / 64; C = (st & 1) * 32 + (swz % 64) / 2; }
__host__ __device__ __forceinline__ int perm32(int rho) { const int n = rho >> 4, i = rho & 15; return 8 * (i >> 2) + 4 * n + (i & 3); }

struct Unit { int pm, pn; };
struct Gemm { const bf16_t* A; const bf16_t* Bt; int M, N, K; int scale_w; };
typedef int v4i_t __attribute__((ext_vector_type(4)));
typedef int v8i_t __attribute__((ext_vector_type(8)));

struct StaticOrder {
    int nM, nN, nwg, G, c;
    __host__ __device__ void init(int M, int N, int G_, int c_) { nM = M / BM; nN = N / BM; nwg = nM * nN; G = G_; c = c_; }
    __host__ __device__ bool next(int i, Unit& u) const {
        const long L = (long)i * G + c; if (L >= nwg) return false;
        int wgid = (int)L; { const int q = nwg / NXCD, r = nwg % NXCD, xcd = wgid % NXCD, off = wgid / NXCD; wgid = (xcd < r ? xcd * (q + 1) : r * (q + 1) + (xcd - r) * q) + off; }
        const int nig = WGM * nN, gid = wgid / nig, fm = gid * WGM, gsz = (nM - fm) < WGM ? (nM - fm) : WGM;
        u.pm = fm + ((wgid % nig) % gsz); u.pn = (wgid % nig) / gsz; return true;
    }
    __device__ __forceinline__ void a_ready(const Unit&) const {}
    __device__ __forceinline__ void done(const Unit&) const {}
};
__device__ __forceinline__ unsigned cvt_pk_bf16(float lo, float hi) { unsigned r; asm volatile("v_cvt_pk_bf16_f32 %0, %1, %2" : "=v"(r) : "v"(lo), "v"(hi)); return r; }
typedef float f32x2 __attribute__((ext_vector_type(2)));
typedef unsigned u32x2 __attribute__((ext_vector_type(2)));
struct EpiStore {
    static constexpr bool PERM = true, AFTER_DRAIN = false;
    bf16_t* O; int ldc;
    __device__ __forceinline__ void operator()(const f32x4 (&acc)[2][2][4][2], const Unit& u, int wr, int wc, int fr, int fq) const {
        const int row0 = u.pm * BM + wr * 64 + fr, col0 = u.pn * BM + wc * 32 + 8 * fq;
#pragma unroll
        for (int ai = 0; ai < 2; ++ai)
#pragma unroll
            for (int m = 0; m < 4; ++m) { bf16_t* rowp = O + (size_t)(row0 + ai * HALF + m * 16) * ldc + col0;
#pragma unroll
                for (int bj = 0; bj < 2; ++bj) { const f32x4 v0 = acc[ai][bj][m][0], v1 = acc[ai][bj][m][1];
                    u32x4 w; w.x = cvt_pk_bf16(v0[0], v0[1]); w.y = cvt_pk_bf16(v0[2], v0[3]); w.z = cvt_pk_bf16(v1[0], v1[1]); w.w = cvt_pk_bf16(v1[2], v1[3]);
                    *(u32x4*)(rowp + bj * HALF) = w; } }
    }
};
struct EpiSwiglu {
    static constexpr bool PERM = true, AFTER_DRAIN = false;
    bf16_t* O; int ldc;
    __device__ __forceinline__ float act(float g, float u) const { const float e = __builtin_amdgcn_exp2f(g * -1.4426950408889634f); return g * __builtin_amdgcn_rcpf(1.0f + e) * u; }
    __device__ __forceinline__ void operator()(const f32x4 (&acc)[2][2][4][2], const Unit& u, int wr, int wc, int fr, int fq) const {
        const int row0 = u.pm * BM + wr * 64 + fr, col0 = u.pn * HALF + wc * 32 + 8 * fq;
#pragma unroll
        for (int ai = 0; ai < 2; ++ai)
#pragma unroll
            for (int m = 0; m < 4; ++m) { bf16_t* rowp = O + (size_t)(row0 + ai * HALF + m * 16) * ldc + col0;
                const f32x4 g0 = acc[ai][0][m][0], g1 = acc[ai][0][m][1], u0 = acc[ai][1][m][0], u1 = acc[ai][1][m][1];
                u32x4 w; w.x = cvt_pk_bf16(act(g0[0], u0[0]), act(g0[1], u0[1])); w.y = cvt_pk_bf16(act(g0[2], u0[2]), act(g0[3], u0[3]));
                w.z = cvt_pk_bf16(act(g1[0], u1[0]), act(g1[1], u1[1])); w.w = cvt_pk_bf16(act(g1[2], u1[2]), act(g1[3], u1[3]));
                *(u32x4*)rowp = w; }
    }
};
struct EpiRes {
    static constexpr bool PERM = false, AFTER_DRAIN = false;
    const bf16_t* X; float* H; int ldc; float alpha;
    __device__ __forceinline__ void operator()(const f32x4 (&acc)[2][2][4][2], const Unit& u, int wr, int wc, int fr, int fq) const {
        const int row0 = u.pm * BM + wr * 64 + fr, col0 = u.pn * BM + wc * 32 + 4 * fq;
#pragma unroll
        for (int ai = 0; ai < 2; ++ai)
#pragma unroll
            for (int m = 0; m < 4; ++m) { const size_t off = (size_t)(row0 + ai * HALF + m * 16) * ldc + col0;
#pragma unroll
                for (int bj = 0; bj < 2; ++bj)
#pragma unroll
                    for (int n = 0; n < 2; ++n) { const size_t c = off + bj * HALF + n * 16; const u32x2 xb = *(const u32x2*)(X + c);
                        f32x4 x; x[0] = __uint_as_float(xb.x << 16); x[1] = __uint_as_float(xb.x & 0xffff0000u); x[2] = __uint_as_float(xb.y << 16); x[3] = __uint_as_float(xb.y & 0xffff0000u);
                        *(f32x4*)(H + c) = acc[ai][bj][m][n] + x * alpha; } }
    }
};

__device__ __forceinline__ float sum16x(float v) { auto rr = __builtin_amdgcn_permlane16_swap(__float_as_uint(v), __float_as_uint(v), false, false); return __uint_as_float(rr[0]) + __uint_as_float(rr[1]); }
__device__ __forceinline__ float sum32x(float v) { auto rr = __builtin_amdgcn_permlane32_swap(__float_as_uint(v), __float_as_uint(v), false, false); return __uint_as_float(rr[0]) + __uint_as_float(rr[1]); }
__device__ __forceinline__ void row_stats(const float* ssum, const float* ssq, int row, float& mu, float& rs) {
    mu = 0.f; rs = 1.f;
    if (ssum) { const float s = ssum[row], q = ssq[row]; mu = s * (1.f / 1024.f); rs = 1.f / sqrtf(fmaxf(q * (1.f / 1024.f) - mu * mu, 0.f) + 1e-5f); }
}
struct EpiStoreLN {
    static constexpr bool PERM = true, AFTER_DRAIN = false;
    bf16_t* O; int ldc; const float* ssum; const float* ssq; const float* c1; const float* c0;
    __device__ __forceinline__ void operator()(const f32x4 (&acc)[2][2][4][2], const Unit& u, int wr, int wc, int fr, int fq) const {
        const int row0 = u.pm * BM + wr * 64 + fr, col0 = u.pn * BM + wc * 32 + 8 * fq;
        f32x4 c1v[2][2], c0v[2][2]; float z_ = 0.f; asm volatile("" : "+v"(z_));
#pragma unroll
        for (int bj = 0; bj < 2; ++bj)
#pragma unroll
            for (int n = 0; n < 2; ++n) { c1v[bj][n] = ssum ? *(const f32x4*)(c1 + col0 + bj * HALF + 4 * n) : (f32x4){z_, z_, z_, z_}; c0v[bj][n] = ssum ? *(const f32x4*)(c0 + col0 + bj * HALF + 4 * n) : (f32x4){z_, z_, z_, z_}; }
#pragma unroll
        for (int ai = 0; ai < 2; ++ai)
#pragma unroll
            for (int m = 0; m < 4; ++m) { const int row = row0 + ai * HALF + m * 16; float mu, rs; row_stats(ssum, ssq, row, mu, rs);
                bf16_t* rowp = O + (size_t)row * ldc + col0;
#pragma unroll
                for (int bj = 0; bj < 2; ++bj) { const f32x4 v0 = (acc[ai][bj][m][0] - c1v[bj][0] * mu) * rs + c0v[bj][0], v1 = (acc[ai][bj][m][1] - c1v[bj][1] * mu) * rs + c0v[bj][1];
                    u32x4 w; w.x = cvt_pk_bf16(v0[0], v0[1]); w.y = cvt_pk_bf16(v0[2], v0[3]); w.z = cvt_pk_bf16(v1[0], v1[1]); w.w = cvt_pk_bf16(v1[2], v1[3]);
                    *(u32x4*)(rowp + bj * HALF) = w; } }
    }
};
struct EpiSwigluLN {
    static constexpr bool PERM = true, AFTER_DRAIN = false;
    bf16_t* O; int ldc; const float* ssum; const float* ssq; const float* c1; const float* c0; float ascale;
    __device__ __forceinline__ float act(float g, float u) const { const float e = __builtin_amdgcn_exp2f(g * -1.4426950408889634f); return g * __builtin_amdgcn_rcpf(1.0f + e) * u; }
    __device__ __forceinline__ void operator()(const f32x4 (&acc)[2][2][4][2], const Unit& u, int wr, int wc, int fr, int fq) const {
        const int row0 = u.pm * BM + wr * 64 + fr, col0 = u.pn * HALF + wc * 32 + 8 * fq, wrow0 = u.pn * BM + wc * 32 + 8 * fq;
        f32x4 c1v[2][2], c0v[2][2];
#pragma unroll
        for (int bj = 0; bj < 2; ++bj)
#pragma unroll
            for (int n = 0; n < 2; ++n) { c1v[bj][n] = *(const f32x4*)(c1 + wrow0 + bj * HALF + 4 * n); c0v[bj][n] = *(const f32x4*)(c0 + wrow0 + bj * HALF + 4 * n); }
#pragma unroll
        for (int ai = 0; ai < 2; ++ai)
#pragma unroll
            for (int m = 0; m < 4; ++m) { const int row = row0 + ai * HALF + m * 16; float mu, rs; row_stats(ssum, ssq, row, mu, rs);
                bf16_t* rowp = O + (size_t)row * ldc + col0;
                const f32x4 g0 = (acc[ai][0][m][0] * ascale - c1v[0][0] * mu) * rs + c0v[0][0], g1 = (acc[ai][0][m][1] * ascale - c1v[0][1] * mu) * rs + c0v[0][1];
                const f32x4 u0 = (acc[ai][1][m][0] * ascale - c1v[1][0] * mu) * rs + c0v[1][0], u1 = (acc[ai][1][m][1] * ascale - c1v[1][1] * mu) * rs + c0v[1][1];
                u32x4 w; w.x = cvt_pk_bf16(act(g0[0], u0[0]), act(g0[1], u0[1])); w.y = cvt_pk_bf16(act(g0[2], u0[2]), act(g0[3], u0[3]));
                w.z = cvt_pk_bf16(act(g1[0], u1[0]), act(g1[1], u1[1])); w.w = cvt_pk_bf16(act(g1[2], u1[2]), act(g1[3], u1[3]));
                *(u32x4*)rowp = w; }
    }
};
struct EpiSwigluLN8 {
    static constexpr bool PERM = true, AFTER_DRAIN = false;
    unsigned char* O; int ldc; const float* ssum; const float* ssq; const float* c1; const float* c0; float ascale;
    __device__ __forceinline__ float act(float g, float u) const { const float e = __builtin_amdgcn_exp2f(g * -1.4426950408889634f); return g * __builtin_amdgcn_rcpf(1.0f + e) * u; }
    __device__ __forceinline__ void operator()(const f32x4 (&acc)[2][2][4][2], const Unit& u, int wr, int wc, int fr, int fq) const {
        const int row0 = u.pm * BM + wr * 64 + fr, col0 = u.pn * HALF + wc * 32 + 8 * fq, wrow0 = u.pn * BM + wc * 32 + 8 * fq;
        f32x4 c1v[2][2], c0v[2][2];
#pragma unroll
        for (int bj = 0; bj < 2; ++bj)
#pragma unroll
            for (int n = 0; n < 2; ++n) { c1v[bj][n] = *(const f32x4*)(c1 + wrow0 + bj * HALF + 4 * n); c0v[bj][n] = *(const f32x4*)(c0 + wrow0 + bj * HALF + 4 * n); }
#pragma unroll
        for (int ai = 0; ai < 2; ++ai)
#pragma unroll
            for (int m = 0; m < 4; ++m) { const int row = row0 + ai * HALF + m * 16; float mu, rs; row_stats(ssum, ssq, row, mu, rs);
                unsigned char* rowp = O + (size_t)row * ldc + col0;
                const f32x4 g0 = (acc[ai][0][m][0] * ascale - c1v[0][0] * mu) * rs + c0v[0][0], g1 = (acc[ai][0][m][1] * ascale - c1v[0][1] * mu) * rs + c0v[0][1];
                const f32x4 u0 = (acc[ai][1][m][0] * ascale - c1v[1][0] * mu) * rs + c0v[1][0], u1 = (acc[ai][1][m][1] * ascale - c1v[1][1] * mu) * rs + c0v[1][1];
                int w0 = __builtin_amdgcn_cvt_pk_fp8_f32(act(g0[0], u0[0]), act(g0[1], u0[1]), 0, false); w0 = __builtin_amdgcn_cvt_pk_fp8_f32(act(g0[2], u0[2]), act(g0[3], u0[3]), w0, true);
                int w1 = __builtin_amdgcn_cvt_pk_fp8_f32(act(g1[0], u1[0]), act(g1[1], u1[1]), 0, false); w1 = __builtin_amdgcn_cvt_pk_fp8_f32(act(g1[2], u1[2]), act(g1[3], u1[3]), w1, true);
                u32x2 w; w.x = (unsigned)w0; w.y = (unsigned)w1; *(u32x2*)rowp = w; }
    }
};
struct EpiResStat {
    static constexpr bool PERM = false, AFTER_DRAIN = false;
    const bf16_t* R; const float* rsum; const float* rsq; const float* g; const float* b; bf16_t* Hb; float* Hf; float* osum; float* osq; int ldc; float alpha; unsigned char* H8; float ascale; int pM;
    __device__ __forceinline__ void operator()(const f32x4 (&acc)[2][2][4][2], const Unit& u, int wr, int wc, int fr, int fq) const {
        const int row0 = u.pm * BM + wr * 64 + fr, col0 = u.pn * BM + wc * 32 + 4 * fq;
        f32x4 gv[2][2], bv[2][2];
#pragma unroll
        for (int bj = 0; bj < 2; ++bj)
#pragma unroll
            for (int n = 0; n < 2; ++n) { float z_ = 0.f, o_ = 1.f; asm volatile("" : "+v"(z_), "+v"(o_)); gv[bj][n] = rsum ? *(const f32x4*)(g + col0 + bj * HALF + n * 16) : (f32x4){o_, o_, o_, o_}; bv[bj][n] = rsum ? *(const f32x4*)(b + col0 + bj * HALF + n * 16) : (f32x4){z_, z_, z_, z_}; }
        float ss[2][4], qq[2][4];
#pragma unroll
        for (int ai = 0; ai < 2; ++ai)
#pragma unroll
            for (int m = 0; m < 4; ++m) { const int row = row0 + ai * HALF + m * 16; float mu, rs; row_stats(rsum, rsq, row, mu, rs);
                const size_t off = (size_t)row * ldc + col0; float s = 0.f, q = 0.f;
#pragma unroll
                for (int bj = 0; bj < 2; ++bj)
#pragma unroll
                    for (int n = 0; n < 2; ++n) { const size_t c = off + bj * HALF + n * 16; const u32x2 xb = *(const u32x2*)(R + c);
                        f32x4 x; x[0] = __uint_as_float(xb.x << 16); x[1] = __uint_as_float(xb.x & 0xffff0000u); x[2] = __uint_as_float(xb.y << 16); x[3] = __uint_as_float(xb.y & 0xffff0000u);
                        x = (x - mu) * rs * gv[bj][n] + bv[bj][n];
                        const f32x4 v = acc[ai][bj][m][n] * ascale + x * alpha;
                        if (Hf) *(f32x4*)(Hf + c) = v;
                        else { u32x2 w; w.x = cvt_pk_bf16(v[0], v[1]); w.y = cvt_pk_bf16(v[2], v[3]); *(u32x2*)(Hb + c) = w; s += (v[0] + v[1]) + (v[2] + v[3]); q += (v[0] * v[0] + v[1] * v[1]) + (v[2] * v[2] + v[3] * v[3]);
                            if (H8) { int w8 = __builtin_amdgcn_cvt_pk_fp8_f32(v[0], v[1], 0, false); w8 = __builtin_amdgcn_cvt_pk_fp8_f32(v[2], v[3], w8, true); *(int*)(H8 + c) = w8; } } }
                ss[ai][m] = sum32x(sum16x(s)); qq[ai][m] = sum32x(sum16x(q)); }
        if (!Hf && osum) { const size_t slot = (size_t)(u.pn * 4 + wc) * (size_t)pM;
#pragma unroll
            for (int ai = 0; ai < 2; ++ai) { const float sv = fq == 0 ? ss[ai][0] : (fq == 1 ? ss[ai][1] : (fq == 2 ? ss[ai][2] : ss[ai][3])), qv = fq == 0 ? qq[ai][0] : (fq == 1 ? qq[ai][1] : (fq == 2 ? qq[ai][2] : qq[ai][3]));
                const int row = row0 + ai * HALF + fq * 16;
                osum[slot + row] = sv; osq[slot + row] = qv; } }
    }
};
template <class Epi, class Sched, bool ALIGN_EPI = false, bool SP2 = false, bool FP8 = false>
__device__ __forceinline__ void gemm_phase(PG8_LAS unsigned char* lds, const Gemm g, const Sched& S, const Epi& E, int wave_in) {
    int lane_; asm volatile("v_mbcnt_lo_u32_b32 %0, -1, 0\n\tv_mbcnt_hi_u32_b32 %0, -1, %0" : "=v"(lane_)); const int tid_ = wave_in * 64 + lane_;
    const int tid = tid_, wid = __builtin_amdgcn_readfirstlane(tid >> 6), lane = tid & 63, wr = wid >> 2, wc = wid & 3, fr = lane & 15, fq = lane >> 4;
    const int K = g.K, nt = K / BK;
    unsigned voffA[2], voffB[2];
#pragma unroll
    for (int i = 0; i < 2; ++i) { int R, C; stage_rc(tid * 16 + i * 8192, R, C); const int Rb = Epi::PERM ? ((R & ~31) + perm32(R & 31)) : R;
        voffA[i] = (unsigned)(R * K + C) * 2u; voffB[i] = (unsigned)(Rb * K + C) * 2u; }
    const size_t kstep = (size_t)(BK * 2);
    const size_t hstep = (size_t)HALF * K * 2;
    const size_t tstep = 2 * hstep;
    const unsigned ldsw = (unsigned)wid * 1024u;
    const int aoff = lds_byte(wr * 64 + fr, fq * 8), boff = lds_byte(wc * 32 + fr, fq * 8);
#define PG8_SA(b, h) (((b) * 2 + (h)) * HTB)
#define PG8_SB(b, h) ((4 + (b) * 2 + (h)) * HTB)
#define PG8_STAGE(bufoff, gbase, voff) do { _Pragma("unroll") for (int _i = 0; _i < 2; ++_i) \
        __builtin_amdgcn_global_load_lds((const unsigned*)((const char*)(gbase) + (voff)[_i]), (PG8_LAS unsigned*)(lds + (bufoff) + ldsw + _i * 8192), 16, 0, 0); } while (0)
#define PG8_LDA16(dst, b, h) do { _Pragma("unroll") for (int m = 0; m < 4; ++m) _Pragma("unroll") for (int k = 0; k < 2; ++k) dst[m][k] = *(const PG8_LAS bf16x8*)(lds + PG8_SA(b, h) + aoff + m * 2048 + k * 1024); } while (0)
#define PG8_LDA8(dst, b, h) do { _Pragma("unroll") for (int m = 0; m < 4; ++m) { const v4i_t lo_ = *(const PG8_LAS v4i_t*)(lds + PG8_SA(b, h) + aoff + m * 2048), hi_ = *(const PG8_LAS v4i_t*)(lds + PG8_SA(b, h) + aoff + m * 2048 + 1024); dst[m] = __builtin_shufflevector(lo_, hi_, 0, 1, 2, 3, 4, 5, 6, 7); } } while (0)
#define PG8_LDA(dst, b, h) do { if constexpr (FP8) PG8_LDA8(dst##8, b, h); else PG8_LDA16(dst, b, h); } while (0)
#define PG8_LDB16(dst, b, h) do { _Pragma("unroll") for (int n = 0; n < 2; ++n) _Pragma("unroll") for (int k = 0; k < 2; ++k) dst[n][k] = *(const PG8_LAS bf16x8*)(lds + PG8_SB(b, h) + boff + n * 2048 + k * 1024); } while (0)
#define PG8_LDB8(dst, b, h) do { _Pragma("unroll") for (int n = 0; n < 2; ++n) { const v4i_t lo_ = *(const PG8_LAS v4i_t*)(lds + PG8_SB(b, h) + boff + n * 2048), hi_ = *(const PG8_LAS v4i_t*)(lds + PG8_SB(b, h) + boff + n * 2048 + 1024); dst[n] = __builtin_shufflevector(lo_, hi_, 0, 1, 2, 3, 4, 5, 6, 7); } } while (0)
#define PG8_LDB(dst, b, h) do { if constexpr (FP8) PG8_LDB8(dst##8, b, h); else PG8_LDB16(dst, b, h); } while (0)
#define PG8_MMA(ai, bj, At, Bt) do { __builtin_amdgcn_s_setprio(1); _Pragma("unroll") for (int m = 0; m < 4; ++m) _Pragma("unroll") for (int n = 0; n < 2; ++n) _Pragma("unroll") for (int k = 0; k < 2; ++k) \
        acc[ai][bj][m][n] = __builtin_amdgcn_mfma_f32_16x16x32_bf16(Bt[n][k], At[m][k], acc[ai][bj][m][n], 0, 0, 0); __builtin_amdgcn_s_setprio(0); } while (0)
#define PG8_MMA8(ai, bj, At, Bt) do { __builtin_amdgcn_s_setprio(1); _Pragma("unroll") for (int m = 0; m < 4; ++m) _Pragma("unroll") for (int n = 0; n < 2; ++n) \
        asm("v_mfma_f32_16x16x128_f8f6f4 %0, %1, %2, %0" : "+v"(acc[ai][bj][m][n]) : "v"(Bt[n]), "v"(At[m])); __builtin_amdgcn_s_setprio(0); } while (0)
#define PG8_MM(ai, bj, At, Bt) do { if constexpr (FP8) PG8_MMA8(ai, bj, At##8, Bt##8); else PG8_MMA(ai, bj, At, Bt); } while (0)
#define PG8_WAIT_V(n) asm volatile("s_waitcnt vmcnt(" #n ")" ::: "memory")
#define PG8_WAIT_L(n) asm volatile("s_waitcnt lgkmcnt(" #n ")" ::: "memory")
#define PG8_BAR __builtin_amdgcn_s_barrier()
#define PG8_SCHED __builtin_amdgcn_sched_barrier(0)
    Unit cur, nxt; int ui = 0;
    if (!S.next(0, cur)) return;
    f32x4 acc[2][2][4][2];
#pragma unroll
    for (int a = 0; a < 2; ++a)
#pragma unroll
        for (int b = 0; b < 2; ++b)
#pragma unroll
            for (int m = 0; m < 4; ++m)
#pragma unroll
                for (int n = 0; n < 2; ++n) acc[a][b][m][n] = (f32x4){0.f, 0.f, 0.f, 0.f};
    bf16x8 At[4][2], B0[2][2], B1[2][2]; v8i_t At8[4], B08[2], B18[2];
    const char* cA = (const char*)g.A + (size_t)cur.pm * tstep; const char* cB = (const char*)g.Bt + (size_t)cur.pn * tstep;
    S.a_ready(cur);
    if constexpr (SP2) {
        PG8_STAGE(PG8_SB(0, 0), cB, voffB); PG8_STAGE(PG8_SB(0, 1), cB + hstep, voffB); PG8_STAGE(PG8_SA(0, 0), cA, voffA); PG8_STAGE(PG8_SA(0, 1), cA + hstep, voffA);
        if (wr == 1) PG8_BAR;
        PG8_WAIT_V(2); PG8_BAR;
        PG8_STAGE(PG8_SB(1, 0), cB + kstep, voffB); PG8_STAGE(PG8_SA(1, 0), cA + kstep, voffA); PG8_STAGE(PG8_SB(1, 1), cB + hstep + kstep, voffB);
        PG8_WAIT_V(6); PG8_BAR;
    } else {
        PG8_STAGE(PG8_SB(0, 0), cB, voffB); PG8_STAGE(PG8_SA(0, 0), cA, voffA); PG8_STAGE(PG8_SB(0, 1), cB + hstep, voffB); PG8_STAGE(PG8_SA(0, 1), cA + hstep, voffA);
        if (wr == 1) PG8_BAR;
        PG8_WAIT_V(4); PG8_BAR;
        PG8_STAGE(PG8_SB(1, 0), cB + kstep, voffB); PG8_STAGE(PG8_SA(1, 0), cA + kstep, voffA); PG8_STAGE(PG8_SB(1, 1), cB + hstep + kstep, voffB);
        PG8_WAIT_V(6); PG8_BAR;
    }
    for (;;) {
        const bool has_next = S.next(ui + 1, nxt);
        const char* nA = has_next ? (const char*)g.A + (size_t)nxt.pm * tstep : cA; const char* nB = has_next ? (const char*)g.Bt + (size_t)nxt.pn * tstep : cB;
#pragma unroll 1
        for (int t = 0; t < nt; t += 2) {
            const bool last = (t == nt - 2);
            const char* a1 = cA + (size_t)(t + 1) * kstep;
            const char* a2 = last ? nA : cA + (size_t)(t + 2) * kstep; const char* b2 = last ? nB : cB + (size_t)(t + 2) * kstep;
            const char* a3 = a2 + kstep; const char* b3 = b2 + kstep;
            if (last && has_next) S.a_ready(nxt);
            if constexpr (SP2) {
            PG8_LDB(B0, 0, 0); PG8_LDB(B1, 0, 1); PG8_SCHED; PG8_LDA(At, 0, 0); PG8_STAGE(PG8_SA(1, 1), a1 + hstep, voffA);
            PG8_WAIT_V(8); PG8_WAIT_L(0); PG8_BAR; PG8_MM(0, 0, At, B0); PG8_MM(0, 1, At, B1); PG8_BAR; PG8_SCHED;
            PG8_LDA(At, 0, 1); PG8_STAGE(PG8_SB(0, 0), b2, voffB); PG8_STAGE(PG8_SB(0, 1), b2 + hstep, voffB); PG8_STAGE(PG8_SA(0, 0), a2, voffA);
            PG8_WAIT_V(8); PG8_WAIT_L(0); PG8_BAR; PG8_MM(1, 0, At, B0); PG8_MM(1, 1, At, B1); PG8_BAR; PG8_SCHED;
            PG8_LDB(B0, 1, 0); PG8_LDB(B1, 1, 1); PG8_SCHED; PG8_LDA(At, 1, 0); PG8_STAGE(PG8_SA(0, 1), a2 + hstep, voffA);
            PG8_WAIT_V(8); PG8_WAIT_L(0); PG8_BAR; PG8_MM(0, 0, At, B0); PG8_MM(0, 1, At, B1); PG8_BAR; PG8_SCHED;
            PG8_LDA(At, 1, 1); PG8_STAGE(PG8_SB(1, 0), b3, voffB); PG8_STAGE(PG8_SB(1, 1), b3 + hstep, voffB); PG8_STAGE(PG8_SA(1, 0), a3, voffA);
            PG8_WAIT_V(8); PG8_WAIT_L(0); PG8_BAR; PG8_MM(1, 0, At, B0); PG8_MM(1, 1, At, B1); PG8_BAR; PG8_SCHED;
            } else {
            PG8_LDB(B0, 0, 0); PG8_SCHED; PG8_LDA(At, 0, 0); PG8_STAGE(PG8_SA(1, 1), a1 + hstep, voffA);
            PG8_WAIT_L(8); PG8_BAR; PG8_WAIT_L(0); PG8_MM(0, 0, At, B0); PG8_BAR; PG8_SCHED;
            PG8_LDB(B1, 0, 1); PG8_STAGE(PG8_SB(0, 0), b2, voffB);
            PG8_BAR; PG8_WAIT_L(0); PG8_MM(0, 1, At, B1); PG8_BAR;
            PG8_LDA(At, 0, 1); PG8_STAGE(PG8_SA(0, 0), a2, voffA);
            PG8_BAR; PG8_WAIT_L(0); PG8_MM(1, 0, At, B0); PG8_BAR; PG8_SCHED;
            PG8_STAGE(PG8_SB(0, 1), b2 + hstep, voffB);
            PG8_WAIT_V(6); PG8_BAR; PG8_MM(1, 1, At, B1); PG8_BAR;
            PG8_LDB(B0, 1, 0); PG8_SCHED; PG8_LDA(At, 1, 0); PG8_STAGE(PG8_SA(0, 1), a2 + hstep, voffA);
            PG8_WAIT_L(8); PG8_BAR; PG8_WAIT_L(0); PG8_MM(0, 0, At, B0); PG8_BAR; PG8_SCHED;
            PG8_LDB(B1, 1, 1); PG8_STAGE(PG8_SB(1, 0), b3, voffB);
            PG8_BAR; PG8_WAIT_L(0); PG8_MM(0, 1, At, B1); PG8_BAR;
            PG8_LDA(At, 1, 1); PG8_STAGE(PG8_SA(1, 0), a3, voffA);
            PG8_BAR; PG8_WAIT_L(0); PG8_MM(1, 0, At, B0); PG8_BAR; PG8_SCHED;
            PG8_STAGE(PG8_SB(1, 1), b3 + hstep, voffB);
            PG8_WAIT_V(6); PG8_BAR; PG8_MM(1, 1, At, B1); PG8_BAR;
            }
        }
        if constexpr (ALIGN_EPI) { if (wr == 0) PG8_BAR; }
        if constexpr (FP8) asm volatile("s_nop 15\n\ts_nop 15" ::: "memory");
        if constexpr (!Epi::AFTER_DRAIN) { int le_; asm volatile("v_mbcnt_lo_u32_b32 %0, -1, 0\n\tv_mbcnt_hi_u32_b32 %0, -1, %0" : "=v"(le_)); E(acc, cur, wr, wc, le_ & 15, le_ >> 4); S.done(cur); }
        if (!has_next) break;
#pragma unroll
        for (int a = 0; a < 2; ++a)
#pragma unroll
            for (int b = 0; b < 2; ++b)
#pragma unroll
                for (int m = 0; m < 4; ++m)
#pragma unroll
                    for (int n = 0; n < 2; ++n) acc[a][b][m][n] = (f32x4){0.f, 0.f, 0.f, 0.f};
        cur = nxt; cA = nA; cB = nB; ++ui;
        if constexpr (ALIGN_EPI) { if (wr == 1) PG8_BAR; }
    }
    PG8_WAIT_V(0);
    if constexpr (!ALIGN_EPI) { if (wr == 0) PG8_BAR; }
    PG8_BAR;
    if constexpr (Epi::AFTER_DRAIN) { E.fused(acc, cur, wr, wc, fr, fq, lds, wid, lane); S.done(cur); }
#undef PG8_SA
#undef PG8_SB
#undef PG8_STAGE
#undef PG8_LDA
#undef PG8_LDA8
#undef PG8_LDA16
#undef PG8_LDB
#undef PG8_LDB8
#undef PG8_LDB16
#undef PG8_MMA
#undef PG8_MMA8
#undef PG8_MM
#undef PG8_WAIT_V
#undef PG8_WAIT_L
#undef PG8_BAR
#undef PG8_SCHED
}
}
constexpr int NWAVES = 8;
constexpr int BATCH = 32, SEQ = 2048, DM = 1024, M = BATCH * SEQ, ZC = 3072, FF = 2816, GU = 2 * FF, DEPTH = 2, INC = 3012;
constexpr float LN_EPS = 1e-5f, LOG2E = 1.4426950408889634f, ALPHA = 1.4142135623730951f;
constexpr int ZC_QA = 0, ZC_KA = 256, ZC_VA = 320, ZC_QI = 384, ZC_KI = 640, ZC_WI = 704, ZC_QB = 768, ZC_KB = 1024, ZC_VB = 1280, ZC_QC = 1536, ZC_KC = 2048, ZC_VC = 2560;
constexpr size_t MiB = 1u << 20;
constexpr size_t WS_CTL = 0, CTL_ZERO_BYTES = 4 * MiB;
constexpr size_t WS_STAT = 1 * MiB;
constexpr size_t WS_CV = 3 * MiB;
constexpr size_t CV_LAYER = 2 * (3072 + 5632);
constexpr size_t WS_W = 4 * MiB;
constexpr size_t W_IN_B = (size_t)ZC * DM * 2, W_O_B = (size_t)DM * DM * 2, W_GU_B = (size_t)GU * DM * 2, W_D_B = (size_t)DM * FF * 2;
constexpr size_t W_LAYER_B = W_IN_B + W_O_B + W_GU_B + W_D_B;
constexpr size_t WS_R0 = 64 * MiB, WS_R1 = 192 * MiB, WS_R2 = 320 * MiB, WS_BIG = 448 * MiB, WS_SP = 896 * MiB  , WS_CVP = 904 * MiB  , WS_END = 908 * MiB;
static_assert(WS_W + DEPTH * W_LAYER_B <= WS_R0, "weights fit below R0");
static_assert((size_t)M * ZC * 2 <= WS_END - WS_BIG && (size_t)M * DM * 4 <= WS_END - WS_BIG && (size_t)M * DM * 2 <= WS_R1 - WS_R0, "activation map");
constexpr int CW_TMO = 0, CW_BAR = 4096;
constexpr int RING_OFF = 0, RING_BYTES = 131072;
constexpr int LDSCTL_OFF = RING_BYTES, MISC_OFF = LDSCTL_OFF + 320;
constexpr int LDS_BYTES = 147456;

typedef unsigned short bf16;
typedef unsigned v4u __attribute__((ext_vector_type(4)));
typedef unsigned v2u __attribute__((ext_vector_type(2)));
typedef float f32x4 __attribute__((ext_vector_type(4)));
#define LDS_WAIT() asm volatile("s_waitcnt lgkmcnt(0)" ::: "memory")
__device__ __forceinline__ unsigned f2bf(float f) { unsigned u = __builtin_bit_cast(unsigned, f); return (u + 0x7fffu + ((u >> 16) & 1u)) >> 16; }
__device__ __forceinline__ unsigned pk2(float lo, float hi) { return f2bf(lo) | (f2bf(hi) << 16); }
__device__ __forceinline__ float bflo(unsigned w) { return __uint_as_float(w << 16); }
__device__ __forceinline__ float bfhi(unsigned w) { return __uint_as_float(w & 0xffff0000u); }
__device__ __forceinline__ float bf1(bf16 b) { return __uint_as_float((unsigned)b << 16); }
__device__ __forceinline__ void unpack8(const v4u w, float (&f)[8]) { f[0] = bflo(w.x); f[1] = bfhi(w.x); f[2] = bflo(w.y); f[3] = bfhi(w.y); f[4] = bflo(w.z); f[5] = bfhi(w.z); f[6] = bflo(w.w); f[7] = bfhi(w.w); }
__device__ __forceinline__ float wave_sum(float v, int lane) {
#pragma unroll
    for (int o = 1; o < 64; o <<= 1) v += __int_as_float(__builtin_amdgcn_ds_bpermute((lane ^ o) << 2, __float_as_int(v)));
    return v;
}
__device__ __forceinline__ int mbcnt64(unsigned long long m) { return (int)__builtin_amdgcn_mbcnt_hi((unsigned)(m >> 32), __builtin_amdgcn_mbcnt_lo((unsigned)m, 0u)); }
#define GAS __attribute__((address_space(1)))
#define LAS __attribute__((address_space(3)))
typedef GAS unsigned gu32;
#define RLX_AGENT __ATOMIC_RELAXED, __HIP_MEMORY_SCOPE_AGENT
#define VM_WAIT() asm volatile("s_waitcnt vmcnt(0)" ::: "memory")
__device__ __forceinline__ int lane_now() { int l; asm volatile("v_mbcnt_lo_u32_b32 %0, -1, 0\n\tv_mbcnt_hi_u32_b32 %0, -1, %0" : "=v"(l)); return l; }
#define XB_TMO      128
#define XB_XCNT(j)  (256  + 64 * (j))
#define XB_XSUB(j)  (1280 + 64 * (j))
#define XB_XGEN(j)  (2304 + 64 * (j))
#define XB_TOP      3328
#define XB_TOPGEN   3392
#define XCD_BAR_WORDS 3456
#define XB_SPIN_CAP (1u << 24)

__device__ __forceinline__ unsigned xb_ld(unsigned* p)              { return __hip_atomic_load(p, __ATOMIC_RELAXED, __HIP_MEMORY_SCOPE_AGENT); }
__device__ __forceinline__ unsigned xb_add(unsigned* p, unsigned v) { return __hip_atomic_fetch_add(p, v, __ATOMIC_RELAXED, __HIP_MEMORY_SCOPE_AGENT); }
__device__ __forceinline__ unsigned xb_xcc_id() { return (unsigned)__builtin_amdgcn_s_getreg((3 << 11) | 20) & 0xFu; }
#define XB_SPIN(cond, bar) do { unsigned _sp = 0; while (cond) { __builtin_amdgcn_s_sleep(1); \
    if ((++_sp & 255u) == 0u) { if (xb_ld(&(bar)[XB_TMO])) break; if (_sp > XB_SPIN_CAP) { atomicAdd(&(bar)[XB_TMO], 1u); break; } } } } while (0)

struct XcdBarrier {
    unsigned* bar; unsigned x;
    volatile LAS unsigned* st;
};

__device__ __forceinline__ XcdBarrier xcd_barrier_post(unsigned* bar, volatile LAS unsigned* st) {
    XcdBarrier b; b.bar = bar; b.x = (unsigned)__builtin_amdgcn_readfirstlane((int)xb_xcc_id()); b.st = st;
    if (threadIdx.x == 0) (void)xb_add(&bar[XB_XCNT(b.x)], 1u);
    return b;
}
__device__ __forceinline__ void xcd_barrier_complete(unsigned* bar, unsigned x, unsigned& nloc, unsigned& nx) {
    const unsigned G = gridDim.x * gridDim.y * gridDim.z;
    unsigned sum, cnt, mine, sp = 0u;
    for (;;) {
        sum = 0u; cnt = 0u; mine = 0u;
#pragma unroll
        for (unsigned j = 0; j < 16; ++j) { const unsigned c = xb_ld(&bar[XB_XCNT(j)]); sum += c; cnt += (c > 0u) ? 1u : 0u; mine = (j == x) ? c : mine; }
        if (sum == G) break;
        __builtin_amdgcn_s_sleep(1);
        if ((++sp & 255u) == 0u) { if (xb_ld(&bar[XB_TMO])) break; if (sp > XB_SPIN_CAP) { atomicAdd(&bar[XB_TMO], 1u); break; } }
    }
    nloc = mine > 0u ? mine : 1u; nx = cnt > 0u ? cnt : 1u;
}

__device__ __forceinline__ void xcd_barrier(const XcdBarrier& b) {
    asm volatile("s_waitcnt vmcnt(0)" ::: "memory");
    __syncthreads();
    if (threadIdx.x == 0) {
        unsigned* bar = b.bar; asm volatile("" : "+s"(bar));
        const unsigned bx_ = (unsigned)__builtin_amdgcn_readfirstlane((int)xb_xcc_id());
        __builtin_amdgcn_s_waitcnt(0);
        unsigned nloc = b.st[0], nx = b.st[1];
        if (nloc == 0u) { xcd_barrier_complete(bar, bx_, nloc, nx); b.st[0] = nloc; b.st[1] = nx; }
        const unsigned old = xb_add(&bar[XB_XSUB(bx_)], 1u);
        const unsigned gen = old / nloc;
        if (old + 1u == (gen + 1u) * nloc) {
            __builtin_amdgcn_fence(__ATOMIC_RELEASE, "agent");
            asm volatile("s_waitcnt vmcnt(0)" ::: "memory");
            const unsigned og = xb_add(&bar[XB_TOP], 1u);
            const unsigned tg = og / nx;
            if (og + 1u == (tg + 1u) * nx) xb_add(&bar[XB_TOPGEN], 1u);
            else XB_SPIN(xb_ld(&bar[XB_TOPGEN]) == tg, bar);
            __builtin_amdgcn_fence(__ATOMIC_ACQUIRE, "agent");
            xb_add(&bar[XB_XGEN(bx_)], 1u);
            asm volatile("s_waitcnt vmcnt(0)" ::: "memory");
        } else {
            XB_SPIN(xb_ld(&bar[XB_XGEN(bx_)]) == gen, bar);
            __builtin_amdgcn_fence(__ATOMIC_ACQUIRE, "agent");
            asm volatile("s_waitcnt vmcnt(0)" ::: "memory");
        }
    }
    __syncthreads();
}
template <int TYPE, int FP8S = 0> __device__ __forceinline__ void transpose_item(const float* W0, const float* W1, const float* gk, const float* bk, float* c1o, float* c0o, int K, int Nsrc, int Ndst, bf16* WT, LAS float* scr, int item, int lane) {
    const int nblk = Ndst / 32, kb = item / nblk, nb = item % nblk, k0 = 64 * kb, n0 = 32 * nb;
    const int nd = n0 + (lane & 31);
    const float* src = W0; int c = nd; float sc = 1.f; bool pad = false;
    if (TYPE == 0) {
        if (nd < 708) c = nd; else if (nd < 768) { pad = true; c = 0; } else c = nd - 60;
        if (nd < 256) sc = 0.125f * LOG2E; else if (nd >= ZC_QB && nd < ZC_KB) sc = 0.17677669529663687f * LOG2E; else if (nd >= ZC_QC && nd < ZC_KC) sc = 0.125f * LOG2E;
    } else if (TYPE == 2) {
        const int tile = nd >> 8, w = nd & 255;
        if (w < 128) { src = W0; c = tile * 128 + w; } else { src = W1; c = tile * 128 + (w - 128); }
    }
    float s1 = 0.f, s0 = 0.f;
#pragma unroll
    for (int i = 0; i < 32; ++i) { const int kk = 2 * i + (lane >> 5); float v = pad ? 0.f : src[(size_t)(k0 + kk) * Nsrc + c] * sc;
        if (gk) { s0 += bk[k0 + kk] * v; v *= gk[k0 + kk];
            if (FP8S) s1 += __builtin_amdgcn_cvt_f32_fp8(__builtin_amdgcn_cvt_pk_fp8_f32(v * (float)(1 << FP8S), 0.f, 0, false), 0) * (1.f / (float)(1 << FP8S));
            else s1 += __uint_as_float(f2bf(v) << 16); }
        scr[kk * 33 + (lane & 31)] = v; }
    if (gk) { s1 += __int_as_float(__builtin_amdgcn_ds_bpermute((lane ^ 32) << 2, __float_as_int(s1))); s0 += __int_as_float(__builtin_amdgcn_ds_bpermute((lane ^ 32) << 2, __float_as_int(s0)));
        if (lane < 32 && c1o) { c1o[(size_t)kb * CV_LAYER + nd] = s1; c0o[(size_t)kb * CV_LAYER + nd] = s0; } }
    LDS_WAIT();
    const int c8 = lane & 7;
#pragma unroll
    for (int j = 0; j < 4; ++j) { const int n = (lane >> 3) + 8 * j; const LAS float* s = scr + (8 * c8) * 33 + n;
        if (FP8S) {
            const float S = (float)(1 << FP8S);
            int w0 = __builtin_amdgcn_cvt_pk_fp8_f32(s[0 * 33] * S, s[1 * 33] * S, 0, false); w0 = __builtin_amdgcn_cvt_pk_fp8_f32(s[2 * 33] * S, s[3 * 33] * S, w0, true);
            int w1 = __builtin_amdgcn_cvt_pk_fp8_f32(s[4 * 33] * S, s[5 * 33] * S, 0, false); w1 = __builtin_amdgcn_cvt_pk_fp8_f32(s[6 * 33] * S, s[7 * 33] * S, w1, true);
            v2u o; o.x = (unsigned)w0; o.y = (unsigned)w1; *(v2u*)((unsigned char*)WT + (size_t)(n0 + n) * K + k0 + 8 * c8) = o;
        } else {
        v4u o; o.x = pk2(s[0 * 33], s[1 * 33]); o.y = pk2(s[2 * 33], s[3 * 33]); o.z = pk2(s[4 * 33], s[5 * 33]); o.w = pk2(s[6 * 33], s[7 * 33]);
        *(v4u*)(WT + (size_t)(n0 + n) * K + k0 + 8 * c8) = o; } }
    LDS_WAIT();
}

template <bool OUT_F32> __device__ __forceinline__ void ln_phase(const float* H, const float* g, const float* b, bf16* ob, float* of, int gw, int NGW, int lane) {
    asm volatile("" : "+v"(lane));
    f32x4 gv[4], bv[4];
#pragma unroll
    for (int j = 0; j < 4; ++j) { gv[j] = ((const f32x4*)g)[lane + 64 * j]; bv[j] = ((const f32x4*)b)[lane + 64 * j]; }
    for (int m = gw; m < M; m += NGW) {
        const f32x4* xr = (const f32x4*)(H + (size_t)m * DM) + lane;
        f32x4 v[4]; float s = 0.f;
#pragma unroll
        for (int j = 0; j < 4; ++j) { v[j] = xr[64 * j]; s += (v[j].x + v[j].y) + (v[j].z + v[j].w); }
        const float mean = wave_sum(s, lane) * (1.f / DM); float s2 = 0.f;
#pragma unroll
        for (int j = 0; j < 4; ++j) { v[j] = v[j] - mean; s2 += (v[j].x * v[j].x + v[j].y * v[j].y) + (v[j].z * v[j].z + v[j].w * v[j].w); }
        const float rstd = 1.f / sqrtf(wave_sum(s2, lane) * (1.f / DM) + LN_EPS);
#pragma unroll
        for (int j = 0; j < 4; ++j) { const f32x4 y = v[j] * rstd * gv[j] + bv[j];
            if (OUT_F32) ((f32x4*)(of + (size_t)m * DM))[lane + 64 * j] = y;
            else { v2u o; o.x = pk2(y.x, y.y); o.y = pk2(y.z, y.w); ((v2u*)(ob + (size_t)m * DM))[lane + 64 * j] = o; } }
    }
}


__device__ __forceinline__ void stats_reduce(const float* part, float* ssum, float* ssq, size_t gt, size_t nth) {
    for (size_t row = gt; row < (size_t)M; row += nth) { float s = 0.f, q = 0.f;
#pragma unroll
        for (int sl = 0; sl < 16; ++sl) { s += part[(size_t)sl * M + row]; q += part[(size_t)(16 + sl) * M + row]; }
        ssum[row] = s; ssq[row] = q; }
}
__device__ __forceinline__ void cv_reduce(const float* cvp, float* cv, size_t gt, size_t nth) {
    for (size_t i = gt; i < (size_t)DEPTH * CV_LAYER; i += nth) { const size_t l = i / CV_LAYER, j = i % CV_LAYER;
        if (l == 0 && j < 2 * (size_t)ZC) continue;
        float s = 0.f;
#pragma unroll
        for (int kb = 0; kb < 16; ++kb) s += cvp[(l * 16 + kb) * CV_LAYER + j];
        cv[i] = s; }
}
typedef short bf16x8v __attribute__((ext_vector_type(8)));
typedef float f32x16 __attribute__((ext_vector_type(16)));
typedef short s16x4 __attribute__((ext_vector_type(4)));
typedef short v4i16_t __attribute__((ext_vector_type(4)));
typedef float f32x2_t __attribute__((ext_vector_type(2)));
typedef __bf16 bf16x2_t __attribute__((ext_vector_type(2)));
__device__ __forceinline__ unsigned cvtpk(float lo, float hi) { f32x2_t v = {lo, hi}; bf16x2_t b = __builtin_convertvector(v, bf16x2_t); return __builtin_bit_cast(unsigned, b); }
__device__ __forceinline__ s16x4 lds_tr(LAS const unsigned char* p) { return __builtin_bit_cast(s16x4, __builtin_amdgcn_ds_read_tr16_b64_v4i16((LAS v4i16_t*)p)); }
__device__ __forceinline__ float swap_max(float v) { auto rr = __builtin_amdgcn_permlane32_swap(__float_as_uint(v), __float_as_uint(v), false, false); return fmaxf(__uint_as_float(rr[0]), __uint_as_float(rr[1])); }
__device__ __forceinline__ float swap_sum(float v) { auto rr = __builtin_amdgcn_permlane32_swap(__float_as_uint(v), __float_as_uint(v), false, false); return __uint_as_float(rr[0]) + __uint_as_float(rr[1]); }
#ifndef FL_MFMA_SUM
#define FL_MFMA_SUM 1
#endif
#ifndef FL_CLASS
#define FL_CLASS 1
#endif
constexpr float FL_THR = 4.0f;
constexpr int FL_K = 0, FL_V = 16384, FL_TAB = 32768, FL_TABN = 2112;

__device__ __forceinline__ void fl_softmax(f32x16& p, float& m, float& l, f32x16 (&o)[2], bf16x8v (&pa)[2]) {
    const bool first = m < -1e29f;
    const float mref = first ? 0.f : m;
#pragma unroll
    for (int r = 0; r < 16; ++r) p[r] -= mref;
    float rm = fmaxf(fmaxf(p[0], p[1]), fmaxf(p[2], p[3]));
#pragma unroll
    for (int r = 4; r < 16; r += 4) rm = fmaxf(rm, fmaxf(fmaxf(p[r], p[r + 1]), fmaxf(p[r + 2], p[r + 3])));
    rm = swap_max(rm);
    const float dl = first ? ((rm > -1e29f) ? rm : 0.f) : ((rm > FL_THR) ? rm : 0.f);
    if (__any(dl != 0.f)) { const float al = first ? 1.f : __builtin_amdgcn_exp2f(-dl); l *= al;     o[0] *= al; o[1] *= al;
#pragma unroll
        for (int r = 0; r < 16; ++r) p[r] -= dl; }
    m = first ? ((rm > -1e29f) ? rm : m) : m + dl;
    float ls = 0.f;
#pragma unroll
    for (int r = 0; r < 16; ++r) { p[r] = __builtin_amdgcn_exp2f(p[r]); ls += p[r]; }
    l += ls;
    typedef unsigned u4 __attribute__((ext_vector_type(4)));
    u4 w0, w1; w0.x = cvtpk(p[0], p[1]); w0.y = cvtpk(p[2], p[3]); w0.z = cvtpk(p[4], p[5]); w0.w = cvtpk(p[6], p[7]);
    w1.x = cvtpk(p[8], p[9]); w1.y = cvtpk(p[10], p[11]); w1.z = cvtpk(p[12], p[13]); w1.w = cvtpk(p[14], p[15]);
    pa[0] = __builtin_bit_cast(bf16x8v, w0); pa[1] = __builtin_bit_cast(bf16x8v, w1);
}

__device__ __forceinline__ void fl_softmax2(f32x16& pa_, f32x16& pb_, float& m, float& l, f32x16 (&o)[2], bf16x8v (&pf)[4]) {
    const bool first = m < -1e29f;
    const float mref = first ? 0.f : m;
#pragma unroll
    for (int r = 0; r < 16; ++r) { pa_[r] -= mref; pb_[r] -= mref; }
    float rm = fmaxf(fmaxf(pa_[0], pa_[1]), fmaxf(pb_[0], pb_[1]));
#pragma unroll
    for (int r = 2; r < 16; r += 2) rm = fmaxf(rm, fmaxf(fmaxf(pa_[r], pa_[r + 1]), fmaxf(pb_[r], pb_[r + 1])));
    rm = swap_max(rm);
    const float dl = first ? ((rm > -1e29f) ? rm : 0.f) : ((rm > FL_THR) ? rm : 0.f);
    if (__any(dl != 0.f)) { const float al = first ? 1.f : __builtin_amdgcn_exp2f(-dl); l *= al; o[0] *= al; o[1] *= al;
#pragma unroll
        for (int r = 0; r < 16; ++r) { pa_[r] -= dl; pb_[r] -= dl; } }
    m = first ? ((rm > -1e29f) ? rm : m) : m + dl;
    float ls0 = 0.f, ls1 = 0.f;
#pragma unroll
    for (int r = 0; r < 16; ++r) { pa_[r] = __builtin_amdgcn_exp2f(pa_[r]); ls0 += pa_[r]; pb_[r] = __builtin_amdgcn_exp2f(pb_[r]); ls1 += pb_[r]; }
    l += ls0 + ls1;
    typedef unsigned u4 __attribute__((ext_vector_type(4)));
    u4 w;
    w.x = cvtpk(pa_[0], pa_[1]); w.y = cvtpk(pa_[2], pa_[3]); w.z = cvtpk(pa_[4], pa_[5]); w.w = cvtpk(pa_[6], pa_[7]); pf[0] = __builtin_bit_cast(bf16x8v, w);
    w.x = cvtpk(pa_[8], pa_[9]); w.y = cvtpk(pa_[10], pa_[11]); w.z = cvtpk(pa_[12], pa_[13]); w.w = cvtpk(pa_[14], pa_[15]); pf[1] = __builtin_bit_cast(bf16x8v, w);
    w.x = cvtpk(pb_[0], pb_[1]); w.y = cvtpk(pb_[2], pb_[3]); w.z = cvtpk(pb_[4], pb_[5]); w.w = cvtpk(pb_[6], pb_[7]); pf[2] = __builtin_bit_cast(bf16x8v, w);
    w.x = cvtpk(pb_[8], pb_[9]); w.y = cvtpk(pb_[10], pb_[11]); w.z = cvtpk(pb_[12], pb_[13]); w.w = cvtpk(pb_[14], pb_[15]); pf[3] = __builtin_bit_cast(bf16x8v, w);
}

__device__ __forceinline__ void fl_softmax3(f32x16& pa_, f32x16& pb_, float sha, float shb, float& m, float& l, f32x16 (&o)[2], bf16x8v (&pf)[4]) {
    const bool first = m < -1e29f;
    const float mref = first ? 0.f : m, ca = sha - mref, cb = shb - mref;
#pragma unroll
    for (int r = 0; r < 16; ++r) { pa_[r] += ca; pb_[r] += cb; }
    float rm = fmaxf(fmaxf(pa_[0], pa_[1]), fmaxf(pb_[0], pb_[1]));
#pragma unroll
    for (int r = 2; r < 16; r += 2) rm = fmaxf(rm, fmaxf(fmaxf(pa_[r], pa_[r + 1]), fmaxf(pb_[r], pb_[r + 1])));
    rm = swap_max(rm);
    const float dl = first ? ((rm > -1e29f) ? rm : 0.f) : ((rm > FL_THR) ? rm : 0.f);
    if (__any(dl != 0.f)) { const float al = first ? 1.f : __builtin_amdgcn_exp2f(-dl); l *= al; o[0] *= al; o[1] *= al;
#pragma unroll
        for (int r = 0; r < 16; ++r) { pa_[r] -= dl; pb_[r] -= dl; } }
    m = first ? ((rm > -1e29f) ? rm : m) : m + dl;
    float ls0 = 0.f, ls1 = 0.f;
#pragma unroll
    for (int r = 0; r < 16; ++r) { pa_[r] = __builtin_amdgcn_exp2f(pa_[r]); ls0 += pa_[r]; pb_[r] = __builtin_amdgcn_exp2f(pb_[r]); ls1 += pb_[r]; }
    l += ls0 + ls1;
    typedef unsigned u4 __attribute__((ext_vector_type(4)));
    u4 w;
    w.x = cvtpk(pa_[0], pa_[1]); w.y = cvtpk(pa_[2], pa_[3]); w.z = cvtpk(pa_[4], pa_[5]); w.w = cvtpk(pa_[6], pa_[7]); pf[0] = __builtin_bit_cast(bf16x8v, w);
    w.x = cvtpk(pa_[8], pa_[9]); w.y = cvtpk(pa_[10], pa_[11]); w.z = cvtpk(pa_[12], pa_[13]); w.w = cvtpk(pa_[14], pa_[15]); pf[1] = __builtin_bit_cast(bf16x8v, w);
    w.x = cvtpk(pb_[0], pb_[1]); w.y = cvtpk(pb_[2], pb_[3]); w.z = cvtpk(pb_[4], pb_[5]); w.w = cvtpk(pb_[6], pb_[7]); pf[2] = __builtin_bit_cast(bf16x8v, w);
    w.x = cvtpk(pb_[8], pb_[9]); w.y = cvtpk(pb_[10], pb_[11]); w.z = cvtpk(pb_[12], pb_[13]); w.w = cvtpk(pb_[14], pb_[15]); pf[3] = __builtin_bit_cast(bf16x8v, w);
}
__device__ __forceinline__ float fl_rowsum(const bf16x8v (&pf)[4]) {
    const bf16x8v ones = (bf16x8v){0x3f80, 0x3f80, 0x3f80, 0x3f80, 0x3f80, 0x3f80, 0x3f80, 0x3f80};
    f32x16 z;
#pragma unroll
    for (int r = 0; r < 16; ++r) z[r] = 0.f;
    z = __builtin_amdgcn_mfma_f32_32x32x16_bf16(ones, pf[0], z, 0, 0, 0); z = __builtin_amdgcn_mfma_f32_32x32x16_bf16(ones, pf[1], z, 0, 0, 0);
    z = __builtin_amdgcn_mfma_f32_32x32x16_bf16(ones, pf[2], z, 0, 0, 0); z = __builtin_amdgcn_mfma_f32_32x32x16_bf16(ones, pf[3], z, 0, 0, 0);
    return z[0];
}

template <int MODE> __device__ __forceinline__ void flash_unit(const bf16* Z, bf16* MIX, LAS unsigned char* L, int b, int h, int qb, float lam_full, float lambda_init, const float* subg, int tid, int wave, int lane) {
    lane = lane_now(); tid = wave * 64 + lane;
    constexpr int NMAP = MODE == 0 ? 2 : 1, KS = 4 / NMAP;
    constexpr int CQ = MODE == 0 ? ZC_QB : ZC_QC, CK = MODE == 0 ? ZC_KB : ZC_KC, CV = MODE == 0 ? ZC_VB : ZC_VC;
    const int r32 = lane & 31, hi = lane >> 5;
    LAS unsigned char* Kb = L + FL_K; LAS unsigned char* Vb = L + FL_V; LAS float* tab = (LAS float*)(L + FL_TAB);
    const int Q0 = qb * 256, tq0 = Q0 + wave * 32, t = tq0 + r32;
    const bf16* zb = Z + (size_t)(b * SEQ) * ZC;
    const float sl = (MODE == 0 ? __builtin_amdgcn_exp2f(-2.f * (float)(h + 1)) : __builtin_amdgcn_exp2f(-(float)(h + 1))) * LOG2E;
    for (int j = tid; j < FL_TABN; j += NWAVES * 64) { const int d = 2047 - j; float v;
        if (MODE == 0) v = d < 0 ? -INFINITY : -sl * (float)d;
        else { const int mult = (d <= 128 ? 1 : 0) + (((d & 3) == 0 && d <= 512) ? 1 : 0) + ((d & 15) == 0 ? 1 : 0);
               v = (d < 0 || mult == 0) ? -INFINITY : -sl * (float)d + (mult == 1 ? 0.f : (mult == 2 ? 1.f : 1.5849625007211562f)); }
        tab[j] = v; }
    bf16x8v qf[NMAP][KS];
#pragma unroll
    for (int mp = 0; mp < NMAP; ++mp)
#pragma unroll
        for (int ks = 0; ks < KS; ++ks) qf[mp][ks] = *(const bf16x8v*)(zb + (size_t)t * ZC + CQ + h * 64 + (mp * KS + ks) * 16 + hi * 8);
    constexpr int NCLS = MODE == 0 ? 1 : 3;
    f32x16 cin[NCLS];
#pragma unroll
    for (int r = 0; r < 16; ++r) { const int cr = (r & 3) + 8 * (r >> 2) + 4 * hi; const float a = sl * (float)cr;
        if (MODE == 0) cin[0][r] = a;
        else { const bool m4 = ((t - cr) & 3) == 0, m16 = ((t - cr) & 15) == 0;
            cin[0][r] = a + (m16 ? 1.5849625007211562f : (m4 ? 1.f : 0.f)); cin[NCLS - 2][r] = m4 ? a + (m16 ? 1.f : 0.f) : -INFINITY; cin[NCLS - 1][r] = m16 ? a : -INFINITY; } }
    float m[NMAP], l[NMAP]; f32x16 o[NMAP][2];
#pragma unroll
    for (int mp = 0; mp < NMAP; ++mp) { m[mp] = -1e30f; l[mp] = 0.f;
#pragma unroll
        for (int r = 0; r < 16; ++r) { o[mp][0][r] = 0.f; o[mp][1][r] = 0.f; } }
    const int skey = tid >> 3, sc = tid & 7;
    const bf16* ksrc = zb + (size_t)skey * ZC + CK + h * 64 + sc * 8;
    const bf16* vsrc = zb + (size_t)skey * ZC + CV + h * 64 + sc * 8;
    const int kdst = (sc >> 1) * 2048 + (sc & 1) * 1024 + (skey >> 5) * 512 + (skey & 31) * 16;
    const int vdst = (sc >> 2) * 4096 + (skey >> 3) * 512 + (skey & 7) * 64 + (sc & 3) * 16;
    const int krd = hi * 1024 + r32 * 16;
    const int vrd = ((lane >> 4) & 1) * 32 + (lane & 3) * 8 + (4 * hi + ((lane & 15) >> 2)) * 64;
    int tilz = 64 * ZC; asm volatile("" : "+s"(tilz));
    int jt = Q0 / 64 + 3;
    v4u kA = *(const v4u*)(ksrc + (size_t)(jt * tilz)), vA = *(const v4u*)(vsrc + (size_t)(jt * tilz));
    v4u kB = *(const v4u*)(ksrc + (size_t)((jt - 1) * tilz)), vB = *(const v4u*)(vsrc + (size_t)((jt - 1) * tilz));
    *(LAS v4u*)(Kb + (jt & 1) * 8192 + kdst) = kA; *(LAS v4u*)(Vb + (jt & 1) * 8192 + vdst) = vA;
    __syncthreads();
#define FL_TILE(JT, KW, VW, KL, VL) do { const int jt_ = (JT); \
        if (jt_ >= 2) { KL = *(const v4u*)(ksrc + (size_t)((jt_ - 2) * tilz)); VL = *(const v4u*)(vsrc + (size_t)((jt_ - 2) * tilz)); } \
        const LAS unsigned char* Kc = Kb + (jt_ & 1) * 8192; const LAS unsigned char* Vc = Vb + (jt_ & 1) * 8192; \
        if (jt_ * 64 <= tq0) {                                            \
              \
            const LAS float* tp = tab + (2047 - t + jt_ * 64 + 4 * hi); \
            f32x16 bias0, bias1; \
            _Pragma("unroll") for (int r = 0; r < 16; ++r) { bias0[r] = tp[(r & 3) + 8 * (r >> 2)]; bias1[r] = tp[32 + (r & 3) + 8 * (r >> 2)]; } \
            _Pragma("unroll") for (int mp = 0; mp < NMAP; ++mp) { \
                f32x16 p0 = bias0, p1 = bias1; \
                _Pragma("unroll") for (int ks = 0; ks < KS; ++ks) { const bf16x8v kf0 = *(const LAS bf16x8v*)(Kc + (mp * KS + ks) * 2048 + krd), kf1 = *(const LAS bf16x8v*)(Kc + (mp * KS + ks) * 2048 + 512 + krd); \
                    p0 = __builtin_amdgcn_mfma_f32_32x32x16_bf16(kf0, qf[mp][ks], p0, 0, 0, 0); p1 = __builtin_amdgcn_mfma_f32_32x32x16_bf16(kf1, qf[mp][ks], p1, 0, 0, 0); } \
                bf16x8v pf[4]; \
                fl_softmax3(p0, p1, 0.f, 0.f, m[mp], l[mp], o[mp], pf); \
                _Pragma("unroll") for (int s4 = 0; s4 < 4; ++s4) _Pragma("unroll") for (int db = 0; db < 2; ++db) { const LAS unsigned char* vp = Vc + db * 4096 + s4 * 1024 + vrd; \
                        const s16x4 lo = lds_tr(vp), hh = lds_tr(vp + 512); \
                        const bf16x8v vf = (bf16x8v){lo[0], lo[1], lo[2], lo[3], hh[0], hh[1], hh[2], hh[3]}; \
                        o[mp][db] = __builtin_amdgcn_mfma_f32_32x32x16_bf16(vf, pf[s4], o[mp][db], 0, 0, 0); } } \
        } \
        if (jt_ >= 1) { *(LAS v4u*)(Kb + ((jt_ - 1) & 1) * 8192 + kdst) = KW; *(LAS v4u*)(Vb + ((jt_ - 1) & 1) * 8192 + vdst) = VW; } \
        __syncthreads(); } while (0)
    for (; jt >= 0; jt -= 2) { FL_TILE(jt, kB, vB, kA, vA); FL_TILE(jt - 1, kA, vA, kB, vB); }
#undef FL_TILE
    bf16* orow = MIX + (size_t)(b * SEQ + t) * DM + (MODE == 0 ? 256 : 512) + h * 64 + 4 * hi;
    if (MODE == 0) {
        const float i0 = 1.f / swap_sum(l[0]), i1 = lam_full / swap_sum(l[NMAP - 1]); float ss = 0.f;
#pragma unroll
        for (int db = 0; db < 2; ++db)
#pragma unroll
            for (int r = 0; r < 16; ++r) { const float v = o[0][db][r] * i0 - o[NMAP - 1][db][r] * i1; o[0][db][r] = v; ss += v * v; }
        const float rs = (1.f / sqrtf(swap_sum(ss) * (1.f / 64.f) + LN_EPS)) * lambda_init;
#pragma unroll
        for (int db = 0; db < 2; ++db)
#pragma unroll
            for (int rg = 0; rg < 4; ++rg) { const f32x4 g = *(const f32x4*)(subg + 32 * db + 8 * rg + 4 * hi);
                v2u w; w.x = cvtpk(o[0][db][4 * rg + 0] * rs * g.x, o[0][db][4 * rg + 1] * rs * g.y); w.y = cvtpk(o[0][db][4 * rg + 2] * rs * g.z, o[0][db][4 * rg + 3] * rs * g.w);
                *(v2u*)(orow + 32 * db + 8 * rg) = w; }
    } else {
        const float i0 = 1.f / swap_sum(l[0]);
#pragma unroll
        for (int db = 0; db < 2; ++db)
#pragma unroll
            for (int rg = 0; rg < 4; ++rg) { v2u w; w.x = cvtpk(o[0][db][4 * rg + 0] * i0, o[0][db][4 * rg + 1] * i0); w.y = cvtpk(o[0][db][4 * rg + 2] * i0, o[0][db][4 * rg + 3] * i0);
                *(v2u*)(orow + 32 * db + 8 * rg) = w; }
    }
}
template <int MODE> __device__ __forceinline__ void flash_phase(const bf16* Z, bf16* MIX, LAS unsigned char* L, const float* lam, const float* subg, float lambda_init, int vcu, int G, int tid, int wave, int lane) {
    asm volatile("" : "+v"(tid), "+v"(lane));
    constexpr int NH = MODE == 0 ? 4 : 8, NPAIR = BATCH * NH * 4;
    float lam_full = 0.f;
    if (MODE == 0) { const int li = lane & 31; const float s01 = wave_sum(lam[li] * lam[32 + li], lane) * 0.5f, s23 = wave_sum(lam[64 + li] * lam[96 + li], lane) * 0.5f; lam_full = __int_as_float(__builtin_amdgcn_readfirstlane(__float_as_int(expf(s01) - expf(s23) + lambda_init))); }
    const float oml = __int_as_float(__builtin_amdgcn_readfirstlane(__float_as_int(1.f - lambda_init)));
    for (int p = vcu; p < NPAIR; p += G) {
        const int b = p / (NH * 4), h = (p >> 2) % NH, x = p & 3;
#pragma unroll 1
        for (int k = 0; k < 2; ++k) { flash_unit<MODE>(Z, MIX, L, b, h, k == 0 ? 7 - x : x, lam_full, oml, subg, tid, wave, lane); __syncthreads(); }
    }
}
constexpr int F2_K = 0, F2_V = 24576, F2_TAB = 40960;
#define F2_QK(S, KSLOT, MP, JT) do { const LAS float* tp_ = tab + (2047 - t + (JT) * 64 + 4 * hi); const LAS unsigned char* kc_ = Kb + (KSLOT) * 8192; \
        _Pragma("unroll") for (int r = 0; r < 16; ++r) { S[0][r] = tp_[(r & 3) + 8 * (r >> 2)]; S[1][r] = tp_[32 + (r & 3) + 8 * (r >> 2)]; } \
        _Pragma("unroll") for (int ks = 0; ks < KS; ++ks) { const bf16x8v k0_ = *(const LAS bf16x8v*)(kc_ + ((MP) * KS + ks) * 2048 + krd), k1_ = *(const LAS bf16x8v*)(kc_ + ((MP) * KS + ks) * 2048 + 512 + krd); \
            S[0] = __builtin_amdgcn_mfma_f32_32x32x16_bf16(k0_, qf[MP][ks], S[0], 0, 0, 0); S[1] = __builtin_amdgcn_mfma_f32_32x32x16_bf16(k1_, qf[MP][ks], S[1], 0, 0, 0); } } while (0)
#define F2_BD(S, MP) do { float rm_ = fmaxf(fmaxf(S[0][0], S[0][1]), fmaxf(S[1][0], S[1][1])); \
        _Pragma("unroll") for (int r = 2; r < 16; r += 2) rm_ = fmaxf(rm_, fmaxf(fmaxf(S[0][r], S[0][r + 1]), fmaxf(S[1][r], S[1][r + 1]))); \
        rm_ = swap_max(rm_); const bool first_ = m[MP] < -1e29f; \
        const bool up_ = first_ ? (rm_ > -1e29f) : (rm_ > m[MP] + FL_THR); \
        if (__any(up_)) { const float nm_ = up_ ? rm_ : m[MP], al_ = (first_ || !up_) ? 1.f : __builtin_amdgcn_exp2f(m[MP] - nm_); l[MP] *= al_; o[MP][0] *= al_; o[MP][1] *= al_; m[MP] = nm_; } } while (0)
#define F2_SM(S, MP, PF) do { const float nm_ = -m[MP]; float ls0_ = 0.f, ls1_ = 0.f; \
        _Pragma("unroll") for (int r = 0; r < 16; ++r) { S[0][r] = __builtin_amdgcn_exp2f(S[0][r] + nm_); ls0_ += S[0][r]; S[1][r] = __builtin_amdgcn_exp2f(S[1][r] + nm_); ls1_ += S[1][r]; } \
        l[MP] += ls0_ + ls1_; \
        { typedef unsigned u4_ __attribute__((ext_vector_type(4))); u4_ w_; \
          w_.x = cvtpk(S[0][0], S[0][1]); w_.y = cvtpk(S[0][2], S[0][3]); w_.z = cvtpk(S[0][4], S[0][5]); w_.w = cvtpk(S[0][6], S[0][7]); PF[0] = __builtin_bit_cast(bf16x8v, w_); \
          w_.x = cvtpk(S[0][8], S[0][9]); w_.y = cvtpk(S[0][10], S[0][11]); w_.z = cvtpk(S[0][12], S[0][13]); w_.w = cvtpk(S[0][14], S[0][15]); PF[1] = __builtin_bit_cast(bf16x8v, w_); \
          w_.x = cvtpk(S[1][0], S[1][1]); w_.y = cvtpk(S[1][2], S[1][3]); w_.z = cvtpk(S[1][4], S[1][5]); w_.w = cvtpk(S[1][6], S[1][7]); PF[2] = __builtin_bit_cast(bf16x8v, w_); \
          w_.x = cvtpk(S[1][8], S[1][9]); w_.y = cvtpk(S[1][10], S[1][11]); w_.z = cvtpk(S[1][12], S[1][13]); w_.w = cvtpk(S[1][14], S[1][15]); PF[3] = __builtin_bit_cast(bf16x8v, w_); } } while (0)
#define F2_PV(MP, VSLOT, PF) do { const LAS unsigned char* vc_ = Vb + (VSLOT) * 8192; \
        _Pragma("unroll") for (int s4 = 0; s4 < 4; ++s4) _Pragma("unroll") for (int db = 0; db < 2; ++db) { const LAS unsigned char* vp_ = vc_ + db * 4096 + s4 * 1024 + vrd; \
            const s16x4 lo_ = lds_tr(vp_), hh_ = lds_tr(vp_ + 512); const bf16x8v vf_ = (bf16x8v){lo_[0], lo_[1], lo_[2], lo_[3], hh_[0], hh_[1], hh_[2], hh_[3]}; \
            o[MP][db] = __builtin_amdgcn_mfma_f32_32x32x16_bf16(vf_, PF[s4], o[MP][db], 0, 0, 0); } } while (0)

template <int MODE> __device__ __forceinline__ void flash_unit2(const bf16* Z, bf16* MIX, LAS unsigned char* L, int b, int h, int qb, float lam_full, float lambda_init, const float* subg, int wave) {
    const int lane = lane_now(), tid = wave * 64 + lane;
    constexpr int NMAP = MODE == 0 ? 2 : 1, KS = 4 / NMAP;
    constexpr int CQ = MODE == 0 ? ZC_QB : ZC_QC, CK = MODE == 0 ? ZC_KB : ZC_KC, CV = MODE == 0 ? ZC_VB : ZC_VC;
    const int r32 = lane & 31, hi = lane >> 5;
    LAS unsigned char* Kb = L + F2_K; LAS unsigned char* Vb = L + F2_V; LAS float* tab = (LAS float*)(L + F2_TAB);
    const int Q0 = qb * 256, tq0 = Q0 + wave * 32, t = tq0 + r32, Jw = tq0 >> 6;
    const bf16* zb = Z + (size_t)(b * SEQ) * ZC;
    const float sl = (MODE == 0 ? __builtin_amdgcn_exp2f(-2.f * (float)(h + 1)) : __builtin_amdgcn_exp2f(-(float)(h + 1))) * LOG2E;
    for (int j = tid; j < FL_TABN; j += NWAVES * 64) { const int d = 2047 - j; float v;
        if (MODE == 0) v = d < 0 ? -INFINITY : -sl * (float)d;
        else { const int mult = (d <= 128 ? 1 : 0) + (((d & 3) == 0 && d <= 512) ? 1 : 0) + ((d & 15) == 0 ? 1 : 0);
               v = (d < 0 || mult == 0) ? -INFINITY : -sl * (float)d + (mult == 1 ? 0.f : (mult == 2 ? 1.f : 1.5849625007211562f)); }
        tab[j] = v; }
    bf16x8v qf[NMAP][KS];
#pragma unroll
    for (int mp = 0; mp < NMAP; ++mp)
#pragma unroll
        for (int ks = 0; ks < KS; ++ks) qf[mp][ks] = *(const bf16x8v*)(zb + (size_t)t * ZC + CQ + h * 64 + (mp * KS + ks) * 16 + hi * 8);
    float m[NMAP], l[NMAP]; f32x16 o[NMAP][2];
#pragma unroll
    for (int mp = 0; mp < NMAP; ++mp) { m[mp] = -1e30f; l[mp] = 0.f;
#pragma unroll
        for (int r = 0; r < 16; ++r) { o[mp][0][r] = 0.f; o[mp][1][r] = 0.f; } }
    const int skey = tid >> 3, sc = tid & 7;
    const bf16* ksrc = zb + (size_t)skey * ZC + CK + h * 64 + sc * 8;
    const bf16* vsrc = zb + (size_t)skey * ZC + CV + h * 64 + sc * 8;
    const int kdst = (sc >> 1) * 2048 + (sc & 1) * 1024 + (skey >> 5) * 512 + (skey & 31) * 16;
    const int vdst = (sc >> 2) * 4096 + (skey >> 3) * 512 + (skey & 7) * 64 + (sc & 3) * 16;
    const int krd = hi * 1024 + r32 * 16;
    const int vrd = ((lane >> 4) & 1) * 32 + (lane & 3) * 8 + (4 * hi + ((lane & 15) >> 2)) * 64;
    const size_t til = (size_t)64 * ZC;
    const int J = Q0 / 64 + 3;
    int k0s = J % 3, k1s = (J + 2) % 3, k2s = (J + 1) % 3;
    { const v4u a = *(const v4u*)(ksrc + J * til), bq = *(const v4u*)(ksrc + (J - 1) * til), c = *(const v4u*)(vsrc + J * til);
      *(LAS v4u*)(Kb + k0s * 8192 + kdst) = a; *(LAS v4u*)(Kb + k1s * 8192 + kdst) = bq; *(LAS v4u*)(Vb + (J & 1) * 8192 + vdst) = c; }
    v4u kA = *(const v4u*)(ksrc + (J - 2) * til), vA = *(const v4u*)(vsrc + (J - 1) * til);
    v4u kB = kA, vB = vA;
    __syncthreads();
    f32x16 Sa[2], Sb[2];
    if (J <= Jw) { F2_QK(Sa, k0s, 0, J); F2_BD(Sa, 0); }
#define F2_TILE(JT, KW, VW, KL, VL, SC, SN) do { const int jt_ = (JT); \
        if (jt_ >= 3) KL = *(const v4u*)(ksrc + (jt_ - 3) * til); if (jt_ >= 2) VL = *(const v4u*)(vsrc + (jt_ - 2) * til); \
        if (MODE == 1) { \
            if (jt_ <= Jw && jt_ >= 1) { bf16x8v pf_[4]; if (wave >= 4) { F2_SM(SC, 0, pf_); F2_PV(0, jt_ & 1, pf_); F2_QK(SN, k1s, 0, jt_ - 1); F2_BD(SN, 0); } else { F2_QK(SN, k1s, 0, jt_ - 1); F2_SM(SC, 0, pf_); F2_PV(0, jt_ & 1, pf_); F2_BD(SN, 0); } } \
            else if (jt_ == Jw + 1) { F2_QK(SN, k1s, 0, jt_ - 1); F2_BD(SN, 0); } \
            else if (jt_ <= Jw) { bf16x8v pf_[4]; F2_SM(SC, 0, pf_); F2_PV(0, jt_ & 1, pf_); } \
        } else { \
            if (jt_ <= Jw) { bf16x8v pf_[4]; F2_QK(Sb, k0s, NMAP - 1, jt_); F2_SM(Sa, 0, pf_); F2_PV(0, jt_ & 1, pf_); F2_BD(Sb, NMAP - 1); } \
            if (jt_ <= Jw + 1 && jt_ >= 1) { F2_QK(Sa, k1s, 0, jt_ - 1); } \
            if (jt_ <= Jw) { bf16x8v pf_[4]; F2_SM(Sb, NMAP - 1, pf_); F2_PV(NMAP - 1, jt_ & 1, pf_); } \
            if (jt_ <= Jw + 1 && jt_ >= 1) { F2_BD(Sa, 0); } \
        } \
        if (jt_ >= 2) *(LAS v4u*)(Kb + k2s * 8192 + kdst) = KW; if (jt_ >= 1) *(LAS v4u*)(Vb + ((jt_ - 1) & 1) * 8192 + vdst) = VW; \
        { const int t_ = k0s; k0s = k1s; k1s = k2s; k2s = t_; } \
        __syncthreads(); } while (0)
    for (int jt = J; jt >= 0; jt -= 2) { F2_TILE(jt, kA, vA, kB, vB, Sa, Sb); F2_TILE(jt - 1, kB, vB, kA, vA, Sb, Sa); }
#undef F2_TILE
    bf16* orow = MIX + (size_t)(b * SEQ + t) * DM + (MODE == 0 ? 256 : 512) + h * 64 + 4 * hi;
    if (MODE == 0) {
        const float i0 = 1.f / swap_sum(l[0]), i1 = lam_full / swap_sum(l[NMAP - 1]); float ss = 0.f;
#pragma unroll
        for (int db = 0; db < 2; ++db)
#pragma unroll
            for (int r = 0; r < 16; ++r) { const float v = o[0][db][r] * i0 - o[NMAP - 1][db][r] * i1; o[0][db][r] = v; ss += v * v; }
        const float rs = (1.f / sqrtf(swap_sum(ss) * (1.f / 64.f) + LN_EPS)) * (1.f - lambda_init);
#pragma unroll
        for (int db = 0; db < 2; ++db)
#pragma unroll
            for (int rg = 0; rg < 4; ++rg) { const f32x4 g = *(const f32x4*)(subg + 32 * db + 8 * rg + 4 * hi);
                v2u w; w.x = cvtpk(o[0][db][4 * rg + 0] * rs * g.x, o[0][db][4 * rg + 1] * rs * g.y); w.y = cvtpk(o[0][db][4 * rg + 2] * rs * g.z, o[0][db][4 * rg + 3] * rs * g.w);
                *(v2u*)(orow + 32 * db + 8 * rg) = w; }
    } else {
        const float i0 = 1.f / swap_sum(l[0]);
#pragma unroll
        for (int db = 0; db < 2; ++db)
#pragma unroll
            for (int rg = 0; rg < 4; ++rg) { v2u w; w.x = cvtpk(o[0][db][4 * rg + 0] * i0, o[0][db][4 * rg + 1] * i0); w.y = cvtpk(o[0][db][4 * rg + 2] * i0, o[0][db][4 * rg + 3] * i0);
                *(v2u*)(orow + 32 * db + 8 * rg) = w; }
    }
}
template <int MODE> __device__ __forceinline__ void flash_phase2(const bf16* Z, bf16* MIX, LAS unsigned char* L, const float* lam, const float* subg, float lambda_init, int vcu, int G, int tid, int wave, int lane) {
    constexpr int NH = MODE == 0 ? 4 : 8, NPAIR = BATCH * NH * 4;
    float lam_full = 0.f;
    if (MODE == 0) { const int li = lane & 31; const float s01 = wave_sum(lam[li] * lam[32 + li], lane) * 0.5f, s23 = wave_sum(lam[64 + li] * lam[96 + li], lane) * 0.5f; lam_full = expf(s01) - expf(s23) + lambda_init; }
    for (int p = vcu; p < NPAIR; p += G) {
        const int b = p / (NH * 4), h = (p >> 2) % NH, x = p & 3;
#pragma unroll 1
        for (int k = 0; k < 2; ++k) { flash_unit2<MODE>(Z, MIX, L, b, h, k == 0 ? 7 - x : x, lam_full, lambda_init, subg, wave); __syncthreads(); }
    }
}
constexpr int MA_K = 0, MA_V = 32768, MA_BM = 65536, MA_BMS = 68  , MA_WQ = MA_BM + 32 * MA_BMS * 4, MA_MG = MA_WQ + 512, MA_SEL = MA_MG + 4 * 34 * 64 * 4, MA_END = MA_SEL + NWAVES * 2560;
static_assert(MA_END <= RING_BYTES, "mixer A LDS map");

__device__ __forceinline__ unsigned ordkey(float f) { const unsigned u = __float_as_uint(f); return u ^ ((unsigned)((int)u >> 31) | 0x80000000u); }
#define DPP_I(v, ctrl) __builtin_amdgcn_update_dpp(0, (v), (ctrl), 0xf, 0xf, false)
__device__ __forceinline__ float wave_max_dpp(float v) {
    v = fmaxf(v, __int_as_float(DPP_I(__float_as_int(v), 0xB1))); v = fmaxf(v, __int_as_float(DPP_I(__float_as_int(v), 0x4E)));
    v = fmaxf(v, __int_as_float(DPP_I(__float_as_int(v), 0x141))); v = fmaxf(v, __int_as_float(DPP_I(__float_as_int(v), 0x140)));
    const int i = __float_as_int(v);
    return fmaxf(fmaxf(__int_as_float(__builtin_amdgcn_readlane(i, 0)), __int_as_float(__builtin_amdgcn_readlane(i, 16))), fmaxf(__int_as_float(__builtin_amdgcn_readlane(i, 32)), __int_as_float(__builtin_amdgcn_readlane(i, 48))));
}
__device__ __forceinline__ float wave_min_dpp(float v) {
    v = fminf(v, __int_as_float(DPP_I(__float_as_int(v), 0xB1))); v = fminf(v, __int_as_float(DPP_I(__float_as_int(v), 0x4E)));
    v = fminf(v, __int_as_float(DPP_I(__float_as_int(v), 0x141))); v = fminf(v, __int_as_float(DPP_I(__float_as_int(v), 0x140)));
    const int i = __float_as_int(v);
    return fminf(fminf(__int_as_float(__builtin_amdgcn_readlane(i, 0)), __int_as_float(__builtin_amdgcn_readlane(i, 16))), fminf(__int_as_float(__builtin_amdgcn_readlane(i, 32)), __int_as_float(__builtin_amdgcn_readlane(i, 48))));
}
__device__ __forceinline__ int wave_prefix_dpp(int x, int lane) {
    x += DPP_I(x, 0x111); x += DPP_I(x, 0x112); x += DPP_I(x, 0x114); x += DPP_I(x, 0x118);
    const int t0 = __builtin_amdgcn_readlane(x, 15), t1 = __builtin_amdgcn_readlane(x, 31), t2 = __builtin_amdgcn_readlane(x, 47);
    return x + (lane >= 16 ? t0 : 0) + (lane >= 32 ? t1 : 0) + (lane >= 48 ? t2 : 0);
}
template <int NJ> __device__ __forceinline__ void select_load(const float* srow, int t, int lane, float (&raw)[NJ]) {
#pragma unroll
    for (int j = 0; j < NJ; ++j) { const int kx = 64 * j + lane; raw[j] = srow[kx < t ? kx : t]; }
}
template <int NJ> __device__ __forceinline__ unsigned select_row_t(const float (&raw)[NJ], int t, LAS unsigned* hist, LAS unsigned* clist, int lane) {
    float f[NJ]; int bn[NJ];
    float NINF = -INFINITY, PINF = INFINITY; int C255 = 255; asm volatile("" : "+v"(NINF), "+v"(PINF), "+v"(C255));
    float vmax = NINF, vmin = PINF;
#pragma unroll
    for (int j = 0; j < NJ; ++j) { const int kx = 64 * j + lane; const float v = raw[j] + 0.0f; const bool ok = kx <= t; f[j] = ok ? v : NINF; vmax = fmaxf(vmax, f[j]); vmin = fminf(vmin, ok ? v : PINF); }
    vmax = wave_max_dpp(vmax); vmin = wave_min_dpp(vmin);
    const float scale = 255.99f / (vmax - vmin);
    { unsigned z_ = 0u; asm volatile("" : "+v"(z_)); ((LAS v4u*)hist)[lane] = (v4u){z_, z_, z_, z_}; }
#pragma unroll
    for (int j = 0; j < NJ; ++j) { int bi = (int)((f[j] - vmin) * scale); bi = bi > C255 ? C255 : bi; bi = bi < 0 ? 0 : bi; bn[j] = (64 * j + lane <= t) ? bi : -1;
        if (bn[j] >= 0) __hip_atomic_fetch_add(hist + bn[j], 1u, __ATOMIC_RELAXED, __HIP_MEMORY_SCOPE_WAVEFRONT); }
    LDS_WAIT();
    const v4u hv = ((const LAS v4u*)hist)[63 - lane];
    const int ssum = (int)(hv.x + hv.y + hv.z + hv.w);
    const int x = wave_prefix_dpp(ssum, lane);
    const int above = x - ssum; const bool found = above < 256 && x >= 256;
    int bsel, cab;
    { const int c3 = above + (int)hv.w, c2 = c3 + (int)hv.z, c1 = c2 + (int)hv.y; const int b0 = 4 * (63 - lane);
      if (c3 >= 256) { bsel = b0 + 3; cab = above; } else if (c2 >= 256) { bsel = b0 + 2; cab = c3; } else if (c1 >= 256) { bsel = b0 + 1; cab = c2; } else { bsel = b0; cab = c1; } }
    const unsigned long long fm = __ballot(found);
    const int src = (int)__builtin_ctzll(fm);
    const int bstar = __builtin_amdgcn_readlane(bsel, src), c_above = __builtin_amdgcn_readlane(cab, src);
    unsigned key[NJ];
#pragma unroll
    for (int j = 0; j < NJ; ++j) key[j] = ordkey(f[j]);
    int base = 0;
#pragma unroll
    for (int j = 0; j < NJ; ++j) { const bool isc = bn[j] == bstar; const unsigned long long cm = __ballot(isc); const int pos = base + mbcnt64(cm);
        clist[(isc && pos < 256) ? pos : 256 + lane] = key[j]; base += __popcll(cm); }
    LDS_WAIT();
    const int ncand = base, need = 256 - c_above;
    unsigned T = 0u; int cge;
    if (ncand <= 64) {
        const unsigned ck = lane < ncand ? clist[lane] : 0u;
        int g = 0, e = 0;
#pragma unroll 1
        for (int i = 0; i < ncand; ++i) { const unsigned sk = (unsigned)__builtin_amdgcn_readlane((int)ck, i); g += (sk > ck) ? 1 : 0; e += (sk == ck) ? 1 : 0; }
        const unsigned long long hit = __ballot(lane < ncand && g < need && need <= g + e);
        const int src2 = (int)__builtin_ctzll(hit);
        T = (unsigned)__builtin_amdgcn_readlane((int)ck, src2);
        cge = c_above + __builtin_amdgcn_readlane(g, src2) + __builtin_amdgcn_readlane(e, src2);
    } else if (ncand <= 256) {
        unsigned ck[4];
#pragma unroll
        for (int r = 0; r < 4; ++r) ck[r] = (r * 64 + lane < ncand) ? clist[r * 64 + lane] : 0u;
#pragma unroll 1
        for (int bit = 31; bit >= 0; --bit) { const unsigned cand = T | (1u << bit);
            const int cnt = __popcll(__ballot(ck[0] >= cand)) + __popcll(__ballot(ck[1] >= cand)) + __popcll(__ballot(ck[2] >= cand)) + __popcll(__ballot(ck[3] >= cand));
            if (cnt >= need) T = cand; }
        cge = c_above + __popcll(__ballot(ck[0] >= T)) + __popcll(__ballot(ck[1] >= T)) + __popcll(__ballot(ck[2] >= T)) + __popcll(__ballot(ck[3] >= T));
    } else {
#pragma unroll 1
        for (int bit = 31; bit >= 0; --bit) { const unsigned cand = T | (1u << bit); int cnt = 0;
#pragma unroll
            for (int j = 0; j < NJ; ++j) cnt += __popcll(__ballot(key[j] >= cand));
            if (cnt >= 256) T = cand; }
        cge = 0;
#pragma unroll
        for (int j = 0; j < NJ; ++j) cge += __popcll(__ballot(key[j] >= T));
    }
    unsigned w = 0u;
    if (cge == 256) {
#pragma unroll
        for (int j = NJ - 1; j >= 0; --j) w = w + w + (key[j] >= T ? 1u : 0u);
    } else {
        int cgt = 0;
#pragma unroll
        for (int j = 0; j < NJ; ++j) cgt += __popcll(__ballot(key[j] > T));
        const int need2 = 256 - cgt; int eqseen = 0;
#pragma unroll
        for (int j = 0; j < NJ; ++j) { const bool gt = key[j] > T, eq = key[j] == T; const unsigned long long em = __ballot(eq); const int er = eqseen + mbcnt64(em);
            w |= (gt || (eq && er < need2)) ? (1u << j) : 0u; eqseen += __popcll(em); }
    }
    return w;
}
constexpr int MB_K = 0, MB_V = 32768, MB_BM = 65536, MB_WQ = MB_BM + 64 * MA_BMS * 4, MB_SEL = MB_WQ + 1024, MB_END = MB_SEL + NWAVES * 2560;
static_assert(MB_END <= RING_BYTES, "mixer A (64-query units) LDS map");
template <int NJ> __device__ __forceinline__ void select8_t(const float* scr0, int t0, LAS unsigned* hist, LAS unsigned* clist, LAS unsigned* bmrow0, int lane) {
    float cur[NJ], nxt[NJ];
    select_load<NJ>(scr0, t0, lane, cur);
#pragma unroll 1
    for (int i = 0; i < 8; ++i) {
        const int t = t0 + i;
        if (i < 7) select_load<NJ>(scr0 + (size_t)(i + 1) * 2048, t + 1, lane, nxt);
        unsigned w;
        if (t < 256) { const int n = t + 1, nf = n >> 6; w = ((1u << nf) - 1u) | ((lane < (n & 63)) ? (1u << nf) : 0u); }
        else w = select_row_t<NJ>(cur, t, hist, clist, lane);
        bmrow0[i * MA_BMS + lane] = w;
#pragma unroll
        for (int j = 0; j < NJ; ++j) cur[j] = nxt[j];
    }
}
__device__ __forceinline__ void mixa_unit64(const bf16* Z, bf16* MIX, float* SCR, LAS unsigned char* L, int b, int qt64, int wave) {
    int lane = lane_now(), tid = wave * 64 + lane;
    int r32 = lane & 31, hi = lane >> 5; const int T0 = qt64 * 64;
    const bf16* zb = Z + (size_t)(b * SEQ) * ZC;
    LAS unsigned* bm = (LAS unsigned*)(L + MB_BM); LAS float* wq = (LAS float*)(L + MB_WQ);
    if (tid < 256) wq[tid] = bf1(zb[(size_t)(T0 + (tid >> 2)) * ZC + ZC_WI + (tid & 3)]);
    __syncthreads();
#pragma unroll 1
    for (int half = 0; half < 2; ++half) {
        const int Th = T0 + 32 * half;
        bf16x8v qi[4][4];
#pragma unroll
        for (int mt = 0; mt < 4; ++mt)
#pragma unroll
            for (int ks = 0; ks < 4; ++ks) qi[mt][ks] = *(const bf16x8v*)(zb + (size_t)(Th + 8 * mt + (r32 >> 2)) * ZC + ZC_QI + (r32 & 3) * 64 + ks * 16 + hi * 8);
        const int nkt = (Th >> 5) + 1;
        bf16x8v kn[4];
        if (wave < nkt) { const bf16* kr0 = zb + (size_t)(wave * 32 + r32) * ZC + ZC_KI + hi * 8;
#pragma unroll
            for (int ks = 0; ks < 4; ++ks) kn[ks] = *(const bf16x8v*)(kr0 + ks * 16); }
        for (int kt = wave; kt < nkt; kt += NWAVES) {
            const int key = kt * 32 + r32;
            bf16x8v kf[4];
#pragma unroll
            for (int ks = 0; ks < 4; ++ks) kf[ks] = kn[ks];
            if (kt + NWAVES < nkt) { const bf16* kr1 = zb + (size_t)((kt + NWAVES) * 32 + r32) * ZC + ZC_KI + hi * 8;
#pragma unroll
                for (int ks = 0; ks < 4; ++ks) kn[ks] = *(const bf16x8v*)(kr1 + ks * 16); }
#pragma unroll
            for (int mt = 0; mt < 4; ++mt) {
                f32x16 d;
#pragma unroll
                for (int r = 0; r < 16; ++r) d[r] = 0.f;
#pragma unroll
                for (int ks = 0; ks < 4; ++ks) d = __builtin_amdgcn_mfma_f32_32x32x16_bf16(qi[mt][ks], kf[ks], d, 0, 0, 0);
#pragma unroll
                for (int g = 0; g < 4; ++g) { const int q = 32 * half + 8 * mt + 2 * g + hi; const f32x4 w = *(const LAS f32x4*)(wq + 4 * q);
                    float s = fmaxf(d[4 * g + 0], 0.f) * w.x + fmaxf(d[4 * g + 1], 0.f) * w.y + fmaxf(d[4 * g + 2], 0.f) * w.z + fmaxf(d[4 * g + 3], 0.f) * w.w;
                    if (key > T0 + q) s = -INFINITY;
                    SCR[(size_t)q * 2048 + key] = s; }
            }
        }
    }
    asm volatile("s_waitcnt vmcnt(0)" ::: "memory");
    __syncthreads();
    {
        lane = lane_now();
        const int q0 = wave * 8, tl = __builtin_amdgcn_readfirstlane(T0 + q0 + 7);
        LAS unsigned* hs = (LAS unsigned*)(L + MB_SEL + wave * 2560);
        if (tl + 1 <= 512) select8_t<8>(SCR + (size_t)q0 * 2048, T0 + q0, hs, hs + 256, bm + q0 * MA_BMS, lane);
        else if (tl + 1 <= 1024) select8_t<16>(SCR + (size_t)q0 * 2048, T0 + q0, hs, hs + 256, bm + q0 * MA_BMS, lane);
        else if (tl + 1 <= 1536) select8_t<24>(SCR + (size_t)q0 * 2048, T0 + q0, hs, hs + 256, bm + q0 * MA_BMS, lane);
        else select8_t<32>(SCR + (size_t)q0 * 2048, T0 + q0, hs, hs + 256, bm + q0 * MA_BMS, lane);
    }
    lane = lane_now(); tid = wave * 64 + lane; r32 = lane & 31; hi = lane >> 5;
    int wv = wave; asm volatile("" : "+s"(wv));
    const int h = wv & 3, qh = wv >> 2, tq0 = T0 + 32 * qh, t = tq0 + r32;
    const float sl = __builtin_amdgcn_exp2f(-2.f * (float)(h + 1)) * LOG2E;
    bf16x8v qf[4];
#pragma unroll
    for (int ks = 0; ks < 4; ++ks) qf[ks] = *(const bf16x8v*)(zb + (size_t)t * ZC + ZC_QA + h * 64 + ks * 16 + hi * 8);
    float m = -1e30f, l = 0.f; f32x16 o[2];
    f32x16 cinA;
#pragma unroll
    for (int r = 0; r < 16; ++r) cinA[r] = sl * (float)((r & 3) + 8 * (r >> 2) + 4 * hi);
#pragma unroll
    for (int r = 0; r < 16; ++r) { o[0][r] = 0.f; o[1][r] = 0.f; }
    LAS unsigned char* Kb = L + MB_K; LAS unsigned char* Vb = L + MB_V;
    const int skey = tid >> 3, sc = tid & 7;
    const bf16* ksrc = zb + (size_t)skey * ZC + ZC_KA + sc * 8;
    const bf16* vsrc = zb + (size_t)skey * ZC + ZC_VA + sc * 8;
    const int kdst = (sc >> 1) * 2048 + (sc & 1) * 1024 + (skey >> 5) * 512 + (skey & 31) * 16;
    const int vdst = (sc >> 2) * 4096 + (skey >> 3) * 512 + (skey & 7) * 64 + (sc & 3) * 16;
    const int krd = hi * 1024 + r32 * 16;
    const int vrd = ((lane >> 4) & 1) * 32 + (lane & 3) * 8 + (4 * hi + ((lane & 15) >> 2)) * 64;
    const LAS v4u* wrow = (const LAS v4u*)(bm + (32 * qh + r32) * MA_BMS + 4 * hi);
    int jp = (T0 + 63) >> 7;
    int stg_ = 128 * ZC, til_ = 64 * ZC; asm volatile("" : "+s"(stg_), "+s"(til_));
    const size_t stg = (size_t)stg_, til = (size_t)til_;
    v4u kA0 = *(const v4u*)(ksrc + jp * stg), vA0 = *(const v4u*)(vsrc + jp * stg), kA1 = *(const v4u*)(ksrc + jp * stg + til), vA1 = *(const v4u*)(vsrc + jp * stg + til);
    { LAS unsigned char* kb = Kb + (jp & 1) * 16384; LAS unsigned char* vb = Vb + (jp & 1) * 16384;
      *(LAS v4u*)(kb + kdst) = kA0; *(LAS v4u*)(vb + vdst) = vA0; *(LAS v4u*)(kb + 8192 + kdst) = kA1; *(LAS v4u*)(vb + 8192 + vdst) = vA1; }
    v4u kB0 = kA0, vB0 = vA0, kB1 = kA1, vB1 = vA1;
    if (jp >= 1) { kB0 = *(const v4u*)(ksrc + (jp - 1) * stg); vB0 = *(const v4u*)(vsrc + (jp - 1) * stg); kB1 = *(const v4u*)(ksrc + (jp - 1) * stg + til); vB1 = *(const v4u*)(vsrc + (jp - 1) * stg + til); }
    __syncthreads();
#define MB_STAGE(JP, KW0, VW0, KW1, VW1, KL0, VL0, KL1, VL1) do { const int jp_ = (JP); \
        if (jp_ >= 2) { KL0 = *(const v4u*)(ksrc + (jp_ - 2) * stg); VL0 = *(const v4u*)(vsrc + (jp_ - 2) * stg); KL1 = *(const v4u*)(ksrc + (jp_ - 2) * stg + til); VL1 = *(const v4u*)(vsrc + (jp_ - 2) * stg + til); } \
        _Pragma("unroll") for (int kp = 1; kp >= 0; --kp) { \
            const int tile = 2 * jp_ + kp, s0 = 64 * tile; \
            if (s0 <= tq0 + 31) {                                          \
                const LAS unsigned char* Kc = Kb + (jp_ & 1) * 16384 + kp * 8192; const LAS unsigned char* Vc = Vb + (jp_ & 1) * 16384 + kp * 8192; \
                const float sha = sl * (float)(s0 - t), shb = sha + 32.f * sl; \
                f32x16 p0 = cinA, p1 = cinA; \
                _Pragma("unroll") for (int ks = 0; ks < 4; ++ks) { const bf16x8v kf0 = *(const LAS bf16x8v*)(Kc + ks * 2048 + krd), kf1 = *(const LAS bf16x8v*)(Kc + ks * 2048 + 512 + krd); \
                    p0 = __builtin_amdgcn_mfma_f32_32x32x16_bf16(kf0, qf[ks], p0, 0, 0, 0); p1 = __builtin_amdgcn_mfma_f32_32x32x16_bf16(kf1, qf[ks], p1, 0, 0, 0); } \
                const unsigned sbit = (unsigned)tile; \
                _Pragma("unroll") for (int g = 0; g < 4; ++g) { const v4u wa = wrow[2 * g], wb = wrow[8 + 2 * g]; \
                    _Pragma("unroll") for (int e = 0; e < 4; ++e) { const int r = 4 * g + e; \
                        const unsigned ma = (unsigned)(-(int)((wa[e] >> sbit) & 1u)), mb = (unsigned)(-(int)((wb[e] >> sbit) & 1u)); \
                        p0[r] = __uint_as_float((__float_as_uint(p0[r]) & ma) | (~ma & 0xff800000u)); p1[r] = __uint_as_float((__float_as_uint(p1[r]) & mb) | (~mb & 0xff800000u)); } } \
                bf16x8v pf[4]; \
                fl_softmax3(p0, p1, sha, shb, m, l, o, pf); \
                _Pragma("unroll") for (int s4 = 0; s4 < 4; ++s4) _Pragma("unroll") for (int db = 0; db < 2; ++db) { const LAS unsigned char* vp = Vc + db * 4096 + s4 * 1024 + vrd; \
                        const s16x4 lo = lds_tr(vp), hh = lds_tr(vp + 512); \
                        const bf16x8v vf = (bf16x8v){lo[0], lo[1], lo[2], lo[3], hh[0], hh[1], hh[2], hh[3]}; \
                        o[db] = __builtin_amdgcn_mfma_f32_32x32x16_bf16(vf, pf[s4], o[db], 0, 0, 0); } \
            } } \
        if (jp_ >= 1) { LAS unsigned char* kb = Kb + ((jp_ - 1) & 1) * 16384; LAS unsigned char* vb = Vb + ((jp_ - 1) & 1) * 16384; \
            *(LAS v4u*)(kb + kdst) = KW0; *(LAS v4u*)(vb + vdst) = VW0; *(LAS v4u*)(kb + 8192 + kdst) = KW1; *(LAS v4u*)(vb + 8192 + vdst) = VW1; } \
        __syncthreads(); } while (0)
    for (; jp >= 0; jp -= 2) { MB_STAGE(jp, kB0, vB0, kB1, vB1, kA0, vA0, kA1, vA1); if (jp >= 1) MB_STAGE(jp - 1, kA0, vA0, kA1, vA1, kB0, vB0, kB1, vB1); }
#undef MB_STAGE
    { const float inv = 1.f / swap_sum(l);
      bf16* orow = MIX + (size_t)(b * SEQ + t) * DM + h * 64 + 4 * hi;
#pragma unroll
      for (int db = 0; db < 2; ++db)
#pragma unroll
          for (int rg = 0; rg < 4; ++rg) { v2u w; w.x = cvtpk(o[db][4 * rg + 0] * inv, o[db][4 * rg + 1] * inv); w.y = cvtpk(o[db][4 * rg + 2] * inv, o[db][4 * rg + 3] * inv); *(v2u*)(orow + 32 * db + 8 * rg) = w; } }
}
__device__ __forceinline__ void mixa_phase64(const bf16* Z, bf16* MIX, float* SCR, LAS unsigned char* L, int vcu, int G, int wave) {
    float* scr = SCR + (size_t)blockIdx.x * (64 * 2048);
    for (int p = vcu; p < BATCH * 16; p += G) {
        const int b = p >> 4, x = p & 15;
#pragma unroll 1
        for (int k = 0; k < 2; ++k) { mixa_unit64(Z, MIX, scr, L, b, k == 0 ? 31 - x : x, wave); __syncthreads(); }
    }
}
#ifndef REP_A
#define REP_A 1
#endif
#ifndef REP_B
#define REP_B 1
#endif
#ifndef REP_C
#define REP_C 1
#endif
#ifndef REP_G
#define REP_G 1
#endif
#ifndef REP_BAR
#define REP_BAR 1
#endif
#ifndef FLASH2
#define FLASH2 1
#endif
#if FLASH2
#define FLASHP flash_phase2
#else
#define FLASHP flash_phase
#endif
#ifndef GM_ALIGN
#define GM_ALIGN true
#endif
#ifndef GM_ALIGN_RES
#define GM_ALIGN_RES true
#endif
#ifndef GM_SP2
#define GM_SP2 true
#endif
#ifndef MIXA64
#define MIXA64 1
#endif
#ifndef FFN_FP8
#define FFN_FP8 1
#endif
#ifndef FFN_FP8_P5
#define FFN_FP8_P5 FFN_FP8
#endif
#define H8_OFF (FFN_FP8_P5 ? (size_t)0 : 352 * MiB)
#define ACT_OFF (FFN_FP8 && FFN_FP8_P5 ? 64 * MiB : (size_t)0)
struct Args { const float* in[12]; float* out; unsigned char* ws; };
__global__ void __launch_bounds__(NWAVES * 64, 2) hybrid_fwd(Args args) {
    extern __shared__ __attribute__((aligned(16))) unsigned char lds[];
    LAS unsigned char* L = (LAS unsigned char*)lds;
    volatile LAS unsigned* MISC = (volatile LAS unsigned*)(L + MISC_OFF);
    const int wave = __builtin_amdgcn_readfirstlane((int)threadIdx.x >> 6);
#define LANE_NOW lane_now()
#define TID_NOW (wave * 64 + lane_now())
    const int G = gridDim.x, bx = blockIdx.x;
    const int vcu = (G % 8 == 0) ? (bx % 8) * (G / 8) + bx / 8 : bx;
    const int gw = vcu * NWAVES + wave, NGW = G * NWAVES;
    unsigned char* ws = args.ws;
    gu32* ctl = (gu32*)(ws + WS_CTL);
    for (int u = TID_NOW; u < (LDS_BYTES - LDSCTL_OFF) / 4; u += NWAVES * 64) ((LAS unsigned*)(L + LDSCTL_OFF))[u] = 0u;
    __syncthreads();
    XcdBarrier bar = xcd_barrier_post((unsigned*)(ctl + CW_BAR), MISC + 8);
    const float* x = args.in[0];
    bf16* R0 = (bf16*)(ws + WS_R0); bf16* R1 = (bf16*)(ws + WS_R1); bf16* R2 = (bf16*)(ws + WS_R2); bf16* BIG = (bf16*)(ws + WS_BIG);

    {
        const int tid_ = TID_NOW;
        const size_t n8 = (size_t)M * DM / 8; const size_t gt = (size_t)bx * (NWAVES * 64) + tid_, nth = (size_t)G * NWAVES * 64;
#ifndef REP_X
#define REP_X 1
#endif
#ifndef REP_T
#define REP_T 1
#endif
        for (int rx_ = 0; rx_ < REP_X; ++rx_)
        for (size_t i = gt; i < n8; i += 4 * nth) {
            f32x4 a[4], b[4];
#pragma unroll
            for (int u = 0; u < 4; ++u) { size_t j = i + u * nth; j = j < n8 ? j : n8 - 1; a[u] = ((const f32x4*)x)[2 * j]; b[u] = ((const f32x4*)x)[2 * j + 1]; }
#pragma unroll
            for (int u = 0; u < 4; ++u) { const size_t j = i + u * nth; if (j < n8) { v4u o; o.x = pk2(a[u].x, a[u].y); o.y = pk2(a[u].z, a[u].w); o.z = pk2(b[u].x, b[u].y); o.w = pk2(b[u].z, b[u].w); ((v4u*)R0)[j] = o; } }
        }
        LAS float* scr = (LAS float*)(L + RING_OFF + wave * 16384);
        constexpr int I_IN = (DM / 64) * (ZC / 32), I_O = (DM / 64) * (DM / 32), I_GU = (DM / 64) * (GU / 32), I_D = (FF / 64) * (DM / 32), I_L = I_IN + I_O + I_GU + I_D;
        for (int rt_ = 0; rt_ < REP_T; ++rt_)
        for (int it = gw; it < DEPTH * I_L; it += NGW) {
            const int l = it / I_L; int r = it % I_L;
            unsigned char* wl = ws + WS_W + (size_t)l * W_LAYER_B;
            float* cv = (float*)(ws + WS_CVP) + (size_t)l * 16 * CV_LAYER; const bool acc_ = rt_ == 0;
            const float* g2p = l > 0 ? args.in[10] + (l - 1) * DM : nullptr; const float* b2p = l > 0 ? args.in[11] + (l - 1) * DM : nullptr;
            const float* g1 = args.in[5] + l * DM; const float* b1 = args.in[6] + l * DM;
            if (r < I_IN) { transpose_item<0>(args.in[1] + (size_t)l * DM * INC, nullptr, g2p, b2p, acc_ ? cv : nullptr, cv + ZC, DM, INC, ZC, (bf16*)wl, scr, r, LANE_NOW); continue; } r -= I_IN;
            if (r < I_O) { transpose_item<1>(args.in[2] + (size_t)l * DM * DM, nullptr, nullptr, nullptr, nullptr, nullptr, DM, DM, DM, (bf16*)(wl + W_IN_B), scr, r, LANE_NOW); continue; } r -= I_O;
            if (r < I_GU) { transpose_item<2, FFN_FP8 ? 6 : 0>(args.in[7] + (size_t)l * DM * FF, args.in[8] + (size_t)l * DM * FF, g1, b1, acc_ ? cv + 2 * ZC : nullptr, cv + 2 * ZC + GU, DM, FF, GU, (bf16*)(wl + W_IN_B + W_O_B), scr, r, LANE_NOW); continue; } r -= I_GU;
            transpose_item<1, FFN_FP8_P5 ? 8 : 0>(args.in[9] + (size_t)l * FF * DM, nullptr, nullptr, nullptr, nullptr, nullptr, FF, DM, DM, (bf16*)(wl + W_IN_B + W_O_B + W_GU_B), scr, r, LANE_NOW);
        }
    }
    xcd_barrier(bar);

#pragma unroll
    for (int l = 0; l < DEPTH; ++l) {
#define WS_NOW ({ unsigned char* w_ = args.ws; asm volatile("" : "+s"(w_)); w_; })
#define OPQ_S(x) ({ int x_ = (x); asm volatile("" : "+s"(x_)); x_; })
#define P_WL(w) ((w) + WS_W + (size_t)l * W_LAYER_B)
#define P_ST(w, ll, which) ((float*)((w) + WS_STAT) + (size_t)(((ll) * 2 + (which)) * 2) * M)
#define P_CV(w) ((const float*)((w) + WS_CV) + (size_t)l * CV_LAYER)
        const float lambda_init = (l == 0) ? 0.2f : 0.35550906759f;
        const bool last = (l + 1 == DEPTH);

        { unsigned char* w = WS_NOW; const float* sP = l > 0 ? P_ST(w, l - 1, 1) : nullptr; const float* cv = P_CV(w);
          pg8::Gemm g{(const pg8::bf16_t*)(w + WS_R0), (const pg8::bf16_t*)P_WL(w), M, ZC, DM}; pg8::StaticOrder S; S.init(M, ZC, OPQ_S(G), OPQ_S(bx));
          pg8::EpiStoreLN E{(pg8::bf16_t*)(w + WS_BIG), ZC, sP, sP ? sP + M : nullptr, cv, cv + ZC};
          for (int rep = 0; rep < REP_G; ++rep) {
          pg8::gemm_phase<pg8::EpiStoreLN, pg8::StaticOrder, GM_ALIGN, GM_SP2>(L + RING_OFF, g, S, E, OPQ_S(wave)); } }
        for (int rb_ = 0; rb_ < REP_BAR; ++rb_) xcd_barrier(bar);
        if (l == 0) { unsigned char* w = WS_NOW; cv_reduce((const float*)(w + WS_CVP), (float*)(w + WS_CV), (size_t)OPQ_S(bx) * (NWAVES * 64) + TID_NOW, (size_t)OPQ_S(G) * NWAVES * 64); }
        { unsigned char* w = WS_NOW; for (int rep = 0; rep < REP_A; ++rep) mixa_phase64((const bf16*)(w + WS_BIG), (bf16*)(w + WS_R1), (float*)(w + WS_R2), L + RING_OFF, OPQ_S(vcu), OPQ_S(G), OPQ_S(wave)); }
        { unsigned char* w = WS_NOW; for (int rep = 0; rep < REP_B; ++rep) FLASHP<0>((const bf16*)(w + WS_BIG), (bf16*)(w + WS_R1), L + RING_OFF, args.in[3] + l * 128, args.in[4] + l * 64, lambda_init, OPQ_S(vcu), OPQ_S(G), TID_NOW, OPQ_S(wave), LANE_NOW); }
        { unsigned char* w = WS_NOW; for (int rep = 0; rep < REP_C; ++rep) FLASHP<1>((const bf16*)(w + WS_BIG), (bf16*)(w + WS_R1), L + RING_OFF, nullptr, nullptr, 0.f, OPQ_S(vcu), OPQ_S(G), TID_NOW, OPQ_S(wave), LANE_NOW); }
        for (int rb_ = 0; rb_ < REP_BAR; ++rb_) xcd_barrier(bar);
        { unsigned char* w = WS_NOW; const float* sP = l > 0 ? P_ST(w, l - 1, 1) : nullptr; float* sA = P_ST(w, l, 0);
          pg8::Gemm g{(const pg8::bf16_t*)(w + WS_R1), (const pg8::bf16_t*)(P_WL(w) + W_IN_B), M, DM, DM}; pg8::StaticOrder S; S.init(M, DM, OPQ_S(G), OPQ_S(bx));
          pg8::EpiResStat E{(const pg8::bf16_t*)(w + WS_R0), sP, sP ? sP + M : nullptr, l > 0 ? args.in[10] + (l - 1) * DM : nullptr, l > 0 ? args.in[11] + (l - 1) * DM : nullptr, (pg8::bf16_t*)(w + WS_R2), nullptr, (float*)(w + WS_SP), (float*)(w + WS_SP) + (size_t)16 * M, DM, ALPHA, FFN_FP8 ? (unsigned char*)(w + WS_BIG + H8_OFF) : nullptr, 1.f, M};
          for (int rep = 0; rep < REP_G; ++rep) { if (rep > 0) { E.osum = nullptr; }
          pg8::gemm_phase<pg8::EpiResStat, pg8::StaticOrder, GM_ALIGN_RES, GM_SP2>(L + RING_OFF, g, S, E, OPQ_S(wave)); } }
        for (int rb_ = 0; rb_ < REP_BAR; ++rb_) xcd_barrier(bar);
        { unsigned char* w = WS_NOW; float* sA = P_ST(w, l, 0); stats_reduce((const float*)(w + WS_SP), sA, sA + M, (size_t)OPQ_S(bx) * (NWAVES * 64) + TID_NOW, (size_t)OPQ_S(G) * NWAVES * 64); }
        xcd_barrier(bar);
        { unsigned char* w = WS_NOW; float* sA = P_ST(w, l, 0); const float* cv = P_CV(w);
          pg8::StaticOrder S; S.init(M, GU, OPQ_S(G), OPQ_S(bx));
#if FFN_FP8
          pg8::Gemm g{(const pg8::bf16_t*)(w + WS_BIG + H8_OFF), (const pg8::bf16_t*)(P_WL(w) + W_IN_B + W_O_B), M, GU, DM / 2, 0};
#if FFN_FP8_P5
          pg8::EpiSwigluLN8 E{w + WS_BIG + ACT_OFF, FF, sA, sA + M, cv + 2 * ZC, cv + 2 * ZC + GU, 1.f / 64.f};
          for (int rep = 0; rep < REP_G; ++rep) {
          pg8::gemm_phase<pg8::EpiSwigluLN8, pg8::StaticOrder, GM_ALIGN, GM_SP2, true>(L + RING_OFF, g, S, E, OPQ_S(wave)); }
#else
          pg8::EpiSwigluLN E{(pg8::bf16_t*)(w + WS_BIG + ACT_OFF), FF, sA, sA + M, cv + 2 * ZC, cv + 2 * ZC + GU, 1.f / 64.f};
          for (int rep = 0; rep < REP_G; ++rep) {
          pg8::gemm_phase<pg8::EpiSwigluLN, pg8::StaticOrder, GM_ALIGN, GM_SP2, true>(L + RING_OFF, g, S, E, OPQ_S(wave)); }
#endif
#else
          pg8::Gemm g{(const pg8::bf16_t*)(w + WS_R2), (const pg8::bf16_t*)(P_WL(w) + W_IN_B + W_O_B), M, GU, DM, 0};
          pg8::EpiSwigluLN E{(pg8::bf16_t*)(w + WS_BIG), FF, sA, sA + M, cv + 2 * ZC, cv + 2 * ZC + GU, 1.f};
          for (int rep = 0; rep < REP_G; ++rep) {
          pg8::gemm_phase<pg8::EpiSwigluLN, pg8::StaticOrder, GM_ALIGN, GM_SP2>(L + RING_OFF, g, S, E, OPQ_S(wave)); }
#endif
        }
        for (int rb_ = 0; rb_ < REP_BAR; ++rb_) xcd_barrier(bar);
        { unsigned char* w = WS_NOW; float* sA = P_ST(w, l, 0); float* sB = P_ST(w, l, 1);
#if FFN_FP8_P5
          pg8::Gemm g{(const pg8::bf16_t*)(w + WS_BIG + ACT_OFF), (const pg8::bf16_t*)(P_WL(w) + W_IN_B + W_O_B + W_GU_B), M, DM, FF / 2, 0};
#else
          pg8::Gemm g{(const pg8::bf16_t*)(w + WS_BIG + ACT_OFF), (const pg8::bf16_t*)(P_WL(w) + W_IN_B + W_O_B + W_GU_B), M, DM, FF, 0};
#endif
          pg8::StaticOrder S; S.init(M, DM, OPQ_S(G), OPQ_S(bx));
          pg8::EpiResStat E{(const pg8::bf16_t*)(w + WS_R2), sA, sA + M, args.in[5] + l * DM, args.in[6] + l * DM, (pg8::bf16_t*)(w + WS_R0), nullptr, (float*)(w + WS_SP), (float*)(w + WS_SP) + (size_t)16 * M, DM, ALPHA, nullptr, FFN_FP8_P5 ? 1.f / 256.f : 1.f, M};
          for (int rep = 0; rep < REP_G; ++rep) { if (rep > 0) { E.osum = nullptr; }
          pg8::gemm_phase<pg8::EpiResStat, pg8::StaticOrder, GM_ALIGN_RES, GM_SP2, FFN_FP8_P5 != 0>(L + RING_OFF, g, S, E, OPQ_S(wave)); } }
        for (int rb_ = 0; rb_ < REP_BAR; ++rb_) xcd_barrier(bar);
        { unsigned char* w = WS_NOW; float* sB = P_ST(w, l, 1); stats_reduce((const float*)(w + WS_SP), sB, sB + M, (size_t)OPQ_S(bx) * (NWAVES * 64) + TID_NOW, (size_t)OPQ_S(G) * NWAVES * 64); }
        xcd_barrier(bar);
        if (last) {
            unsigned char* w = WS_NOW; const bf16* R0 = (const bf16*)(w + WS_R0); const float* sB = P_ST(w, l, 1);
            const int tid_ = TID_NOW;
            const size_t gt = (size_t)bx * (NWAVES * 64) + tid_, nth = (size_t)G * NWAVES * 64;
            if (nth % 128 == 0) {
                const int cc = (int)(gt & 127) * 8; const float* g2 = args.in[10] + l * DM + cc; const float* b2 = args.in[11] + l * DM + cc;
                const f32x4 ga = *(const f32x4*)g2, gb = *(const f32x4*)(g2 + 4), ba = *(const f32x4*)b2, bb = *(const f32x4*)(b2 + 4);
                const size_t rstep = nth / 128;
                for (size_t row = gt >> 7; row < (size_t)M; row += 4 * rstep) {
                    v4u hv[4]; float mu[4], rs[4];
#pragma unroll
                    for (int u = 0; u < 4; ++u) { size_t r = row + u * rstep; r = r < (size_t)M ? r : (size_t)M - 1; hv[u] = *(const v4u*)(R0 + r * DM + cc); const float s = sB[r], q = sB[M + r]; mu[u] = s * (1.f / DM); rs[u] = __builtin_amdgcn_rsqf(fmaxf(q * (1.f / DM) - mu[u] * mu[u], 0.f) + LN_EPS); }
#pragma unroll
                    for (int u = 0; u < 4; ++u) { const size_t r = row + u * rstep; if (r < (size_t)M) {
                        f32x4 ya, yb; ya.x = bflo(hv[u].x); ya.y = bfhi(hv[u].x); ya.z = bflo(hv[u].y); ya.w = bfhi(hv[u].y); yb.x = bflo(hv[u].z); yb.y = bfhi(hv[u].z); yb.z = bflo(hv[u].w); yb.w = bfhi(hv[u].w);
                        ya = (ya - mu[u]) * rs[u] * ga + ba; yb = (yb - mu[u]) * rs[u] * gb + bb;
                        float* op = args.out + r * DM + cc; *(f32x4*)op = ya; *(f32x4*)(op + 4) = yb; } }
                }
            }
        }
    }
}

extern "C" void kernel_launch(void* const* d_in, const int* in_sizes, int n_in, void* d_out, int out_size, void* d_ws, size_t ws_size, hipStream_t stream) {
    static int grid = 0;
    if (grid == 0) {
        if (n_in != 12 || in_sizes[0] != M * DM || out_size != M * DM || ws_size < WS_END) { fprintf(stderr, "kernel_launch: unexpected shapes / workspace (n_in %d, in0 %d, out %d, ws %zu < %zu)\n", n_in, n_in > 0 ? in_sizes[0] : -1, out_size, ws_size, (size_t)WS_END); grid = -1; return; }
        int dev = 0, cus = 0, per_cu = 0;
        if (hipGetDevice(&dev) != hipSuccess || hipDeviceGetAttribute(&cus, hipDeviceAttributeMultiprocessorCount, dev) != hipSuccess) { grid = -1; return; }
        if (hipFuncSetAttribute((const void*)hybrid_fwd, hipFuncAttributeMaxDynamicSharedMemorySize, LDS_BYTES) != hipSuccess) { fprintf(stderr, "kernel_launch: hipFuncSetAttribute failed\n"); grid = -1; return; }
        if (hipOccupancyMaxActiveBlocksPerMultiprocessor(&per_cu, (const void*)hybrid_fwd, NWAVES * 64, LDS_BYTES) != hipSuccess || per_cu < 1) { fprintf(stderr, "kernel_launch: occupancy query reports %d\n", per_cu); }
        (void)hipGetLastError();
        grid = cus < 256 ? cus : 256;
    }
    if (grid < 0) return;
    if (hipMemsetAsync((char*)d_ws + WS_CTL, 0, CTL_ZERO_BYTES, stream) != hipSuccess) return;
    Args a{};
    for (int i = 0; i < 12; ++i) a.in[i] = (const float*)d_in[i];
    a.out = (float*)d_out; a.ws = (unsigned char*)d_ws;
    hipLaunchKernelGGL(hybrid_fwd, dim3(grid), dim3(NWAVES * 64), LDS_BYTES, stream, a);
}
```

```cpp
#include <hip/hip_runtime.h>
#include <cstdio>
#include <cstdint>
#include <cmath>
#define FL_CLASS 0
#define FLASH2 0
#define MIX_FP8 1
namespace pg8 {
#define PG8_LAS __attribute__((address_space(3)))
typedef unsigned short bf16_t;
typedef short bf16x8 __attribute__((ext_vector_type(8)));
typedef float f32x4 __attribute__((ext_vector_type(4)));
typedef unsigned u32x4 __attribute__((ext_vector_type(4)));
constexpr int BM = 256, BK = 64, HALF = 128, HTB = HALF * BK * 2  , STAGE_BYTES = 8 * HTB, NXCD = 8, WGM = 8;

__host__ __device__ __forceinline__ int lds_byte(int r, int c) { const int st = (r >> 4) * 2 + (c >> 5), rr = r & 15, cc = c & 31, ob = rr * 64 + cc * 2; return st * 1024 + (ob ^ (((ob >> 9) & 1) << 5)); }
__host__ __device__ __forceinline__ void stage_rc(int b, int& R, int& C) { const int st = b / 1024, sb = b % 1024, swz = sb ^ (((sb >> 9) & 1) << 5); R = (st >> 1) * 16 + swz / 64; C = (st & 1) * 32 + (swz % 64) / 2; }
__host__ __device__ __forceinline__ int perm32(int rho) { const int n = rho >> 4, i = rho & 15; return 8 * (i >> 2) + 4 * n + (i & 3); }

struct Unit { int pm, pn; };
struct Gemm { const bf16_t* A; const bf16_t* Bt; int M, N, K; int scale_w; };
typedef int v4i_t __attribute__((ext_vector_type(4)));
typedef int v8i_t __attribute__((ext_vector_type(8)));

struct StaticOrder {
    int nM, nN, nwg, G, c;
    __host__ __device__ void init(int M, int N, int G_, int c_) { nM = M / BM; nN = N / BM; nwg = nM * nN; G = G_; c = c_; }
    __host__ __device__ bool next(int i, Unit& u) const {
        const long L = (long)i * G + c; if (L >= nwg) return false;
        int wgid = (int)L; { const int q = nwg / NXCD, r = nwg % NXCD, xcd = wgid % NXCD, off = wgid / NXCD; wgid = (xcd < r ? xcd * (q + 1) : r * (q + 1) + (xcd - r) * q) + off; }
        const int nig = WGM * nN, gid = wgid / nig, fm = gid * WGM, gsz = (nM - fm) < WGM ? (nM - fm) : WGM;
        u.pm = fm + ((wgid % nig) % gsz); u.pn = (wgid % nig) / gsz; return true;
    }
    __device__ __forceinline__ void a_ready(const Unit&) const {}
    __device__ __forceinline__ void done(const Unit&) const {}
};
__device__ __forceinline__ unsigned cvt_pk_bf16(float lo, float hi) { unsigned r; asm volatile("v_cvt_pk_bf16_f32 %0, %1, %2" : "=v"(r) : "v"(lo), "v"(hi)); return r; }
typedef float f32x2 __attribute__((ext_vector_type(2)));
typedef unsigned u32x2 __attribute__((ext_vector_type(2)));
struct EpiStore {
    static constexpr bool PERM = true, AFTER_DRAIN = false;
    bf16_t* O; int ldc;
    __device__ __forceinline__ void operator()(const f32x4 (&acc)[2][2][4][2], const Unit& u, int wr, int wc, int fr, int fq) const {
        const int row0 = u.pm * BM + wr * 64 + fr, col0 = u.pn * BM + wc * 32 + 8 * fq;
#pragma unroll
        for (int ai = 0; ai < 2; ++ai)
#pragma unroll
            for (int m = 0; m < 4; ++m) { bf16_t* rowp = O + (size_t)(row0 + ai * HALF + m * 16) * ldc + col0;
#pragma unroll
                for (int bj = 0; bj < 2; ++bj) { const f32x4 v0 = acc[ai][bj][m][0], v1 = acc[ai][bj][m][1];
                    u32x4 w; w.x = cvt_pk_bf16(v0[0], v0[1]); w.y = cvt_pk_bf16(v0[2], v0[3]); w.z = cvt_pk_bf16(v1[0], v1[1]); w.w = cvt_pk_bf16(v1[2], v1[3]);
                    *(u32x4*)(rowp + bj * HALF) = w; } }
    }
};
struct EpiSwiglu {
    static constexpr bool PERM = true, AFTER_DRAIN = false;
    bf16_t* O; int ldc;
    __device__ __forceinline__ float act(float g, float u) const { const float e = __builtin_amdgcn_exp2f(g * -1.4426950408889634f); return g * __builtin_amdgcn_rcpf(1.0f + e) * u; }
    __device__ __forceinline__ void operator()(const f32x4 (&acc)[2][2][4][2], const Unit& u, int wr, int wc, int fr, int fq) const {
        const int row0 = u.pm * BM + wr * 64 + fr, col0 = u.pn * HALF + wc * 32 + 8 * fq;
#pragma unroll
        for (int ai = 0; ai < 2; ++ai)
#pragma unroll
            for (int m = 0; m < 4; ++m) { bf16_t* rowp = O + (size_t)(row0 + ai * HALF + m * 16) * ldc + col0;
                const f32x4 g0 = acc[ai][0][m][0], g1 = acc[ai][0][m][1], u0 = acc[ai][1][m][0], u1 = acc[ai][1][m][1];
                u32x4 w; w.x = cvt_pk_bf16(act(g0[0], u0[0]), act(g0[1], u0[1])); w.y = cvt_pk_bf16(act(g0[2], u0[2]), act(g0[3], u0[3]));
                w.z = cvt_pk_bf16(act(g1[0], u1[0]), act(g1[1], u1[1])); w.w = cvt_pk_bf16(act(g1[2], u1[2]), act(g1[3], u1[3]));
                *(u32x4*)rowp = w; }
    }
};
struct EpiRes {
    static constexpr bool PERM = false, AFTER_DRAIN = false;
    const bf16_t* X; float* H; int ldc; float alpha;
    __device__ __forceinline__ void operator()(const f32x4 (&acc)[2][2][4][2], const Unit& u, int wr, int wc, int fr, int fq) const {
        const int row0 = u.pm * BM + wr * 64 + fr, col0 = u.pn * BM + wc * 32 + 4 * fq;
#pragma unroll
        for (int ai = 0; ai < 2; ++ai)
#pragma unroll
            for (int m = 0; m < 4; ++m) { const size_t off = (size_t)(row0 + ai * HALF + m * 16) * ldc + col0;
#pragma unroll
                for (int bj = 0; bj < 2; ++bj)
#pragma unroll
                    for (int n = 0; n < 2; ++n) { const size_t c = off + bj * HALF + n * 16; const u32x2 xb = *(const u32x2*)(X + c);
                        f32x4 x; x[0] = __uint_as_float(xb.x << 16); x[1] = __uint_as_float(xb.x & 0xffff0000u); x[2] = __uint_as_float(xb.y << 16); x[3] = __uint_as_float(xb.y & 0xffff0000u);
                        *(f32x4*)(H + c) = acc[ai][bj][m][n] + x * alpha; } }
    }
};

__device__ __forceinline__ float sum16x(float v) { auto rr = __builtin_amdgcn_permlane16_swap(__float_as_uint(v), __float_as_uint(v), false, false); return __uint_as_float(rr[0]) + __uint_as_float(rr[1]); }
__device__ __forceinline__ float sum32x(float v) { auto rr = __builtin_amdgcn_permlane32_swap(__float_as_uint(v), __float_as_uint(v), false, false); return __uint_as_float(rr[0]) + __uint_as_float(rr[1]); }
__device__ __forceinline__ void row_stats(const float* ssum, const float* ssq, int row, float& mu, float& rs) {
    mu = 0.f; rs = 1.f;
    if (ssum) { const float s = ssum[row], q = ssq[row]; mu = s * (1.f / 1024.f); rs = 1.f / sqrtf(fmaxf(q * (1.f / 1024.f) - mu * mu, 0.f) + 1e-5f); }
}
struct EpiStoreLN {
    static constexpr bool PERM = true, AFTER_DRAIN = false;
    bf16_t* O; int ldc; const float* ssum; const float* ssq; const float* c1; const float* c0;
    __device__ __forceinline__ void operator()(const f32x4 (&acc)[2][2][4][2], const Unit& u, int wr, int wc, int fr, int fq) const {
        const int row0 = u.pm * BM + wr * 64 + fr, col0 = u.pn * BM + wc * 32 + 8 * fq;
        f32x4 c1v[2][2], c0v[2][2]; float z_ = 0.f; asm volatile("" : "+v"(z_));
#pragma unroll
        for (int bj = 0; bj < 2; ++bj)
#pragma unroll
            for (int n = 0; n < 2; ++n) { c1v[bj][n] = ssum ? *(const f32x4*)(c1 + col0 + bj * HALF + 4 * n) : (f32x4){z_, z_, z_, z_}; c0v[bj][n] = ssum ? *(const f32x4*)(c0 + col0 + bj * HALF + 4 * n) : (f32x4){z_, z_, z_, z_}; }
#pragma unroll
        for (int ai = 0; ai < 2; ++ai)
#pragma unroll
            for (int m = 0; m < 4; ++m) { const int row = row0 + ai * HALF + m * 16; float mu, rs; row_stats(ssum, ssq, row, mu, rs);
                bf16_t* rowp = O + (size_t)row * ldc + col0;
#pragma unroll
                for (int bj = 0; bj < 2; ++bj) { const f32x4 v0 = (acc[ai][bj][m][0] - c1v[bj][0] * mu) * rs + c0v[bj][0], v1 = (acc[ai][bj][m][1] - c1v[bj][1] * mu) * rs + c0v[bj][1];
                    u32x4 w; w.x = cvt_pk_bf16(v0[0], v0[1]); w.y = cvt_pk_bf16(v0[2], v0[3]); w.z = cvt_pk_bf16(v1[0], v1[1]); w.w = cvt_pk_bf16(v1[2], v1[3]);
                    *(u32x4*)(rowp + bj * HALF) = w; } }
    }
};
struct EpiSwigluLN {
    static constexpr bool PERM = true, AFTER_DRAIN = false;
    bf16_t* O; int ldc; const float* ssum; const float* ssq; const float* c1; const float* c0; float ascale;
    __device__ __forceinline__ float act(float g, float u) const { const float e = __builtin_amdgcn_exp2f(g * -1.4426950408889634f); return g * __builtin_amdgcn_rcpf(1.0f + e) * u; }
    __device__ __forceinline__ void operator()(const f32x4 (&acc)[2][2][4][2], const Unit& u, int wr, int wc, int fr, int fq) const {
        const int row0 = u.pm * BM + wr * 64 + fr, col0 = u.pn * HALF + wc * 32 + 8 * fq, wrow0 = u.pn * BM + wc * 32 + 8 * fq;
        f32x4 c1v[2][2], c0v[2][2];
#pragma unroll
        for (int bj = 0; bj < 2; ++bj)
#pragma unroll
            for (int n = 0; n < 2; ++n) { c1v[bj][n] = *(const f32x4*)(c1 + wrow0 + bj * HALF + 4 * n); c0v[bj][n] = *(const f32x4*)(c0 + wrow0 + bj * HALF + 4 * n); }
#pragma unroll
        for (int ai = 0; ai < 2; ++ai)
#pragma unroll
            for (int m = 0; m < 4; ++m) { const int row = row0 + ai * HALF + m * 16; float mu, rs; row_stats(ssum, ssq, row, mu, rs);
                bf16_t* rowp = O + (size_t)row * ldc + col0;
                const f32x4 g0 = (acc[ai][0][m][0] * ascale - c1v[0][0] * mu) * rs + c0v[0][0], g1 = (acc[ai][0][m][1] * ascale - c1v[0][1] * mu) * rs + c0v[0][1];
                const f32x4 u0 = (acc[ai][1][m][0] * ascale - c1v[1][0] * mu) * rs + c0v[1][0], u1 = (acc[ai][1][m][1] * ascale - c1v[1][1] * mu) * rs + c0v[1][1];
                u32x4 w; w.x = cvt_pk_bf16(act(g0[0], u0[0]), act(g0[1], u0[1])); w.y = cvt_pk_bf16(act(g0[2], u0[2]), act(g0[3], u0[3]));
                w.z = cvt_pk_bf16(act(g1[0], u1[0]), act(g1[1], u1[1])); w.w = cvt_pk_bf16(act(g1[2], u1[2]), act(g1[3], u1[3]));
                *(u32x4*)rowp = w; }
    }
};
struct EpiSwigluLN8 {
    static constexpr bool PERM = true, AFTER_DRAIN = false;
    unsigned char* O; int ldc; const float* ssum; const float* ssq; const float* c1; const float* c0; float ascale;
    __device__ __forceinline__ float act(float g, float u) const { const float e = __builtin_amdgcn_exp2f(g * -1.4426950408889634f); return g * __builtin_amdgcn_rcpf(1.0f + e) * u; }
    __device__ __forceinline__ void operator()(const f32x4 (&acc)[2][2][4][2], const Unit& u, int wr, int wc, int fr, int fq) const {
        const int row0 = u.pm * BM + wr * 64 + fr, col0 = u.pn * HALF + wc * 32 + 8 * fq, wrow0 = u.pn * BM + wc * 32 + 8 * fq;
        f32x4 c1v[2][2], c0v[2][2];
#pragma unroll
        for (int bj = 0; bj < 2; ++bj)
#pragma unroll
            for (int n = 0; n < 2; ++n) { c1v[bj][n] = *(const f32x4*)(c1 + wrow0 + bj * HALF + 4 * n); c0v[bj][n] = *(const f32x4*)(c0 + wrow0 + bj * HALF + 4 * n); }
#pragma unroll
        for (int ai = 0; ai < 2; ++ai)
#pragma unroll
            for (int m = 0; m < 4; ++m) { const int row = row0 + ai * HALF + m * 16; float mu, rs; row_stats(ssum, ssq, row, mu, rs);
                unsigned char* rowp = O + (size_t)row * ldc + col0;
                const f32x4 g0 = (acc[ai][0][m][0] * ascale - c1v[0][0] * mu) * rs + c0v[0][0], g1 = (acc[ai][0][m][1] * ascale - c1v[0][1] * mu) * rs + c0v[0][1];
                const f32x4 u0 = (acc[ai][1][m][0] * ascale - c1v[1][0] * mu) * rs + c0v[1][0], u1 = (acc[ai][1][m][1] * ascale - c1v[1][1] * mu) * rs + c0v[1][1];
                int w0 = __builtin_amdgcn_cvt_pk_fp8_f32(act(g0[0], u0[0]), act(g0[1], u0[1]), 0, false); w0 = __builtin_amdgcn_cvt_pk_fp8_f32(act(g0[2], u0[2]), act(g0[3], u0[3]), w0, true);
                int w1 = __builtin_amdgcn_cvt_pk_fp8_f32(act(g1[0], u1[0]), act(g1[1], u1[1]), 0, false); w1 = __builtin_amdgcn_cvt_pk_fp8_f32(act(g1[2], u1[2]), act(g1[3], u1[3]), w1, true);
                u32x2 w; w.x = (unsigned)w0; w.y = (unsigned)w1; *(u32x2*)rowp = w; }
    }
};
struct EpiResStat {
    static constexpr bool PERM = false, AFTER_DRAIN = false;
    const bf16_t* R; const float* rsum; const float* rsq; const float* g; const float* b; bf16_t* Hb; float* Hf; float* osum; float* osq; int ldc; float alpha; unsigned char* H8; float ascale; int pM;
    __device__ __forceinline__ void operator()(const f32x4 (&acc)[2][2][4][2], const Unit& u, int wr, int wc, int fr, int fq) const {
        const int row0 = u.pm * BM + wr * 64 + fr, col0 = u.pn * BM + wc * 32 + 4 * fq;
        f32x4 gv[2][2], bv[2][2];
#pragma unroll
        for (int bj = 0; bj < 2; ++bj)
#pragma unroll
            for (int n = 0; n < 2; ++n) { float z_ = 0.f, o_ = 1.f; asm volatile("" : "+v"(z_), "+v"(o_)); gv[bj][n] = rsum ? *(const f32x4*)(g + col0 + bj * HALF + n * 16) : (f32x4){o_, o_, o_, o_}; bv[bj][n] = rsum ? *(const f32x4*)(b + col0 + bj * HALF + n * 16) : (f32x4){z_, z_, z_, z_}; }
        float ss[2][4], qq[2][4];
#pragma unroll
        for (int ai = 0; ai < 2; ++ai)
#pragma unroll
            for (int m = 0; m < 4; ++m) { const int row = row0 + ai * HALF + m * 16; float mu, rs; row_stats(rsum, rsq, row, mu, rs);
                const size_t off = (size_t)row * ldc + col0; float s = 0.f, q = 0.f;
#pragma unroll
                for (int bj = 0; bj < 2; ++bj)
#pragma unroll
                    for (int n = 0; n < 2; ++n) { const size_t c = off + bj * HALF + n * 16; const u32x2 xb = *(const u32x2*)(R + c);
                        f32x4 x; x[0] = __uint_as_float(xb.x << 16); x[1] = __uint_as_float(xb.x & 0xffff0000u); x[2] = __uint_as_float(xb.y << 16); x[3] = __uint_as_float(xb.y & 0xffff0000u);
                        x = (x - mu) * rs * gv[bj][n] + bv[bj][n];
                        const f32x4 v = acc[ai][bj][m][n] * ascale + x * alpha;
                        if (Hf) *(f32x4*)(Hf + c) = v;
                        else { u32x2 w; w.x = cvt_pk_bf16(v[0], v[1]); w.y = cvt_pk_bf16(v[2], v[3]); *(u32x2*)(Hb + c) = w; s += (v[0] + v[1]) + (v[2] + v[3]); q += (v[0] * v[0] + v[1] * v[1]) + (v[2] * v[2] + v[3] * v[3]);
                            if (H8) { int w8 = __builtin_amdgcn_cvt_pk_fp8_f32(v[0], v[1], 0, false); w8 = __builtin_amdgcn_cvt_pk_fp8_f32(v[2], v[3], w8, true); *(int*)(H8 + c) = w8; } } }
                ss[ai][m] = sum32x(sum16x(s)); qq[ai][m] = sum32x(sum16x(q)); }
        if (!Hf && osum) { const size_t slot = (size_t)(u.pn * 4 + wc) * (size_t)pM;
#pragma unroll
            for (int ai = 0; ai < 2; ++ai) { const float sv = fq == 0 ? ss[ai][0] : (fq == 1 ? ss[ai][1] : (fq == 2 ? ss[ai][2] : ss[ai][3])), qv = fq == 0 ? qq[ai][0] : (fq == 1 ? qq[ai][1] : (fq == 2 ? qq[ai][2] : qq[ai][3]));
                const int row = row0 + ai * HALF + fq * 16;
                osum[slot + row] = sv; osq[slot + row] = qv; } }
    }
};
template <class Epi, class Sched, bool ALIGN_EPI = false, bool SP2 = false, bool FP8 = false>
__device__ __forceinline__ void gemm_phase(PG8_LAS unsigned char* lds, const Gemm g, const Sched& S, const Epi& E, int wave_in) {
    int lane_; asm volatile("v_mbcnt_lo_u32_b32 %0, -1, 0\n\tv_mbcnt_hi_u32_b32 %0, -1, %0" : "=v"(lane_)); const int tid_ = wave_in * 64 + lane_;
    const int tid = tid_, wid = __builtin_amdgcn_readfirstlane(tid >> 6), lane = tid & 63, wr = wid >> 2, wc = wid & 3, fr = lane & 15, fq = lane >> 4;
    const int K = g.K, nt = K / BK;
    unsigned voffA[2], voffB[2];
#pragma unroll
    for (int i = 0; i < 2; ++i) { int R, C; stage_rc(tid * 16 + i * 8192, R, C); const int Rb = Epi::PERM ? ((R & ~31) + perm32(R & 31)) : R;
        voffA[i] = (unsigned)(R * K + C) * 2u; voffB[i] = (unsigned)(Rb * K + C) * 2u; }
    const size_t kstep = (size_t)(BK * 2);
    const size_t hstep = (size_t)HALF * K * 2;
    const size_t tstep = 2 * hstep;
    const unsigned ldsw = (unsigned)wid * 1024u;
    const int aoff = lds_byte(wr * 64 + fr, fq * 8), boff = lds_byte(wc * 32 + fr, fq * 8);
#define PG8_SA(b, h) (((b) * 2 + (h)) * HTB)
#define PG8_SB(b, h) ((4 + (b) * 2 + (h)) * HTB)
#define PG8_STAGE(bufoff, gbase, voff) do { _Pragma("unroll") for (int _i = 0; _i < 2; ++_i) \
        __builtin_amdgcn_global_load_lds((const unsigned*)((const char*)(gbase) + (voff)[_i]), (PG8_LAS unsigned*)(lds + (bufoff) + ldsw + _i * 8192), 16, 0, 0); } while (0)
#define PG8_LDA16(dst, b, h) do { _Pragma("unroll") for (int m = 0; m < 4; ++m) _Pragma("unroll") for (int k = 0; k < 2; ++k) dst[m][k] = *(const PG8_LAS bf16x8*)(lds + PG8_SA(b, h) + aoff + m * 2048 + k * 1024); } while (0)
#define PG8_LDA8(dst, b, h) do { _Pragma("unroll") for (int m = 0; m < 4; ++m) { const v4i_t lo_ = *(const PG8_LAS v4i_t*)(lds + PG8_SA(b, h) + aoff + m * 2048), hi_ = *(const PG8_LAS v4i_t*)(lds + PG8_SA(b, h) + aoff + m * 2048 + 1024); dst[m] = __builtin_shufflevector(lo_, hi_, 0, 1, 2, 3, 4, 5, 6, 7); } } while (0)
#define PG8_LDA(dst, b, h) do { if constexpr (FP8) PG8_LDA8(dst##8, b, h); else PG8_LDA16(dst, b, h); } while (0)
#define PG8_LDB16(dst, b, h) do { _Pragma("unroll") for (int n = 0; n < 2; ++n) _Pragma("unroll") for (int k = 0; k < 2; ++k) dst[n][k] = *(const PG8_LAS bf16x8*)(lds + PG8_SB(b, h) + boff + n * 2048 + k * 1024); } while (0)
#define PG8_LDB8(dst, b, h) do { _Pragma("unroll") for (int n = 0; n < 2; ++n) { const v4i_t lo_ = *(const PG8_LAS v4i_t*)(lds + PG8_SB(b, h) + boff + n * 2048), hi_ = *(const PG8_LAS v4i_t*)(lds + PG8_SB(b, h) + boff + n * 2048 + 1024); dst[n] = __builtin_shufflevector(lo_, hi_, 0, 1, 2, 3, 4, 5, 6, 7); } } while (0)
#define PG8_LDB(dst, b, h) do { if constexpr (FP8) PG8_LDB8(dst##8, b, h); else PG8_LDB16(dst, b, h); } while (0)
#define PG8_MMA(ai, bj, At, Bt) do { __builtin_amdgcn_s_setprio(1); _Pragma("unroll") for (int m = 0; m < 4; ++m) _Pragma("unroll") for (int n = 0; n < 2; ++n) _Pragma("unroll") for (int k = 0; k < 2; ++k) \
        acc[ai][bj][m][n] = __builtin_amdgcn_mfma_f32_16x16x32_bf16(Bt[n][k], At[m][k], acc[ai][bj][m][n], 0, 0, 0); __builtin_amdgcn_s_setprio(0); } while (0)
#define PG8_MMA8(ai, bj, At, Bt) do { __builtin_amdgcn_s_setprio(1); _Pragma("unroll") for (int m = 0; m < 4; ++m) _Pragma("unroll") for (int n = 0; n < 2; ++n) \
        asm("v_mfma_f32_16x16x128_f8f6f4 %0, %1, %2, %0" : "+v"(acc[ai][bj][m][n]) : "v"(Bt[n]), "v"(At[m])); __builtin_amdgcn_s_setprio(0); } while (0)
#define PG8_MM(ai, bj, At, Bt) do { if constexpr (FP8) PG8_MMA8(ai, bj, At##8, Bt##8); else PG8_MMA(ai, bj, At, Bt); } while (0)
#define PG8_WAIT_V(n) asm volatile("s_waitcnt vmcnt(" #n ")" ::: "memory")
#define PG8_WAIT_L(n) asm volatile("s_waitcnt lgkmcnt(" #n ")" ::: "memory")
#define PG8_BAR __builtin_amdgcn_s_barrier()
#define PG8_SCHED __builtin_amdgcn_sched_barrier(0)
    Unit cur, nxt; int ui = 0;
    if (!S.next(0, cur)) return;
    f32x4 acc[2][2][4][2];
#pragma unroll
    for (int a = 0; a < 2; ++a)
#pragma unroll
        for (int b = 0; b < 2; ++b)
#pragma unroll
            for (int m = 0; m < 4; ++m)
#pragma unroll
                for (int n = 0; n < 2; ++n) acc[a][b][m][n] = (f32x4){0.f, 0.f, 0.f, 0.f};
    bf16x8 At[4][2], B0[2][2], B1[2][2]; v8i_t At8[4], B08[2], B18[2];
    const char* cA = (const char*)g.A + (size_t)cur.pm * tstep; const char* cB = (const char*)g.Bt + (size_t)cur.pn * tstep;
    S.a_ready(cur);
    if constexpr (SP2) {
        PG8_STAGE(PG8_SB(0, 0), cB, voffB); PG8_STAGE(PG8_SB(0, 1), cB + hstep, voffB); PG8_STAGE(PG8_SA(0, 0), cA, voffA); PG8_STAGE(PG8_SA(0, 1), cA + hstep, voffA);
        if (wr == 1) PG8_BAR;
        PG8_WAIT_V(2); PG8_BAR;
        PG8_STAGE(PG8_SB(1, 0), cB + kstep, voffB); PG8_STAGE(PG8_SA(1, 0), cA + kstep, voffA); PG8_STAGE(PG8_SB(1, 1), cB + hstep + kstep, voffB);
        PG8_WAIT_V(6); PG8_BAR;
    } else {
        PG8_STAGE(PG8_SB(0, 0), cB, voffB); PG8_STAGE(PG8_SA(0, 0), cA, voffA); PG8_STAGE(PG8_SB(0, 1), cB + hstep, voffB); PG8_STAGE(PG8_SA(0, 1), cA + hstep, voffA);
        if (wr == 1) PG8_BAR;
        PG8_WAIT_V(4); PG8_BAR;
        PG8_STAGE(PG8_SB(1, 0), cB + kstep, voffB); PG8_STAGE(PG8_SA(1, 0), cA + kstep, voffA); PG8_STAGE(PG8_SB(1, 1), cB + hstep + kstep, voffB);
        PG8_WAIT_V(6); PG8_BAR;
    }
    for (;;) {
        const bool has_next = S.next(ui + 1, nxt);
        const char* nA = has_next ? (const char*)g.A + (size_t)nxt.pm * tstep : cA; const char* nB = has_next ? (const char*)g.Bt + (size_t)nxt.pn * tstep : cB;
#pragma unroll 1
        for (int t = 0; t < nt; t += 2) {
            const bool last = (t == nt - 2);
            const char* a1 = cA + (size_t)(t + 1) * kstep;
            const char* a2 = last ? nA : cA + (size_t)(t + 2) * kstep; const char* b2 = last ? nB : cB + (size_t)(t + 2) * kstep;
            const char* a3 = a2 + kstep; const char* b3 = b2 + kstep;
            if (last && has_next) S.a_ready(nxt);
            if constexpr (SP2) {
            PG8_LDB(B0, 0, 0); PG8_LDB(B1, 0, 1); PG8_SCHED; PG8_LDA(At, 0, 0); PG8_STAGE(PG8_SA(1, 1), a1 + hstep, voffA);
            PG8_WAIT_V(8); PG8_WAIT_L(0); PG8_BAR; PG8_MM(0, 0, At, B0); PG8_MM(0, 1, At, B1); PG8_BAR; PG8_SCHED;
            PG8_LDA(At, 0, 1); PG8_STAGE(PG8_SB(0, 0), b2, voffB); PG8_STAGE(PG8_SB(0, 1), b2 + hstep, voffB); PG8_STAGE(PG8_SA(0, 0), a2, voffA);
            PG8_WAIT_V(8); PG8_WAIT_L(0); PG8_BAR; PG8_MM(1, 0, At, B0); PG8_MM(1, 1, At, B1); PG8_BAR; PG8_SCHED;
            PG8_LDB(B0, 1, 0); PG8_LDB(B1, 1, 1); PG8_SCHED; PG8_LDA(At, 1, 0); PG8_STAGE(PG8_SA(0, 1), a2 + hstep, voffA);
            PG8_WAIT_V(8); PG8_WAIT_L(0); PG8_BAR; PG8_MM(0, 0, At, B0); PG8_MM(0, 1, At, B1); PG8_BAR; PG8_SCHED;
            PG8_LDA(At, 1, 1); PG8_STAGE(PG8_SB(1, 0), b3, voffB); PG8_STAGE(PG8_SB(1, 1), b3 + hstep, voffB); PG8_STAGE(PG8_SA(1, 0), a3, voffA);
            PG8_WAIT_V(8); PG8_WAIT_L(0); PG8_BAR; PG8_MM(1, 0, At, B0); PG8_MM(1, 1, At, B1); PG8_BAR; PG8_SCHED;
            } else {
            PG8_LDB(B0, 0, 0); PG8_SCHED; PG8_LDA(At, 0, 0); PG8_STAGE(PG8_SA(1, 1), a1 + hstep, voffA);
            PG8_WAIT_L(8); PG8_BAR; PG8_WAIT_L(0); PG8_MM(0, 0, At, B0); PG8_BAR; PG8_SCHED;
            PG8_LDB(B1, 0, 1); PG8_STAGE(PG8_SB(0, 0), b2, voffB);
            PG8_BAR; PG8_WAIT_L(0); PG8_MM(0, 1, At, B1); PG8_BAR;
            PG8_LDA(At, 0, 1); PG8_STAGE(PG8_SA(0, 0), a2, voffA);
            PG8_BAR; PG8_WAIT_L(0); PG8_MM(1, 0, At, B0); PG8_BAR; PG8_SCHED;
            PG8_STAGE(PG8_SB(0, 1), b2 + hstep, voffB);
            PG8_WAIT_V(6); PG8_BAR; PG8_MM(1, 1, At, B1); PG8_BAR;
            PG8_LDB(B0, 1, 0); PG8_SCHED; PG8_LDA(At, 1, 0); PG8_STAGE(PG8_SA(0, 1), a2 + hstep, voffA);
            PG8_WAIT_L(8); PG8_BAR; PG8_WAIT_L(0); PG8_MM(0, 0, At, B0); PG8_BAR; PG8_SCHED;
            PG8_LDB(B1, 1, 1); PG8_STAGE(PG8_SB(1, 0), b3, voffB);
            PG8_BAR; PG8_WAIT_L(0); PG8_MM(0, 1, At, B1); PG8_BAR;
            PG8_LDA(At, 1, 1); PG8_STAGE(PG8_SA(1, 0), a3, voffA);
            PG8_BAR; PG8_WAIT_L(0); PG8_MM(1, 0, At, B0); PG8_BAR; PG8_SCHED;
            PG8_STAGE(PG8_SB(1, 1), b3 + hstep, voffB);
            PG8_WAIT_V(6); PG8_BAR; PG8_MM(1, 1, At, B1); PG8_BAR;
            }
        }
        if constexpr (ALIGN_EPI) { if (wr == 0) PG8_BAR; }
        if constexpr (FP8) asm volatile("s_nop 15\n\ts_nop 15" ::: "memory");
        if constexpr (!Epi::AFTER_DRAIN) { int le_; asm volatile("v_mbcnt_lo_u32_b32 %0, -1, 0\n\tv_mbcnt_hi_u32_b32 %0, -1, %0" : "=v"(le_)); E(acc, cur, wr, wc, le_ & 15, le_ >> 4); S.done(cur); }
        if (!has_next) break;
#pragma unroll
        for (int a = 0; a < 2; ++a)
#pragma unroll
            for (int b = 0; b < 2; ++b)
#pragma unroll
                for (int m = 0; m < 4; ++m)
#pragma unroll
                    for (int n = 0; n < 2; ++n) acc[a][b][m][n] = (f32x4){0.f, 0.f, 0.f, 0.f};
        cur = nxt; cA = nA; cB = nB; ++ui;
        if constexpr (ALIGN_EPI) { if (wr == 1) PG8_BAR; }
    }
    PG8_WAIT_V(0);
    if constexpr (!ALIGN_EPI) { if (wr == 0) PG8_BAR; }
    PG8_BAR;
    if constexpr (Epi::AFTER_DRAIN) { E.fused(acc, cur, wr, wc, fr, fq, lds, wid, lane); S.done(cur); }
#undef PG8_SA
#undef PG8_SB
#undef PG8_STAGE
#undef PG8_LDA
#undef PG8_LDA8
#undef PG8_LDA16
#undef PG8_LDB
#undef PG8_LDB8
#undef PG8_LDB16
#undef PG8_MMA
#undef PG8_MMA8
#undef PG8_MM
#undef PG8_WAIT_V
#undef PG8_WAIT_L
#undef PG8_BAR
#undef PG8_SCHED
}
}
constexpr int NWAVES = 8;
constexpr int BATCH = 32, SEQ = 2048, DM = 1024, M = BATCH * SEQ, ZC = 3072, FF = 2816, GU = 2 * FF, DEPTH = 2, INC = 3012;
constexpr float LN_EPS = 1e-5f, LOG2E = 1.4426950408889634f, ALPHA = 1.4142135623730951f;
constexpr int ZC_QA = 0, ZC_KA = 256, ZC_VA = 320, ZC_QI = 384, ZC_KI = 640, ZC_WI = 704, ZC_QB = 768, ZC_KB = 1024, ZC_VB = 1280, ZC_QC = 1536, ZC_KC = 2048, ZC_VC = 2560;
constexpr size_t MiB = 1u << 20;
constexpr size_t WS_CTL = 0, CTL_ZERO_BYTES = 4 * MiB;
constexpr size_t WS_STAT = 1 * MiB;
constexpr size_t WS_CV = 3 * MiB;
constexpr size_t CV_LAYER = 2 * (3072 + 5632);
constexpr size_t WS_W = 4 * MiB;
constexpr size_t W_IN_B = (size_t)ZC * DM * 2, W_O_B = (size_t)DM * DM * 2, W_GU_B = (size_t)GU * DM * 2, W_D_B = (size_t)DM * FF * 2;
constexpr size_t W_LAYER_B = W_IN_B + W_O_B + W_GU_B + W_D_B;
constexpr size_t WS_R0 = 64 * MiB, WS_R1 = 192 * MiB, WS_R2 = 320 * MiB, WS_BIG = 448 * MiB, WS_SP = 896 * MiB  , WS_CVP = 904 * MiB  , WS_END = 908 * MiB;
static_assert(WS_W + DEPTH * W_LAYER_B <= WS_R0, "weights fit below R0");
static_assert((size_t)M * ZC * 2 <= WS_END - WS_BIG && (size_t)M * DM * 4 <= WS_END - WS_BIG && (size_t)M * DM * 2 <= WS_R1 - WS_R0, "activation map");
constexpr int CW_TMO = 0, CW_BAR = 4096;
constexpr int RING_OFF = 0, RING_BYTES = 131072;
constexpr int LDSCTL_OFF = RING_BYTES, MISC_OFF = LDSCTL_OFF + 320;
constexpr int LDS_BYTES = 147456;

typedef unsigned short bf16;
typedef unsigned v4u __attribute__((ext_vector_type(4)));
typedef unsigned v2u __attribute__((ext_vector_type(2)));
typedef float f32x4 __attribute__((ext_vector_type(4)));
#define LDS_WAIT() asm volatile("s_waitcnt lgkmcnt(0)" ::: "memory")
__device__ __forceinline__ unsigned f2bf(float f) { unsigned u = __builtin_bit_cast(unsigned, f); return (u + 0x7fffu + ((u >> 16) & 1u)) >> 16; }
__device__ __forceinline__ unsigned pk2(float lo, float hi) { return f2bf(lo) | (f2bf(hi) << 16); }
__device__ __forceinline__ float bflo(unsigned w) { return __uint_as_float(w << 16); }
__device__ __forceinline__ float bfhi(unsigned w) { return __uint_as_float(w & 0xffff0000u); }
__device__ __forceinline__ float bf1(bf16 b) { return __uint_as_float((unsigned)b << 16); }
__device__ __forceinline__ void unpack8(const v4u w, float (&f)[8]) { f[0] = bflo(w.x); f[1] = bfhi(w.x); f[2] = bflo(w.y); f[3] = bfhi(w.y); f[4] = bflo(w.z); f[5] = bfhi(w.z); f[6] = bflo(w.w); f[7] = bfhi(w.w); }
__device__ __forceinline__ float wave_sum(float v, int lane) {
#pragma unroll
    for (int o = 1; o < 64; o <<= 1) v += __int_as_float(__builtin_amdgcn_ds_bpermute((lane ^ o) << 2, __float_as_int(v)));
    return v;
}
__device__ __forceinline__ int mbcnt64(unsigned long long m) { return (int)__builtin_amdgcn_mbcnt_hi((unsigned)(m >> 32), __builtin_amdgcn_mbcnt_lo((unsigned)m, 0u)); }
#define GAS __attribute__((address_space(1)))
#define LAS __attribute__((address_space(3)))
typedef GAS unsigned gu32;
#define RLX_AGENT __ATOMIC_RELAXED, __HIP_MEMORY_SCOPE_AGENT
#define VM_WAIT() asm volatile("s_waitcnt vmcnt(0)" ::: "memory")
__device__ __forceinline__ int lane_now() { int l; asm volatile("v_mbcnt_lo_u32_b32 %0, -1, 0\n\tv_mbcnt_hi_u32_b32 %0, -1, %0" : "=v"(l)); return l; }
#define XB_TMO      128
#define XB_XCNT(j)  (256  + 64 * (j))
#define XB_XSUB(j)  (1280 + 64 * (j))
#define XB_XGEN(j)  (2304 + 64 * (j))
#define XB_TOP      3328
#define XB_TOPGEN   3392
#define XCD_BAR_WORDS 3456
#define XB_SPIN_CAP (1u << 24)

__device__ __forceinline__ unsigned xb_ld(unsigned* p)              { return __hip_atomic_load(p, __ATOMIC_RELAXED, __HIP_MEMORY_SCOPE_AGENT); }
__device__ __forceinline__ unsigned xb_add(unsigned* p, unsigned v) { return __hip_atomic_fetch_add(p, v, __ATOMIC_RELAXED, __HIP_MEMORY_SCOPE_AGENT); }
__device__ __forceinline__ unsigned xb_xcc_id() { return (unsigned)__builtin_amdgcn_s_getreg((3 << 11) | 20) & 0xFu; }
#define XB_SPIN(cond, bar) do { unsigned _sp = 0; while (cond) { __builtin_amdgcn_s_sleep(1); \
    if ((++_sp & 255u) == 0u) { if (xb_ld(&(bar)[XB_TMO])) break; if (_sp > XB_SPIN_CAP) { atomicAdd(&(bar)[XB_TMO], 1u); break; } } } } while (0)

struct XcdBarrier {
    unsigned* bar; unsigned x;
    volatile LAS unsigned* st;
};

__device__ __forceinline__ XcdBarrier xcd_barrier_post(unsigned* bar, volatile LAS unsigned* st) {
    XcdBarrier b; b.bar = bar; b.x = (unsigned)__builtin_amdgcn_readfirstlane((int)xb_xcc_id()); b.st = st;
    if (threadIdx.x == 0) (void)xb_add(&bar[XB_XCNT(b.x)], 1u);
    return b;
}
__device__ __forceinline__ void xcd_barrier_complete(unsigned* bar, unsigned x, unsigned& nloc, unsigned& nx) {
    const unsigned G = gridDim.x * gridDim.y * gridDim.z;
    unsigned sum, cnt, mine, sp = 0u;
    for (;;) {
        sum = 0u; cnt = 0u; mine = 0u;
#pragma unroll
        for (unsigned j = 0; j < 16; ++j) { const unsigned c = xb_ld(&bar[XB_XCNT(j)]); sum += c; cnt += (c > 0u) ? 1u : 0u; mine = (j == x) ? c : mine; }
        if (sum == G) break;
        __builtin_amdgcn_s_sleep(1);
        if ((++sp & 255u) == 0u) { if (xb_ld(&bar[XB_TMO])) break; if (sp > XB_SPIN_CAP) { atomicAdd(&bar[XB_TMO], 1u); break; } }
    }
    nloc = mine > 0u ? mine : 1u; nx = cnt > 0u ? cnt : 1u;
}

__device__ __forceinline__ void xcd_barrier(const XcdBarrier& b) {
    asm volatile("s_waitcnt vmcnt(0)" ::: "memory");
    __syncthreads();
    if (threadIdx.x == 0) {
        unsigned* bar = b.bar; asm volatile("" : "+s"(bar));
        const unsigned bx_ = (unsigned)__builtin_amdgcn_readfirstlane((int)xb_xcc_id());
        __builtin_amdgcn_s_waitcnt(0);
        unsigned nloc = b.st[0], nx = b.st[1];
        if (nloc == 0u) { xcd_barrier_complete(bar, bx_, nloc, nx); b.st[0] = nloc; b.st[1] = nx; }
        const unsigned old = xb_add(&bar[XB_XSUB(bx_)], 1u);
        const unsigned gen = old / nloc;
        if (old + 1u == (gen + 1u) * nloc) {
            __builtin_amdgcn_fence(__ATOMIC_RELEASE, "agent");
            asm volatile("s_waitcnt vmcnt(0)" ::: "memory");
            const unsigned og = xb_add(&bar[XB_TOP], 1u);
            const unsigned tg = og / nx;
            if (og + 1u == (tg + 1u) * nx) xb_add(&bar[XB_TOPGEN], 1u);
            else XB_SPIN(xb_ld(&bar[XB_TOPGEN]) == tg, bar);
            __builtin_amdgcn_fence(__ATOMIC_ACQUIRE, "agent");
            xb_add(&bar[XB_XGEN(bx_)], 1u);
            asm volatile("s_waitcnt vmcnt(0)" ::: "memory");
        } else {
            XB_SPIN(xb_ld(&bar[XB_XGEN(bx_)]) == gen, bar);
            __builtin_amdgcn_fence(__ATOMIC_ACQUIRE, "agent");
            asm volatile("s_waitcnt vmcnt(0)" ::: "memory");
        }
    }
    __syncthreads();
}
template <int TYPE, int FP8S = 0> __device__ __forceinline__ void transpose_item(const float* W0, const float* W1, const float* gk, const float* bk, float* c1o, float* c0o, int K, int Nsrc, int Ndst, bf16* WT, LAS float* scr, int item, int lane) {
    const int nblk = Ndst / 32, kb = item / nblk, nb = item % nblk, k0 = 64 * kb, n0 = 32 * nb;
    const int nd = n0 + (lane & 31);
    const float* src = W0; int c = nd; float sc = 1.f; bool pad = false;
    if (TYPE == 0) {
        if (nd < 708) c = nd; else if (nd < 768) { pad = true; c = 0; } else c = nd - 60;
        if (nd < 256) sc = 0.125f * LOG2E; else if (nd >= ZC_QB && nd < ZC_KB) sc = 0.17677669529663687f * LOG2E; else if (nd >= ZC_QC && nd < ZC_KC) sc = 0.125f * LOG2E;
    } else if (TYPE == 2) {
        const int tile = nd >> 8, w = nd & 255;
        if (w < 128) { src = W0; c = tile * 128 + w; } else { src = W1; c = tile * 128 + (w - 128); }
    }
    float s1 = 0.f, s0 = 0.f;
#pragma unroll
    for (int i = 0; i < 32; ++i) { const int kk = 2 * i + (lane >> 5); float v = pad ? 0.f : src[(size_t)(k0 + kk) * Nsrc + c] * sc;
        if (gk) { s0 += bk[k0 + kk] * v; v *= gk[k0 + kk];
            if (FP8S) s1 += __builtin_amdgcn_cvt_f32_fp8(__builtin_amdgcn_cvt_pk_fp8_f32(v * (float)(1 << FP8S), 0.f, 0, false), 0) * (1.f / (float)(1 << FP8S));
            else s1 += __uint_as_float(f2bf(v) << 16); }
        scr[kk * 33 + (lane & 31)] = v; }
    if (gk) { s1 += __int_as_float(__builtin_amdgcn_ds_bpermute((lane ^ 32) << 2, __float_as_int(s1))); s0 += __int_as_float(__builtin_amdgcn_ds_bpermute((lane ^ 32) << 2, __float_as_int(s0)));
        if (lane < 32 && c1o) { c1o[(size_t)kb * CV_LAYER + nd] = s1; c0o[(size_t)kb * CV_LAYER + nd] = s0; } }
    LDS_WAIT();
    const int c8 = lane & 7;
#pragma unroll
    for (int j = 0; j < 4; ++j) { const int n = (lane >> 3) + 8 * j; const LAS float* s = scr + (8 * c8) * 33 + n;
        if (FP8S) {
            const float S = (float)(1 << FP8S);
            int w0 = __builtin_amdgcn_cvt_pk_fp8_f32(s[0 * 33] * S, s[1 * 33] * S, 0, false); w0 = __builtin_amdgcn_cvt_pk_fp8_f32(s[2 * 33] * S, s[3 * 33] * S, w0, true);
            int w1 = __builtin_amdgcn_cvt_pk_fp8_f32(s[4 * 33] * S, s[5 * 33] * S, 0, false); w1 = __builtin_amdgcn_cvt_pk_fp8_f32(s[6 * 33] * S, s[7 * 33] * S, w1, true);
            v2u o; o.x = (unsigned)w0; o.y = (unsigned)w1; *(v2u*)((unsigned char*)WT + (size_t)(n0 + n) * K + k0 + 8 * c8) = o;
        } else {
        v4u o; o.x = pk2(s[0 * 33], s[1 * 33]); o.y = pk2(s[2 * 33], s[3 * 33]); o.z = pk2(s[4 * 33], s[5 * 33]); o.w = pk2(s[6 * 33], s[7 * 33]);
        *(v4u*)(WT + (size_t)(n0 + n) * K + k0 + 8 * c8) = o; } }
    LDS_WAIT();
}

template <bool OUT_F32> __device__ __forceinline__ void ln_phase(const float* H, const float* g, const float* b, bf16* ob, float* of, int gw, int NGW, int lane) {
    asm volatile("" : "+v"(lane));
    f32x4 gv[4], bv[4];
#pragma unroll
    for (int j = 0; j < 4; ++j) { gv[j] = ((const f32x4*)g)[lane + 64 * j]; bv[j] = ((const f32x4*)b)[lane + 64 * j]; }
    for (int m = gw; m < M; m += NGW) {
        const f32x4* xr = (const f32x4*)(H + (size_t)m * DM) + lane;
        f32x4 v[4]; float s = 0.f;
#pragma unroll
        for (int j = 0; j < 4; ++j) { v[j] = xr[64 * j]; s += (v[j].x + v[j].y) + (v[j].z + v[j].w); }
        const float mean = wave_sum(s, lane) * (1.f / DM); float s2 = 0.f;
#pragma unroll
        for (int j = 0; j < 4; ++j) { v[j] = v[j] - mean; s2 += (v[j].x * v[j].x + v[j].y * v[j].y) + (v[j].z * v[j].z + v[j].w * v[j].w); }
        const float rstd = 1.f / sqrtf(wave_sum(s2, lane) * (1.f / DM) + LN_EPS);
#pragma unroll
        for (int j = 0; j < 4; ++j) { const f32x4 y = v[j] * rstd * gv[j] + bv[j];
            if (OUT_F32) ((f32x4*)(of + (size_t)m * DM))[lane + 64 * j] = y;
            else { v2u o; o.x = pk2(y.x, y.y); o.y = pk2(y.z, y.w); ((v2u*)(ob + (size_t)m * DM))[lane + 64 * j] = o; } }
    }
}


__device__ __forceinline__ void stats_reduce(const float* part, float* ssum, float* ssq, size_t gt, size_t nth) {
    for (size_t row = gt; row < (size_t)M; row += nth) { float s = 0.f, q = 0.f;
#pragma unroll
        for (int sl = 0; sl < 16; ++sl) { s += part[(size_t)sl * M + row]; q += part[(size_t)(16 + sl) * M + row]; }
        ssum[row] = s; ssq[row] = q; }
}
__device__ __forceinline__ void cv_reduce(const float* cvp, float* cv, size_t gt, size_t nth) {
    for (size_t i = gt; i < (size_t)DEPTH * CV_LAYER; i += nth) { const size_t l = i / CV_LAYER, j = i % CV_LAYER;
        if (l == 0 && j < 2 * (size_t)ZC) continue;
        float s = 0.f;
#pragma unroll
        for (int kb = 0; kb < 16; ++kb) s += cvp[(l * 16 + kb) * CV_LAYER + j];
        cv[i] = s; }
}
typedef short bf16x8v __attribute__((ext_vector_type(8)));
typedef float f32x16 __attribute__((ext_vector_type(16)));
typedef short s16x4 __attribute__((ext_vector_type(4)));
typedef short v4i16_t __attribute__((ext_vector_type(4)));
typedef float f32x2_t __attribute__((ext_vector_type(2)));
typedef __bf16 bf16x2_t __attribute__((ext_vector_type(2)));
__device__ __forceinline__ unsigned cvtpk(float lo, float hi) { f32x2_t v = {lo, hi}; bf16x2_t b = __builtin_convertvector(v, bf16x2_t); return __builtin_bit_cast(unsigned, b); }
__device__ __forceinline__ s16x4 lds_tr(LAS const unsigned char* p) { return __builtin_bit_cast(s16x4, __builtin_amdgcn_ds_read_tr16_b64_v4i16((LAS v4i16_t*)p)); }
__device__ __forceinline__ float swap_max(float v) { auto rr = __builtin_amdgcn_permlane32_swap(__float_as_uint(v), __float_as_uint(v), false, false); return fmaxf(__uint_as_float(rr[0]), __uint_as_float(rr[1])); }
__device__ __forceinline__ float swap_sum(float v) { auto rr = __builtin_amdgcn_permlane32_swap(__float_as_uint(v), __float_as_uint(v), false, false); return __uint_as_float(rr[0]) + __uint_as_float(rr[1]); }
#ifndef FL_MFMA_SUM
#define FL_MFMA_SUM 1
#endif
#ifndef FL_CLASS
#define FL_CLASS 1
#endif
#ifndef MIX_FP8
#define MIX_FP8 0
#endif
__device__ __forceinline__ void mix_store4(bf16* MIX, size_t idx, float a, float b, float c, float d) {
#if MIX_FP8
    int w8 = __builtin_amdgcn_cvt_pk_fp8_f32(a, b, 0, false); w8 = __builtin_amdgcn_cvt_pk_fp8_f32(c, d, w8, true); *(int*)((unsigned char*)MIX + idx) = w8;
#else
    v2u w; w.x = cvtpk(a, b); w.y = cvtpk(c, d); *(v2u*)(MIX + idx) = w;
#endif
}
constexpr float FL_THR = 4.0f;
constexpr int FL_K = 0, FL_V = 16384, FL_TAB = 32768, FL_TABN = 2112;

__device__ __forceinline__ void fl_softmax(f32x16& p, float& m, float& l, f32x16 (&o)[2], bf16x8v (&pa)[2]) {
    const bool first = m < -1e29f;
    const float mref = first ? 0.f : m;
#pragma unroll
    for (int r = 0; r < 16; ++r) p[r] -= mref;
    float rm = fmaxf(fmaxf(p[0], p[1]), fmaxf(p[2], p[3]));
#pragma unroll
    for (int r = 4; r < 16; r += 4) rm = fmaxf(rm, fmaxf(fmaxf(p[r], p[r + 1]), fmaxf(p[r + 2], p[r + 3])));
    rm = swap_max(rm);
    const float dl = first ? ((rm > -1e29f) ? rm : 0.f) : ((rm > FL_THR) ? rm : 0.f);
    if (__any(dl != 0.f)) { const float al = first ? 1.f : __builtin_amdgcn_exp2f(-dl); l *= al;     o[0] *= al; o[1] *= al;
#pragma unroll
        for (int r = 0; r < 16; ++r) p[r] -= dl; }
    m = first ? ((rm > -1e29f) ? rm : m) : m + dl;
    float ls = 0.f;
#pragma unroll
    for (int r = 0; r < 16; ++r) { p[r] = __builtin_amdgcn_exp2f(p[r]); ls += p[r]; }
    l += ls;
    typedef unsigned u4 __attribute__((ext_vector_type(4)));
    u4 w0, w1; w0.x = cvtpk(p[0], p[1]); w0.y = cvtpk(p[2], p[3]); w0.z = cvtpk(p[4], p[5]); w0.w = cvtpk(p[6], p[7]);
    w1.x = cvtpk(p[8], p[9]); w1.y = cvtpk(p[10], p[11]); w1.z = cvtpk(p[12], p[13]); w1.w = cvtpk(p[14], p[15]);
    pa[0] = __builtin_bit_cast(bf16x8v, w0); pa[1] = __builtin_bit_cast(bf16x8v, w1);
}

__device__ __forceinline__ void fl_softmax2(f32x16& pa_, f32x16& pb_, float& m, float& l, f32x16 (&o)[2], bf16x8v (&pf)[4]) {
    const bool first = m < -1e29f;
    const float mref = first ? 0.f : m;
#pragma unroll
    for (int r = 0; r < 16; ++r) { pa_[r] -= mref; pb_[r] -= mref; }
    float rm = fmaxf(fmaxf(pa_[0], pa_[1]), fmaxf(pb_[0], pb_[1]));
#pragma unroll
    for (int r = 2; r < 16; r += 2) rm = fmaxf(rm, fmaxf(fmaxf(pa_[r], pa_[r + 1]), fmaxf(pb_[r], pb_[r + 1])));
    rm = swap_max(rm);
    const float dl = first ? ((rm > -1e29f) ? rm : 0.f) : ((rm > FL_THR) ? rm : 0.f);
    if (__any(dl != 0.f)) { const float al = first ? 1.f : __builtin_amdgcn_exp2f(-dl); l *= al; o[0] *= al; o[1] *= al;
#pragma unroll
        for (int r = 0; r < 16; ++r) { pa_[r] -= dl; pb_[r] -= dl; } }
    m = first ? ((rm > -1e29f) ? rm : m) : m + dl;
    float ls0 = 0.f, ls1 = 0.f;
#pragma unroll
    for (int r = 0; r < 16; ++r) { pa_[r] = __builtin_amdgcn_exp2f(pa_[r]); ls0 += pa_[r]; pb_[r] = __builtin_amdgcn_exp2f(pb_[r]); ls1 += pb_[r]; }
    l += ls0 + ls1;
    typedef unsigned u4 __attribute__((ext_vector_type(4)));
    u4 w;
    w.x = cvtpk(pa_[0], pa_[1]); w.y = cvtpk(pa_[2], pa_[3]); w.z = cvtpk(pa_[4], pa_[5]); w.w = cvtpk(pa_[6], pa_[7]); pf[0] = __builtin_bit_cast(bf16x8v, w);
    w.x = cvtpk(pa_[8], pa_[9]); w.y = cvtpk(pa_[10], pa_[11]); w.z = cvtpk(pa_[12], pa_[13]); w.w = cvtpk(pa_[14], pa_[15]); pf[1] = __builtin_bit_cast(bf16x8v, w);
    w.x = cvtpk(pb_[0], pb_[1]); w.y = cvtpk(pb_[2], pb_[3]); w.z = cvtpk(pb_[4], pb_[5]); w.w = cvtpk(pb_[6], pb_[7]); pf[2] = __builtin_bit_cast(bf16x8v, w);
    w.x = cvtpk(pb_[8], pb_[9]); w.y = cvtpk(pb_[10], pb_[11]); w.z = cvtpk(pb_[12], pb_[13]); w.w = cvtpk(pb_[14], pb_[15]); pf[3] = __builtin_bit_cast(bf16x8v, w);
}

__device__ __forceinline__ void fl_softmax3(f32x16& pa_, f32x16& pb_, float sha, float shb, float& m, float& l, f32x16 (&o)[2], bf16x8v (&pf)[4]) {
    const bool first = m < -1e29f;
    const float mref = first ? 0.f : m, ca = sha - mref, cb = shb - mref;
#pragma unroll
    for (int r = 0; r < 16; ++r) { pa_[r] += ca; pb_[r] += cb; }
    float rm = fmaxf(fmaxf(pa_[0], pa_[1]), fmaxf(pb_[0], pb_[1]));
#pragma unroll
    for (int r = 2; r < 16; r += 2) rm = fmaxf(rm, fmaxf(fmaxf(pa_[r], pa_[r + 1]), fmaxf(pb_[r], pb_[r + 1])));
    rm = swap_max(rm);
    const float dl = first ? ((rm > -1e29f) ? rm : 0.f) : ((rm > FL_THR) ? rm : 0.f);
    if (__any(dl != 0.f)) { const float al = first ? 1.f : __builtin_amdgcn_exp2f(-dl); l *= al; o[0] *= al; o[1] *= al;
#pragma unroll
        for (int r = 0; r < 16; ++r) { pa_[r] -= dl; pb_[r] -= dl; } }
    m = first ? ((rm > -1e29f) ? rm : m) : m + dl;
    float ls0 = 0.f, ls1 = 0.f;
#pragma unroll
    for (int r = 0; r < 16; ++r) { pa_[r] = __builtin_amdgcn_exp2f(pa_[r]); ls0 += pa_[r]; pb_[r] = __builtin_amdgcn_exp2f(pb_[r]); ls1 += pb_[r]; }
    l += ls0 + ls1;
    typedef unsigned u4 __attribute__((ext_vector_type(4)));
    u4 w;
    w.x = cvtpk(pa_[0], pa_[1]); w.y = cvtpk(pa_[2], pa_[3]); w.z = cvtpk(pa_[4], pa_[5]); w.w = cvtpk(pa_[6], pa_[7]); pf[0] = __builtin_bit_cast(bf16x8v, w);
    w.x = cvtpk(pa_[8], pa_[9]); w.y = cvtpk(pa_[10], pa_[11]); w.z = cvtpk(pa_[12], pa_[13]); w.w = cvtpk(pa_[14], pa_[15]); pf[1] = __builtin_bit_cast(bf16x8v, w);
    w.x = cvtpk(pb_[0], pb_[1]); w.y = cvtpk(pb_[2], pb_[3]); w.z = cvtpk(pb_[4], pb_[5]); w.w = cvtpk(pb_[6], pb_[7]); pf[2] = __builtin_bit_cast(bf16x8v, w);
    w.x = cvtpk(pb_[8], pb_[9]); w.y = cvtpk(pb_[10], pb_[11]); w.z = cvtpk(pb_[12], pb_[13]); w.w = cvtpk(pb_[14], pb_[15]); pf[3] = __builtin_bit_cast(bf16x8v, w);
}
__device__ __forceinline__ float fl_rowsum(const bf16x8v (&pf)[4]) {
    const bf16x8v ones = (bf16x8v){0x3f80, 0x3f80, 0x3f80, 0x3f80, 0x3f80, 0x3f80, 0x3f80, 0x3f80};
    f32x16 z;
#pragma unroll
    for (int r = 0; r < 16; ++r) z[r] = 0.f;
    z = __builtin_amdgcn_mfma_f32_32x32x16_bf16(ones, pf[0], z, 0, 0, 0); z = __builtin_amdgcn_mfma_f32_32x32x16_bf16(ones, pf[1], z, 0, 0, 0);
    z = __builtin_amdgcn_mfma_f32_32x32x16_bf16(ones, pf[2], z, 0, 0, 0); z = __builtin_amdgcn_mfma_f32_32x32x16_bf16(ones, pf[3], z, 0, 0, 0);
    return z[0];
}

template <int MODE> __device__ __forceinline__ void flash_unit(const bf16* Z, bf16* MIX, LAS unsigned char* L, int b, int h, int qb, float lam_full, float lambda_init, const float* subg, int tid, int wave, int lane) {
    lane = lane_now(); tid = wave * 64 + lane;
    constexpr int NMAP = MODE == 0 ? 2 : 1, KS = 4 / NMAP;
    constexpr int CQ = MODE == 0 ? ZC_QB : ZC_QC, CK = MODE == 0 ? ZC_KB : ZC_KC, CV = MODE == 0 ? ZC_VB : ZC_VC;
    const int r32 = lane & 31, hi = lane >> 5;
    LAS unsigned char* Kb = L + FL_K; LAS unsigned char* Vb = L + FL_V; LAS float* tab = (LAS float*)(L + FL_TAB);
    const int Q0 = qb * 256, tq0 = Q0 + wave * 32, t = tq0 + r32;
    const bf16* zb = Z + (size_t)(b * SEQ) * ZC;
    const float sl = (MODE == 0 ? __builtin_amdgcn_exp2f(-2.f * (float)(h + 1)) : __builtin_amdgcn_exp2f(-(float)(h + 1))) * LOG2E;
    for (int j = tid; j < FL_TABN; j += NWAVES * 64) { const int d = 2047 - j; float v;
        if (MODE == 0) v = d < 0 ? -INFINITY : -sl * (float)d;
        else { const int mult = (d <= 128 ? 1 : 0) + (((d & 3) == 0 && d <= 512) ? 1 : 0) + ((d & 15) == 0 ? 1 : 0);
               v = (d < 0 || mult == 0) ? -INFINITY : -sl * (float)d + (mult == 1 ? 0.f : (mult == 2 ? 1.f : 1.5849625007211562f)); }
        tab[j] = v; }
    bf16x8v qf[NMAP][KS];
#pragma unroll
    for (int mp = 0; mp < NMAP; ++mp)
#pragma unroll
        for (int ks = 0; ks < KS; ++ks) qf[mp][ks] = *(const bf16x8v*)(zb + (size_t)t * ZC + CQ + h * 64 + (mp * KS + ks) * 16 + hi * 8);
    constexpr int NCLS = MODE == 0 ? 1 : 3;
    f32x16 cin[NCLS];
#pragma unroll
    for (int r = 0; r < 16; ++r) { const int cr = (r & 3) + 8 * (r >> 2) + 4 * hi; const float a = sl * (float)cr;
        if (MODE == 0) cin[0][r] = a;
        else { const bool m4 = ((t - cr) & 3) == 0, m16 = ((t - cr) & 15) == 0;
            cin[0][r] = a + (m16 ? 1.5849625007211562f : (m4 ? 1.f : 0.f)); cin[NCLS - 2][r] = m4 ? a + (m16 ? 1.f : 0.f) : -INFINITY; cin[NCLS - 1][r] = m16 ? a : -INFINITY; } }
    float m[NMAP], l[NMAP]; f32x16 o[NMAP][2];
#pragma unroll
    for (int mp = 0; mp < NMAP; ++mp) { m[mp] = -1e30f; l[mp] = 0.f;
#pragma unroll
        for (int r = 0; r < 16; ++r) { o[mp][0][r] = 0.f; o[mp][1][r] = 0.f; } }
    const int skey = tid >> 3, sc = tid & 7;
    const bf16* ksrc = zb + (size_t)skey * ZC + CK + h * 64 + sc * 8;
    const bf16* vsrc = zb + (size_t)skey * ZC + CV + h * 64 + sc * 8;
    const int kdst = (sc >> 1) * 2048 + (sc & 1) * 1024 + (skey >> 5) * 512 + (skey & 31) * 16;
    const int vdst = (sc >> 2) * 4096 + (skey >> 3) * 512 + (skey & 7) * 64 + (sc & 3) * 16;
    const int krd = hi * 1024 + r32 * 16;
    const int vrd = ((lane >> 4) & 1) * 32 + (lane & 3) * 8 + (4 * hi + ((lane & 15) >> 2)) * 64;
    int tilz = 64 * ZC; asm volatile("" : "+s"(tilz));
    int jt = Q0 / 64 + 3;
    v4u kA = *(const v4u*)(ksrc + (size_t)(jt * tilz)), vA = *(const v4u*)(vsrc + (size_t)(jt * tilz));
    v4u kB = *(const v4u*)(ksrc + (size_t)((jt - 1) * tilz)), vB = *(const v4u*)(vsrc + (size_t)((jt - 1) * tilz));
    *(LAS v4u*)(Kb + (jt & 1) * 8192 + kdst) = kA; *(LAS v4u*)(Vb + (jt & 1) * 8192 + vdst) = vA;
    __syncthreads();
#define FL_TILE(JT, KW, VW, KL, VL) do { const int jt_ = (JT); \
        if (jt_ >= 2) { KL = *(const v4u*)(ksrc + (size_t)((jt_ - 2) * tilz)); VL = *(const v4u*)(vsrc + (size_t)((jt_ - 2) * tilz)); } \
        const LAS unsigned char* Kc = Kb + (jt_ & 1) * 8192; const LAS unsigned char* Vc = Vb + (jt_ & 1) * 8192; \
        if (jt_ * 64 <= tq0) {                                            \
              \
            const LAS float* tp = tab + (2047 - t + jt_ * 64 + 4 * hi); \
            f32x16 bias0, bias1; \
            _Pragma("unroll") for (int r = 0; r < 16; ++r) { bias0[r] = tp[(r & 3) + 8 * (r >> 2)]; bias1[r] = tp[32 + (r & 3) + 8 * (r >> 2)]; } \
            _Pragma("unroll") for (int mp = 0; mp < NMAP; ++mp) { \
                f32x16 p0 = bias0, p1 = bias1; \
                _Pragma("unroll") for (int ks = 0; ks < KS; ++ks) { const bf16x8v kf0 = *(const LAS bf16x8v*)(Kc + (mp * KS + ks) * 2048 + krd), kf1 = *(const LAS bf16x8v*)(Kc + (mp * KS + ks) * 2048 + 512 + krd); \
                    p0 = __builtin_amdgcn_mfma_f32_32x32x16_bf16(kf0, qf[mp][ks], p0, 0, 0, 0); p1 = __builtin_amdgcn_mfma_f32_32x32x16_bf16(kf1, qf[mp][ks], p1, 0, 0, 0); } \
                bf16x8v pf[4]; \
                fl_softmax3(p0, p1, 0.f, 0.f, m[mp], l[mp], o[mp], pf); \
                _Pragma("unroll") for (int s4 = 0; s4 < 4; ++s4) _Pragma("unroll") for (int db = 0; db < 2; ++db) { const LAS unsigned char* vp = Vc + db * 4096 + s4 * 1024 + vrd; \
                        const s16x4 lo = lds_tr(vp), hh = lds_tr(vp + 512); \
                        const bf16x8v vf = (bf16x8v){lo[0], lo[1], lo[2], lo[3], hh[0], hh[1], hh[2], hh[3]}; \
                        o[mp][db] = __builtin_amdgcn_mfma_f32_32x32x16_bf16(vf, pf[s4], o[mp][db], 0, 0, 0); } } \
        } \
        if (jt_ >= 1) { *(LAS v4u*)(Kb + ((jt_ - 1) & 1) * 8192 + kdst) = KW; *(LAS v4u*)(Vb + ((jt_ - 1) & 1) * 8192 + vdst) = VW; } \
        __syncthreads(); } while (0)
    for (; jt >= 0; jt -= 2) { FL_TILE(jt, kB, vB, kA, vA); FL_TILE(jt - 1, kA, vA, kB, vB); }
#undef FL_TILE
    const size_t orow = (size_t)(b * SEQ + t) * DM + (MODE == 0 ? 256 : 512) + h * 64 + 4 * hi;
    if (MODE == 0) {
        const float i0 = 1.f / swap_sum(l[0]), i1 = lam_full / swap_sum(l[NMAP - 1]); float ss = 0.f;
#pragma unroll
        for (int db = 0; db < 2; ++db)
#pragma unroll
            for (int r = 0; r < 16; ++r) { const float v = o[0][db][r] * i0 - o[NMAP - 1][db][r] * i1; o[0][db][r] = v; ss += v * v; }
        const float rs = (1.f / sqrtf(swap_sum(ss) * (1.f / 64.f) + LN_EPS)) * lambda_init;
#pragma unroll
        for (int db = 0; db < 2; ++db)
#pragma unroll
            for (int rg = 0; rg < 4; ++rg) { const f32x4 g = *(const f32x4*)(subg + 32 * db + 8 * rg + 4 * hi);
                mix_store4(MIX, orow + 32 * db + 8 * rg, o[0][db][4 * rg + 0] * rs * g.x, o[0][db][4 * rg + 1] * rs * g.y, o[0][db][4 * rg + 2] * rs * g.z, o[0][db][4 * rg + 3] * rs * g.w); }
    } else {
        const float i0 = 1.f / swap_sum(l[0]);
#pragma unroll
        for (int db = 0; db < 2; ++db)
#pragma unroll
            for (int rg = 0; rg < 4; ++rg) mix_store4(MIX, orow + 32 * db + 8 * rg, o[0][db][4 * rg + 0] * i0, o[0][db][4 * rg + 1] * i0, o[0][db][4 * rg + 2] * i0, o[0][db][4 * rg + 3] * i0);
    }
}
template <int MODE> __device__ __forceinline__ void flash_phase(const bf16* Z, bf16* MIX, LAS unsigned char* L, const float* lam, const float* subg, float lambda_init, int vcu, int G, int tid, int wave, int lane) {
    asm volatile("" : "+v"(tid), "+v"(lane));
    constexpr int NH = MODE == 0 ? 4 : 8, NPAIR = BATCH * NH * 4;
    float lam_full = 0.f;
    if (MODE == 0) { const int li = lane & 31; const float s01 = wave_sum(lam[li] * lam[32 + li], lane) * 0.5f, s23 = wave_sum(lam[64 + li] * lam[96 + li], lane) * 0.5f; lam_full = __int_as_float(__builtin_amdgcn_readfirstlane(__float_as_int(expf(s01) - expf(s23) + lambda_init))); }
    const float oml = __int_as_float(__builtin_amdgcn_readfirstlane(__float_as_int(1.f - lambda_init)));
    for (int p = vcu; p < NPAIR; p += G) {
        const int b = p / (NH * 4), h = (p >> 2) % NH, x = p & 3;
#pragma unroll 1
        for (int k = 0; k < 2; ++k) { flash_unit<MODE>(Z, MIX, L, b, h, k == 0 ? 7 - x : x, lam_full, oml, subg, tid, wave, lane); __syncthreads(); }
    }
}
constexpr int F2_K = 0, F2_V = 24576, F2_TAB = 40960;
#define F2_QK(S, KSLOT, MP, JT) do { const LAS float* tp_ = tab + (2047 - t + (JT) * 64 + 4 * hi); const LAS unsigned char* kc_ = Kb + (KSLOT) * 8192; \
        _Pragma("unroll") for (int r = 0; r < 16; ++r) { S[0][r] = tp_[(r & 3) + 8 * (r >> 2)]; S[1][r] = tp_[32 + (r & 3) + 8 * (r >> 2)]; } \
        _Pragma("unroll") for (int ks = 0; ks < KS; ++ks) { const bf16x8v k0_ = *(const LAS bf16x8v*)(kc_ + ((MP) * KS + ks) * 2048 + krd), k1_ = *(const LAS bf16x8v*)(kc_ + ((MP) * KS + ks) * 2048 + 512 + krd); \
            S[0] = __builtin_amdgcn_mfma_f32_32x32x16_bf16(k0_, qf[MP][ks], S[0], 0, 0, 0); S[1] = __builtin_amdgcn_mfma_f32_32x32x16_bf16(k1_, qf[MP][ks], S[1], 0, 0, 0); } } while (0)
#define F2_BD(S, MP) do { float rm_ = fmaxf(fmaxf(S[0][0], S[0][1]), fmaxf(S[1][0], S[1][1])); \
        _Pragma("unroll") for (int r = 2; r < 16; r += 2) rm_ = fmaxf(rm_, fmaxf(fmaxf(S[0][r], S[0][r + 1]), fmaxf(S[1][r], S[1][r + 1]))); \
        rm_ = swap_max(rm_); const bool first_ = m[MP] < -1e29f; \
        const bool up_ = first_ ? (rm_ > -1e29f) : (rm_ > m[MP] + FL_THR); \
        if (__any(up_)) { const float nm_ = up_ ? rm_ : m[MP], al_ = (first_ || !up_) ? 1.f : __builtin_amdgcn_exp2f(m[MP] - nm_); l[MP] *= al_; o[MP][0] *= al_; o[MP][1] *= al_; m[MP] = nm_; } } while (0)
#define F2_SM(S, MP, PF) do { const float nm_ = -m[MP]; float ls0_ = 0.f, ls1_ = 0.f; \
        _Pragma("unroll") for (int r = 0; r < 16; ++r) { S[0][r] = __builtin_amdgcn_exp2f(S[0][r] + nm_); ls0_ += S[0][r]; S[1][r] = __builtin_amdgcn_exp2f(S[1][r] + nm_); ls1_ += S[1][r]; } \
        l[MP] += ls0_ + ls1_; \
        { typedef unsigned u4_ __attribute__((ext_vector_type(4))); u4_ w_; \
          w_.x = cvtpk(S[0][0], S[0][1]); w_.y = cvtpk(S[0][2], S[0][3]); w_.z = cvtpk(S[0][4], S[0][5]); w_.w = cvtpk(S[0][6], S[0][7]); PF[0] = __builtin_bit_cast(bf16x8v, w_); \
          w_.x = cvtpk(S[0][8], S[0][9]); w_.y = cvtpk(S[0][10], S[0][11]); w_.z = cvtpk(S[0][12], S[0][13]); w_.w = cvtpk(S[0][14], S[0][15]); PF[1] = __builtin_bit_cast(bf16x8v, w_); \
          w_.x = cvtpk(S[1][0], S[1][1]); w_.y = cvtpk(S[1][2], S[1][3]); w_.z = cvtpk(S[1][4], S[1][5]); w_.w = cvtpk(S[1][6], S[1][7]); PF[2] = __builtin_bit_cast(bf16x8v, w_); \
          w_.x = cvtpk(S[1][8], S[1][9]); w_.y = cvtpk(S[1][10], S[1][11]); w_.z = cvtpk(S[1][12], S[1][13]); w_.w = cvtpk(S[1][14], S[1][15]); PF[3] = __builtin_bit_cast(bf16x8v, w_); } } while (0)
#define F2_PV(MP, VSLOT, PF) do { const LAS unsigned char* vc_ = Vb + (VSLOT) * 8192; \
        _Pragma("unroll") for (int s4 = 0; s4 < 4; ++s4) _Pragma("unroll") for (int db = 0; db < 2; ++db) { const LAS unsigned char* vp_ = vc_ + db * 4096 + s4 * 1024 + vrd; \
            const s16x4 lo_ = lds_tr(vp_), hh_ = lds_tr(vp_ + 512); const bf16x8v vf_ = (bf16x8v){lo_[0], lo_[1], lo_[2], lo_[3], hh_[0], hh_[1], hh_[2], hh_[3]}; \
            o[MP][db] = __builtin_amdgcn_mfma_f32_32x32x16_bf16(vf_, PF[s4], o[MP][db], 0, 0, 0); } } while (0)

template <int MODE> __device__ __forceinline__ void flash_unit2(const bf16* Z, bf16* MIX, LAS unsigned char* L, int b, int h, int qb, float lam_full, float lambda_init, const float* subg, int wave) {
    const int lane = lane_now(), tid = wave * 64 + lane;
    constexpr int NMAP = MODE == 0 ? 2 : 1, KS = 4 / NMAP;
    constexpr int CQ = MODE == 0 ? ZC_QB : ZC_QC, CK = MODE == 0 ? ZC_KB : ZC_KC, CV = MODE == 0 ? ZC_VB : ZC_VC;
    const int r32 = lane & 31, hi = lane >> 5;
    LAS unsigned char* Kb = L + F2_K; LAS unsigned char* Vb = L + F2_V; LAS float* tab = (LAS float*)(L + F2_TAB);
    const int Q0 = qb * 256, tq0 = Q0 + wave * 32, t = tq0 + r32, Jw = tq0 >> 6;
    const bf16* zb = Z + (size_t)(b * SEQ) * ZC;
    const float sl = (MODE == 0 ? __builtin_amdgcn_exp2f(-2.f * (float)(h + 1)) : __builtin_amdgcn_exp2f(-(float)(h + 1))) * LOG2E;
    for (int j = tid; j < FL_TABN; j += NWAVES * 64) { const int d = 2047 - j; float v;
        if (MODE == 0) v = d < 0 ? -INFINITY : -sl * (float)d;
        else { const int mult = (d <= 128 ? 1 : 0) + (((d & 3) == 0 && d <= 512) ? 1 : 0) + ((d & 15) == 0 ? 1 : 0);
               v = (d < 0 || mult == 0) ? -INFINITY : -sl * (float)d + (mult == 1 ? 0.f : (mult == 2 ? 1.f : 1.5849625007211562f)); }
        tab[j] = v; }
    bf16x8v qf[NMAP][KS];
#pragma unroll
    for (int mp = 0; mp < NMAP; ++mp)
#pragma unroll
        for (int ks = 0; ks < KS; ++ks) qf[mp][ks] = *(const bf16x8v*)(zb + (size_t)t * ZC + CQ + h * 64 + (mp * KS + ks) * 16 + hi * 8);
    float m[NMAP], l[NMAP]; f32x16 o[NMAP][2];
#pragma unroll
    for (int mp = 0; mp < NMAP; ++mp) { m[mp] = -1e30f; l[mp] = 0.f;
#pragma unroll
        for (int r = 0; r < 16; ++r) { o[mp][0][r] = 0.f; o[mp][1][r] = 0.f; } }
    const int skey = tid >> 3, sc = tid & 7;
    const bf16* ksrc = zb + (size_t)skey * ZC + CK + h * 64 + sc * 8;
    const bf16* vsrc = zb + (size_t)skey * ZC + CV + h * 64 + sc * 8;
    const int kdst = (sc >> 1) * 2048 + (sc & 1) * 1024 + (skey >> 5) * 512 + (skey & 31) * 16;
    const int vdst = (sc >> 2) * 4096 + (skey >> 3) * 512 + (skey & 7) * 64 + (sc & 3) * 16;
    const int krd = hi * 1024 + r32 * 16;
    const int vrd = ((lane >> 4) & 1) * 32 + (lane & 3) * 8 + (4 * hi + ((lane & 15) >> 2)) * 64;
    const size_t til = (size_t)64 * ZC;
    const int J = Q0 / 64 + 3;
    int k0s = J % 3, k1s = (J + 2) % 3, k2s = (J + 1) % 3;
    { const v4u a = *(const v4u*)(ksrc + J * til), bq = *(const v4u*)(ksrc + (J - 1) * til), c = *(const v4u*)(vsrc + J * til);
      *(LAS v4u*)(Kb + k0s * 8192 + kdst) = a; *(LAS v4u*)(Kb + k1s * 8192 + kdst) = bq; *(LAS v4u*)(Vb + (J & 1) * 8192 + vdst) = c; }
    v4u kA = *(const v4u*)(ksrc + (J - 2) * til), vA = *(const v4u*)(vsrc + (J - 1) * til);
    v4u kB = kA, vB = vA;
    __syncthreads();
    f32x16 Sa[2], Sb[2];
    if (J <= Jw) { F2_QK(Sa, k0s, 0, J); F2_BD(Sa, 0); }
#define F2_TILE(JT, KW, VW, KL, VL, SC, SN) do { const int jt_ = (JT); \
        if (jt_ >= 3) KL = *(const v4u*)(ksrc + (jt_ - 3) * til); if (jt_ >= 2) VL = *(const v4u*)(vsrc + (jt_ - 2) * til); \
        if (MODE == 1) { \
            if (jt_ <= Jw && jt_ >= 1) { bf16x8v pf_[4]; if (wave >= 4) { F2_SM(SC, 0, pf_); F2_PV(0, jt_ & 1, pf_); F2_QK(SN, k1s, 0, jt_ - 1); F2_BD(SN, 0); } else { F2_QK(SN, k1s, 0, jt_ - 1); F2_SM(SC, 0, pf_); F2_PV(0, jt_ & 1, pf_); F2_BD(SN, 0); } } \
            else if (jt_ == Jw + 1) { F2_QK(SN, k1s, 0, jt_ - 1); F2_BD(SN, 0); } \
            else if (jt_ <= Jw) { bf16x8v pf_[4]; F2_SM(SC, 0, pf_); F2_PV(0, jt_ & 1, pf_); } \
        } else { \
            if (jt_ <= Jw) { bf16x8v pf_[4]; F2_QK(Sb, k0s, NMAP - 1, jt_); F2_SM(Sa, 0, pf_); F2_PV(0, jt_ & 1, pf_); F2_BD(Sb, NMAP - 1); } \
            if (jt_ <= Jw + 1 && jt_ >= 1) { F2_QK(Sa, k1s, 0, jt_ - 1); } \
            if (jt_ <= Jw) { bf16x8v pf_[4]; F2_SM(Sb, NMAP - 1, pf_); F2_PV(NMAP - 1, jt_ & 1, pf_); } \
            if (jt_ <= Jw + 1 && jt_ >= 1) { F2_BD(Sa, 0); } \
        } \
        if (jt_ >= 2) *(LAS v4u*)(Kb + k2s * 8192 + kdst) = KW; if (jt_ >= 1) *(LAS v4u*)(Vb + ((jt_ - 1) & 1) * 8192 + vdst) = VW; \
        { const int t_ = k0s; k0s = k1s; k1s = k2s; k2s = t_; } \
        __syncthreads(); } while (0)
    for (int jt = J; jt >= 0; jt -= 2) { F2_TILE(jt, kA, vA, kB, vB, Sa, Sb); F2_TILE(jt - 1, kB, vB, kA, vA, Sb, Sa); }
#undef F2_TILE
    bf16* orow = MIX + (size_t)(b * SEQ + t) * DM + (MODE == 0 ? 256 : 512) + h * 64 + 4 * hi;
    if (MODE == 0) {
        const float i0 = 1.f / swap_sum(l[0]), i1 = lam_full / swap_sum(l[NMAP - 1]); float ss = 0.f;
#pragma unroll
        for (int db = 0; db < 2; ++db)
#pragma unroll
            for (int r = 0; r < 16; ++r) { const float v = o[0][db][r] * i0 - o[NMAP - 1][db][r] * i1; o[0][db][r] = v; ss += v * v; }
        const float rs = (1.f / sqrtf(swap_sum(ss) * (1.f / 64.f) + LN_EPS)) * (1.f - lambda_init);
#pragma unroll
        for (int db = 0; db < 2; ++db)
#pragma unroll
            for (int rg = 0; rg < 4; ++rg) { const f32x4 g = *(const f32x4*)(subg + 32 * db + 8 * rg + 4 * hi);
                v2u w; w.x = cvtpk(o[0][db][4 * rg + 0] * rs * g.x, o[0][db][4 * rg + 1] * rs * g.y); w.y = cvtpk(o[0][db][4 * rg + 2] * rs * g.z, o[0][db][4 * rg + 3] * rs * g.w);
                *(v2u*)(orow + 32 * db + 8 * rg) = w; }
    } else {
        const float i0 = 1.f / swap_sum(l[0]);
#pragma unroll
        for (int db = 0; db < 2; ++db)
#pragma unroll
            for (int rg = 0; rg < 4; ++rg) { v2u w; w.x = cvtpk(o[0][db][4 * rg + 0] * i0, o[0][db][4 * rg + 1] * i0); w.y = cvtpk(o[0][db][4 * rg + 2] * i0, o[0][db][4 * rg + 3] * i0);
                *(v2u*)(orow + 32 * db + 8 * rg) = w; }
    }
}
template <int MODE> __device__ __forceinline__ void flash_phase2(const bf16* Z, bf16* MIX, LAS unsigned char* L, const float* lam, const float* subg, float lambda_init, int vcu, int G, int tid, int wave, int lane) {
    constexpr int NH = MODE == 0 ? 4 : 8, NPAIR = BATCH * NH * 4;
    float lam_full = 0.f;
    if (MODE == 0) { const int li = lane & 31; const float s01 = wave_sum(lam[li] * lam[32 + li], lane) * 0.5f, s23 = wave_sum(lam[64 + li] * lam[96 + li], lane) * 0.5f; lam_full = expf(s01) - expf(s23) + lambda_init; }
    for (int p = vcu; p < NPAIR; p += G) {
        const int b = p / (NH * 4), h = (p >> 2) % NH, x = p & 3;
#pragma unroll 1
        for (int k = 0; k < 2; ++k) { flash_unit2<MODE>(Z, MIX, L, b, h, k == 0 ? 7 - x : x, lam_full, lambda_init, subg, wave); __syncthreads(); }
    }
}
constexpr int MA_K = 0, MA_V = 32768, MA_BM = 65536, MA_BMS = 68  , MA_WQ = MA_BM + 32 * MA_BMS * 4, MA_MG = MA_WQ + 512, MA_SEL = MA_MG + 4 * 34 * 64 * 4, MA_END = MA_SEL + NWAVES * 2560;
static_assert(MA_END <= RING_BYTES, "mixer A LDS map");

__device__ __forceinline__ unsigned ordkey(float f) { const unsigned u = __float_as_uint(f); return u ^ ((unsigned)((int)u >> 31) | 0x80000000u); }
#define DPP_I(v, ctrl) __builtin_amdgcn_update_dpp(0, (v), (ctrl), 0xf, 0xf, false)
__device__ __forceinline__ float wave_max_dpp(float v) {
    v = fmaxf(v, __int_as_float(DPP_I(__float_as_int(v), 0xB1))); v = fmaxf(v, __int_as_float(DPP_I(__float_as_int(v), 0x4E)));
    v = fmaxf(v, __int_as_float(DPP_I(__float_as_int(v), 0x141))); v = fmaxf(v, __int_as_float(DPP_I(__float_as_int(v), 0x140)));
    const int i = __float_as_int(v);
    return fmaxf(fmaxf(__int_as_float(__builtin_amdgcn_readlane(i, 0)), __int_as_float(__builtin_amdgcn_readlane(i, 16))), fmaxf(__int_as_float(__builtin_amdgcn_readlane(i, 32)), __int_as_float(__builtin_amdgcn_readlane(i, 48))));
}
__device__ __forceinline__ float wave_min_dpp(float v) {
    v = fminf(v, __int_as_float(DPP_I(__float_as_int(v), 0xB1))); v = fminf(v, __int_as_float(DPP_I(__float_as_int(v), 0x4E)));
    v = fminf(v, __int_as_float(DPP_I(__float_as_int(v), 0x141))); v = fminf(v, __int_as_float(DPP_I(__float_as_int(v), 0x140)));
    const int i = __float_as_int(v);
    return fminf(fminf(__int_as_float(__builtin_amdgcn_readlane(i, 0)), __int_as_float(__builtin_amdgcn_readlane(i, 16))), fminf(__int_as_float(__builtin_amdgcn_readlane(i, 32)), __int_as_float(__builtin_amdgcn_readlane(i, 48))));
}
__device__ __forceinline__ int wave_prefix_dpp(int x, int lane) {
    x += DPP_I(x, 0x111); x += DPP_I(x, 0x112); x += DPP_I(x, 0x114); x += DPP_I(x, 0x118);
    const int t0 = __builtin_amdgcn_readlane(x, 15), t1 = __builtin_amdgcn_readlane(x, 31), t2 = __builtin_amdgcn_readlane(x, 47);
    return x + (lane >= 16 ? t0 : 0) + (lane >= 32 ? t1 : 0) + (lane >= 48 ? t2 : 0);
}
template <int NJ> __device__ __forceinline__ void select_load(const float* srow, int t, int lane, float (&raw)[NJ]) {
#pragma unroll
    for (int j = 0; j < NJ; ++j) { const int kx = 64 * j + lane; raw[j] = srow[kx < t ? kx : t]; }
}
template <int NJ> __device__ __forceinline__ unsigned select_row_t(const float (&raw)[NJ], int t, LAS unsigned* hist, LAS unsigned* clist, int lane) {
    float f[NJ]; int bn[NJ];
    float NINF = -INFINITY, PINF = INFINITY; int C255 = 255; asm volatile("" : "+v"(NINF), "+v"(PINF), "+v"(C255));
    float vmax = NINF, vmin = PINF;
#pragma unroll
    for (int j = 0; j < NJ; ++j) { const int kx = 64 * j + lane; const float v = raw[j] + 0.0f; const bool ok = kx <= t; f[j] = ok ? v : NINF; vmax = fmaxf(vmax, f[j]); vmin = fminf(vmin, ok ? v : PINF); }
    vmax = wave_max_dpp(vmax); vmin = wave_min_dpp(vmin);
    const float scale = 255.99f / (vmax - vmin);
    { unsigned z_ = 0u; asm volatile("" : "+v"(z_)); ((LAS v4u*)hist)[lane] = (v4u){z_, z_, z_, z_}; }
#pragma unroll
    for (int j = 0; j < NJ; ++j) { int bi = (int)((f[j] - vmin) * scale); bi = bi > C255 ? C255 : bi; bi = bi < 0 ? 0 : bi; bn[j] = (64 * j + lane <= t) ? bi : -1;
        if (bn[j] >= 0) __hip_atomic_fetch_add(hist + bn[j], 1u, __ATOMIC_RELAXED, __HIP_MEMORY_SCOPE_WAVEFRONT); }
    LDS_WAIT();
    const v4u hv = ((const LAS v4u*)hist)[63 - lane];
    const int ssum = (int)(hv.x + hv.y + hv.z + hv.w);
    const int x = wave_prefix_dpp(ssum, lane);
    const int above = x - ssum; const bool found = above < 256 && x >= 256;
    int bsel, cab;
    { const int c3 = above + (int)hv.w, c2 = c3 + (int)hv.z, c1 = c2 + (int)hv.y; const int b0 = 4 * (63 - lane);
      if (c3 >= 256) { bsel = b0 + 3; cab = above; } else if (c2 >= 256) { bsel = b0 + 2; cab = c3; } else if (c1 >= 256) { bsel = b0 + 1; cab = c2; } else { bsel = b0; cab = c1; } }
    const unsigned long long fm = __ballot(found);
    const int src = (int)__builtin_ctzll(fm);
    const int bstar = __builtin_amdgcn_readlane(bsel, src), c_above = __builtin_amdgcn_readlane(cab, src);
    unsigned key[NJ];
#pragma unroll
    for (int j = 0; j < NJ; ++j) key[j] = ordkey(f[j]);
    int base = 0;
#pragma unroll
    for (int j = 0; j < NJ; ++j) { const bool isc = bn[j] == bstar; const unsigned long long cm = __ballot(isc); const int pos = base + mbcnt64(cm);
        clist[(isc && pos < 256) ? pos : 256 + lane] = key[j]; base += __popcll(cm); }
    LDS_WAIT();
    const int ncand = base, need = 256 - c_above;
    unsigned T = 0u; int cge;
    if (ncand <= 64) {
        const unsigned ck = lane < ncand ? clist[lane] : 0u;
        int g = 0, e = 0;
#pragma unroll 1
        for (int i = 0; i < ncand; ++i) { const unsigned sk = (unsigned)__builtin_amdgcn_readlane((int)ck, i); g += (sk > ck) ? 1 : 0; e += (sk == ck) ? 1 : 0; }
        const unsigned long long hit = __ballot(lane < ncand && g < need && need <= g + e);
        const int src2 = (int)__builtin_ctzll(hit);
        T = (unsigned)__builtin_amdgcn_readlane((int)ck, src2);
        cge = c_above + __builtin_amdgcn_readlane(g, src2) + __builtin_amdgcn_readlane(e, src2);
    } else if (ncand <= 256) {
        unsigned ck[4];
#pragma unroll
        for (int r = 0; r < 4; ++r) ck[r] = (r * 64 + lane < ncand) ? clist[r * 64 + lane] : 0u;
#pragma unroll 1
        for (int bit = 31; bit >= 0; --bit) { const unsigned cand = T | (1u << bit);
            const int cnt = __popcll(__ballot(ck[0] >= cand)) + __popcll(__ballot(ck[1] >= cand)) + __popcll(__ballot(ck[2] >= cand)) + __popcll(__ballot(ck[3] >= cand));
            if (cnt >= need) T = cand; }
        cge = c_above + __popcll(__ballot(ck[0] >= T)) + __popcll(__ballot(ck[1] >= T)) + __popcll(__ballot(ck[2] >= T)) + __popcll(__ballot(ck[3] >= T));
    } else {
#pragma unroll 1
        for (int bit = 31; bit >= 0; --bit) { const unsigned cand = T | (1u << bit); int cnt = 0;
#pragma unroll
            for (int j = 0; j < NJ; ++j) cnt += __popcll(__ballot(key[j] >= cand));
            if (cnt >= 256) T = cand; }
        cge = 0;
#pragma unroll
        for (int j = 0; j < NJ; ++j) cge += __popcll(__ballot(key[j] >= T));
    }
    unsigned w = 0u;
    if (cge == 256) {
#pragma unroll
        for (int j = NJ - 1; j >= 0; --j) w = w + w + (key[j] >= T ? 1u : 0u);
    } else {
        int cgt = 0;
#pragma unroll
        for (int j = 0; j < NJ; ++j) cgt += __popcll(__ballot(key[j] > T));
        const int need2 = 256 - cgt; int eqseen = 0;
#pragma unroll
        for (int j = 0; j < NJ; ++j) { const bool gt = key[j] > T, eq = key[j] == T; const unsigned long long em = __ballot(eq); const int er = eqseen + mbcnt64(em);
            w |= (gt || (eq && er < need2)) ? (1u << j) : 0u; eqseen += __popcll(em); }
    }
    return w;
}
constexpr int MB_K = 0, MB_V = 32768, MB_BM = 65536, MB_WQ = MB_BM + 64 * MA_BMS * 4, MB_SEL = MB_WQ + 1024, MB_END = MB_SEL + NWAVES * 2560;
static_assert(MB_END <= RING_BYTES, "mixer A (64-query units) LDS map");
template <int NJ> __device__ __forceinline__ void select8_t(const float* scr0, int t0, LAS unsigned* hist, LAS unsigned* clist, LAS unsigned* bmrow0, int lane) {
    float cur[NJ], nxt[NJ];
    select_load<NJ>(scr0, t0, lane, cur);
#pragma unroll 1
    for (int i = 0; i < 8; ++i) {
        const int t = t0 + i;
        if (i < 7) select_load<NJ>(scr0 + (size_t)(i + 1) * 2048, t + 1, lane, nxt);
        unsigned w;
        if (t < 256) { const int n = t + 1, nf = n >> 6; w = ((1u << nf) - 1u) | ((lane < (n & 63)) ? (1u << nf) : 0u); }
        else w = select_row_t<NJ>(cur, t, hist, clist, lane);
        bmrow0[i * MA_BMS + lane] = w;
#pragma unroll
        for (int j = 0; j < NJ; ++j) cur[j] = nxt[j];
    }
}
__device__ __forceinline__ void mixa_unit64(const bf16* Z, bf16* MIX, float* SCR, LAS unsigned char* L, int b, int qt64, int wave) {
    int lane = lane_now(), tid = wave * 64 + lane;
    int r32 = lane & 31, hi = lane >> 5; const int T0 = qt64 * 64;
    const bf16* zb = Z + (size_t)(b * SEQ) * ZC;
    LAS unsigned* bm = (LAS unsigned*)(L + MB_BM); LAS float* wq = (LAS float*)(L + MB_WQ);
    if (tid < 256) wq[tid] = bf1(zb[(size_t)(T0 + (tid >> 2)) * ZC + ZC_WI + (tid & 3)]);
    __syncthreads();
#pragma unroll 1
    for (int half = 0; half < 2; ++half) {
        const int Th = T0 + 32 * half;
        bf16x8v qi[4][4];
#pragma unroll
        for (int mt = 0; mt < 4; ++mt)
#pragma unroll
            for (int ks = 0; ks < 4; ++ks) qi[mt][ks] = *(const bf16x8v*)(zb + (size_t)(Th + 8 * mt + (r32 >> 2)) * ZC + ZC_QI + (r32 & 3) * 64 + ks * 16 + hi * 8);
        const int nkt = (Th >> 5) + 1;
        bf16x8v kn[4];
        if (wave < nkt) { const bf16* kr0 = zb + (size_t)(wave * 32 + r32) * ZC + ZC_KI + hi * 8;
#pragma unroll
            for (int ks = 0; ks < 4; ++ks) kn[ks] = *(const bf16x8v*)(kr0 + ks * 16); }
        for (int kt = wave; kt < nkt; kt += NWAVES) {
            const int key = kt * 32 + r32;
            bf16x8v kf[4];
#pragma unroll
            for (int ks = 0; ks < 4; ++ks) kf[ks] = kn[ks];
            if (kt + NWAVES < nkt) { const bf16* kr1 = zb + (size_t)((kt + NWAVES) * 32 + r32) * ZC + ZC_KI + hi * 8;
#pragma unroll
                for (int ks = 0; ks < 4; ++ks) kn[ks] = *(const bf16x8v*)(kr1 + ks * 16); }
#pragma unroll
            for (int mt = 0; mt < 4; ++mt) {
                f32x16 d;
#pragma unroll
                for (int r = 0; r < 16; ++r) d[r] = 0.f;
#pragma unroll
                for (int ks = 0; ks < 4; ++ks) d = __builtin_amdgcn_mfma_f32_32x32x16_bf16(qi[mt][ks], kf[ks], d, 0, 0, 0);
#pragma unroll
                for (int g = 0; g < 4; ++g) { const int q = 32 * half + 8 * mt + 2 * g + hi; const f32x4 w = *(const LAS f32x4*)(wq + 4 * q);
                    float s = fmaxf(d[4 * g + 0], 0.f) * w.x + fmaxf(d[4 * g + 1], 0.f) * w.y + fmaxf(d[4 * g + 2], 0.f) * w.z + fmaxf(d[4 * g + 3], 0.f) * w.w;
                    if (key > T0 + q) s = -INFINITY;
                    SCR[(size_t)q * 2048 + key] = s; }
            }
        }
    }
    asm volatile("s_waitcnt vmcnt(0)" ::: "memory");
    __syncthreads();
    {
        lane = lane_now();
        const int q0 = wave * 8, tl = __builtin_amdgcn_readfirstlane(T0 + q0 + 7);
        LAS unsigned* hs = (LAS unsigned*)(L + MB_SEL + wave * 2560);
        if (tl + 1 <= 512) select8_t<8>(SCR + (size_t)q0 * 2048, T0 + q0, hs, hs + 256, bm + q0 * MA_BMS, lane);
        else if (tl + 1 <= 1024) select8_t<16>(SCR + (size_t)q0 * 2048, T0 + q0, hs, hs + 256, bm + q0 * MA_BMS, lane);
        else if (tl + 1 <= 1536) select8_t<24>(SCR + (size_t)q0 * 2048, T0 + q0, hs, hs + 256, bm + q0 * MA_BMS, lane);
        else select8_t<32>(SCR + (size_t)q0 * 2048, T0 + q0, hs, hs + 256, bm + q0 * MA_BMS, lane);
    }
    lane = lane_now(); tid = wave * 64 + lane; r32 = lane & 31; hi = lane >> 5;
    int wv = wave; asm volatile("" : "+s"(wv));
    const int h = wv & 3, qh = wv >> 2, tq0 = T0 + 32 * qh, t = tq0 + r32;
    const float sl = __builtin_amdgcn_exp2f(-2.f * (float)(h + 1)) * LOG2E;
    bf16x8v qf[4];
#pragma unroll
    for (int ks = 0; ks < 4; ++ks) qf[ks] = *(const bf16x8v*)(zb + (size_t)t * ZC + ZC_QA + h * 64 + ks * 16 + hi * 8);
    float m = -1e30f, l = 0.f; f32x16 o[2];
    f32x16 cinA;
#pragma unroll
    for (int r = 0; r < 16; ++r) cinA[r] = sl * (float)((r & 3) + 8 * (r >> 2) + 4 * hi);
#pragma unroll
    for (int r = 0; r < 16; ++r) { o[0][r] = 0.f; o[1][r] = 0.f; }
    LAS unsigned char* Kb = L + MB_K; LAS unsigned char* Vb = L + MB_V;
    const int skey = tid >> 3, sc = tid & 7;
    const bf16* ksrc = zb + (size_t)skey * ZC + ZC_KA + sc * 8;
    const bf16* vsrc = zb + (size_t)skey * ZC + ZC_VA + sc * 8;
    const int kdst = (sc >> 1) * 2048 + (sc & 1) * 1024 + (skey >> 5) * 512 + (skey & 31) * 16;
    const int vdst = (sc >> 2) * 4096 + (skey >> 3) * 512 + (skey & 7) * 64 + (sc & 3) * 16;
    const int krd = hi * 1024 + r32 * 16;
    const int vrd = ((lane >> 4) & 1) * 32 + (lane & 3) * 8 + (4 * hi + ((lane & 15) >> 2)) * 64;
    const LAS v4u* wrow = (const LAS v4u*)(bm + (32 * qh + r32) * MA_BMS + 4 * hi);
    int jp = (T0 + 63) >> 7;
    int stg_ = 128 * ZC, til_ = 64 * ZC; asm volatile("" : "+s"(stg_), "+s"(til_));
    const size_t stg = (size_t)stg_, til = (size_t)til_;
    v4u kA0 = *(const v4u*)(ksrc + jp * stg), vA0 = *(const v4u*)(vsrc + jp * stg), kA1 = *(const v4u*)(ksrc + jp * stg + til), vA1 = *(const v4u*)(vsrc + jp * stg + til);
    { LAS unsigned char* kb = Kb + (jp & 1) * 16384; LAS unsigned char* vb = Vb + (jp & 1) * 16384;
      *(LAS v4u*)(kb + kdst) = kA0; *(LAS v4u*)(vb + vdst) = vA0; *(LAS v4u*)(kb + 8192 + kdst) = kA1; *(LAS v4u*)(vb + 8192 + vdst) = vA1; }
    v4u kB0 = kA0, vB0 = vA0, kB1 = kA1, vB1 = vA1;
    if (jp >= 1) { kB0 = *(const v4u*)(ksrc + (jp - 1) * stg); vB0 = *(const v4u*)(vsrc + (jp - 1) * stg); kB1 = *(const v4u*)(ksrc + (jp - 1) * stg + til); vB1 = *(const v4u*)(vsrc + (jp - 1) * stg + til); }
    __syncthreads();
#define MB_STAGE(JP, KW0, VW0, KW1, VW1, KL0, VL0, KL1, VL1) do { const int jp_ = (JP); \
        if (jp_ >= 2) { KL0 = *(const v4u*)(ksrc + (jp_ - 2) * stg); VL0 = *(const v4u*)(vsrc + (jp_ - 2) * stg); KL1 = *(const v4u*)(ksrc + (jp_ - 2) * stg + til); VL1 = *(const v4u*)(vsrc + (jp_ - 2) * stg + til); } \
        _Pragma("unroll") for (int kp = 1; kp >= 0; --kp) { \
            const int tile = 2 * jp_ + kp, s0 = 64 * tile; \
            if (s0 <= tq0 + 31) {                                          \
                const LAS unsigned char* Kc = Kb + (jp_ & 1) * 16384 + kp * 8192; const LAS unsigned char* Vc = Vb + (jp_ & 1) * 16384 + kp * 8192; \
                const float sha = sl * (float)(s0 - t), shb = sha + 32.f * sl; \
                f32x16 p0 = cinA, p1 = cinA; \
                _Pragma("unroll") for (int ks = 0; ks < 4; ++ks) { const bf16x8v kf0 = *(const LAS bf16x8v*)(Kc + ks * 2048 + krd), kf1 = *(const LAS bf16x8v*)(Kc + ks * 2048 + 512 + krd); \
                    p0 = __builtin_amdgcn_mfma_f32_32x32x16_bf16(kf0, qf[ks], p0, 0, 0, 0); p1 = __builtin_amdgcn_mfma_f32_32x32x16_bf16(kf1, qf[ks], p1, 0, 0, 0); } \
                const unsigned sbit = (unsigned)tile; \
                _Pragma("unroll") for (int g = 0; g < 4; ++g) { const v4u wa = wrow[2 * g], wb = wrow[8 + 2 * g]; \
                    _Pragma("unroll") for (int e = 0; e < 4; ++e) { const int r = 4 * g + e; \
                        const unsigned ma = (unsigned)(-(int)((wa[e] >> sbit) & 1u)), mb = (unsigned)(-(int)((wb[e] >> sbit) & 1u)); \
                        p0[r] = __uint_as_float((__float_as_uint(p0[r]) & ma) | (~ma & 0xff800000u)); p1[r] = __uint_as_float((__float_as_uint(p1[r]) & mb) | (~mb & 0xff800000u)); } } \
                bf16x8v pf[4]; \
                fl_softmax3(p0, p1, sha, shb, m, l, o, pf); \
                _Pragma("unroll") for (int s4 = 0; s4 < 4; ++s4) _Pragma("unroll") for (int db = 0; db < 2; ++db) { const LAS unsigned char* vp = Vc + db * 4096 + s4 * 1024 + vrd; \
                        const s16x4 lo = lds_tr(vp), hh = lds_tr(vp + 512); \
                        const bf16x8v vf = (bf16x8v){lo[0], lo[1], lo[2], lo[3], hh[0], hh[1], hh[2], hh[3]}; \
                        o[db] = __builtin_amdgcn_mfma_f32_32x32x16_bf16(vf, pf[s4], o[db], 0, 0, 0); } \
            } } \
        if (jp_ >= 1) { LAS unsigned char* kb = Kb + ((jp_ - 1) & 1) * 16384; LAS unsigned char* vb = Vb + ((jp_ - 1) & 1) * 16384; \
            *(LAS v4u*)(kb + kdst) = KW0; *(LAS v4u*)(vb + vdst) = VW0; *(LAS v4u*)(kb + 8192 + kdst) = KW1; *(LAS v4u*)(vb + 8192 + vdst) = VW1; } \
        __syncthreads(); } while (0)
    for (; jp >= 0; jp -= 2) { MB_STAGE(jp, kB0, vB0, kB1, vB1, kA0, vA0, kA1, vA1); if (jp >= 1) MB_STAGE(jp - 1, kA0, vA0, kA1, vA1, kB0, vB0, kB1, vB1); }
#undef MB_STAGE
    { const float inv = 1.f / swap_sum(l);
      const size_t orow = (size_t)(b * SEQ + t) * DM + h * 64 + 4 * hi;
#pragma unroll
      for (int db = 0; db < 2; ++db)
#pragma unroll
          for (int rg = 0; rg < 4; ++rg) mix_store4(MIX, orow + 32 * db + 8 * rg, o[db][4 * rg + 0] * inv, o[db][4 * rg + 1] * inv, o[db][4 * rg + 2] * inv, o[db][4 * rg + 3] * inv); }
}
__device__ __forceinline__ void mixa_phase64(const bf16* Z, bf16* MIX, float* SCR, LAS unsigned char* L, int vcu, int G, int wave) {
    float* scr = SCR + (size_t)blockIdx.x * (64 * 2048);
    for (int p = vcu; p < BATCH * 16; p += G) {
        const int b = p >> 4, x = p & 15;
#pragma unroll 1
        for (int k = 0; k < 2; ++k) { mixa_unit64(Z, MIX, scr, L, b, k == 0 ? 31 - x : x, wave); __syncthreads(); }
    }
}
#ifndef REP_A
#define REP_A 1
#endif
#ifndef REP_B
#define REP_B 1
#endif
#ifndef REP_C
#define REP_C 1
#endif
#ifndef REP_G
#define REP_G 1
#endif
#ifndef REP_BAR
#define REP_BAR 1
#endif
#ifndef FLASH2
#define FLASH2 1
#endif
#if FLASH2
#define FLASHP flash_phase2
#else
#define FLASHP flash_phase
#endif
#ifndef GM_ALIGN
#define GM_ALIGN true
#endif
#ifndef GM_ALIGN_RES
#define GM_ALIGN_RES true
#endif
#ifndef GM_ALIGN_F8
#define GM_ALIGN_F8 true
#endif
#ifndef GM_SP2_F8
#define GM_SP2_F8 true
#endif
#ifndef GM_SP2
#define GM_SP2 true
#endif
#ifndef MIXA64
#define MIXA64 1
#endif
#ifndef FFN_FP8
#define FFN_FP8 1
#endif
#ifndef FFN_FP8_P5
#define FFN_FP8_P5 FFN_FP8
#endif
#define H8_OFF (FFN_FP8_P5 ? (size_t)0 : 352 * MiB)
#define ACT_OFF (FFN_FP8 && FFN_FP8_P5 ? 64 * MiB : (size_t)0)
struct Args { const float* in[12]; float* out; unsigned char* ws; };
__global__ void __launch_bounds__(NWAVES * 64, 2) hybrid_fwd(Args args) {
    extern __shared__ __attribute__((aligned(16))) unsigned char lds[];
    LAS unsigned char* L = (LAS unsigned char*)lds;
    volatile LAS unsigned* MISC = (volatile LAS unsigned*)(L + MISC_OFF);
    const int wave = __builtin_amdgcn_readfirstlane((int)threadIdx.x >> 6);
#define LANE_NOW lane_now()
#define TID_NOW (wave * 64 + lane_now())
    const int G = gridDim.x, bx = blockIdx.x;
    const int vcu = (G % 8 == 0) ? (bx % 8) * (G / 8) + bx / 8 : bx;
    const int gw = vcu * NWAVES + wave, NGW = G * NWAVES;
    unsigned char* ws = args.ws;
    gu32* ctl = (gu32*)(ws + WS_CTL);
    for (int u = TID_NOW; u < (LDS_BYTES - LDSCTL_OFF) / 4; u += NWAVES * 64) ((LAS unsigned*)(L + LDSCTL_OFF))[u] = 0u;
    __syncthreads();
    XcdBarrier bar = xcd_barrier_post((unsigned*)(ctl + CW_BAR), MISC + 8);
    const float* x = args.in[0];
    bf16* R0 = (bf16*)(ws + WS_R0); bf16* R1 = (bf16*)(ws + WS_R1); bf16* R2 = (bf16*)(ws + WS_R2); bf16* BIG = (bf16*)(ws + WS_BIG);

    {
        const int tid_ = TID_NOW;
        const size_t n8 = (size_t)M * DM / 8; const size_t gt = (size_t)bx * (NWAVES * 64) + tid_, nth = (size_t)G * NWAVES * 64;
#ifndef REP_X
#define REP_X 1
#endif
#ifndef REP_T
#define REP_T 1
#endif
        for (int rx_ = 0; rx_ < REP_X; ++rx_)
        for (size_t i = gt; i < n8; i += 4 * nth) {
            f32x4 a[4], b[4];
#pragma unroll
            for (int u = 0; u < 4; ++u) { size_t j = i + u * nth; j = j < n8 ? j : n8 - 1; a[u] = ((const f32x4*)x)[2 * j]; b[u] = ((const f32x4*)x)[2 * j + 1]; }
#pragma unroll
            for (int u = 0; u < 4; ++u) { const size_t j = i + u * nth; if (j < n8) { v4u o; o.x = pk2(a[u].x, a[u].y); o.y = pk2(a[u].z, a[u].w); o.z = pk2(b[u].x, b[u].y); o.w = pk2(b[u].z, b[u].w); ((v4u*)R0)[j] = o; } }
        }
        LAS float* scr = (LAS float*)(L + RING_OFF + wave * 16384);
        constexpr int I_IN = (DM / 64) * (ZC / 32), I_O = (DM / 64) * (DM / 32), I_GU = (DM / 64) * (GU / 32), I_D = (FF / 64) * (DM / 32), I_L = I_IN + I_O + I_GU + I_D;
        for (int rt_ = 0; rt_ < REP_T; ++rt_)
        for (int it = gw; it < DEPTH * I_L; it += NGW) {
            const int l = it / I_L; int r = it % I_L;
            unsigned char* wl = ws + WS_W + (size_t)l * W_LAYER_B;
            float* cv = (float*)(ws + WS_CVP) + (size_t)l * 16 * CV_LAYER; const bool acc_ = rt_ == 0;
            const float* g2p = l > 0 ? args.in[10] + (l - 1) * DM : nullptr; const float* b2p = l > 0 ? args.in[11] + (l - 1) * DM : nullptr;
            const float* g1 = args.in[5] + l * DM; const float* b1 = args.in[6] + l * DM;
            if (r < I_IN) { transpose_item<0>(args.in[1] + (size_t)l * DM * INC, nullptr, g2p, b2p, acc_ ? cv : nullptr, cv + ZC, DM, INC, ZC, (bf16*)wl, scr, r, LANE_NOW); continue; } r -= I_IN;
            if (r < I_O) { transpose_item<1, MIX_FP8 ? 6 : 0>(args.in[2] + (size_t)l * DM * DM, nullptr, nullptr, nullptr, nullptr, nullptr, DM, DM, DM, (bf16*)(wl + W_IN_B), scr, r, LANE_NOW); continue; } r -= I_O;
            if (r < I_GU) { transpose_item<2, FFN_FP8 ? 6 : 0>(args.in[7] + (size_t)l * DM * FF, args.in[8] + (size_t)l * DM * FF, g1, b1, acc_ ? cv + 2 * ZC : nullptr, cv + 2 * ZC + GU, DM, FF, GU, (bf16*)(wl + W_IN_B + W_O_B), scr, r, LANE_NOW); continue; } r -= I_GU;
            transpose_item<1, FFN_FP8_P5 ? 8 : 0>(args.in[9] + (size_t)l * FF * DM, nullptr, nullptr, nullptr, nullptr, nullptr, FF, DM, DM, (bf16*)(wl + W_IN_B + W_O_B + W_GU_B), scr, r, LANE_NOW);
        }
    }
    xcd_barrier(bar);

#pragma unroll
    for (int l = 0; l < DEPTH; ++l) {
#define WS_NOW ({ unsigned char* w_ = args.ws; asm volatile("" : "+s"(w_)); w_; })
#define OPQ_S(x) ({ int x_ = (x); asm volatile("" : "+s"(x_)); x_; })
#define P_WL(w) ((w) + WS_W + (size_t)l * W_LAYER_B)
#define P_ST(w, ll, which) ((float*)((w) + WS_STAT) + (size_t)(((ll) * 2 + (which)) * 2) * M)
#define P_CV(w) ((const float*)((w) + WS_CV) + (size_t)l * CV_LAYER)
        const float lambda_init = (l == 0) ? 0.2f : 0.35550906759f;
        const bool last = (l + 1 == DEPTH);

        { unsigned char* w = WS_NOW; const float* sP = l > 0 ? P_ST(w, l - 1, 1) : nullptr; const float* cv = P_CV(w);
          pg8::Gemm g{(const pg8::bf16_t*)(w + WS_R0), (const pg8::bf16_t*)P_WL(w), M, ZC, DM}; pg8::StaticOrder S; S.init(M, ZC, OPQ_S(G), OPQ_S(bx));
          pg8::EpiStoreLN E{(pg8::bf16_t*)(w + WS_BIG), ZC, sP, sP ? sP + M : nullptr, cv, cv + ZC};
          for (int rep = 0; rep < REP_G; ++rep) {
          pg8::gemm_phase<pg8::EpiStoreLN, pg8::StaticOrder, GM_ALIGN, GM_SP2>(L + RING_OFF, g, S, E, OPQ_S(wave)); } }
        for (int rb_ = 0; rb_ < REP_BAR; ++rb_) xcd_barrier(bar);
        if (l == 0) { unsigned char* w = WS_NOW; cv_reduce((const float*)(w + WS_CVP), (float*)(w + WS_CV), (size_t)OPQ_S(bx) * (NWAVES * 64) + TID_NOW, (size_t)OPQ_S(G) * NWAVES * 64); }
        { unsigned char* w = WS_NOW; for (int rep = 0; rep < REP_A; ++rep) mixa_phase64((const bf16*)(w + WS_BIG), (bf16*)(w + WS_R1), (float*)(w + WS_R2), L + RING_OFF, OPQ_S(vcu), OPQ_S(G), OPQ_S(wave)); }
        { unsigned char* w = WS_NOW; for (int rep = 0; rep < REP_B; ++rep) FLASHP<0>((const bf16*)(w + WS_BIG), (bf16*)(w + WS_R1), L + RING_OFF, args.in[3] + l * 128, args.in[4] + l * 64, lambda_init, OPQ_S(vcu), OPQ_S(G), TID_NOW, OPQ_S(wave), LANE_NOW); }
        { unsigned char* w = WS_NOW; for (int rep = 0; rep < REP_C; ++rep) FLASHP<1>((const bf16*)(w + WS_BIG), (bf16*)(w + WS_R1), L + RING_OFF, nullptr, nullptr, 0.f, OPQ_S(vcu), OPQ_S(G), TID_NOW, OPQ_S(wave), LANE_NOW); }
        for (int rb_ = 0; rb_ < REP_BAR; ++rb_) xcd_barrier(bar);
        { unsigned char* w = WS_NOW; const float* sP = l > 0 ? P_ST(w, l - 1, 1) : nullptr; float* sA = P_ST(w, l, 0);
          pg8::Gemm g{(const pg8::bf16_t*)(w + WS_R1), (const pg8::bf16_t*)(P_WL(w) + W_IN_B), M, DM, MIX_FP8 ? DM / 2 : DM, 0}; pg8::StaticOrder S; S.init(M, DM, OPQ_S(G), OPQ_S(bx));
          pg8::EpiResStat E{(const pg8::bf16_t*)(w + WS_R0), sP, sP ? sP + M : nullptr, l > 0 ? args.in[10] + (l - 1) * DM : nullptr, l > 0 ? args.in[11] + (l - 1) * DM : nullptr, (pg8::bf16_t*)(w + WS_R2), nullptr, (float*)(w + WS_SP), (float*)(w + WS_SP) + (size_t)16 * M, DM, ALPHA, FFN_FP8 ? (unsigned char*)(w + WS_BIG + H8_OFF) : nullptr, MIX_FP8 ? 1.f / 64.f : 1.f, M};
          for (int rep = 0; rep < REP_G; ++rep) { if (rep > 0) { E.osum = nullptr; }
          pg8::gemm_phase<pg8::EpiResStat, pg8::StaticOrder, GM_ALIGN_RES, GM_SP2, MIX_FP8 != 0>(L + RING_OFF, g, S, E, OPQ_S(wave)); } }
        for (int rb_ = 0; rb_ < REP_BAR; ++rb_) xcd_barrier(bar);
        { unsigned char* w = WS_NOW; float* sA = P_ST(w, l, 0); stats_reduce((const float*)(w + WS_SP), sA, sA + M, (size_t)OPQ_S(bx) * (NWAVES * 64) + TID_NOW, (size_t)OPQ_S(G) * NWAVES * 64); }
        xcd_barrier(bar);
        { unsigned char* w = WS_NOW; float* sA = P_ST(w, l, 0); const float* cv = P_CV(w);
          pg8::StaticOrder S; S.init(M, GU, OPQ_S(G), OPQ_S(bx));
#if FFN_FP8
          pg8::Gemm g{(const pg8::bf16_t*)(w + WS_BIG + H8_OFF), (const pg8::bf16_t*)(P_WL(w) + W_IN_B + W_O_B), M, GU, DM / 2, 0};
#if FFN_FP8_P5
          pg8::EpiSwigluLN8 E{w + WS_BIG + ACT_OFF, FF, sA, sA + M, cv + 2 * ZC, cv + 2 * ZC + GU, 1.f / 64.f};
          for (int rep = 0; rep < REP_G; ++rep) {
          pg8::gemm_phase<pg8::EpiSwigluLN8, pg8::StaticOrder, GM_ALIGN_F8, GM_SP2_F8, true>(L + RING_OFF, g, S, E, OPQ_S(wave)); }
#else
          pg8::EpiSwigluLN E{(pg8::bf16_t*)(w + WS_BIG + ACT_OFF), FF, sA, sA + M, cv + 2 * ZC, cv + 2 * ZC + GU, 1.f / 64.f};
          for (int rep = 0; rep < REP_G; ++rep) {
          pg8::gemm_phase<pg8::EpiSwigluLN, pg8::StaticOrder, GM_ALIGN, GM_SP2, true>(L + RING_OFF, g, S, E, OPQ_S(wave)); }
#endif
#else
          pg8::Gemm g{(const pg8::bf16_t*)(w + WS_R2), (const pg8::bf16_t*)(P_WL(w) + W_IN_B + W_O_B), M, GU, DM, 0};
          pg8::EpiSwigluLN E{(pg8::bf16_t*)(w + WS_BIG), FF, sA, sA + M, cv + 2 * ZC, cv + 2 * ZC + GU, 1.f};
          for (int rep = 0; rep < REP_G; ++rep) {
          pg8::gemm_phase<pg8::EpiSwigluLN, pg8::StaticOrder, GM_ALIGN, GM_SP2>(L + RING_OFF, g, S, E, OPQ_S(wave)); }
#endif
        }
        for (int rb_ = 0; rb_ < REP_BAR; ++rb_) xcd_barrier(bar);
        { unsigned char* w = WS_NOW; float* sA = P_ST(w, l, 0); float* sB = P_ST(w, l, 1);
#if FFN_FP8_P5
          pg8::Gemm g{(const pg8::bf16_t*)(w + WS_BIG + ACT_OFF), (const pg8::bf16_t*)(P_WL(w) + W_IN_B + W_O_B + W_GU_B), M, DM, FF / 2, 0};
#else
          pg8::Gemm g{(const pg8::bf16_t*)(w + WS_BIG + ACT_OFF), (const pg8::bf16_t*)(P_WL(w) + W_IN_B + W_O_B + W_GU_B), M, DM, FF, 0};
#endif
          pg8::StaticOrder S; S.init(M, DM, OPQ_S(G), OPQ_S(bx));
          pg8::EpiResStat E{(const pg8::bf16_t*)(w + WS_R2), sA, sA + M, args.in[5] + l * DM, args.in[6] + l * DM, (pg8::bf16_t*)(w + WS_R0), nullptr, (float*)(w + WS_SP), (float*)(w + WS_SP) + (size_t)16 * M, DM, ALPHA, nullptr, FFN_FP8_P5 ? 1.f / 256.f : 1.f, M};
          for (int rep = 0; rep < REP_G; ++rep) { if (rep > 0) { E.osum = nullptr; }
          pg8::gemm_phase<pg8::EpiResStat, pg8::StaticOrder, GM_ALIGN_RES, GM_SP2, FFN_FP8_P5 != 0>(L + RING_OFF, g, S, E, OPQ_S(wave)); } }
        for (int rb_ = 0; rb_ < REP_BAR; ++rb_) xcd_barrier(bar);
        { unsigned char* w = WS_NOW; float* sB = P_ST(w, l, 1); stats_reduce((const float*)(w + WS_SP), sB, sB + M, (size_t)OPQ_S(bx) * (NWAVES * 64) + TID_NOW, (size_t)OPQ_S(G) * NWAVES * 64); }
        xcd_barrier(bar);
        if (last) {
            unsigned char* w = WS_NOW; const bf16* R0 = (const bf16*)(w + WS_R0); const float* sB = P_ST(w, l, 1);
            const int tid_ = TID_NOW;
            const size_t gt = (size_t)bx * (NWAVES * 64) + tid_, nth = (size_t)G * NWAVES * 64;
            if (nth % 128 == 0) {
                const int cc = (int)(gt & 127) * 8; const float* g2 = args.in[10] + l * DM + cc; const float* b2 = args.in[11] + l * DM + cc;
                const f32x4 ga = *(const f32x4*)g2, gb = *(const f32x4*)(g2 + 4), ba = *(const f32x4*)b2, bb = *(const f32x4*)(b2 + 4);
                const size_t rstep = nth / 128;
                for (size_t row = gt >> 7; row < (size_t)M; row += 4 * rstep) {
                    v4u hv[4]; float mu[4], rs[4];
#pragma unroll
                    for (int u = 0; u < 4; ++u) { size_t r = row + u * rstep; r = r < (size_t)M ? r : (size_t)M - 1; hv[u] = *(const v4u*)(R0 + r * DM + cc); const float s = sB[r], q = sB[M + r]; mu[u] = s * (1.f / DM); rs[u] = __builtin_amdgcn_rsqf(fmaxf(q * (1.f / DM) - mu[u] * mu[u], 0.f) + LN_EPS); }
#pragma unroll
                    for (int u = 0; u < 4; ++u) { const size_t r = row + u * rstep; if (r < (size_t)M) {
                        f32x4 ya, yb; ya.x = bflo(hv[u].x); ya.y = bfhi(hv[u].x); ya.z = bflo(hv[u].y); ya.w = bfhi(hv[u].y); yb.x = bflo(hv[u].z); yb.y = bfhi(hv[u].z); yb.z = bflo(hv[u].w); yb.w = bfhi(hv[u].w);
                        ya = (ya - mu[u]) * rs[u] * ga + ba; yb = (yb - mu[u]) * rs[u] * gb + bb;
                        float* op = args.out + r * DM + cc; *(f32x4*)op = ya; *(f32x4*)(op + 4) = yb; } }
                }
            }
        }
    }
}

extern "C" void kernel_launch(void* const* d_in, const int* in_sizes, int n_in, void* d_out, int out_size, void* d_ws, size_t ws_size, hipStream_t stream) {
    static int grid = 0;
    if (grid == 0) {
        if (n_in != 12 || in_sizes[0] != M * DM || out_size != M * DM || ws_size < WS_END) { fprintf(stderr, "kernel_launch: unexpected shapes / workspace (n_in %d, in0 %d, out %d, ws %zu < %zu)\n", n_in, n_in > 0 ? in_sizes[0] : -1, out_size, ws_size, (size_t)WS_END); grid = -1; return; }
        int dev = 0, cus = 0, per_cu = 0;
        if (hipGetDevice(&dev) != hipSuccess || hipDeviceGetAttribute(&cus, hipDeviceAttributeMultiprocessorCount, dev) != hipSuccess) { grid = -1; return; }
        if (hipFuncSetAttribute((const void*)hybrid_fwd, hipFuncAttributeMaxDynamicSharedMemorySize, LDS_BYTES) != hipSuccess) { fprintf(stderr, "kernel_launch: hipFuncSetAttribute failed\n"); grid = -1; return; }
        if (hipOccupancyMaxActiveBlocksPerMultiprocessor(&per_cu, (const void*)hybrid_fwd, NWAVES * 64, LDS_BYTES) != hipSuccess || per_cu < 1) { fprintf(stderr, "kernel_launch: occupancy query reports %d\n", per_cu); }
        (void)hipGetLastError();
        grid = cus < 256 ? cus : 256;
    }
    if (grid < 0) return;
    if (hipMemsetAsync((char*)d_ws + WS_CTL, 0, CTL_ZERO_BYTES, stream) != hipSuccess) return;
    Args a{};
    for (int i = 0; i < 12; ++i) a.in[i] = (const float*)d_in[i];
    a.out = (float*)d_out; a.ws = (unsigned char*)d_ws;
    hipLaunchKernelGGL(hybrid_fwd, dim3(grid), dim3(NWAVES * 64), LDS_BYTES, stream, a);
}
```

```cpp
#include <hip/hip_runtime.h>
#include <cstdio>
#include <cstdint>
#include <cmath>
#define FL_CLASS 0
#define FLASH2 0
#define MIX_FP8 1
#define P1_FP8 1
#define CSUB 1
#define LNFUSE 1
#define B3 1
#ifndef REP_EPI
#define REP_EPI 1
#endif
#ifndef REP_EPI_MASK
#define REP_EPI_MASK 0xff
#endif
namespace pg8 {
#define PG8_LAS __attribute__((address_space(3)))
typedef unsigned short bf16_t;
typedef short bf16x8 __attribute__((ext_vector_type(8)));
typedef float f32x4 __attribute__((ext_vector_type(4)));
typedef unsigned u32x4 __attribute__((ext_vector_type(4)));
constexpr int BM = 256, BK = 64, HALF = 128, HTB = HALF * BK * 2  , STAGE_BYTES = 8 * HTB, NXCD = 8, WGM = 8;

__host__ __device__ __forceinline__ int lds_byte(int r, int c) { const int st = (r >> 4) * 2 + (c >> 5), rr = r & 15, cc = c & 31, ob = rr * 64 + cc * 2; return st * 1024 + (ob ^ (((ob >> 9) & 1) << 5)); }
__host__ __device__ __forceinline__ void stage_rc(int b, int& R, int& C) { const int st = b / 1024, sb = b % 1024, swz = sb ^ (((sb >> 9) & 1) << 5); R = (st >> 1) * 16 + swz / 64; C = (st & 1) * 32 + (swz % 64) / 2; }
__host__ __device__ __forceinline__ int perm32(int rho) { const int n = rho >> 4, i = rho & 15; return 8 * (i >> 2) + 4 * n + (i & 3); }

struct Unit { int pm, pn; };
struct Gemm { const bf16_t* A; const bf16_t* Bt; int M, N, K; int scale_w; };
typedef int v4i_t __attribute__((ext_vector_type(4)));
typedef int v8i_t __attribute__((ext_vector_type(8)));

struct StaticOrder {
    int nM, nN, nwg, G, c, skip_at, skip_n, i0 = 0, iN = 1 << 30;
    __host__ __device__ void init(int M, int N, int G_, int c_, int skip_at_ = 1 << 20, int skip_n_ = 0) { nM = M / BM; nN = N / BM; nwg = nM * nN; G = G_; c = c_; skip_at = skip_at_; skip_n = skip_n_; }
    __host__ __device__ bool next(int i, Unit& u) const {
        if (i >= iN) return false; i += i0;
        const long L = (long)i * G + c; if (L >= nwg) return false;
        int wgid = (int)L; { const int q = nwg / NXCD, r = nwg % NXCD, xcd = wgid % NXCD, off = wgid / NXCD; wgid = (xcd < r ? xcd * (q + 1) : r * (q + 1) + (xcd - r) * q) + off; }
        const int nig = WGM * nN, gid = wgid / nig, fm = gid * WGM, gsz = (nM - fm) < WGM ? (nM - fm) : WGM;
        u.pm = fm + ((wgid % nig) % gsz); u.pn = (wgid % nig) / gsz; if (u.pn >= skip_at) u.pn += skip_n; return true;
    }
    __device__ __forceinline__ void a_ready(const Unit&) const {}
    __device__ __forceinline__ void done(const Unit&) const {}
};
__device__ __forceinline__ unsigned cvt_pk_bf16(float lo, float hi) { unsigned r; asm volatile("v_cvt_pk_bf16_f32 %0, %1, %2" : "=v"(r) : "v"(lo), "v"(hi)); return r; }
typedef float f32x2 __attribute__((ext_vector_type(2)));
typedef unsigned u32x2 __attribute__((ext_vector_type(2)));
struct EpiStore {
    static constexpr int ID = 4;
    static constexpr bool PERM = true, AFTER_DRAIN = false;
    bf16_t* O; int ldc;
    __device__ __forceinline__ void operator()(const f32x4 (&acc)[2][2][4][2], const Unit& u, int wr, int wc, int fr, int fq) const {
        const int row0 = u.pm * BM + wr * 64 + fr, col0 = u.pn * BM + wc * 32 + 8 * fq;
#pragma unroll
        for (int ai = 0; ai < 2; ++ai)
#pragma unroll
            for (int m = 0; m < 4; ++m) { bf16_t* rowp = O + (size_t)(row0 + ai * HALF + m * 16) * ldc + col0;
#pragma unroll
                for (int bj = 0; bj < 2; ++bj) { const f32x4 v0 = acc[ai][bj][m][0], v1 = acc[ai][bj][m][1];
                    u32x4 w; w.x = cvt_pk_bf16(v0[0], v0[1]); w.y = cvt_pk_bf16(v0[2], v0[3]); w.z = cvt_pk_bf16(v1[0], v1[1]); w.w = cvt_pk_bf16(v1[2], v1[3]);
                    *(u32x4*)(rowp + bj * HALF) = w; } }
    }
};
struct EpiSwiglu {
    static constexpr int ID = 5;
    static constexpr bool PERM = true, AFTER_DRAIN = false;
    bf16_t* O; int ldc;
    __device__ __forceinline__ float act(float g, float u) const { const float e = __builtin_amdgcn_exp2f(g * -1.4426950408889634f); return g * __builtin_amdgcn_rcpf(1.0f + e) * u; }
    __device__ __forceinline__ void operator()(const f32x4 (&acc)[2][2][4][2], const Unit& u, int wr, int wc, int fr, int fq) const {
        const int row0 = u.pm * BM + wr * 64 + fr, col0 = u.pn * HALF + wc * 32 + 8 * fq;
#pragma unroll
        for (int ai = 0; ai < 2; ++ai)
#pragma unroll
            for (int m = 0; m < 4; ++m) { bf16_t* rowp = O + (size_t)(row0 + ai * HALF + m * 16) * ldc + col0;
                const f32x4 g0 = acc[ai][0][m][0], g1 = acc[ai][0][m][1], u0 = acc[ai][1][m][0], u1 = acc[ai][1][m][1];
                u32x4 w; w.x = cvt_pk_bf16(act(g0[0], u0[0]), act(g0[1], u0[1])); w.y = cvt_pk_bf16(act(g0[2], u0[2]), act(g0[3], u0[3]));
                w.z = cvt_pk_bf16(act(g1[0], u1[0]), act(g1[1], u1[1])); w.w = cvt_pk_bf16(act(g1[2], u1[2]), act(g1[3], u1[3]));
                *(u32x4*)rowp = w; }
    }
};
struct EpiRes {
    static constexpr int ID = 6;
    static constexpr bool PERM = false, AFTER_DRAIN = false;
    const bf16_t* X; float* H; int ldc; float alpha;
    __device__ __forceinline__ void operator()(const f32x4 (&acc)[2][2][4][2], const Unit& u, int wr, int wc, int fr, int fq) const {
        const int row0 = u.pm * BM + wr * 64 + fr, col0 = u.pn * BM + wc * 32 + 4 * fq;
#pragma unroll
        for (int ai = 0; ai < 2; ++ai)
#pragma unroll
            for (int m = 0; m < 4; ++m) { const size_t off = (size_t)(row0 + ai * HALF + m * 16) * ldc + col0;
#pragma unroll
                for (int bj = 0; bj < 2; ++bj)
#pragma unroll
                    for (int n = 0; n < 2; ++n) { const size_t c = off + bj * HALF + n * 16; const u32x2 xb = *(const u32x2*)(X + c);
                        f32x4 x; x[0] = __uint_as_float(xb.x << 16); x[1] = __uint_as_float(xb.x & 0xffff0000u); x[2] = __uint_as_float(xb.y << 16); x[3] = __uint_as_float(xb.y & 0xffff0000u);
                        *(f32x4*)(H + c) = acc[ai][bj][m][n] + x * alpha; } }
    }
};

__device__ __forceinline__ float sum16x(float v) { auto rr = __builtin_amdgcn_permlane16_swap(__float_as_uint(v), __float_as_uint(v), false, false); return __uint_as_float(rr[0]) + __uint_as_float(rr[1]); }
__device__ __forceinline__ float sum32x(float v) { auto rr = __builtin_amdgcn_permlane32_swap(__float_as_uint(v), __float_as_uint(v), false, false); return __uint_as_float(rr[0]) + __uint_as_float(rr[1]); }
__device__ __forceinline__ void row_stats(const float* ssum, const float* ssq, int row, float& mu, float& rs) {
    mu = 0.f; rs = 1.f;
    if (ssum) { mu = ssum[row]; rs = ssq[row]; }
}
struct EpiStoreLN {
    static constexpr int ID = 0;
    static constexpr bool PERM = true, AFTER_DRAIN = false;
    bf16_t* O; int ldc; const float* ssum; const float* ssq; const float* c1; const float* c0; float ascale;
    __device__ __forceinline__ void operator()(const f32x4 (&acc)[2][2][4][2], const Unit& u, int wr, int wc, int fr, int fq) const {
        const int row0 = u.pm * BM + wr * 64 + fr, col0 = u.pn * BM + wc * 32 + 8 * fq;
        f32x4 c1v[2][2], c0v[2][2]; float z_ = 0.f; asm volatile("" : "+v"(z_));
#pragma unroll
        for (int bj = 0; bj < 2; ++bj)
#pragma unroll
            for (int n = 0; n < 2; ++n) { c1v[bj][n] = ssum ? *(const f32x4*)(c1 + col0 + bj * HALF + 4 * n) : (f32x4){z_, z_, z_, z_}; c0v[bj][n] = ssum ? *(const f32x4*)(c0 + col0 + bj * HALF + 4 * n) : (f32x4){z_, z_, z_, z_}; }
        float ra_[2][4], rb_[2][4];
#pragma unroll
        for (int ai = 0; ai < 2; ++ai)
#pragma unroll
            for (int m = 0; m < 4; ++m) { float mu, rs; row_stats(ssum, ssq, row0 + ai * HALF + m * 16, mu, rs); ra_[ai][m] = ascale * rs; rb_[ai][m] = -mu * rs; }
#pragma unroll
        for (int ai = 0; ai < 2; ++ai)
#pragma unroll
            for (int m = 0; m < 4; ++m) { const int row = row0 + ai * HALF + m * 16; const float ra = ra_[ai][m], rb = rb_[ai][m];
                bf16_t* rowp = O + (size_t)row * ldc + col0;
#pragma unroll
                for (int bj = 0; bj < 2; ++bj) { const f32x4 v0 = acc[ai][bj][m][0] * ra + (c1v[bj][0] * rb + c0v[bj][0]), v1 = acc[ai][bj][m][1] * ra + (c1v[bj][1] * rb + c0v[bj][1]);
                    u32x4 w; w.x = cvt_pk_bf16(v0[0], v0[1]); w.y = cvt_pk_bf16(v0[2], v0[3]); w.z = cvt_pk_bf16(v1[0], v1[1]); w.w = cvt_pk_bf16(v1[2], v1[3]);
                    *(u32x4*)(rowp + bj * HALF) = w; } }
    }
};
struct EpiSwigluLN {
    static constexpr int ID = 3;
    static constexpr bool PERM = true, AFTER_DRAIN = false;
    bf16_t* O; int ldc; const float* ssum; const float* ssq; const float* c1; const float* c0; float ascale;
    __device__ __forceinline__ float act(float g, float u) const { const float e = __builtin_amdgcn_exp2f(g * -1.4426950408889634f); return g * __builtin_amdgcn_rcpf(1.0f + e) * u; }
    __device__ __forceinline__ void operator()(const f32x4 (&acc)[2][2][4][2], const Unit& u, int wr, int wc, int fr, int fq) const {
        const int row0 = u.pm * BM + wr * 64 + fr, col0 = u.pn * HALF + wc * 32 + 8 * fq, wrow0 = u.pn * BM + wc * 32 + 8 * fq;
        f32x4 c1v[2][2], c0v[2][2];
#pragma unroll
        for (int bj = 0; bj < 2; ++bj)
#pragma unroll
            for (int n = 0; n < 2; ++n) { c1v[bj][n] = *(const f32x4*)(c1 + wrow0 + bj * HALF + 4 * n); c0v[bj][n] = *(const f32x4*)(c0 + wrow0 + bj * HALF + 4 * n); }
#pragma unroll
        for (int ai = 0; ai < 2; ++ai)
#pragma unroll
            for (int m = 0; m < 4; ++m) { const int row = row0 + ai * HALF + m * 16; float mu, rs; row_stats(ssum, ssq, row, mu, rs);
                bf16_t* rowp = O + (size_t)row * ldc + col0;
                const f32x4 g0 = (acc[ai][0][m][0] * ascale - c1v[0][0] * mu) * rs + c0v[0][0], g1 = (acc[ai][0][m][1] * ascale - c1v[0][1] * mu) * rs + c0v[0][1];
                const f32x4 u0 = (acc[ai][1][m][0] * ascale - c1v[1][0] * mu) * rs + c0v[1][0], u1 = (acc[ai][1][m][1] * ascale - c1v[1][1] * mu) * rs + c0v[1][1];
                u32x4 w; w.x = cvt_pk_bf16(act(g0[0], u0[0]), act(g0[1], u0[1])); w.y = cvt_pk_bf16(act(g0[2], u0[2]), act(g0[3], u0[3]));
                w.z = cvt_pk_bf16(act(g1[0], u1[0]), act(g1[1], u1[1])); w.w = cvt_pk_bf16(act(g1[2], u1[2]), act(g1[3], u1[3]));
                *(u32x4*)rowp = w; }
    }
};
struct EpiSwigluLN8 {
    static constexpr int ID = 1;
    static constexpr bool PERM = true, AFTER_DRAIN = false;
    unsigned char* O; int ldc; const float* ssum; const float* ssq; const float* c1; const float* c0; float ascale;
    __device__ __forceinline__ float act(float g, float u) const { const float e = __builtin_amdgcn_exp2f(g); return g * __builtin_amdgcn_rcpf(1.0f + e) * u; }
    __device__ __forceinline__ void operator()(const f32x4 (&acc)[2][2][4][2], const Unit& u, int wr, int wc, int fr, int fq) const {
        const int row0 = u.pm * BM + wr * 64 + fr, col0 = u.pn * HALF + wc * 32 + 8 * fq, wrow0 = u.pn * BM + wc * 32 + 8 * fq;
        f32x4 c1v[2][2], c0v[2][2];
#pragma unroll
        for (int bj = 0; bj < 2; ++bj)
#pragma unroll
            for (int n = 0; n < 2; ++n) { const float k_ = bj == 0 ? -1.4426950408889634f : -0.6931471805599453f; c1v[bj][n] = *(const f32x4*)(c1 + wrow0 + bj * HALF + 4 * n) * k_; c0v[bj][n] = *(const f32x4*)(c0 + wrow0 + bj * HALF + 4 * n) * k_; }
        float ra_[2][4], rb_[2][4];
#pragma unroll
        for (int ai = 0; ai < 2; ++ai)
#pragma unroll
            for (int m = 0; m < 4; ++m) { float mu, rs; row_stats(ssum, ssq, row0 + ai * HALF + m * 16, mu, rs); ra_[ai][m] = ascale * rs; rb_[ai][m] = -mu * rs; }
#pragma unroll
        for (int ai = 0; ai < 2; ++ai)
#pragma unroll
            for (int m = 0; m < 4; ++m) { const int row = row0 + ai * HALF + m * 16;
                const float rb = rb_[ai][m], rg = ra_[ai][m] * -1.4426950408889634f, ru = ra_[ai][m] * -0.6931471805599453f;
                unsigned char* rowp = O + (size_t)row * ldc + col0;
                const f32x4 g0 = acc[ai][0][m][0] * rg + (c1v[0][0] * rb + c0v[0][0]), g1 = acc[ai][0][m][1] * rg + (c1v[0][1] * rb + c0v[0][1]);
                const f32x4 u0 = acc[ai][1][m][0] * ru + (c1v[1][0] * rb + c0v[1][0]), u1 = acc[ai][1][m][1] * ru + (c1v[1][1] * rb + c0v[1][1]);
                int w0 = __builtin_amdgcn_cvt_pk_fp8_f32(act(g0[0], u0[0]), act(g0[1], u0[1]), 0, false); w0 = __builtin_amdgcn_cvt_pk_fp8_f32(act(g0[2], u0[2]), act(g0[3], u0[3]), w0, true);
                int w1 = __builtin_amdgcn_cvt_pk_fp8_f32(act(g1[0], u1[0]), act(g1[1], u1[1]), 0, false); w1 = __builtin_amdgcn_cvt_pk_fp8_f32(act(g1[2], u1[2]), act(g1[3], u1[3]), w1, true);
                u32x2 w; w.x = (unsigned)w0; w.y = (unsigned)w1; *(u32x2*)rowp = w; }
    }
};
struct EpiSwiglu8 {
    static constexpr int ID = 8;
    static constexpr bool PERM = true, AFTER_DRAIN = false;
    unsigned char* O; int ldc; float ascale;
    __device__ __forceinline__ float act(float g, float u) const { const float e = __builtin_amdgcn_exp2f(g); return g * __builtin_amdgcn_rcpf(1.0f + e) * u; }
    __device__ __forceinline__ void operator()(const f32x4 (&acc)[2][2][4][2], const Unit& u, int wr, int wc, int fr, int fq) const {
        const int row0 = u.pm * BM + wr * 64 + fr, col0 = u.pn * HALF + wc * 32 + 8 * fq;
        const float kg = ascale * -1.4426950408889634f, ku = ascale * -0.6931471805599453f;
#pragma unroll
        for (int ai = 0; ai < 2; ++ai)
#pragma unroll
            for (int m = 0; m < 4; ++m) { const int row = row0 + ai * HALF + m * 16;
                unsigned char* rowp = O + (size_t)row * ldc + col0;
                const f32x4 g0 = acc[ai][0][m][0] * kg, g1 = acc[ai][0][m][1] * kg, u0 = acc[ai][1][m][0] * ku, u1 = acc[ai][1][m][1] * ku;
                int w0 = __builtin_amdgcn_cvt_pk_fp8_f32(act(g0[0], u0[0]), act(g0[1], u0[1]), 0, false); w0 = __builtin_amdgcn_cvt_pk_fp8_f32(act(g0[2], u0[2]), act(g0[3], u0[3]), w0, true);
                int w1 = __builtin_amdgcn_cvt_pk_fp8_f32(act(g1[0], u1[0]), act(g1[1], u1[1]), 0, false); w1 = __builtin_amdgcn_cvt_pk_fp8_f32(act(g1[2], u1[2]), act(g1[3], u1[3]), w1, true);
                u32x2 w; w.x = (unsigned)w0; w.y = (unsigned)w1; *(u32x2*)rowp = w; }
    }
};
struct EpiResLN {
    static constexpr int ID = 7;
    static constexpr bool PERM = true, AFTER_DRAIN = false;
    const bf16_t* R; const float* g; const float* b; bf16_t* Yb; unsigned char* Y8; float* Yf; int ldc; float alpha; float ascale;
    unsigned long long* xbuf; unsigned* cnt; unsigned* tmo; PG8_LAS unsigned char* xl;
    __device__ __forceinline__ void operator()(f32x4 (&acc)[2][2][4][2], const Unit& u, int wr, int wc, int fr, int fq) const {
        typedef float f32x2v __attribute__((ext_vector_type(2)));
        const int row0 = u.pm * BM + wr * 64 + fr, col0 = u.pn * BM + wc * 32 + 8 * fq;
        float alpha_ = alpha, ascale_ = ascale; asm volatile("" : "+s"(alpha_), "+s"(ascale_));
        PG8_LAS f32x2v* P = (PG8_LAS f32x2v*)xl;
        PG8_LAS f32x2v* S = (PG8_LAS f32x2v*)(xl + 8192);
#pragma unroll
        for (int ai = 0; ai < 2; ++ai) {
            u32x4 xr[4][2];
#pragma unroll
            for (int m = 0; m < 4; ++m)
#pragma unroll
                for (int bj = 0; bj < 2; ++bj) xr[m][bj] = *(const u32x4*)(R + (size_t)(row0 + ai * HALF + m * 16) * ldc + col0 + bj * HALF);
            float ss[4], qq[4];
#pragma unroll
            for (int m = 0; m < 4; ++m) { float s = 0.f, q = 0.f;
#pragma unroll
                for (int bj = 0; bj < 2; ++bj) { const u32x4 xb = xr[m][bj];
                    f32x4 x0, x1; x0[0] = __uint_as_float(xb.x << 16); x0[1] = __uint_as_float(xb.x & 0xffff0000u); x0[2] = __uint_as_float(xb.y << 16); x0[3] = __uint_as_float(xb.y & 0xffff0000u);
                    x1[0] = __uint_as_float(xb.z << 16); x1[1] = __uint_as_float(xb.z & 0xffff0000u); x1[2] = __uint_as_float(xb.w << 16); x1[3] = __uint_as_float(xb.w & 0xffff0000u);
                    const f32x4 v0 = acc[ai][bj][m][0] * ascale_ + x0 * alpha_, v1 = acc[ai][bj][m][1] * ascale_ + x1 * alpha_;
                    acc[ai][bj][m][0] = v0; acc[ai][bj][m][1] = v1;
                    s += ((v0[0] + v0[1]) + (v0[2] + v0[3])) + ((v1[0] + v1[1]) + (v1[2] + v1[3]));
                    q += ((v0[0] * v0[0] + v0[1] * v0[1]) + (v0[2] * v0[2] + v0[3] * v0[3])) + ((v1[0] * v1[0] + v1[1] * v1[1]) + (v1[2] * v1[2] + v1[3] * v1[3])); }
                ss[m] = sum32x(sum16x(s)); qq[m] = sum32x(sum16x(q)); }
            const float sv = fq == 0 ? ss[0] : (fq == 1 ? ss[1] : (fq == 2 ? ss[2] : ss[3])), qv = fq == 0 ? qq[0] : (fq == 1 ? qq[1] : (fq == 2 ? qq[2] : qq[3]));
            P[(ai * HALF + wr * 64 + fq * 16 + fr) * 4 + wc] = (f32x2v){sv, qv}; }
        asm volatile("s_waitcnt lgkmcnt(0)" ::: "memory"); __builtin_amdgcn_s_barrier(); asm volatile("" ::: "memory");
        const int wid_ = wr * 4 + wc; int ln_; asm volatile("v_mbcnt_lo_u32_b32 %0, -1, 0\n\tv_mbcnt_hi_u32_b32 %0, -1, %0" : "=v"(ln_));
        const int row = wid_ * 64 + ln_;
        unsigned* cn = cnt + 16 * u.pm;
        if (wid_ < 4) {
            const f32x2v a = P[row * 4 + 0], b_ = P[row * 4 + 1], c = P[row * 4 + 2], d = P[row * 4 + 3];
            const float s4 = (a.x + b_.x) + (c.x + d.x), q4 = (a.y + b_.y) + (c.y + d.y);
            __hip_atomic_store(xbuf + ((size_t)(u.pm * BM + row) * 4 + u.pn), ((unsigned long long)__float_as_uint(q4) << 32) | __float_as_uint(s4), __ATOMIC_RELAXED, __HIP_MEMORY_SCOPE_AGENT);
            asm volatile("s_waitcnt vmcnt(0)" ::: "memory");
            if (ln_ == 0) __hip_atomic_fetch_add(cn, 1u, __ATOMIC_RELAXED, __HIP_MEMORY_SCOPE_AGENT);
        }
        if (wid_ == 0) { unsigned sp = 0;
            while ((unsigned)__builtin_amdgcn_readfirstlane((int)__hip_atomic_load(cn, __ATOMIC_RELAXED, __HIP_MEMORY_SCOPE_AGENT)) < 16u) {
                __builtin_amdgcn_s_sleep(1);
                if (++sp > (1u << 22)) { if (ln_ == 0) __hip_atomic_store(tmo, 1u, __ATOMIC_RELAXED, __HIP_MEMORY_SCOPE_AGENT); break; } }
            __builtin_amdgcn_fence(__ATOMIC_ACQUIRE, "agent"); asm volatile("s_waitcnt vmcnt(0)" ::: "memory"); }
        __builtin_amdgcn_s_barrier(); asm volatile("" ::: "memory");
        if (wid_ < 4) { float s = 0.f, q = 0.f;
#pragma unroll
            for (int j = 0; j < 4; ++j) { const unsigned long long w = __hip_atomic_load(xbuf + ((size_t)(u.pm * BM + row) * 4 + j), __ATOMIC_RELAXED, __HIP_MEMORY_SCOPE_AGENT); s += __uint_as_float((unsigned)w); q += __uint_as_float((unsigned)(w >> 32)); }
            const float mu = s * (1.f / 1024.f); S[row] = (f32x2v){mu, __builtin_amdgcn_rsqf(fmaxf(q * (1.f / 1024.f) - mu * mu, 0.f) + 1e-5f)}; }
        asm volatile("s_waitcnt lgkmcnt(0)" ::: "memory"); __builtin_amdgcn_s_barrier(); asm volatile("" ::: "memory");
        f32x4 gv[2][2], bv[2][2];
#pragma unroll
        for (int bj = 0; bj < 2; ++bj)
#pragma unroll
            for (int n = 0; n < 2; ++n) { gv[bj][n] = *(const f32x4*)(g + col0 + bj * HALF + 4 * n); bv[bj][n] = *(const f32x4*)(b + col0 + bj * HALF + 4 * n); }
#pragma unroll
        for (int ai = 0; ai < 2; ++ai)
#pragma unroll
            for (int m = 0; m < 4; ++m) { const int rl = ai * HALF + wr * 64 + m * 16 + fr; const f32x2v st = S[rl]; const float rs = st.y, rb = -st.x * st.y;
                const size_t off = (size_t)(u.pm * BM + rl) * ldc + col0;
#pragma unroll
                for (int bj = 0; bj < 2; ++bj) { const size_t c = off + bj * HALF;
                    const f32x4 y0 = (acc[ai][bj][m][0] * rs + rb) * gv[bj][0] + bv[bj][0], y1 = (acc[ai][bj][m][1] * rs + rb) * gv[bj][1] + bv[bj][1];
                    if (Yf) { *(f32x4*)(Yf + c) = y0; *(f32x4*)(Yf + c + 4) = y1; }
                    if (Yb) { u32x4 w; w.x = cvt_pk_bf16(y0[0], y0[1]); w.y = cvt_pk_bf16(y0[2], y0[3]); w.z = cvt_pk_bf16(y1[0], y1[1]); w.w = cvt_pk_bf16(y1[2], y1[3]); *(u32x4*)(Yb + c) = w; }
                    if (Y8) { int w0 = __builtin_amdgcn_cvt_pk_fp8_f32(y0[0], y0[1], 0, false); w0 = __builtin_amdgcn_cvt_pk_fp8_f32(y0[2], y0[3], w0, true);
                              int w1 = __builtin_amdgcn_cvt_pk_fp8_f32(y1[0], y1[1], 0, false); w1 = __builtin_amdgcn_cvt_pk_fp8_f32(y1[2], y1[3], w1, true);
                              u32x2 w8; w8.x = (unsigned)w0; w8.y = (unsigned)w1; *(u32x2*)(Y8 + c) = w8; } } }
    }
};
struct EpiResStat {
    static constexpr int ID = 2;
    static constexpr bool PERM = true, AFTER_DRAIN = false;
    const bf16_t* R; const float* rsum; const float* rsq; const float* g; const float* b; bf16_t* Hb; float* Hf; float* osum; float* osq; int ldc; float alpha; unsigned char* H8; float ascale; int pM;
    __device__ __forceinline__ void operator()(const f32x4 (&acc)[2][2][4][2], const Unit& u, int wr, int wc, int fr, int fq) const {
        const int row0 = u.pm * BM + wr * 64 + fr, col0 = u.pn * BM + wc * 32 + 8 * fq;
        float alpha_ = alpha, ascale_ = ascale; unsigned char* H8_ = H8; asm volatile("" : "+s"(alpha_), "+s"(ascale_), "+s"(H8_));
        f32x4 gv[2][2], bv[2][2];
#pragma unroll
        for (int bj = 0; bj < 2; ++bj)
#pragma unroll
            for (int n = 0; n < 2; ++n) { float z_ = 0.f, o_ = 1.f; asm volatile("" : "+v"(z_), "+v"(o_)); gv[bj][n] = rsum ? *(const f32x4*)(g + col0 + bj * HALF + 4 * n) : (f32x4){o_, o_, o_, o_}; bv[bj][n] = rsum ? *(const f32x4*)(b + col0 + bj * HALF + 4 * n) : (f32x4){z_, z_, z_, z_}; }
        float ss[2][4], qq[2][4];
#pragma unroll
        for (int ai = 0; ai < 2; ++ai) {
            u32x4 xr[4][2];
#pragma unroll
            for (int m = 0; m < 4; ++m)
#pragma unroll
                for (int bj = 0; bj < 2; ++bj) xr[m][bj] = *(const u32x4*)(R + (size_t)(row0 + ai * HALF + m * 16) * ldc + col0 + bj * HALF);
            float rs_[4], rb_[4];
#pragma unroll
            for (int m = 0; m < 4; ++m) { float mu, rs; row_stats(rsum, rsq, row0 + ai * HALF + m * 16, mu, rs); rs_[m] = rs; rb_[m] = -mu * rs; }
#pragma unroll
            for (int m = 0; m < 4; ++m) { const int row = row0 + ai * HALF + m * 16; const float rs = rs_[m], rb = rb_[m];
                const size_t off = (size_t)row * ldc + col0; float s = 0.f, q = 0.f;
#pragma unroll
                for (int bj = 0; bj < 2; ++bj) { const size_t c = off + bj * HALF; const u32x4 xb = xr[m][bj];
                    f32x4 x0, x1; x0[0] = __uint_as_float(xb.x << 16); x0[1] = __uint_as_float(xb.x & 0xffff0000u); x0[2] = __uint_as_float(xb.y << 16); x0[3] = __uint_as_float(xb.y & 0xffff0000u);
                    x1[0] = __uint_as_float(xb.z << 16); x1[1] = __uint_as_float(xb.z & 0xffff0000u); x1[2] = __uint_as_float(xb.w << 16); x1[3] = __uint_as_float(xb.w & 0xffff0000u);
                    x0 = (x0 * rs + rb) * gv[bj][0] + bv[bj][0]; x1 = (x1 * rs + rb) * gv[bj][1] + bv[bj][1];
                    const f32x4 v0 = acc[ai][bj][m][0] * ascale_ + x0 * alpha_, v1 = acc[ai][bj][m][1] * ascale_ + x1 * alpha_;
                    u32x4 w; w.x = cvt_pk_bf16(v0[0], v0[1]); w.y = cvt_pk_bf16(v0[2], v0[3]); w.z = cvt_pk_bf16(v1[0], v1[1]); w.w = cvt_pk_bf16(v1[2], v1[3]); *(u32x4*)(Hb + c) = w;
                    s += ((v0[0] + v0[1]) + (v0[2] + v0[3])) + ((v1[0] + v1[1]) + (v1[2] + v1[3]));
                    q += ((v0[0] * v0[0] + v0[1] * v0[1]) + (v0[2] * v0[2] + v0[3] * v0[3])) + ((v1[0] * v1[0] + v1[1] * v1[1]) + (v1[2] * v1[2] + v1[3] * v1[3]));
                    if (H8_) { int w0 = __builtin_amdgcn_cvt_pk_fp8_f32(v0[0], v0[1], 0, false); w0 = __builtin_amdgcn_cvt_pk_fp8_f32(v0[2], v0[3], w0, true);
                              int w1 = __builtin_amdgcn_cvt_pk_fp8_f32(v1[0], v1[1], 0, false); w1 = __builtin_amdgcn_cvt_pk_fp8_f32(v1[2], v1[3], w1, true);
                              u32x2 w8; w8.x = (unsigned)w0; w8.y = (unsigned)w1; *(u32x2*)(H8_ + c) = w8; } }
                ss[ai][m] = sum32x(sum16x(s)); qq[ai][m] = sum32x(sum16x(q)); } }
        if (!Hf && osum) { int l2_; asm volatile("v_mbcnt_lo_u32_b32 %0, -1, 0\n\tv_mbcnt_hi_u32_b32 %0, -1, %0" : "=v"(l2_)); const int fr = l2_ & 15, fq = l2_ >> 4, row0 = u.pm * BM + wr * 64 + fr;
            const size_t slot = (size_t)(u.pn * 4 + wc) * (size_t)pM;
#pragma unroll
            for (int ai = 0; ai < 2; ++ai) { const float sv = fq == 0 ? ss[ai][0] : (fq == 1 ? ss[ai][1] : (fq == 2 ? ss[ai][2] : ss[ai][3])), qv = fq == 0 ? qq[ai][0] : (fq == 1 ? qq[ai][1] : (fq == 2 ? qq[ai][2] : qq[ai][3]));
                const int row = row0 + ai * HALF + fq * 16;
                osum[slot + row] = sv; osq[slot + row] = qv; } }
    }
};
template <class Epi, class Sched, bool ALIGN_EPI = false, bool SP2 = false, bool FP8 = false>
__device__ __forceinline__ void gemm_phase(PG8_LAS unsigned char* lds, const Gemm g, const Sched& S, const Epi& E, int wave_in) {
    int lane_; asm volatile("v_mbcnt_lo_u32_b32 %0, -1, 0\n\tv_mbcnt_hi_u32_b32 %0, -1, %0" : "=v"(lane_)); const int tid_ = wave_in * 64 + lane_;
    const int tid = tid_, wid = __builtin_amdgcn_readfirstlane(tid >> 6), lane = tid & 63, wr = wid >> 2, wc = wid & 3, fr = lane & 15, fq = lane >> 4;
    const int K = g.K, nt = K / BK;
    unsigned voffA[2], voffB[2];
#pragma unroll
    for (int i = 0; i < 2; ++i) { int R, C; stage_rc(tid * 16 + i * 8192, R, C); const int Rb = Epi::PERM ? ((R & ~31) + perm32(R & 31)) : R;
        voffA[i] = (unsigned)(R * K + C) * 2u; voffB[i] = (unsigned)(Rb * K + C) * 2u; }
    const size_t kstep = g.scale_w == 777 ? (size_t)0 : (size_t)(BK * 2);
    const size_t hstep = (size_t)HALF * K * 2;
    const size_t tstep = 2 * hstep;
    const unsigned ldsw = (unsigned)wid * 1024u;
    const int aoff = lds_byte(wr * 64 + fr, fq * 8), boff = lds_byte(wc * 32 + fr, fq * 8);
#define PG8_SA(b, h) (((b) * 2 + (h)) * HTB)
#define PG8_SB(b, h) ((4 + (b) * 2 + (h)) * HTB)
#define PG8_STAGE(bufoff, gbase, voff) do { _Pragma("unroll") for (int _i = 0; _i < 2; ++_i) \
        __builtin_amdgcn_global_load_lds((const unsigned*)((const char*)(gbase) + (voff)[_i]), (PG8_LAS unsigned*)(lds + (bufoff) + ldsw + _i * 8192), 16, 0, 0); } while (0)
#define PG8_LDA16(dst, b, h) do { _Pragma("unroll") for (int m = 0; m < 4; ++m) _Pragma("unroll") for (int k = 0; k < 2; ++k) dst[m][k] = *(const PG8_LAS bf16x8*)(lds + PG8_SA(b, h) + aoff + m * 2048 + k * 1024); } while (0)
#define PG8_LDA8(dst, b, h) do { _Pragma("unroll") for (int m = 0; m < 4; ++m) { const v4i_t lo_ = *(const PG8_LAS v4i_t*)(lds + PG8_SA(b, h) + aoff + m * 2048), hi_ = *(const PG8_LAS v4i_t*)(lds + PG8_SA(b, h) + aoff + m * 2048 + 1024); dst[m] = __builtin_shufflevector(lo_, hi_, 0, 1, 2, 3, 4, 5, 6, 7); } } while (0)
#define PG8_LDA(dst, b, h) do { if constexpr (FP8) PG8_LDA8(dst##8, b, h); else PG8_LDA16(dst, b, h); } while (0)
#define PG8_LDB16(dst, b, h) do { _Pragma("unroll") for (int n = 0; n < 2; ++n) _Pragma("unroll") for (int k = 0; k < 2; ++k) dst[n][k] = *(const PG8_LAS bf16x8*)(lds + PG8_SB(b, h) + boff + n * 2048 + k * 1024); } while (0)
#define PG8_LDB8(dst, b, h) do { _Pragma("unroll") for (int n = 0; n < 2; ++n) { const v4i_t lo_ = *(const PG8_LAS v4i_t*)(lds + PG8_SB(b, h) + boff + n * 2048), hi_ = *(const PG8_LAS v4i_t*)(lds + PG8_SB(b, h) + boff + n * 2048 + 1024); dst[n] = __builtin_shufflevector(lo_, hi_, 0, 1, 2, 3, 4, 5, 6, 7); } } while (0)
#define PG8_LDB(dst, b, h) do { if constexpr (FP8) PG8_LDB8(dst##8, b, h); else PG8_LDB16(dst, b, h); } while (0)
#define PG8_MMA(ai, bj, At, Bt) do { __builtin_amdgcn_s_setprio(1); _Pragma("unroll") for (int m = 0; m < 4; ++m) _Pragma("unroll") for (int n = 0; n < 2; ++n) _Pragma("unroll") for (int k = 0; k < 2; ++k) \
        acc[ai][bj][m][n] = __builtin_amdgcn_mfma_f32_16x16x32_bf16(Bt[n][k], At[m][k], acc[ai][bj][m][n], 0, 0, 0); __builtin_amdgcn_s_setprio(0); } while (0)
#define PG8_MMA8(ai, bj, At, Bt) do { __builtin_amdgcn_s_setprio(1); _Pragma("unroll") for (int m = 0; m < 4; ++m) _Pragma("unroll") for (int n = 0; n < 2; ++n) \
        asm("v_mfma_f32_16x16x128_f8f6f4 %0, %1, %2, %0" : "+v"(acc[ai][bj][m][n]) : "v"(Bt[n]), "v"(At[m])); __builtin_amdgcn_s_setprio(0); } while (0)
#define PG8_MM(ai, bj, At, Bt) do { if constexpr (FP8) PG8_MMA8(ai, bj, At##8, Bt##8); else PG8_MMA(ai, bj, At, Bt); } while (0)
#define PG8_WAIT_V(n) asm volatile("s_waitcnt vmcnt(" #n ")" ::: "memory")
#define PG8_WAIT_L(n) asm volatile("s_waitcnt lgkmcnt(" #n ")" ::: "memory")
#define PG8_BAR __builtin_amdgcn_s_barrier()
#define PG8_SCHED __builtin_amdgcn_sched_barrier(0)
    Unit cur, nxt; int ui = 0;
    if (!S.next(0, cur)) return;
    f32x4 acc[2][2][4][2];
#pragma unroll
    for (int a = 0; a < 2; ++a)
#pragma unroll
        for (int b = 0; b < 2; ++b)
#pragma unroll
            for (int m = 0; m < 4; ++m)
#pragma unroll
                for (int n = 0; n < 2; ++n) acc[a][b][m][n] = (f32x4){0.f, 0.f, 0.f, 0.f};
    bf16x8 At[4][2], B0[2][2], B1[2][2]; v8i_t At8[4], B08[2], B18[2];
    const char* cA = (const char*)g.A + (size_t)cur.pm * tstep; const char* cB = (const char*)g.Bt + (size_t)cur.pn * tstep;
    S.a_ready(cur);
    if constexpr (SP2) {
        PG8_STAGE(PG8_SB(0, 0), cB, voffB); PG8_STAGE(PG8_SB(0, 1), cB + hstep, voffB); PG8_STAGE(PG8_SA(0, 0), cA, voffA); PG8_STAGE(PG8_SA(0, 1), cA + hstep, voffA);
        if (wr == 1) PG8_BAR;
        PG8_WAIT_V(2); PG8_BAR;
        PG8_STAGE(PG8_SB(1, 0), cB + kstep, voffB); PG8_STAGE(PG8_SA(1, 0), cA + kstep, voffA); PG8_STAGE(PG8_SB(1, 1), cB + hstep + kstep, voffB);
        PG8_WAIT_V(6); PG8_BAR;
    } else {
        PG8_STAGE(PG8_SB(0, 0), cB, voffB); PG8_STAGE(PG8_SA(0, 0), cA, voffA); PG8_STAGE(PG8_SB(0, 1), cB + hstep, voffB); PG8_STAGE(PG8_SA(0, 1), cA + hstep, voffA);
        if (wr == 1) PG8_BAR;
        PG8_WAIT_V(4); PG8_BAR;
        PG8_STAGE(PG8_SB(1, 0), cB + kstep, voffB); PG8_STAGE(PG8_SA(1, 0), cA + kstep, voffA); PG8_STAGE(PG8_SB(1, 1), cB + hstep + kstep, voffB);
        PG8_WAIT_V(6); PG8_BAR;
    }
    for (;;) {
        const bool has_next = S.next(ui + 1, nxt);
        const char* nA = has_next ? (const char*)g.A + (size_t)nxt.pm * tstep : cA; const char* nB = has_next ? (const char*)g.Bt + (size_t)nxt.pn * tstep : cB;
#pragma unroll 1
        for (int t = 0; t < nt; t += 2) {
            const bool last = (t == nt - 2);
            const char* a1 = cA + (size_t)(t + 1) * kstep;
            const char* a2 = last ? nA : cA + (size_t)(t + 2) * kstep; const char* b2 = last ? nB : cB + (size_t)(t + 2) * kstep;
            const char* a3 = a2 + kstep; const char* b3 = b2 + kstep;
            if (last && has_next) S.a_ready(nxt);
            if constexpr (SP2) {
            PG8_LDB(B0, 0, 0); PG8_LDB(B1, 0, 1); PG8_SCHED; PG8_LDA(At, 0, 0); PG8_STAGE(PG8_SA(1, 1), a1 + hstep, voffA);
            PG8_WAIT_V(8); PG8_WAIT_L(0); PG8_BAR; PG8_MM(0, 0, At, B0); PG8_MM(0, 1, At, B1); PG8_BAR; PG8_SCHED;
            PG8_LDA(At, 0, 1); PG8_STAGE(PG8_SB(0, 0), b2, voffB); PG8_STAGE(PG8_SB(0, 1), b2 + hstep, voffB); PG8_STAGE(PG8_SA(0, 0), a2, voffA);
            PG8_WAIT_V(8); PG8_WAIT_L(0); PG8_BAR; PG8_MM(1, 0, At, B0); PG8_MM(1, 1, At, B1); PG8_BAR; PG8_SCHED;
            PG8_LDB(B0, 1, 0); PG8_LDB(B1, 1, 1); PG8_SCHED; PG8_LDA(At, 1, 0); PG8_STAGE(PG8_SA(0, 1), a2 + hstep, voffA);
            PG8_WAIT_V(8); PG8_WAIT_L(0); PG8_BAR; PG8_MM(0, 0, At, B0); PG8_MM(0, 1, At, B1); PG8_BAR; PG8_SCHED;
            PG8_LDA(At, 1, 1); PG8_STAGE(PG8_SB(1, 0), b3, voffB); PG8_STAGE(PG8_SB(1, 1), b3 + hstep, voffB); PG8_STAGE(PG8_SA(1, 0), a3, voffA);
            PG8_WAIT_V(8); PG8_WAIT_L(0); PG8_BAR; PG8_MM(1, 0, At, B0); PG8_MM(1, 1, At, B1); PG8_BAR; PG8_SCHED;
            } else {
            PG8_LDB(B0, 0, 0); PG8_SCHED; PG8_LDA(At, 0, 0); PG8_STAGE(PG8_SA(1, 1), a1 + hstep, voffA);
            PG8_WAIT_L(8); PG8_BAR; PG8_WAIT_L(0); PG8_MM(0, 0, At, B0); PG8_BAR; PG8_SCHED;
            PG8_LDB(B1, 0, 1); PG8_STAGE(PG8_SB(0, 0), b2, voffB);
            PG8_BAR; PG8_WAIT_L(0); PG8_MM(0, 1, At, B1); PG8_BAR;
            PG8_LDA(At, 0, 1); PG8_STAGE(PG8_SA(0, 0), a2, voffA);
            PG8_BAR; PG8_WAIT_L(0); PG8_MM(1, 0, At, B0); PG8_BAR; PG8_SCHED;
            PG8_STAGE(PG8_SB(0, 1), b2 + hstep, voffB);
            PG8_WAIT_V(6); PG8_BAR; PG8_MM(1, 1, At, B1); PG8_BAR;
            PG8_LDB(B0, 1, 0); PG8_SCHED; PG8_LDA(At, 1, 0); PG8_STAGE(PG8_SA(0, 1), a2 + hstep, voffA);
            PG8_WAIT_L(8); PG8_BAR; PG8_WAIT_L(0); PG8_MM(0, 0, At, B0); PG8_BAR; PG8_SCHED;
            PG8_LDB(B1, 1, 1); PG8_STAGE(PG8_SB(1, 0), b3, voffB);
            PG8_BAR; PG8_WAIT_L(0); PG8_MM(0, 1, At, B1); PG8_BAR;
            PG8_LDA(At, 1, 1); PG8_STAGE(PG8_SA(1, 0), a3, voffA);
            PG8_BAR; PG8_WAIT_L(0); PG8_MM(1, 0, At, B0); PG8_BAR; PG8_SCHED;
            PG8_STAGE(PG8_SB(1, 1), b3 + hstep, voffB);
            PG8_WAIT_V(6); PG8_BAR; PG8_MM(1, 1, At, B1); PG8_BAR;
            }
        }
        if constexpr (ALIGN_EPI) { if (wr == 0) PG8_BAR; }
        if constexpr (FP8) asm volatile("s_nop 15\n\ts_nop 15" ::: "memory");
        if constexpr (!Epi::AFTER_DRAIN) { int le_; asm volatile("v_mbcnt_lo_u32_b32 %0, -1, 0\n\tv_mbcnt_hi_u32_b32 %0, -1, %0" : "=v"(le_)); E(acc, cur, wr, wc, le_ & 15, le_ >> 4);
#if REP_EPI > 1
            if constexpr ((REP_EPI_MASK >> Epi::ID) & 1) { for (int rr_ = 1; rr_ < REP_EPI; ++rr_) { asm volatile("" ::: "memory"); asm volatile("v_mbcnt_lo_u32_b32 %0, -1, 0\n\tv_mbcnt_hi_u32_b32 %0, -1, %0" : "=v"(le_)); E(acc, cur, wr, wc, le_ & 15, le_ >> 4); } }
#endif
            S.done(cur); }
        if (!has_next) break;
#pragma unroll
        for (int a = 0; a < 2; ++a)
#pragma unroll
            for (int b = 0; b < 2; ++b)
#pragma unroll
                for (int m = 0; m < 4; ++m)
#pragma unroll
                    for (int n = 0; n < 2; ++n) acc[a][b][m][n] = (f32x4){0.f, 0.f, 0.f, 0.f};
        cur = nxt; cA = nA; cB = nB; ++ui;
        if constexpr (ALIGN_EPI) { if (wr == 1) PG8_BAR; }
    }
    PG8_WAIT_V(0);
    if constexpr (!ALIGN_EPI) { if (wr == 0) PG8_BAR; }
    PG8_BAR;
    if constexpr (Epi::AFTER_DRAIN) { E.fused(acc, cur, wr, wc, fr, fq, lds, wid, lane); S.done(cur); }
#undef PG8_SA
#undef PG8_SB
#undef PG8_STAGE
#undef PG8_LDA
#undef PG8_LDA8
#undef PG8_LDA16
#undef PG8_LDB
#undef PG8_LDB8
#undef PG8_LDB16
#undef PG8_MMA
#undef PG8_MMA8
#undef PG8_MM
#undef PG8_WAIT_V
#undef PG8_WAIT_L
#undef PG8_BAR
#undef PG8_SCHED
}
}
constexpr int NWAVES = 8;
constexpr int BATCH = 32, SEQ = 2048, DM = 1024, M = BATCH * SEQ, ZC = 3072, FF = 2816, GU = 2 * FF, DEPTH = 2, INC = 3012;
constexpr float LN_EPS = 1e-5f, LOG2E = 1.4426950408889634f, ALPHA = 1.4142135623730951f;
constexpr int ZC_QA = 0, ZC_KA = 256, ZC_VA = 320, ZC_QI = 384, ZC_KI = 640, ZC_WI = 704, ZC_QB = 768, ZC_KB = 1024, ZC_VB = 1280, ZC_QC = 1536, ZC_KC = 2048, ZC_VC = 2560;
constexpr size_t MiB = 1u << 20;
constexpr size_t XCNT_OFF = 128 * 1024;
constexpr size_t WS_CTL = 0, CTL_ZERO_BYTES = 256 * 1024;
constexpr size_t WS_STAT = 1 * MiB;
constexpr size_t WS_CV = 3 * MiB;
constexpr size_t CV_LAYER = 2 * (3072 + 5632);
constexpr size_t WS_W = 4 * MiB;
constexpr size_t W_IN_B = (size_t)ZC * DM * 2, W_O_B = (size_t)DM * DM * 2, W_GU_B = (size_t)GU * DM * 2, W_D_B = (size_t)DM * FF * 2;
constexpr size_t W_LAYER_B = W_IN_B + W_O_B + W_GU_B + W_D_B;
constexpr size_t W_IN8_OFF = 3 * MiB;
constexpr size_t WS_X8 = 256 * MiB;
constexpr size_t WS_R0 = 64 * MiB, WS_R1 = 192 * MiB, WS_R2 = 320 * MiB, WS_BIG = 448 * MiB, WS_SP = 896 * MiB  , WS_CVP = 904 * MiB  , WS_END = 908 * MiB;
static_assert(WS_W + DEPTH * W_LAYER_B <= WS_R0, "weights fit below R0");
static_assert((size_t)M * ZC * 2 <= WS_END - WS_BIG && (size_t)M * DM * 4 <= WS_END - WS_BIG && (size_t)M * DM * 2 <= WS_R1 - WS_R0, "activation map");
constexpr int CW_TMO = 0, CW_BAR = 4096;
constexpr int RING_OFF = 0, RING_BYTES = 131072;
constexpr int LDSCTL_OFF = RING_BYTES, MISC_OFF = LDSCTL_OFF + 320;
constexpr int XT_OFF = RING_BYTES + 2048;
constexpr int LDS_BYTES = 147456;

typedef unsigned short bf16;
typedef unsigned v4u __attribute__((ext_vector_type(4)));
typedef unsigned v2u __attribute__((ext_vector_type(2)));
typedef float f32x4 __attribute__((ext_vector_type(4)));
#define LDS_WAIT() asm volatile("s_waitcnt lgkmcnt(0)" ::: "memory")
__device__ __forceinline__ unsigned f2bf(float f) { unsigned u = __builtin_bit_cast(unsigned, f); return (u + 0x7fffu + ((u >> 16) & 1u)) >> 16; }
__device__ __forceinline__ unsigned pk2(float lo, float hi) { return f2bf(lo) | (f2bf(hi) << 16); }
__device__ __forceinline__ float bflo(unsigned w) { return __uint_as_float(w << 16); }
__device__ __forceinline__ float bfhi(unsigned w) { return __uint_as_float(w & 0xffff0000u); }
__device__ __forceinline__ float bf1(bf16 b) { return __uint_as_float((unsigned)b << 16); }
__device__ __forceinline__ void unpack8(const v4u w, float (&f)[8]) { f[0] = bflo(w.x); f[1] = bfhi(w.x); f[2] = bflo(w.y); f[3] = bfhi(w.y); f[4] = bflo(w.z); f[5] = bfhi(w.z); f[6] = bflo(w.w); f[7] = bfhi(w.w); }
__device__ __forceinline__ float wave_sum(float v, int lane) {
#pragma unroll
    for (int o = 1; o < 64; o <<= 1) v += __int_as_float(__builtin_amdgcn_ds_bpermute((lane ^ o) << 2, __float_as_int(v)));
    return v;
}
__device__ __forceinline__ int mbcnt64(unsigned long long m) { return (int)__builtin_amdgcn_mbcnt_hi((unsigned)(m >> 32), __builtin_amdgcn_mbcnt_lo((unsigned)m, 0u)); }
#define GAS __attribute__((address_space(1)))
#define LAS __attribute__((address_space(3)))
typedef GAS unsigned gu32;
#define RLX_AGENT __ATOMIC_RELAXED, __HIP_MEMORY_SCOPE_AGENT
#define VM_WAIT() asm volatile("s_waitcnt vmcnt(0)" ::: "memory")
__device__ __forceinline__ int lane_now() { int l; asm volatile("v_mbcnt_lo_u32_b32 %0, -1, 0\n\tv_mbcnt_hi_u32_b32 %0, -1, %0" : "=v"(l)); return l; }
#define XB_TMO      128
#define XB_XCNT(j)  (256  + 64 * (j))
#define XB_XSUB(j)  (1280 + 64 * (j))
#define XB_XGEN(j)  (2304 + 64 * (j))
#define XB_TOP      3328
#define XB_TOPGEN   3392
#define XCD_BAR_WORDS 3456
#define XB_SPIN_CAP (1u << 24)

__device__ __forceinline__ unsigned xb_ld(unsigned* p)              { return __hip_atomic_load(p, __ATOMIC_RELAXED, __HIP_MEMORY_SCOPE_AGENT); }
__device__ __forceinline__ unsigned xb_add(unsigned* p, unsigned v) { return __hip_atomic_fetch_add(p, v, __ATOMIC_RELAXED, __HIP_MEMORY_SCOPE_AGENT); }
__device__ __forceinline__ unsigned xb_xcc_id() { return (unsigned)__builtin_amdgcn_s_getreg((3 << 11) | 20) & 0xFu; }
#define XB_SPIN(cond, bar) do { unsigned _sp = 0; while (cond) { __builtin_amdgcn_s_sleep(1); \
    if ((++_sp & 255u) == 0u) { if (xb_ld(&(bar)[XB_TMO])) break; if (_sp > XB_SPIN_CAP) { atomicAdd(&(bar)[XB_TMO], 1u); break; } } } } while (0)

struct XcdBarrier {
    unsigned* bar; unsigned x;
    volatile LAS unsigned* st;
};

__device__ __forceinline__ XcdBarrier xcd_barrier_post(unsigned* bar, volatile LAS unsigned* st) {
    XcdBarrier b; b.bar = bar; b.x = (unsigned)__builtin_amdgcn_readfirstlane((int)xb_xcc_id()); b.st = st;
    if (threadIdx.x == 0) (void)xb_add(&bar[XB_XCNT(b.x)], 1u);
    return b;
}
__device__ __forceinline__ void xcd_barrier_complete(unsigned* bar, unsigned x, unsigned& nloc, unsigned& nx) {
    const unsigned G = gridDim.x * gridDim.y * gridDim.z;
    unsigned sum, cnt, mine, sp = 0u;
    for (;;) {
        sum = 0u; cnt = 0u; mine = 0u;
#pragma unroll
        for (unsigned j = 0; j < 16; ++j) { const unsigned c = xb_ld(&bar[XB_XCNT(j)]); sum += c; cnt += (c > 0u) ? 1u : 0u; mine = (j == x) ? c : mine; }
        if (sum == G) break;
        __builtin_amdgcn_s_sleep(1);
        if ((++sp & 255u) == 0u) { if (xb_ld(&bar[XB_TMO])) break; if (sp > XB_SPIN_CAP) { atomicAdd(&bar[XB_TMO], 1u); break; } }
    }
    nloc = mine > 0u ? mine : 1u; nx = cnt > 0u ? cnt : 1u;
}

__device__ __forceinline__ void xcd_barrier(const XcdBarrier& b) {
    asm volatile("s_waitcnt vmcnt(0)" ::: "memory");
    __syncthreads();
    if (threadIdx.x == 0) {
        unsigned* bar = b.bar; asm volatile("" : "+s"(bar));
        const unsigned bx_ = (unsigned)__builtin_amdgcn_readfirstlane((int)xb_xcc_id());
        __builtin_amdgcn_s_waitcnt(0);
        unsigned nloc = b.st[0], nx = b.st[1];
        if (nloc == 0u) { xcd_barrier_complete(bar, bx_, nloc, nx); b.st[0] = nloc; b.st[1] = nx; }
        const unsigned old = xb_add(&bar[XB_XSUB(bx_)], 1u);
        const unsigned gen = old / nloc;
        if (old + 1u == (gen + 1u) * nloc) {
            __builtin_amdgcn_fence(__ATOMIC_RELEASE, "agent");
            asm volatile("s_waitcnt vmcnt(0)" ::: "memory");
            const unsigned og = xb_add(&bar[XB_TOP], 1u);
            const unsigned tg = og / nx;
            if (og + 1u == (tg + 1u) * nx) xb_add(&bar[XB_TOPGEN], 1u);
            else XB_SPIN(xb_ld(&bar[XB_TOPGEN]) == tg, bar);
            __builtin_amdgcn_fence(__ATOMIC_ACQUIRE, "agent");
            xb_add(&bar[XB_XGEN(bx_)], 1u);
            asm volatile("s_waitcnt vmcnt(0)" ::: "memory");
        } else {
            XB_SPIN(xb_ld(&bar[XB_XGEN(bx_)]) == gen, bar);
            __builtin_amdgcn_fence(__ATOMIC_ACQUIRE, "agent");
            asm volatile("s_waitcnt vmcnt(0)" ::: "memory");
        }
    }
    __syncthreads();
}
template <int TYPE, int FP8S = 0> __device__ __forceinline__ void transpose_item(const float* W0, const float* W1, const float* gk, const float* bk, float* c1o, float* c0o, int K, int Nsrc, int Ndst, bf16* WT, LAS float* scr, int item, int lane) {
    const int nblk = Ndst / 32, kb = item / nblk, nb = item % nblk, k0 = 64 * kb, n0 = 32 * nb;
    const int nd = n0 + (lane & 31);
    const float* src = W0; int c = nd; float sc = 1.f; bool pad = false;
    if (TYPE == 0) {
        if (nd < 708) c = nd; else if (nd < 768) { pad = true; c = 0; } else c = nd - 60;
        if (nd < 256) sc = 0.125f * LOG2E; else if (nd >= ZC_QB && nd < ZC_KB) sc = 0.17677669529663687f * LOG2E; else if (nd >= ZC_QC && nd < ZC_KC) sc = 0.125f * LOG2E;
    } else if (TYPE == 2) {
        const int tile = nd >> 8, w = nd & 255;
        if (w < 128) { src = W0; c = tile * 128 + w; } else { src = W1; c = tile * 128 + (w - 128); }
    }
    const bool f8 = FP8S && (TYPE != 0 || n0 < 256 || n0 >= 768);
    float s1 = 0.f, s0 = 0.f;
#pragma unroll
    for (int i = 0; i < 32; ++i) { const int kk = 2 * i + (lane >> 5); float v = pad ? 0.f : src[(size_t)(k0 + kk) * Nsrc + c] * sc;
        if (gk) { s0 += bk[k0 + kk] * v; v *= gk[k0 + kk];
            if (f8) s1 += __builtin_amdgcn_cvt_f32_fp8(__builtin_amdgcn_cvt_pk_fp8_f32(v * (float)(1 << FP8S), 0.f, 0, false), 0) * (1.f / (float)(1 << FP8S));
            else s1 += __uint_as_float(f2bf(v) << 16); }
        scr[kk * 33 + (lane & 31)] = v; }
    if (gk) { s1 += __int_as_float(__builtin_amdgcn_ds_bpermute((lane ^ 32) << 2, __float_as_int(s1))); s0 += __int_as_float(__builtin_amdgcn_ds_bpermute((lane ^ 32) << 2, __float_as_int(s0)));
        if (lane < 32 && c1o) { c1o[(size_t)kb * CV_LAYER + nd] = s1; c0o[(size_t)kb * CV_LAYER + nd] = s0; } }
    LDS_WAIT();
    const int c8 = lane & 7;
#pragma unroll
    for (int j = 0; j < 4; ++j) { const int n = (lane >> 3) + 8 * j; const LAS float* s = scr + (8 * c8) * 33 + n;
        if (f8) {
            const float S = (float)(1 << FP8S);
            int w0 = __builtin_amdgcn_cvt_pk_fp8_f32(s[0 * 33] * S, s[1 * 33] * S, 0, false); w0 = __builtin_amdgcn_cvt_pk_fp8_f32(s[2 * 33] * S, s[3 * 33] * S, w0, true);
            int w1 = __builtin_amdgcn_cvt_pk_fp8_f32(s[4 * 33] * S, s[5 * 33] * S, 0, false); w1 = __builtin_amdgcn_cvt_pk_fp8_f32(s[6 * 33] * S, s[7 * 33] * S, w1, true);
            v2u o; o.x = (unsigned)w0; o.y = (unsigned)w1; *(v2u*)((unsigned char*)WT + (TYPE == 0 ? W_IN8_OFF : 0) + (size_t)(n0 + n) * K + k0 + 8 * c8) = o;
        } else {
        v4u o; o.x = pk2(s[0 * 33], s[1 * 33]); o.y = pk2(s[2 * 33], s[3 * 33]); o.z = pk2(s[4 * 33], s[5 * 33]); o.w = pk2(s[6 * 33], s[7 * 33]);
        *(v4u*)(WT + (size_t)(n0 + n) * K + k0 + 8 * c8) = o; } }
    LDS_WAIT();
}

template <bool OUT_F32> __device__ __forceinline__ void ln_phase(const float* H, const float* g, const float* b, bf16* ob, float* of, int gw, int NGW, int lane) {
    asm volatile("" : "+v"(lane));
    f32x4 gv[4], bv[4];
#pragma unroll
    for (int j = 0; j < 4; ++j) { gv[j] = ((const f32x4*)g)[lane + 64 * j]; bv[j] = ((const f32x4*)b)[lane + 64 * j]; }
    for (int m = gw; m < M; m += NGW) {
        const f32x4* xr = (const f32x4*)(H + (size_t)m * DM) + lane;
        f32x4 v[4]; float s = 0.f;
#pragma unroll
        for (int j = 0; j < 4; ++j) { v[j] = xr[64 * j]; s += (v[j].x + v[j].y) + (v[j].z + v[j].w); }
        const float mean = wave_sum(s, lane) * (1.f / DM); float s2 = 0.f;
#pragma unroll
        for (int j = 0; j < 4; ++j) { v[j] = v[j] - mean; s2 += (v[j].x * v[j].x + v[j].y * v[j].y) + (v[j].z * v[j].z + v[j].w * v[j].w); }
        const float rstd = 1.f / sqrtf(wave_sum(s2, lane) * (1.f / DM) + LN_EPS);
#pragma unroll
        for (int j = 0; j < 4; ++j) { const f32x4 y = v[j] * rstd * gv[j] + bv[j];
            if (OUT_F32) ((f32x4*)(of + (size_t)m * DM))[lane + 64 * j] = y;
            else { v2u o; o.x = pk2(y.x, y.y); o.y = pk2(y.z, y.w); ((v2u*)(ob + (size_t)m * DM))[lane + 64 * j] = o; } }
    }
}


__device__ __forceinline__ void stats_reduce(const float* part, float* ssum, float* ssq, size_t gt, size_t nth) {
    for (size_t row = gt; row < (size_t)M; row += nth) { float s = 0.f, q = 0.f;
#pragma unroll
        for (int sl = 0; sl < 16; ++sl) { s += part[(size_t)sl * M + row]; q += part[(size_t)(16 + sl) * M + row]; }
        const float mu = s * (1.f / DM); ssum[row] = mu; ssq[row] = __builtin_amdgcn_rsqf(fmaxf(q * (1.f / DM) - mu * mu, 0.f) + LN_EPS); }
}
__device__ __forceinline__ void cv_reduce(const float* cvp, float* cv, size_t gt, size_t nth) {
    for (size_t i = gt; i < (size_t)DEPTH * CV_LAYER; i += nth) { const size_t l = i / CV_LAYER, j = i % CV_LAYER;
        if (l == 0 && j < 2 * (size_t)ZC) continue;
        float s = 0.f;
#pragma unroll
        for (int kb = 0; kb < 16; ++kb) s += cvp[(l * 16 + kb) * CV_LAYER + j];
        cv[i] = s; }
}
typedef short bf16x8v __attribute__((ext_vector_type(8)));
typedef float f32x16 __attribute__((ext_vector_type(16)));
typedef short s16x4 __attribute__((ext_vector_type(4)));
typedef short v4i16_t __attribute__((ext_vector_type(4)));
typedef float f32x2_t __attribute__((ext_vector_type(2)));
typedef __bf16 bf16x2_t __attribute__((ext_vector_type(2)));
__device__ __forceinline__ unsigned cvtpk(float lo, float hi) { f32x2_t v = {lo, hi}; bf16x2_t b = __builtin_convertvector(v, bf16x2_t); return __builtin_bit_cast(unsigned, b); }
__device__ __forceinline__ s16x4 lds_tr(LAS const unsigned char* p) { return __builtin_bit_cast(s16x4, __builtin_amdgcn_ds_read_tr16_b64_v4i16((LAS v4i16_t*)p)); }
__device__ __forceinline__ float swap_max(float v) { auto rr = __builtin_amdgcn_permlane32_swap(__float_as_uint(v), __float_as_uint(v), false, false); return fmaxf(__uint_as_float(rr[0]), __uint_as_float(rr[1])); }
__device__ __forceinline__ float swap_sum(float v) { auto rr = __builtin_amdgcn_permlane32_swap(__float_as_uint(v), __float_as_uint(v), false, false); return __uint_as_float(rr[0]) + __uint_as_float(rr[1]); }
#ifndef FL_MFMA_SUM
#define FL_MFMA_SUM 1
#endif
#ifndef FL_CLASS
#define FL_CLASS 1
#endif
#ifndef MIX_FP8
#define MIX_FP8 0
#endif
__device__ __forceinline__ void mix_store4(bf16* MIX, size_t idx, float a, float b, float c, float d) {
#if MIX_FP8
    int w8 = __builtin_amdgcn_cvt_pk_fp8_f32(a, b, 0, false); w8 = __builtin_amdgcn_cvt_pk_fp8_f32(c, d, w8, true); *(int*)((unsigned char*)MIX + idx) = w8;
#else
    v2u w; w.x = cvtpk(a, b); w.y = cvtpk(c, d); *(v2u*)(MIX + idx) = w;
#endif
}
__device__ __forceinline__ void mix_store_head(bf16* MIX, size_t orow  , int hi, const f32x16& a, const f32x16& b) {
#if MIX_FP8
    unsigned wa[4], wb[4];
#pragma unroll
    for (int rg = 0; rg < 4; ++rg) {
        int x = __builtin_amdgcn_cvt_pk_fp8_f32(a[4 * rg + 0], a[4 * rg + 1], 0, false); x = __builtin_amdgcn_cvt_pk_fp8_f32(a[4 * rg + 2], a[4 * rg + 3], x, true);
        int y = __builtin_amdgcn_cvt_pk_fp8_f32(b[4 * rg + 0], b[4 * rg + 1], 0, false); y = __builtin_amdgcn_cvt_pk_fp8_f32(b[4 * rg + 2], b[4 * rg + 3], y, true);
        auto rr = __builtin_amdgcn_permlane32_swap((unsigned)x, (unsigned)y, false, false);
        wa[rg] = rr[0]; wb[rg] = rr[1]; }
    unsigned char* p = (unsigned char*)MIX + (orow - 4 * hi) + 32 * hi;
    v4u w0, w1; w0.x = wa[0]; w0.y = wb[0]; w0.z = wa[1]; w0.w = wb[1]; w1.x = wa[2]; w1.y = wb[2]; w1.z = wa[3]; w1.w = wb[3];
    *(v4u*)p = w0; *(v4u*)(p + 16) = w1;
#else
#pragma unroll
    for (int rg = 0; rg < 4; ++rg) { mix_store4(MIX, orow + 8 * rg, a[4 * rg + 0], a[4 * rg + 1], a[4 * rg + 2], a[4 * rg + 3]); mix_store4(MIX, orow + 32 + 8 * rg, b[4 * rg + 0], b[4 * rg + 1], b[4 * rg + 2], b[4 * rg + 3]); }
#endif
}
constexpr float FL_THR = 4.0f;
constexpr int FL_K = 0, FL_V = 16384, FL_TAB = 32768, FL_TABN = 2112;

__device__ __forceinline__ void fl_softmax(f32x16& p, float& m, float& l, f32x16 (&o)[2], bf16x8v (&pa)[2]) {
    const bool first = m < -1e29f;
    const float mref = first ? 0.f : m;
#pragma unroll
    for (int r = 0; r < 16; ++r) p[r] -= mref;
    float rm = fmaxf(fmaxf(p[0], p[1]), fmaxf(p[2], p[3]));
#pragma unroll
    for (int r = 4; r < 16; r += 4) rm = fmaxf(rm, fmaxf(fmaxf(p[r], p[r + 1]), fmaxf(p[r + 2], p[r + 3])));
    rm = swap_max(rm);
    const float dl = first ? ((rm > -1e29f) ? rm : 0.f) : ((rm > FL_THR) ? rm : 0.f);
    if (__any(dl != 0.f)) { const float al = first ? 1.f : __builtin_amdgcn_exp2f(-dl); l *= al;     o[0] *= al; o[1] *= al;
#pragma unroll
        for (int r = 0; r < 16; ++r) p[r] -= dl; }
    m = first ? ((rm > -1e29f) ? rm : m) : m + dl;
    float ls = 0.f;
#pragma unroll
    for (int r = 0; r < 16; ++r) { p[r] = __builtin_amdgcn_exp2f(p[r]); ls += p[r]; }
    l += ls;
    typedef unsigned u4 __attribute__((ext_vector_type(4)));
    u4 w0, w1; w0.x = cvtpk(p[0], p[1]); w0.y = cvtpk(p[2], p[3]); w0.z = cvtpk(p[4], p[5]); w0.w = cvtpk(p[6], p[7]);
    w1.x = cvtpk(p[8], p[9]); w1.y = cvtpk(p[10], p[11]); w1.z = cvtpk(p[12], p[13]); w1.w = cvtpk(p[14], p[15]);
    pa[0] = __builtin_bit_cast(bf16x8v, w0); pa[1] = __builtin_bit_cast(bf16x8v, w1);
}

__device__ __forceinline__ void fl_softmax2(f32x16& pa_, f32x16& pb_, float& m, float& l, f32x16 (&o)[2], bf16x8v (&pf)[4]) {
    const bool first = m < -1e29f;
    const float mref = first ? 0.f : m;
#pragma unroll
    for (int r = 0; r < 16; ++r) { pa_[r] -= mref; pb_[r] -= mref; }
    float rm = fmaxf(fmaxf(pa_[0], pa_[1]), fmaxf(pb_[0], pb_[1]));
#pragma unroll
    for (int r = 2; r < 16; r += 2) rm = fmaxf(rm, fmaxf(fmaxf(pa_[r], pa_[r + 1]), fmaxf(pb_[r], pb_[r + 1])));
    rm = swap_max(rm);
    const float dl = first ? ((rm > -1e29f) ? rm : 0.f) : ((rm > FL_THR) ? rm : 0.f);
    if (__any(dl != 0.f)) { const float al = first ? 1.f : __builtin_amdgcn_exp2f(-dl); l *= al; o[0] *= al; o[1] *= al;
#pragma unroll
        for (int r = 0; r < 16; ++r) { pa_[r] -= dl; pb_[r] -= dl; } }
    m = first ? ((rm > -1e29f) ? rm : m) : m + dl;
    float ls0 = 0.f, ls1 = 0.f;
#pragma unroll
    for (int r = 0; r < 16; ++r) { pa_[r] = __builtin_amdgcn_exp2f(pa_[r]); ls0 += pa_[r]; pb_[r] = __builtin_amdgcn_exp2f(pb_[r]); ls1 += pb_[r]; }
    l += ls0 + ls1;
    typedef unsigned u4 __attribute__((ext_vector_type(4)));
    u4 w;
    w.x = cvtpk(pa_[0], pa_[1]); w.y = cvtpk(pa_[2], pa_[3]); w.z = cvtpk(pa_[4], pa_[5]); w.w = cvtpk(pa_[6], pa_[7]); pf[0] = __builtin_bit_cast(bf16x8v, w);
    w.x = cvtpk(pa_[8], pa_[9]); w.y = cvtpk(pa_[10], pa_[11]); w.z = cvtpk(pa_[12], pa_[13]); w.w = cvtpk(pa_[14], pa_[15]); pf[1] = __builtin_bit_cast(bf16x8v, w);
    w.x = cvtpk(pb_[0], pb_[1]); w.y = cvtpk(pb_[2], pb_[3]); w.z = cvtpk(pb_[4], pb_[5]); w.w = cvtpk(pb_[6], pb_[7]); pf[2] = __builtin_bit_cast(bf16x8v, w);
    w.x = cvtpk(pb_[8], pb_[9]); w.y = cvtpk(pb_[10], pb_[11]); w.z = cvtpk(pb_[12], pb_[13]); w.w = cvtpk(pb_[14], pb_[15]); pf[3] = __builtin_bit_cast(bf16x8v, w);
}

__device__ __forceinline__ void fl_softmax3(f32x16& pa_, f32x16& pb_, float sha, float shb, float& m, float& l, f32x16 (&o)[2], bf16x8v (&pf)[4]) {
    const bool first = m < -1e29f;
    const float mref = first ? 0.f : m, ca = sha - mref, cb = shb - mref;
#pragma unroll
    for (int r = 0; r < 16; ++r) { pa_[r] += ca; pb_[r] += cb; }
    float rm = fmaxf(fmaxf(pa_[0], pa_[1]), fmaxf(pb_[0], pb_[1]));
#pragma unroll
    for (int r = 2; r < 16; r += 2) rm = fmaxf(rm, fmaxf(fmaxf(pa_[r], pa_[r + 1]), fmaxf(pb_[r], pb_[r + 1])));
    rm = swap_max(rm);
    const float dl = first ? ((rm > -1e29f) ? rm : 0.f) : ((rm > FL_THR) ? rm : 0.f);
    if (__any(dl != 0.f)) { const float al = first ? 1.f : __builtin_amdgcn_exp2f(-dl); l *= al; o[0] *= al; o[1] *= al;
#pragma unroll
        for (int r = 0; r < 16; ++r) { pa_[r] -= dl; pb_[r] -= dl; } }
    m = first ? ((rm > -1e29f) ? rm : m) : m + dl;
    float ls0 = 0.f, ls1 = 0.f;
#pragma unroll
    for (int r = 0; r < 16; ++r) { pa_[r] = __builtin_amdgcn_exp2f(pa_[r]); ls0 += pa_[r]; pb_[r] = __builtin_amdgcn_exp2f(pb_[r]); ls1 += pb_[r]; }
    l += ls0 + ls1;
    typedef unsigned u4 __attribute__((ext_vector_type(4)));
    u4 w;
    w.x = cvtpk(pa_[0], pa_[1]); w.y = cvtpk(pa_[2], pa_[3]); w.z = cvtpk(pa_[4], pa_[5]); w.w = cvtpk(pa_[6], pa_[7]); pf[0] = __builtin_bit_cast(bf16x8v, w);
    w.x = cvtpk(pa_[8], pa_[9]); w.y = cvtpk(pa_[10], pa_[11]); w.z = cvtpk(pa_[12], pa_[13]); w.w = cvtpk(pa_[14], pa_[15]); pf[1] = __builtin_bit_cast(bf16x8v, w);
    w.x = cvtpk(pb_[0], pb_[1]); w.y = cvtpk(pb_[2], pb_[3]); w.z = cvtpk(pb_[4], pb_[5]); w.w = cvtpk(pb_[6], pb_[7]); pf[2] = __builtin_bit_cast(bf16x8v, w);
    w.x = cvtpk(pb_[8], pb_[9]); w.y = cvtpk(pb_[10], pb_[11]); w.z = cvtpk(pb_[12], pb_[13]); w.w = cvtpk(pb_[14], pb_[15]); pf[3] = __builtin_bit_cast(bf16x8v, w);
}
__device__ __forceinline__ float fl_rowsum(const bf16x8v (&pf)[4]) {
    const bf16x8v ones = (bf16x8v){0x3f80, 0x3f80, 0x3f80, 0x3f80, 0x3f80, 0x3f80, 0x3f80, 0x3f80};
    f32x16 z;
#pragma unroll
    for (int r = 0; r < 16; ++r) z[r] = 0.f;
    z = __builtin_amdgcn_mfma_f32_32x32x16_bf16(ones, pf[0], z, 0, 0, 0); z = __builtin_amdgcn_mfma_f32_32x32x16_bf16(ones, pf[1], z, 0, 0, 0);
    z = __builtin_amdgcn_mfma_f32_32x32x16_bf16(ones, pf[2], z, 0, 0, 0); z = __builtin_amdgcn_mfma_f32_32x32x16_bf16(ones, pf[3], z, 0, 0, 0);
    return z[0];
}

template <int MODE> __device__ __forceinline__ void flash_unit(const bf16* Z, bf16* MIX, LAS unsigned char* L, int b, int h, int qb, float lam_full, float lambda_init, const float* subg, int tid, int wave, int lane) {
    lane = lane_now(); tid = wave * 64 + lane;
    constexpr int NMAP = MODE == 0 ? 2 : 1, KS = 4 / NMAP;
    constexpr int CQ = MODE == 0 ? ZC_QB : ZC_QC, CK = MODE == 0 ? ZC_KB : ZC_KC, CV = MODE == 0 ? ZC_VB : ZC_VC;
    const int r32 = lane & 31, hi = lane >> 5;
    LAS unsigned char* Kb = L + FL_K; LAS unsigned char* Vb = L + FL_V; LAS float* tab = (LAS float*)(L + FL_TAB);
    const int Q0 = qb * 256, tq0 = Q0 + wave * 32, t = tq0 + r32;
    const bf16* zb = Z + (size_t)(b * SEQ) * ZC;
    const float sl = (MODE == 0 ? __builtin_amdgcn_exp2f(-2.f * (float)(h + 1)) : __builtin_amdgcn_exp2f(-(float)(h + 1))) * LOG2E;
    for (int j = tid; j < FL_TABN; j += NWAVES * 64) { const int d = 2047 - j; float v;
        if (MODE == 0) v = d < 0 ? -INFINITY : -sl * (float)d;
        else { const int mult = (d <= 128 ? 1 : 0) + (((d & 3) == 0 && d <= 512) ? 1 : 0) + ((d & 15) == 0 ? 1 : 0);
               v = (d < 0 || mult == 0) ? -INFINITY : -sl * (float)d + (mult == 1 ? 0.f : (mult == 2 ? 1.f : 1.5849625007211562f)); }
        tab[j] = v; }
    bf16x8v qf[NMAP][KS];
#pragma unroll
    for (int mp = 0; mp < NMAP; ++mp)
#pragma unroll
        for (int ks = 0; ks < KS; ++ks) qf[mp][ks] = *(const bf16x8v*)(zb + (size_t)t * ZC + CQ + h * 64 + (mp * KS + ks) * 16 + hi * 8);
    constexpr int NCLS = MODE == 0 ? 1 : 3;
    f32x16 cin[NCLS];
#pragma unroll
    for (int r = 0; r < 16; ++r) { const int cr = (r & 3) + 8 * (r >> 2) + 4 * hi; const float a = sl * (float)cr;
        if (MODE == 0) cin[0][r] = a;
        else { const bool m4 = ((t - cr) & 3) == 0, m16 = ((t - cr) & 15) == 0;
            cin[0][r] = a + (m16 ? 1.5849625007211562f : (m4 ? 1.f : 0.f)); cin[NCLS - 2][r] = m4 ? a + (m16 ? 1.f : 0.f) : -INFINITY; cin[NCLS - 1][r] = m16 ? a : -INFINITY; } }
    float m[NMAP], l[NMAP]; f32x16 o[NMAP][2];
#pragma unroll
    for (int mp = 0; mp < NMAP; ++mp) { m[mp] = -1e30f; l[mp] = 0.f;
#pragma unroll
        for (int r = 0; r < 16; ++r) { o[mp][0][r] = 0.f; o[mp][1][r] = 0.f; } }
    const int skey = tid >> 3, sc = tid & 7;
    const bf16* ksrc = zb + (size_t)skey * ZC + CK + h * 64 + sc * 8;
    const bf16* vsrc = zb + (size_t)skey * ZC + CV + h * 64 + sc * 8;
    const int kdst = (sc >> 1) * 2048 + (sc & 1) * 1024 + (skey >> 5) * 512 + (skey & 31) * 16;
    const int vdst = (sc >> 2) * 4096 + (skey >> 3) * 512 + (skey & 7) * 64 + (sc & 3) * 16;
    const int krd = hi * 1024 + r32 * 16;
    const int vrd = ((lane >> 4) & 1) * 32 + (lane & 3) * 8 + (4 * hi + ((lane & 15) >> 2)) * 64;
    int tilz = 64 * ZC; asm volatile("" : "+s"(tilz));
    int jt = Q0 / 64 + 3;
    v4u kA = *(const v4u*)(ksrc + (size_t)(jt * tilz)), vA = *(const v4u*)(vsrc + (size_t)(jt * tilz));
    v4u kB = *(const v4u*)(ksrc + (size_t)((jt - 1) * tilz)), vB = *(const v4u*)(vsrc + (size_t)((jt - 1) * tilz));
    *(LAS v4u*)(Kb + (jt & 1) * 8192 + kdst) = kA; *(LAS v4u*)(Vb + (jt & 1) * 8192 + vdst) = vA;
    __syncthreads();
#define FL_TILE(JT, KW, VW, KL, VL) do { const int jt_ = (JT); \
        if (jt_ >= 2) { KL = *(const v4u*)(ksrc + (size_t)((jt_ - 2) * tilz)); VL = *(const v4u*)(vsrc + (size_t)((jt_ - 2) * tilz)); } \
        const LAS unsigned char* Kc = Kb + (jt_ & 1) * 8192; const LAS unsigned char* Vc = Vb + (jt_ & 1) * 8192; \
        if (jt_ * 64 <= tq0) {                                            \
              \
            const LAS float* tp = tab + (2047 - t + jt_ * 64 + 4 * hi); \
            f32x16 bias0, bias1; \
            _Pragma("unroll") for (int r = 0; r < 16; ++r) { bias0[r] = tp[(r & 3) + 8 * (r >> 2)]; bias1[r] = tp[32 + (r & 3) + 8 * (r >> 2)]; } \
            _Pragma("unroll") for (int mp = 0; mp < NMAP; ++mp) { \
                f32x16 p0 = bias0, p1 = bias1; \
                _Pragma("unroll") for (int ks = 0; ks < KS; ++ks) { const bf16x8v kf0 = *(const LAS bf16x8v*)(Kc + (mp * KS + ks) * 2048 + krd), kf1 = *(const LAS bf16x8v*)(Kc + (mp * KS + ks) * 2048 + 512 + krd); \
                    p0 = __builtin_amdgcn_mfma_f32_32x32x16_bf16(kf0, qf[mp][ks], p0, 0, 0, 0); p1 = __builtin_amdgcn_mfma_f32_32x32x16_bf16(kf1, qf[mp][ks], p1, 0, 0, 0); } \
                bf16x8v pf[4]; \
                fl_softmax3(p0, p1, 0.f, 0.f, m[mp], l[mp], o[mp], pf); \
                _Pragma("unroll") for (int s4 = 0; s4 < 4; ++s4) _Pragma("unroll") for (int db = 0; db < 2; ++db) { const LAS unsigned char* vp = Vc + db * 4096 + s4 * 1024 + vrd; \
                        const s16x4 lo = lds_tr(vp), hh = lds_tr(vp + 512); \
                        const bf16x8v vf = (bf16x8v){lo[0], lo[1], lo[2], lo[3], hh[0], hh[1], hh[2], hh[3]}; \
                        o[mp][db] = __builtin_amdgcn_mfma_f32_32x32x16_bf16(vf, pf[s4], o[mp][db], 0, 0, 0); } } \
        } \
        if (jt_ >= 1) { *(LAS v4u*)(Kb + ((jt_ - 1) & 1) * 8192 + kdst) = KW; *(LAS v4u*)(Vb + ((jt_ - 1) & 1) * 8192 + vdst) = VW; } \
        __syncthreads(); } while (0)
    for (; jt >= 0; jt -= 2) { FL_TILE(jt, kB, vB, kA, vA); FL_TILE(jt - 1, kA, vA, kB, vB); }
#undef FL_TILE
    const size_t orow = (size_t)(b * SEQ + t) * DM + (MODE == 0 ? 256 : 512) + h * 64 + 4 * hi;
    if (MODE == 0) {
        const float i0 = 1.f / swap_sum(l[0]), i1 = lam_full / swap_sum(l[NMAP - 1]); float ss = 0.f;
#pragma unroll
        for (int db = 0; db < 2; ++db)
#pragma unroll
            for (int r = 0; r < 16; ++r) { const float v = o[0][db][r] * i0 - o[NMAP - 1][db][r] * i1; o[0][db][r] = v; ss += v * v; }
        const float rs = (1.f / sqrtf(swap_sum(ss) * (1.f / 64.f) + LN_EPS)) * lambda_init;
#pragma unroll
        for (int db = 0; db < 2; ++db)
#pragma unroll
            for (int rg = 0; rg < 4; ++rg) { const f32x4 g = *(const f32x4*)(subg + 32 * db + 8 * rg + 4 * hi);
                o[0][db][4 * rg + 0] *= rs * g.x; o[0][db][4 * rg + 1] *= rs * g.y; o[0][db][4 * rg + 2] *= rs * g.z; o[0][db][4 * rg + 3] *= rs * g.w; }
        mix_store_head(MIX, orow, hi, o[0][0], o[0][1]);
    } else {
        const float i0 = 1.f / swap_sum(l[0]);
        o[0][0] *= i0; o[0][1] *= i0; mix_store_head(MIX, orow, hi, o[0][0], o[0][1]);
    }
}
template <int MODE> __device__ __forceinline__ void flash_phase(const bf16* Z, bf16* MIX, LAS unsigned char* L, const float* lam, const float* subg, float lambda_init, int vcu, int G, int tid, int wave, int lane) {
    asm volatile("" : "+v"(tid), "+v"(lane));
    constexpr int NH = MODE == 0 ? 4 : 8, NPAIR = BATCH * NH * 4;
    float lam_full = 0.f;
    if (MODE == 0) { const int li = lane & 31; const float s01 = wave_sum(lam[li] * lam[32 + li], lane) * 0.5f, s23 = wave_sum(lam[64 + li] * lam[96 + li], lane) * 0.5f; lam_full = __int_as_float(__builtin_amdgcn_readfirstlane(__float_as_int(expf(s01) - expf(s23) + lambda_init))); }
    const float oml = __int_as_float(__builtin_amdgcn_readfirstlane(__float_as_int(1.f - lambda_init)));
    for (int p = vcu; p < NPAIR; p += G) {
        const int b = p / (NH * 4), h = (p >> 2) % NH, x = p & 3;
#pragma unroll 1
        for (int k = 0; k < 2; ++k) { flash_unit<MODE>(Z, MIX, L, b, h, k == 0 ? 7 - x : x, lam_full, oml, subg, tid, wave, lane); __syncthreads(); }
    }
}
constexpr int F2_K = 0, F2_V = 24576, F2_TAB = 40960;
#define F2_QK(S, KSLOT, MP, JT) do { const LAS float* tp_ = tab + (2047 - t + (JT) * 64 + 4 * hi); const LAS unsigned char* kc_ = Kb + (KSLOT) * 8192; \
        _Pragma("unroll") for (int r = 0; r < 16; ++r) { S[0][r] = tp_[(r & 3) + 8 * (r >> 2)]; S[1][r] = tp_[32 + (r & 3) + 8 * (r >> 2)]; } \
        _Pragma("unroll") for (int ks = 0; ks < KS; ++ks) { const bf16x8v k0_ = *(const LAS bf16x8v*)(kc_ + ((MP) * KS + ks) * 2048 + krd), k1_ = *(const LAS bf16x8v*)(kc_ + ((MP) * KS + ks) * 2048 + 512 + krd); \
            S[0] = __builtin_amdgcn_mfma_f32_32x32x16_bf16(k0_, qf[MP][ks], S[0], 0, 0, 0); S[1] = __builtin_amdgcn_mfma_f32_32x32x16_bf16(k1_, qf[MP][ks], S[1], 0, 0, 0); } } while (0)
#define F2_BD(S, MP) do { float rm_ = fmaxf(fmaxf(S[0][0], S[0][1]), fmaxf(S[1][0], S[1][1])); \
        _Pragma("unroll") for (int r = 2; r < 16; r += 2) rm_ = fmaxf(rm_, fmaxf(fmaxf(S[0][r], S[0][r + 1]), fmaxf(S[1][r], S[1][r + 1]))); \
        rm_ = swap_max(rm_); const bool first_ = m[MP] < -1e29f; \
        const bool up_ = first_ ? (rm_ > -1e29f) : (rm_ > m[MP] + FL_THR); \
        if (__any(up_)) { const float nm_ = up_ ? rm_ : m[MP], al_ = (first_ || !up_) ? 1.f : __builtin_amdgcn_exp2f(m[MP] - nm_); l[MP] *= al_; o[MP][0] *= al_; o[MP][1] *= al_; m[MP] = nm_; } } while (0)
#define F2_SM(S, MP, PF) do { const float nm_ = -m[MP]; float ls0_ = 0.f, ls1_ = 0.f; \
        _Pragma("unroll") for (int r = 0; r < 16; ++r) { S[0][r] = __builtin_amdgcn_exp2f(S[0][r] + nm_); ls0_ += S[0][r]; S[1][r] = __builtin_amdgcn_exp2f(S[1][r] + nm_); ls1_ += S[1][r]; } \
        l[MP] += ls0_ + ls1_; \
        { typedef unsigned u4_ __attribute__((ext_vector_type(4))); u4_ w_; \
          w_.x = cvtpk(S[0][0], S[0][1]); w_.y = cvtpk(S[0][2], S[0][3]); w_.z = cvtpk(S[0][4], S[0][5]); w_.w = cvtpk(S[0][6], S[0][7]); PF[0] = __builtin_bit_cast(bf16x8v, w_); \
          w_.x = cvtpk(S[0][8], S[0][9]); w_.y = cvtpk(S[0][10], S[0][11]); w_.z = cvtpk(S[0][12], S[0][13]); w_.w = cvtpk(S[0][14], S[0][15]); PF[1] = __builtin_bit_cast(bf16x8v, w_); \
          w_.x = cvtpk(S[1][0], S[1][1]); w_.y = cvtpk(S[1][2], S[1][3]); w_.z = cvtpk(S[1][4], S[1][5]); w_.w = cvtpk(S[1][6], S[1][7]); PF[2] = __builtin_bit_cast(bf16x8v, w_); \
          w_.x = cvtpk(S[1][8], S[1][9]); w_.y = cvtpk(S[1][10], S[1][11]); w_.z = cvtpk(S[1][12], S[1][13]); w_.w = cvtpk(S[1][14], S[1][15]); PF[3] = __builtin_bit_cast(bf16x8v, w_); } } while (0)
#define F2_PV(MP, VSLOT, PF) do { const LAS unsigned char* vc_ = Vb + (VSLOT) * 8192; \
        _Pragma("unroll") for (int s4 = 0; s4 < 4; ++s4) _Pragma("unroll") for (int db = 0; db < 2; ++db) { const LAS unsigned char* vp_ = vc_ + db * 4096 + s4 * 1024 + vrd; \
            const s16x4 lo_ = lds_tr(vp_), hh_ = lds_tr(vp_ + 512); const bf16x8v vf_ = (bf16x8v){lo_[0], lo_[1], lo_[2], lo_[3], hh_[0], hh_[1], hh_[2], hh_[3]}; \
            o[MP][db] = __builtin_amdgcn_mfma_f32_32x32x16_bf16(vf_, PF[s4], o[MP][db], 0, 0, 0); } } while (0)

template <int MODE> __device__ __forceinline__ void flash_unit2(const bf16* Z, bf16* MIX, LAS unsigned char* L, int b, int h, int qb, float lam_full, float lambda_init, const float* subg, int wave) {
    const int lane = lane_now(), tid = wave * 64 + lane;
    constexpr int NMAP = MODE == 0 ? 2 : 1, KS = 4 / NMAP;
    constexpr int CQ = MODE == 0 ? ZC_QB : ZC_QC, CK = MODE == 0 ? ZC_KB : ZC_KC, CV = MODE == 0 ? ZC_VB : ZC_VC;
    const int r32 = lane & 31, hi = lane >> 5;
    LAS unsigned char* Kb = L + F2_K; LAS unsigned char* Vb = L + F2_V; LAS float* tab = (LAS float*)(L + F2_TAB);
    const int Q0 = qb * 256, tq0 = Q0 + wave * 32, t = tq0 + r32, Jw = tq0 >> 6;
    const bf16* zb = Z + (size_t)(b * SEQ) * ZC;
    const float sl = (MODE == 0 ? __builtin_amdgcn_exp2f(-2.f * (float)(h + 1)) : __builtin_amdgcn_exp2f(-(float)(h + 1))) * LOG2E;
    for (int j = tid; j < FL_TABN; j += NWAVES * 64) { const int d = 2047 - j; float v;
        if (MODE == 0) v = d < 0 ? -INFINITY : -sl * (float)d;
        else { const int mult = (d <= 128 ? 1 : 0) + (((d & 3) == 0 && d <= 512) ? 1 : 0) + ((d & 15) == 0 ? 1 : 0);
               v = (d < 0 || mult == 0) ? -INFINITY : -sl * (float)d + (mult == 1 ? 0.f : (mult == 2 ? 1.f : 1.5849625007211562f)); }
        tab[j] = v; }
    bf16x8v qf[NMAP][KS];
#pragma unroll
    for (int mp = 0; mp < NMAP; ++mp)
#pragma unroll
        for (int ks = 0; ks < KS; ++ks) qf[mp][ks] = *(const bf16x8v*)(zb + (size_t)t * ZC + CQ + h * 64 + (mp * KS + ks) * 16 + hi * 8);
    float m[NMAP], l[NMAP]; f32x16 o[NMAP][2];
#pragma unroll
    for (int mp = 0; mp < NMAP; ++mp) { m[mp] = -1e30f; l[mp] = 0.f;
#pragma unroll
        for (int r = 0; r < 16; ++r) { o[mp][0][r] = 0.f; o[mp][1][r] = 0.f; } }
    const int skey = tid >> 3, sc = tid & 7;
    const bf16* ksrc = zb + (size_t)skey * ZC + CK + h * 64 + sc * 8;
    const bf16* vsrc = zb + (size_t)skey * ZC + CV + h * 64 + sc * 8;
    const int kdst = (sc >> 1) * 2048 + (sc & 1) * 1024 + (skey >> 5) * 512 + (skey & 31) * 16;
    const int vdst = (sc >> 2) * 4096 + (skey >> 3) * 512 + (skey & 7) * 64 + (sc & 3) * 16;
    const int krd = hi * 1024 + r32 * 16;
    const int vrd = ((lane >> 4) & 1) * 32 + (lane & 3) * 8 + (4 * hi + ((lane & 15) >> 2)) * 64;
    const size_t til = (size_t)64 * ZC;
    const int J = Q0 / 64 + 3;
    int k0s = J % 3, k1s = (J + 2) % 3, k2s = (J + 1) % 3;
    { const v4u a = *(const v4u*)(ksrc + J * til), bq = *(const v4u*)(ksrc + (J - 1) * til), c = *(const v4u*)(vsrc + J * til);
      *(LAS v4u*)(Kb + k0s * 8192 + kdst) = a; *(LAS v4u*)(Kb + k1s * 8192 + kdst) = bq; *(LAS v4u*)(Vb + (J & 1) * 8192 + vdst) = c; }
    v4u kA = *(const v4u*)(ksrc + (J - 2) * til), vA = *(const v4u*)(vsrc + (J - 1) * til);
    v4u kB = kA, vB = vA;
    __syncthreads();
    f32x16 Sa[2], Sb[2];
    if (J <= Jw) { F2_QK(Sa, k0s, 0, J); F2_BD(Sa, 0); }
#define F2_TILE(JT, KW, VW, KL, VL, SC, SN) do { const int jt_ = (JT); \
        if (jt_ >= 3) KL = *(const v4u*)(ksrc + (jt_ - 3) * til); if (jt_ >= 2) VL = *(const v4u*)(vsrc + (jt_ - 2) * til); \
        if (MODE == 1) { \
            if (jt_ <= Jw && jt_ >= 1) { bf16x8v pf_[4]; if (wave >= 4) { F2_SM(SC, 0, pf_); F2_PV(0, jt_ & 1, pf_); F2_QK(SN, k1s, 0, jt_ - 1); F2_BD(SN, 0); } else { F2_QK(SN, k1s, 0, jt_ - 1); F2_SM(SC, 0, pf_); F2_PV(0, jt_ & 1, pf_); F2_BD(SN, 0); } } \
            else if (jt_ == Jw + 1) { F2_QK(SN, k1s, 0, jt_ - 1); F2_BD(SN, 0); } \
            else if (jt_ <= Jw) { bf16x8v pf_[4]; F2_SM(SC, 0, pf_); F2_PV(0, jt_ & 1, pf_); } \
        } else { \
            if (jt_ <= Jw) { bf16x8v pf_[4]; F2_QK(Sb, k0s, NMAP - 1, jt_); F2_SM(Sa, 0, pf_); F2_PV(0, jt_ & 1, pf_); F2_BD(Sb, NMAP - 1); } \
            if (jt_ <= Jw + 1 && jt_ >= 1) { F2_QK(Sa, k1s, 0, jt_ - 1); } \
            if (jt_ <= Jw) { bf16x8v pf_[4]; F2_SM(Sb, NMAP - 1, pf_); F2_PV(NMAP - 1, jt_ & 1, pf_); } \
            if (jt_ <= Jw + 1 && jt_ >= 1) { F2_BD(Sa, 0); } \
        } \
        if (jt_ >= 2) *(LAS v4u*)(Kb + k2s * 8192 + kdst) = KW; if (jt_ >= 1) *(LAS v4u*)(Vb + ((jt_ - 1) & 1) * 8192 + vdst) = VW; \
        { const int t_ = k0s; k0s = k1s; k1s = k2s; k2s = t_; } \
        __syncthreads(); } while (0)
    for (int jt = J; jt >= 0; jt -= 2) { F2_TILE(jt, kA, vA, kB, vB, Sa, Sb); F2_TILE(jt - 1, kB, vB, kA, vA, Sb, Sa); }
#undef F2_TILE
    bf16* orow = MIX + (size_t)(b * SEQ + t) * DM + (MODE == 0 ? 256 : 512) + h * 64 + 4 * hi;
    if (MODE == 0) {
        const float i0 = 1.f / swap_sum(l[0]), i1 = lam_full / swap_sum(l[NMAP - 1]); float ss = 0.f;
#pragma unroll
        for (int db = 0; db < 2; ++db)
#pragma unroll
            for (int r = 0; r < 16; ++r) { const float v = o[0][db][r] * i0 - o[NMAP - 1][db][r] * i1; o[0][db][r] = v; ss += v * v; }
        const float rs = (1.f / sqrtf(swap_sum(ss) * (1.f / 64.f) + LN_EPS)) * (1.f - lambda_init);
#pragma unroll
        for (int db = 0; db < 2; ++db)
#pragma unroll
            for (int rg = 0; rg < 4; ++rg) { const f32x4 g = *(const f32x4*)(subg + 32 * db + 8 * rg + 4 * hi);
                v2u w; w.x = cvtpk(o[0][db][4 * rg + 0] * rs * g.x, o[0][db][4 * rg + 1] * rs * g.y); w.y = cvtpk(o[0][db][4 * rg + 2] * rs * g.z, o[0][db][4 * rg + 3] * rs * g.w);
                *(v2u*)(orow + 32 * db + 8 * rg) = w; }
    } else {
        const float i0 = 1.f / swap_sum(l[0]);
#pragma unroll
        for (int db = 0; db < 2; ++db)
#pragma unroll
            for (int rg = 0; rg < 4; ++rg) { v2u w; w.x = cvtpk(o[0][db][4 * rg + 0] * i0, o[0][db][4 * rg + 1] * i0); w.y = cvtpk(o[0][db][4 * rg + 2] * i0, o[0][db][4 * rg + 3] * i0);
                *(v2u*)(orow + 32 * db + 8 * rg) = w; }
    }
}
template <int MODE> __device__ __forceinline__ void flash_phase2(const bf16* Z, bf16* MIX, LAS unsigned char* L, const float* lam, const float* subg, float lambda_init, int vcu, int G, int tid, int wave, int lane) {
    constexpr int NH = MODE == 0 ? 4 : 8, NPAIR = BATCH * NH * 4;
    float lam_full = 0.f;
    if (MODE == 0) { const int li = lane & 31; const float s01 = wave_sum(lam[li] * lam[32 + li], lane) * 0.5f, s23 = wave_sum(lam[64 + li] * lam[96 + li], lane) * 0.5f; lam_full = expf(s01) - expf(s23) + lambda_init; }
    for (int p = vcu; p < NPAIR; p += G) {
        const int b = p / (NH * 4), h = (p >> 2) % NH, x = p & 3;
#pragma unroll 1
        for (int k = 0; k < 2; ++k) { flash_unit2<MODE>(Z, MIX, L, b, h, k == 0 ? 7 - x : x, lam_full, lambda_init, subg, wave); __syncthreads(); }
    }
}
#ifndef FSUB_STREAM
#define FSUB_STREAM 1
#endif
constexpr int FLS_TABN = 2304;
constexpr int FLS_TABW = FL_TAB + FLS_TABN * 4;
constexpr int FLS_WK = 44032, FLS_WV = FLS_WK + 9 * 4096;
static_assert(FLS_TABW + 3 * 96 * 4 <= FLS_WK && FLS_WV + 9 * 4096 <= RING_BYTES, "sub-lattice LDS map");

#define FS_SBAR() __builtin_amdgcn_sched_barrier(0)
#define FS_PIN(x) asm volatile("" : "+v"(x))
#define FS_MFMA(a, b, c) __builtin_amdgcn_mfma_f32_32x32x16_bf16(a, b, c, 0, 0, 0)
#define FS_WAIT_BAR(N) asm volatile("s_waitcnt vmcnt(" #N ") lgkmcnt(0)\n\ts_barrier" ::: "memory")
#define FS_MX3(a, b, c) __builtin_fmaxf(__builtin_fmaxf((a), (b)), (c))
#ifndef FS_THR_V
#define FS_THR_V 8.0f
#endif
constexpr float FS_THR = FS_THR_V;
__device__ __forceinline__ void fs_glds16(const void* g, unsigned lds_base) {
    unsigned sv; asm volatile("s_mov_b32 %0, m0\n\ts_mov_b32 m0, %2\n\ts_nop 0\n\tglobal_load_lds_dwordx4 %1, off\n\ts_mov_b32 m0, %0" : "=&s"(sv) : "v"(g), "s"(lds_base) : "memory"); }
__device__ __forceinline__ void fs_kload2(bf16x8v* kf, const LAS unsigned char* kp, int d0) { kf[2 * d0] = *(const LAS bf16x8v*)(kp + d0 * 2048); kf[2 * d0 + 1] = *(const LAS bf16x8v*)(kp + d0 * 2048 + 512); }
__device__ __forceinline__ float fs_rowmax(const f32x16& p0, const f32x16& p1) {
    float a = FS_MX3(p0[0], p0[1], p1[0]), b = FS_MX3(p0[2], p0[3], p1[1]); a = FS_MX3(a, p1[2], p1[3]);
#pragma unroll
    for (int r = 4; r < 16; r += 4) { a = FS_MX3(a, p0[r], p0[r + 1]); b = FS_MX3(b, p0[r + 2], p0[r + 3]); a = FS_MX3(a, p1[r], p1[r + 1]); b = FS_MX3(b, p1[r + 2], p1[r + 3]); }
    return swap_max(__builtin_fmaxf(a, b)); }
__device__ __forceinline__ void fsub_stream(const bf16* zb, int zs4, int h, int Q0, int wid, int lane, LAS unsigned char* L, const bf16x8v (&qr)[4], float& m_io, float& l_io, f32x16 (&o)[2]) {
    const int r32 = lane & 31, hi = lane >> 5; const int NT = Q0 / 64 + 4, t = Q0 + wid * 32 + r32;
    constexpr int SLOTB = 8192, RK = FLS_WK, RV = FLS_WK + 3 * SLOTB;
    const unsigned lds0 = (unsigned)(size_t)L;
    size_t tilz = (size_t)64 * (size_t)zs4;
    const bf16* ksrc = zb + (size_t)lane * zs4 + ZC_KC + h * 64 + wid * 8;
    const bf16* vsrc = zb + (size_t)(16 * (wid & 3) + (lane >> 2)) * zs4 + ZC_VC + h * 64 + (wid >> 2) * 32 + (lane & 3) * 8;
    const unsigned kdst = lds0 + RK + wid * 1024, vdst = lds0 + RV + wid * 1024;
#define DMA_K(s_, slot) fs_glds16(ksrc + (size_t)(NT - 1 - (s_)) * tilz, (unsigned)__builtin_amdgcn_readfirstlane(kdst + (slot)))
#define DMA_V(s_, slot) fs_glds16(vsrc + (size_t)(NT - 1 - (s_)) * tilz, (unsigned)__builtin_amdgcn_readfirstlane(vdst + (slot)))
    const LAS unsigned char* vp0 = L + RV + ((lane >> 4) & 1) * 32 + (lane & 3) * 8 + (4 * hi + ((lane & 15) >> 2)) * 64;
    const LAS unsigned char* kp0 = L + RK + hi * 1024 + r32 * 16;
    const LAS float* tp = (const LAS float*)(L + FL_TAB) + (2047 - t + (NT - 1) * 64 + 4 * hi);
    DMA_K(0, 0); DMA_V(0, 0); DMA_K(1, SLOTB); DMA_K(2, 2 * SLOTB);
    float mhat = m_io, l_reg = l_io; bool resc = false; float fsc = 1.f;
    f32x16 pA0, pA1, pB0, pB1; bf16x8v kf[8]; s16x4 vlo[8], vhi[8]; v4u pw0, pw1, pw2, pw3;
    int sl_prev = 0, sl_cur = 0, sl_next = SLOTB;
#define ROT() do { sl_prev = sl_cur; sl_cur = sl_next; sl_next = (sl_next == 2 * SLOTB) ? 0 : sl_next + SLOTB; } while (0)
#define EX(v) __builtin_amdgcn_exp2f((v) + nmh)
#define RESC() do { if (resc) { o[0] *= fsc; o[1] *= fsc; } } while (0)
#define DECIDE(C0, C1) do { const float rm = fs_rowmax(C0, C1); const bool first = mhat < -1e29f; const bool cond = first ? (rm > -1e29f) : (rm - mhat > FS_THR); resc = false; \
        if (__builtin_expect(__any(cond), 0)) { const float nm = cond ? rm : mhat; fsc = (first || !cond) ? 1.f : __builtin_amdgcn_exp2f(mhat - nm); l_reg *= fsc; mhat = nm; resc = true; } } while (0)
#pragma unroll
    for (int r = 0; r < 16; ++r) { pA0[r] = tp[(r & 3) + 8 * (r >> 2)]; pA1[r] = tp[32 + (r & 3) + 8 * (r >> 2)]; }
    FS_WAIT_BAR(3);
#pragma unroll
    for (int d0 = 0; d0 < 4; ++d0) fs_kload2(kf, kp0, d0);
    pA0 = FS_MFMA(kf[0], qr[0], pA0); pA1 = FS_MFMA(kf[1], qr[0], pA1); pA0 = FS_MFMA(kf[2], qr[1], pA0); pA1 = FS_MFMA(kf[3], qr[1], pA1);
    pA0 = FS_MFMA(kf[4], qr[2], pA0); pA1 = FS_MFMA(kf[5], qr[2], pA1); pA0 = FS_MFMA(kf[6], qr[3], pA0); pA1 = FS_MFMA(kf[7], qr[3], pA1);
    { DECIDE(pA0, pA1); RESC(); const float nmh = -mhat;
#pragma unroll
      for (int r = 0; r < 16; ++r) { pA0[r] = EX(pA0[r]); pA1[r] = EX(pA1[r]); } }
    { const LAS float* tq = tp - 64;
#pragma unroll
      for (int r = 0; r < 16; ++r) { pB0[r] = tq[(r & 3) + 8 * (r >> 2)]; pB1[r] = tq[32 + (r & 3) + 8 * (r >> 2)]; } }
    FS_WAIT_BAR(0);
    DMA_K(3, 0); DMA_V(1, SLOTB); ROT();
#pragma unroll
    for (int d0 = 0; d0 < 4; ++d0) fs_kload2(kf, kp0 + sl_cur, d0);
    FS_WAIT_BAR(2);
#define PKW(P, i) cvtpk(P[i], P[i + 1])
#define PAF(k) __builtin_bit_cast(bf16x8v, pw##k)
#define VFR(i) (bf16x8v){vlo[i][0], vlo[i][1], vlo[i][2], vlo[i][3], vhi[i][0], vhi[i][1], vhi[i][2], vhi[i][3]}
#define VRD(i) do { vlo[i] = lds_tr(vp_ + (((i) >> 2) * 4096 + ((i) & 3) * 1024)); vhi[i] = lds_tr(vp_ + (((i) >> 2) * 4096 + ((i) & 3) * 1024 + 512)); } while (0)
#define KRD(G, d0) do { if (G) { fs_kload2(kf, kp0 + sl_next, d0); FS_SBAR(); } } while (0)
#define GAPA(MF, a0, a1, a2, a3, W0, W1, PW) do { MF; sacc += a0; sacc += a1; sacc += a2; sacc += a3; W0; W1; FS_PIN(PW); FS_PIN(sacc); FS_SBAR(); } while (0)
#define GAPB(MF, X, i, Y, j) do { MF; X[i] = EX(X[i]); X[i + 1] = EX(X[i + 1]); X[i + 2] = EX(X[i + 2]); X[i + 3] = EX(X[i + 3]); \
        Y[j] = tn_[((j) & 3) + 8 * ((j) >> 2)]; Y[j + 1] = tn_[((j + 1) & 3) + 8 * ((j + 1) >> 2)]; Y[j + 2] = tn_[((j + 2) & 3) + 8 * ((j + 2) >> 2)]; Y[j + 3] = tn_[((j + 3) & 3) + 8 * ((j + 3) >> 2)]; FS_PIN(X); FS_SBAR(); } while (0)
#define GAPB1(MF, X, i, Y, j) do { MF; X[i] = EX(X[i]); X[i + 1] = EX(X[i + 1]); X[i + 2] = EX(X[i + 2]); X[i + 3] = EX(X[i + 3]); \
        Y[j] = tn_[32 + ((j) & 3) + 8 * ((j) >> 2)]; Y[j + 1] = tn_[32 + ((j + 1) & 3) + 8 * ((j + 1) >> 2)]; Y[j + 2] = tn_[32 + ((j + 2) & 3) + 8 * ((j + 2) >> 2)]; Y[j + 3] = tn_[32 + ((j + 3) & 3) + 8 * ((j + 3) >> 2)]; FS_PIN(X); FS_SBAR(); } while (0)
#define STEP(C0, C1, P0, P1, s_, GK, GV, GL) do { FS_SBAR(); \
    const LAS unsigned char* vp_ = vp0 + sl_prev; const LAS float* tn_ = tp - 64 * ((s_) + 1); \
    VRD(0); FS_SBAR(); float sacc = P0[0] + P0[1]; \
                       GAPA(C0 = FS_MFMA(kf[0], qr[0], C0), P0[2], P0[3], P0[4], P0[5],     pw0[0] = PKW(P0, 0),  pw0[1] = PKW(P0, 2),  pw0); \
    VRD(4); FS_SBAR(); GAPA(C1 = FS_MFMA(kf[1], qr[0], C1), P0[6], P0[7], P0[8], P0[9],     pw0[2] = PKW(P0, 4),  pw0[3] = PKW(P0, 6),  pw0); \
    VRD(1); FS_SBAR(); GAPA(C0 = FS_MFMA(kf[2], qr[1], C0), P0[10], P0[11], P0[12], P0[13], pw1[0] = PKW(P0, 8),  pw1[1] = PKW(P0, 10), pw1); \
    VRD(5); FS_SBAR(); GAPA(C1 = FS_MFMA(kf[3], qr[1], C1), P0[14], P0[15], P1[0], P1[1],   pw1[2] = PKW(P0, 12), pw1[3] = PKW(P0, 14), pw1); \
    VRD(2); FS_SBAR(); GAPA(C0 = FS_MFMA(kf[4], qr[2], C0), P1[2], P1[3], P1[4], P1[5],     pw2[0] = PKW(P1, 0),  pw2[1] = PKW(P1, 2),  pw2); \
    VRD(6); FS_SBAR(); GAPA(C1 = FS_MFMA(kf[5], qr[2], C1), P1[6], P1[7], P1[8], P1[9],     pw2[2] = PKW(P1, 4),  pw2[3] = PKW(P1, 6),  pw2); \
    VRD(3); FS_SBAR(); GAPA(C0 = FS_MFMA(kf[6], qr[3], C0), P1[10], P1[11], P1[12], P1[13], pw3[0] = PKW(P1, 8),  pw3[1] = PKW(P1, 10), pw3); \
    VRD(7); FS_SBAR(); GAPA(C1 = FS_MFMA(kf[7], qr[3], C1), P1[14], P1[15], 0.f, 0.f,       pw3[2] = PKW(P1, 12), pw3[3] = PKW(P1, 14), pw3); \
    l_reg += sacc; \
    if (GK) DMA_K((s_) + 3, sl_cur); if (GV) DMA_V((s_) + 1, sl_next); \
    DECIDE(C0, C1); \
    const float nmh = -mhat; FS_SBAR(); \
    GAPB(o[0] = FS_MFMA(VFR(0), PAF(0), o[0]), C0, 0, P0, 0);               GAPB(o[1] = FS_MFMA(VFR(4), PAF(0), o[1]), C0, 4, P0, 4); \
    KRD(GL, 0); GAPB(o[0] = FS_MFMA(VFR(1), PAF(1), o[0]), C0, 8, P0, 8);   KRD(GL, 1); GAPB(o[1] = FS_MFMA(VFR(5), PAF(1), o[1]), C0, 12, P0, 12); \
    KRD(GL, 2); GAPB1(o[0] = FS_MFMA(VFR(2), PAF(2), o[0]), C1, 0, P1, 0);  KRD(GL, 3); GAPB1(o[1] = FS_MFMA(VFR(6), PAF(2), o[1]), C1, 4, P1, 4); \
    GAPB1(o[0] = FS_MFMA(VFR(3), PAF(3), o[0]), C1, 8, P1, 8);              GAPB1(o[1] = FS_MFMA(VFR(7), PAF(3), o[1]), C1, 12, P1, 12); \
    } while (0)
    int s = 1;
    for (; s + 5 < NT; s += 2) {
        STEP(pB0, pB1, pA0, pA1, s, true, true, true);     FS_WAIT_BAR(2); RESC(); ROT();
        STEP(pA0, pA1, pB0, pB1, s + 1, true, true, true); FS_WAIT_BAR(2); RESC(); ROT();
    }
#define ENDW(tt) do { if ((tt) + 3 < NT) { FS_WAIT_BAR(2); } else if ((tt) + 2 < NT) { FS_WAIT_BAR(1); } else { FS_WAIT_BAR(0); } } while (0)
    for (; s + 1 < NT; s += 2) {
        STEP(pB0, pB1, pA0, pA1, s, (s + 3 < NT), (s + 1 < NT), (s + 1 < NT));         ENDW(s);     RESC(); ROT();
        STEP(pA0, pA1, pB0, pB1, s + 1, (s + 4 < NT), (s + 2 < NT), (s + 2 < NT));     ENDW(s + 1); RESC(); ROT();
    }
    STEP(pB0, pB1, pA0, pA1, NT - 1, false, false, false); RESC();
    { float sacc = pB0[0] + pB0[1];
#pragma unroll
      for (int r = 2; r < 16; ++r) sacc += pB0[r];
#pragma unroll
      for (int r = 0; r < 16; ++r) sacc += pB1[r];
      l_reg += sacc;
      pw0 = (v4u){PKW(pB0, 0), PKW(pB0, 2), PKW(pB0, 4), PKW(pB0, 6)}; pw1 = (v4u){PKW(pB0, 8), PKW(pB0, 10), PKW(pB0, 12), PKW(pB0, 14)};
      pw2 = (v4u){PKW(pB1, 0), PKW(pB1, 2), PKW(pB1, 4), PKW(pB1, 6)}; pw3 = (v4u){PKW(pB1, 8), PKW(pB1, 10), PKW(pB1, 12), PKW(pB1, 14)};
      const LAS unsigned char* vp_ = vp0 + sl_cur;
#pragma unroll
      for (int i = 0; i < 8; ++i) VRD(i);
      o[0] = FS_MFMA(VFR(0), PAF(0), o[0]); o[1] = FS_MFMA(VFR(4), PAF(0), o[1]); o[0] = FS_MFMA(VFR(1), PAF(1), o[0]); o[1] = FS_MFMA(VFR(5), PAF(1), o[1]);
      o[0] = FS_MFMA(VFR(2), PAF(2), o[0]); o[1] = FS_MFMA(VFR(6), PAF(2), o[1]); o[0] = FS_MFMA(VFR(3), PAF(3), o[0]); o[1] = FS_MFMA(VFR(7), PAF(3), o[1]); }
    m_io = mhat; l_io = l_reg;
    asm volatile("s_waitcnt lgkmcnt(0)\n\ts_barrier" ::: "memory");
#undef DMA_K
#undef DMA_V
#undef ROT
#undef EX
#undef RESC
#undef DECIDE
#undef PKW
#undef PAF
#undef VFR
#undef VRD
#undef KRD
#undef ENDW
#undef GAPA
#undef GAPB
#undef GAPB1
#undef STEP
}

__device__ __forceinline__ void flash_unit_sub(const bf16* Z, bf16* MIX, LAS unsigned char* L, int b, int h, int res, int qb, int wave) {
    const int lane = lane_now(), tid = wave * 64 + lane;
    constexpr int KS = 4, CQ = ZC_QC, CK = ZC_KC, CV = ZC_VC;
    const int r32 = lane & 31, hi = lane >> 5;
    LAS unsigned char* Kb = L + FL_K; LAS unsigned char* Vb = L + FL_V; LAS float* tab = (LAS float*)(L + FL_TAB); LAS float* tabw = (LAS float*)(L + FLS_TABW);
    const int Q0 = qb * 256, tq0 = Q0 + wave * 32, t = tq0 + r32;
    const bf16* zb = Z + (size_t)(b * SEQ + res) * ZC;
    int zs4 = 4 * ZC; asm volatile("" : "+s"(zs4));
    const float sl = __builtin_amdgcn_exp2f(-(float)(h + 1)) * LOG2E;
    v4u wk[5], wv[5];
#define FLS_WLOAD(RES2) do { const bf16* zw = Z + (size_t)(b * SEQ + (RES2)) * ZC + h * 64; \
        _Pragma("unroll") for (int i = 0; i < 5; ++i) { int idx = tid + 512 * i; idx = idx < 2304 ? idx : 2303; const int rho = idx >> 3, c = idx & 7, k = Q0 - 32 + rho, kc = k < 0 ? 0 : k; \
            const bf16* p = zw + (size_t)kc * zs4 + c * 8; const v4u a = *(const v4u*)(p + CK), bq = *(const v4u*)(p + CV); const unsigned msk = k < 0 ? 0u : 0xffffffffu; \
            wk[i].x = a.x & msk; wk[i].y = a.y & msk; wk[i].z = a.z & msk; wk[i].w = a.w & msk; wv[i].x = bq.x & msk; wv[i].y = bq.y & msk; wv[i].z = bq.z & msk; wv[i].w = bq.w & msk; } } while (0)
#define FLS_WSTORE() do { \
        _Pragma("unroll") for (int i = 0; i < 5; ++i) { int idx = tid + 512 * i; idx = idx < 2304 ? idx : 2303; const int rho = idx >> 3, c = idx & 7, blk = rho >> 5, kk = rho & 31; \
            *(LAS v4u*)(L + FLS_WK + blk * 4096 + (c >> 1) * 1024 + (c & 1) * 512 + kk * 16) = wk[i]; \
            *(LAS v4u*)(L + FLS_WV + blk * 4096 + (c >> 2) * 2048 + (kk >> 3) * 512 + (kk & 7) * 64 + (c & 3) * 16) = wv[i]; } } while (0)
    FLS_WLOAD((res + 1) & 3);
    for (int j = tid; j < FLS_TABN; j += NWAVES * 64) { const int e = 2047 - j; const int mult = (e <= 32 ? 1 : 0) + (e <= 128 ? 1 : 0) + ((e & 3) == 0 ? 1 : 0);
        tab[j] = (e < 0 || mult == 0) ? -INFINITY : -sl * (float)(4 * e) + (mult == 1 ? 0.f : (mult == 2 ? 1.f : 1.5849625007211562f)); }
    if (tid < 3 * 96) { const int w3 = tid / 96, i = tid % 96, res2 = (res + 1 + w3) & 3, d = 4 * (63 - i) + (res - res2);
        tabw[tid] = (d >= 0 && d <= 128) ? -sl * (float)d : -INFINITY; }
    bf16x8v qf[KS];
#pragma unroll
    for (int ks = 0; ks < KS; ++ks) qf[ks] = *(const bf16x8v*)(zb + (size_t)t * zs4 + CQ + h * 64 + ks * 16 + hi * 8);
    float m = -1e30f, l = 0.f; f32x16 o[2];
#pragma unroll
    for (int r = 0; r < 16; ++r) { o[0][r] = 0.f; o[1][r] = 0.f; }
    const int krd = hi * 1024 + r32 * 16;
    const int vrd = ((lane >> 4) & 1) * 32 + (lane & 3) * 8 + (4 * hi + ((lane & 15) >> 2)) * 64;
#pragma unroll
    for (int w3 = 0; w3 < 3; ++w3) {
        FLS_WSTORE();
        __syncthreads();
        if (w3 < 2) FLS_WLOAD((res + 2 + w3) & 3);
        { const LAS float* tp = tabw + w3 * 96 + (31 - r32 + 4 * hi);
          const LAS float* tp0 = tq0 == 0 ? (const LAS float*)tab + 2048 + 4 * hi : tp;
          f32x16 p0, p1;
#pragma unroll
          for (int r = 0; r < 16; ++r) { p0[r] = tp0[(r & 3) + 8 * (r >> 2)]; p1[r] = tp[32 + (r & 3) + 8 * (r >> 2)]; }
          const LAS unsigned char* K0 = L + FLS_WK + wave * 4096 + hi * 512 + r32 * 16;
#pragma unroll
          for (int ks = 0; ks < KS; ++ks) { const bf16x8v kf0 = *(const LAS bf16x8v*)(K0 + ks * 1024), kf1 = *(const LAS bf16x8v*)(K0 + 4096 + ks * 1024);
              p0 = __builtin_amdgcn_mfma_f32_32x32x16_bf16(kf0, qf[ks], p0, 0, 0, 0); p1 = __builtin_amdgcn_mfma_f32_32x32x16_bf16(kf1, qf[ks], p1, 0, 0, 0); }
          bf16x8v pf[4];
          fl_softmax3(p0, p1, 0.f, 0.f, m, l, o, pf);
#pragma unroll
          for (int s4 = 0; s4 < 4; ++s4)
#pragma unroll
              for (int db = 0; db < 2; ++db) { const LAS unsigned char* vp = L + FLS_WV + (wave + (s4 >> 1)) * 4096 + db * 2048 + (s4 & 1) * 1024 + vrd;
                  const s16x4 lo = lds_tr(vp), hh = lds_tr(vp + 512);
                  const bf16x8v vf = (bf16x8v){lo[0], lo[1], lo[2], lo[3], hh[0], hh[1], hh[2], hh[3]};
                  o[db] = __builtin_amdgcn_mfma_f32_32x32x16_bf16(vf, pf[s4], o[db], 0, 0, 0); } }
        __syncthreads();
    }
#undef FLS_WLOAD
#undef FLS_WSTORE
#if FSUB_STREAM
    fsub_stream(zb, zs4, h, Q0, wave, lane, L, qf, m, l, o);
#else
    const int skey = tid >> 3, sc = tid & 7;
    const bf16* ksrc = zb + (size_t)skey * zs4 + CK + h * 64 + sc * 8;
    const bf16* vsrc = zb + (size_t)skey * zs4 + CV + h * 64 + sc * 8;
    const int kdst = (sc >> 1) * 2048 + (sc & 1) * 1024 + (skey >> 5) * 512 + (skey & 31) * 16;
    const int vdst = (sc >> 2) * 4096 + (skey >> 3) * 512 + (skey & 7) * 64 + (sc & 3) * 16;
    int tilz = 64 * 4 * ZC; asm volatile("" : "+s"(tilz));
    int jt = Q0 / 64 + 3;
    v4u kA = *(const v4u*)(ksrc + (size_t)jt * tilz), vA = *(const v4u*)(vsrc + (size_t)jt * tilz);
    v4u kB = *(const v4u*)(ksrc + (size_t)(jt - 1) * tilz), vB = *(const v4u*)(vsrc + (size_t)(jt - 1) * tilz);
    *(LAS v4u*)(Kb + (jt & 1) * 8192 + kdst) = kA; *(LAS v4u*)(Vb + (jt & 1) * 8192 + vdst) = vA;
    __syncthreads();
#define FLS_TILE(JT, KW, VW, KL, VL) do { const int jt_ = (JT); \
        if (jt_ >= 2) { KL = *(const v4u*)(ksrc + (size_t)(jt_ - 2) * tilz); VL = *(const v4u*)(vsrc + (size_t)(jt_ - 2) * tilz); } \
        const LAS unsigned char* Kc = Kb + (jt_ & 1) * 8192; const LAS unsigned char* Vc = Vb + (jt_ & 1) * 8192; \
        if (jt_ * 64 <= tq0) { \
            const LAS float* tp = tab + (2047 - t + jt_ * 64 + 4 * hi); \
            f32x16 p0, p1; \
            _Pragma("unroll") for (int r = 0; r < 16; ++r) { p0[r] = tp[(r & 3) + 8 * (r >> 2)]; p1[r] = tp[32 + (r & 3) + 8 * (r >> 2)]; } \
            _Pragma("unroll") for (int ks = 0; ks < KS; ++ks) { const bf16x8v kf0 = *(const LAS bf16x8v*)(Kc + ks * 2048 + krd), kf1 = *(const LAS bf16x8v*)(Kc + ks * 2048 + 512 + krd); \
                p0 = __builtin_amdgcn_mfma_f32_32x32x16_bf16(kf0, qf[ks], p0, 0, 0, 0); p1 = __builtin_amdgcn_mfma_f32_32x32x16_bf16(kf1, qf[ks], p1, 0, 0, 0); } \
            bf16x8v pf[4]; \
            fl_softmax3(p0, p1, 0.f, 0.f, m, l, o, pf); \
            _Pragma("unroll") for (int s4 = 0; s4 < 4; ++s4) _Pragma("unroll") for (int db = 0; db < 2; ++db) { const LAS unsigned char* vp = Vc + db * 4096 + s4 * 1024 + vrd; \
                    const s16x4 lo = lds_tr(vp), hh = lds_tr(vp + 512); \
                    const bf16x8v vf = (bf16x8v){lo[0], lo[1], lo[2], lo[3], hh[0], hh[1], hh[2], hh[3]}; \
                    o[db] = __builtin_amdgcn_mfma_f32_32x32x16_bf16(vf, pf[s4], o[db], 0, 0, 0); } \
        } \
        if (jt_ >= 1) { *(LAS v4u*)(Kb + ((jt_ - 1) & 1) * 8192 + kdst) = KW; *(LAS v4u*)(Vb + ((jt_ - 1) & 1) * 8192 + vdst) = VW; } \
        __syncthreads(); } while (0)
    for (; jt >= 0; jt -= 2) { FLS_TILE(jt, kB, vB, kA, vA); FLS_TILE(jt - 1, kA, vA, kB, vB); }
#undef FLS_TILE
#endif
    const size_t orow = (size_t)(b * SEQ + 4 * t + res) * DM + 512 + h * 64 + 4 * hi;
    const float i0 = 1.f / swap_sum(l);
    o[0] *= i0; o[1] *= i0; mix_store_head(MIX, orow, hi, o[0], o[1]);
}
__device__ __forceinline__ void flash_phase_sub(const bf16* Z, bf16* MIX, LAS unsigned char* L, int vcu, int G, int wave) {
    constexpr int NITEM = BATCH * 8 * 4;
    for (int p = vcu; p < NITEM; p += G) {
        const int b = p >> 5, h = (p >> 2) & 7, res = p & 3;
#pragma unroll 1
        for (int k = 0; k < 2; ++k) { flash_unit_sub(Z, MIX, L, b, h, res, 1 - k, wave); __syncthreads(); }
    }
}
constexpr int FB3_V = 49152;
static_assert(FL_TAB + FL_TABN * 4 <= FB3_V && FB3_V + 3 * 8192 <= RING_BYTES, "mixer B (out-of-phase) LDS map");
template <bool late> __device__ __forceinline__ void flash_unit_b3(const bf16* Z, bf16* MIX, LAS unsigned char* L, int b, int h, int qb, float lam_full, float oml, const float* subg, int wave) {
    const int lane = lane_now(), tid = wave * 64 + lane;
    constexpr int KS = 2, CQ = ZC_QB, CK = ZC_KB, CV = ZC_VB;
    const int r32 = lane & 31, hi = lane >> 5;
    LAS unsigned char* Kb = L + FL_K; LAS unsigned char* Vb = L + FB3_V; LAS float* tab = (LAS float*)(L + FL_TAB);
    const int Q0 = qb * 256, tq0 = Q0 + wave * 32, t = tq0 + r32;
    const bf16* zb = Z + (size_t)(b * SEQ) * ZC;
    const float sl = __builtin_amdgcn_exp2f(-2.f * (float)(h + 1)) * LOG2E;
    for (int j = tid; j < FL_TABN; j += NWAVES * 64) { const int d = 2047 - j; tab[j] = d < 0 ? -INFINITY : -sl * (float)d; }
    bf16x8v qf[2][KS];
#pragma unroll
    for (int mp = 0; mp < 2; ++mp)
#pragma unroll
        for (int ks = 0; ks < KS; ++ks) qf[mp][ks] = *(const bf16x8v*)(zb + (size_t)t * ZC + CQ + h * 64 + (mp * KS + ks) * 16 + hi * 8);
    float m[2], l[2]; f32x16 o[2][2];
#pragma unroll
    for (int mp = 0; mp < 2; ++mp) { m[mp] = -1e30f; l[mp] = 0.f;
#pragma unroll
        for (int r = 0; r < 16; ++r) { o[mp][0][r] = 0.f; o[mp][1][r] = 0.f; } }
    const int skey = tid >> 3, sc = tid & 7;
    const bf16* ksrc = zb + (size_t)skey * ZC + CK + h * 64 + sc * 8;
    const bf16* vsrc = zb + (size_t)skey * ZC + CV + h * 64 + sc * 8;
    const int kdst = (sc >> 1) * 2048 + (sc & 1) * 1024 + (skey >> 5) * 512 + (skey & 31) * 16;
    const int vdst = (sc >> 2) * 4096 + (skey >> 3) * 512 + (skey & 7) * 64 + (sc & 3) * 16;
    const int krd = hi * 1024 + r32 * 16;
    const int vrd = ((lane >> 4) & 1) * 32 + (lane & 3) * 8 + (4 * hi + ((lane & 15) >> 2)) * 64;
    int tilz = 64 * ZC; asm volatile("" : "+s"(tilz));
    int jt = Q0 / 64 + 3;
    v4u kA = *(const v4u*)(ksrc + (size_t)(jt * tilz)), vA = *(const v4u*)(vsrc + (size_t)(jt * tilz));
    v4u kB = *(const v4u*)(ksrc + (size_t)((jt - 1) * tilz)), vB = *(const v4u*)(vsrc + (size_t)((jt - 1) * tilz));
    *(LAS v4u*)(Kb + (jt & 1) * 8192 + kdst) = kA; *(LAS v4u*)(Vb + (jt % 3) * 8192 + vdst) = vA;
    __syncthreads();
    bf16x8v pq[2][4];
    int pend = -1;
#define FB3_PV1(VS, MP) do { const LAS unsigned char* Vc = Vb + (VS) * 8192; \
        _Pragma("unroll") for (int s4 = 0; s4 < 4; ++s4) _Pragma("unroll") for (int db = 0; db < 2; ++db) { const LAS unsigned char* vp = Vc + db * 4096 + s4 * 1024 + vrd; \
                const s16x4 lo = lds_tr(vp), hh = lds_tr(vp + 512); \
                const bf16x8v vf = (bf16x8v){lo[0], lo[1], lo[2], lo[3], hh[0], hh[1], hh[2], hh[3]}; \
                o[MP][db] = __builtin_amdgcn_mfma_f32_32x32x16_bf16(vf, pq[MP][s4], o[MP][db], 0, 0, 0); } } while (0)
#define FB3_PV2(VS) do { const LAS unsigned char* Vc = Vb + (VS) * 8192; \
          \
        s16x4 vl_[8], vh_[8]; \
        _Pragma("unroll") for (int i = 0; i < 8; ++i) { const LAS unsigned char* vp = Vc + (i >> 2) * 4096 + (i & 3) * 1024 + vrd; vl_[i] = lds_tr(vp); vh_[i] = lds_tr(vp + 512); } \
        _Pragma("unroll") for (int s4 = 0; s4 < 4; ++s4) _Pragma("unroll") for (int db = 0; db < 2; ++db) { const int i = db * 4 + s4; \
                const bf16x8v vf = (bf16x8v){vl_[i][0], vl_[i][1], vl_[i][2], vl_[i][3], vh_[i][0], vh_[i][1], vh_[i][2], vh_[i][3]}; \
                o[0][db] = __builtin_amdgcn_mfma_f32_32x32x16_bf16(vf, pq[0][s4], o[0][db], 0, 0, 0); o[1][db] = __builtin_amdgcn_mfma_f32_32x32x16_bf16(vf, pq[1][s4], o[1][db], 0, 0, 0); } } while (0)
#define FB3_QS(MP) do { f32x16 p0 = bias0, p1 = bias1; \
        _Pragma("unroll") for (int ks = 0; ks < KS; ++ks) { const bf16x8v kf0 = *(const LAS bf16x8v*)(Kc + ((MP) * KS + ks) * 2048 + krd), kf1 = *(const LAS bf16x8v*)(Kc + ((MP) * KS + ks) * 2048 + 512 + krd); \
            p0 = __builtin_amdgcn_mfma_f32_32x32x16_bf16(kf0, qf[MP][ks], p0, 0, 0, 0); p1 = __builtin_amdgcn_mfma_f32_32x32x16_bf16(kf1, qf[MP][ks], p1, 0, 0, 0); } \
        fl_softmax3(p0, p1, 0.f, 0.f, m[MP], l[MP], o[MP], pq[MP]); } while (0)
#define FB3_TILE(JT, KW, VW, KL, VL) do { const int jt_ = (JT); \
        if (jt_ >= 2) { KL = *(const v4u*)(ksrc + (size_t)((jt_ - 2) * tilz)); VL = *(const v4u*)(vsrc + (size_t)((jt_ - 2) * tilz)); } \
        const LAS unsigned char* Kc = Kb + (jt_ & 1) * 8192; \
        const int pv_ = pend; \
        if (late && pv_ >= 0 && !(jt_ * 64 <= tq0)) { FB3_PV1(pv_ % 3, 0); FB3_PV1(pv_ % 3, 1); pend = -1; }     \
        if (jt_ * 64 <= tq0) {                                            \
            const LAS float* tp = tab + (2047 - t + jt_ * 64 + 4 * hi); \
            f32x16 bias0, bias1; \
            _Pragma("unroll") for (int r = 0; r < 16; ++r) { bias0[r] = tp[(r & 3) + 8 * (r >> 2)]; bias1[r] = tp[32 + (r & 3) + 8 * (r >> 2)]; } \
            if (late) { if (pv_ >= 0) { FB3_PV1(pv_ % 3, 0); FB3_PV1(pv_ % 3, 1); } FB3_QS(0); FB3_QS(1); pend = jt_; } \
            else { FB3_QS(0); FB3_PV1(jt_ % 3, 0); FB3_QS(1); FB3_PV1(jt_ % 3, 1); } \
        } \
        if (jt_ >= 1) { *(LAS v4u*)(Kb + ((jt_ - 1) & 1) * 8192 + kdst) = KW; *(LAS v4u*)(Vb + ((jt_ - 1) % 3) * 8192 + vdst) = VW; } \
        __syncthreads(); } while (0)
    for (; jt >= 0; jt -= 2) { FB3_TILE(jt, kB, vB, kA, vA); FB3_TILE(jt - 1, kA, vA, kB, vB); }
    if (late && pend >= 0) { FB3_PV1(pend % 3, 0); FB3_PV1(pend % 3, 1); }
#undef FB3_TILE
#undef FB3_PV1
#undef FB3_PV2
#undef FB3_QS
    const size_t orow = (size_t)(b * SEQ + t) * DM + 256 + h * 64 + 4 * hi;
    const float i0 = 1.f / swap_sum(l[0]), i1 = lam_full / swap_sum(l[1]); float ss = 0.f;
#pragma unroll
    for (int db = 0; db < 2; ++db)
#pragma unroll
        for (int r = 0; r < 16; ++r) { const float v = o[0][db][r] * i0 - o[1][db][r] * i1; o[0][db][r] = v; ss += v * v; }
    const float rs = (1.f / sqrtf(swap_sum(ss) * (1.f / 64.f) + LN_EPS)) * oml;
#pragma unroll
    for (int db = 0; db < 2; ++db)
#pragma unroll
        for (int rg = 0; rg < 4; ++rg) { const f32x4 g = *(const f32x4*)(subg + 32 * db + 8 * rg + 4 * hi);
            o[0][db][4 * rg + 0] *= rs * g.x; o[0][db][4 * rg + 1] *= rs * g.y; o[0][db][4 * rg + 2] *= rs * g.z; o[0][db][4 * rg + 3] *= rs * g.w; }
    mix_store_head(MIX, orow, hi, o[0][0], o[0][1]);
}
__device__ __forceinline__ void flash_phase_b3(const bf16* Z, bf16* MIX, LAS unsigned char* L, const float* lam, const float* subg, float lambda_init, int vcu, int G, int wave) {
    const int lane = lane_now();
    constexpr int NPAIR = BATCH * 4 * 4;
    const int li = lane & 31; const float s01 = wave_sum(lam[li] * lam[32 + li], lane) * 0.5f, s23 = wave_sum(lam[64 + li] * lam[96 + li], lane) * 0.5f;
    const float lam_full = __int_as_float(__builtin_amdgcn_readfirstlane(__float_as_int(expf(s01) - expf(s23) + lambda_init)));
    const float oml = __int_as_float(__builtin_amdgcn_readfirstlane(__float_as_int(1.f - lambda_init)));
    for (int p = vcu; p < NPAIR; p += G) {
        const int b = p >> 4, h = (p >> 2) & 3, x = p & 3;
#pragma unroll 1
        for (int k = 0; k < 2; ++k) { if (wave >= 4) flash_unit_b3<true>(Z, MIX, L, b, h, k == 0 ? 7 - x : x, lam_full, oml, subg, wave); else flash_unit_b3<false>(Z, MIX, L, b, h, k == 0 ? 7 - x : x, lam_full, oml, subg, wave);
            __syncthreads(); }
    }
}
constexpr int MA_K = 0, MA_V = 32768, MA_BM = 65536, MA_BMS = 68  , MA_WQ = MA_BM + 32 * MA_BMS * 4, MA_MG = MA_WQ + 512, MA_SEL = MA_MG + 4 * 34 * 64 * 4, MA_END = MA_SEL + NWAVES * 2560;
static_assert(MA_END <= RING_BYTES, "mixer A LDS map");

__device__ __forceinline__ unsigned ordkey(float f) { const unsigned u = __float_as_uint(f); return u ^ ((unsigned)((int)u >> 31) | 0x80000000u); }
#define DPP_I(v, ctrl) __builtin_amdgcn_update_dpp(0, (v), (ctrl), 0xf, 0xf, false)
__device__ __forceinline__ float wave_max_dpp(float v) {
    v = fmaxf(v, __int_as_float(DPP_I(__float_as_int(v), 0xB1))); v = fmaxf(v, __int_as_float(DPP_I(__float_as_int(v), 0x4E)));
    v = fmaxf(v, __int_as_float(DPP_I(__float_as_int(v), 0x141))); v = fmaxf(v, __int_as_float(DPP_I(__float_as_int(v), 0x140)));
    const int i = __float_as_int(v);
    return fmaxf(fmaxf(__int_as_float(__builtin_amdgcn_readlane(i, 0)), __int_as_float(__builtin_amdgcn_readlane(i, 16))), fmaxf(__int_as_float(__builtin_amdgcn_readlane(i, 32)), __int_as_float(__builtin_amdgcn_readlane(i, 48))));
}
__device__ __forceinline__ float wave_min_dpp(float v) {
    v = fminf(v, __int_as_float(DPP_I(__float_as_int(v), 0xB1))); v = fminf(v, __int_as_float(DPP_I(__float_as_int(v), 0x4E)));
    v = fminf(v, __int_as_float(DPP_I(__float_as_int(v), 0x141))); v = fminf(v, __int_as_float(DPP_I(__float_as_int(v), 0x140)));
    const int i = __float_as_int(v);
    return fminf(fminf(__int_as_float(__builtin_amdgcn_readlane(i, 0)), __int_as_float(__builtin_amdgcn_readlane(i, 16))), fminf(__int_as_float(__builtin_amdgcn_readlane(i, 32)), __int_as_float(__builtin_amdgcn_readlane(i, 48))));
}
__device__ __forceinline__ int wave_prefix_dpp(int x, int lane) {
    x += DPP_I(x, 0x111); x += DPP_I(x, 0x112); x += DPP_I(x, 0x114); x += DPP_I(x, 0x118);
    const int t0 = __builtin_amdgcn_readlane(x, 15), t1 = __builtin_amdgcn_readlane(x, 31), t2 = __builtin_amdgcn_readlane(x, 47);
    return x + (lane >= 16 ? t0 : 0) + (lane >= 32 ? t1 : 0) + (lane >= 48 ? t2 : 0);
}
template <int NJ> __device__ __forceinline__ void select_load(const float* srow, int t, int lane, float (&raw)[NJ]) {
#pragma unroll
    for (int j = 0; j < NJ; ++j) { const int kx = 64 * j + lane; raw[j] = srow[kx < t ? kx : t]; }
}
template <int NJ> __device__ __forceinline__ unsigned select_row_t(const float (&raw)[NJ], int t, LAS unsigned* hist, LAS unsigned* clist, int lane) {
    float f[NJ]; int bn[NJ];
    float NINF = -INFINITY, PINF = INFINITY; int C255 = 255; asm volatile("" : "+v"(NINF), "+v"(PINF), "+v"(C255));
    float vmax = NINF, vmin = PINF;
#pragma unroll
    for (int j = 0; j < NJ; ++j) { const int kx = 64 * j + lane; const float v = raw[j] + 0.0f; const bool ok = kx <= t; f[j] = ok ? v : NINF; vmax = fmaxf(vmax, f[j]); vmin = fminf(vmin, ok ? v : PINF); }
    vmax = wave_max_dpp(vmax); vmin = wave_min_dpp(vmin);
    const float scale = 255.99f / (vmax - vmin);
    { unsigned z_ = 0u; asm volatile("" : "+v"(z_)); ((LAS v4u*)hist)[lane] = (v4u){z_, z_, z_, z_}; }
#pragma unroll
    for (int j = 0; j < NJ; ++j) { int bi = (int)((f[j] - vmin) * scale); bi = bi > C255 ? C255 : bi; bi = bi < 0 ? 0 : bi; bn[j] = (64 * j + lane <= t) ? bi : -1;
        if (bn[j] >= 0) __hip_atomic_fetch_add(hist + bn[j], 1u, __ATOMIC_RELAXED, __HIP_MEMORY_SCOPE_WAVEFRONT); }
    LDS_WAIT();
    const v4u hv = ((const LAS v4u*)hist)[63 - lane];
    const int ssum = (int)(hv.x + hv.y + hv.z + hv.w);
    const int x = wave_prefix_dpp(ssum, lane);
    const int above = x - ssum; const bool found = above < 256 && x >= 256;
    int bsel, cab;
    { const int c3 = above + (int)hv.w, c2 = c3 + (int)hv.z, c1 = c2 + (int)hv.y; const int b0 = 4 * (63 - lane);
      if (c3 >= 256) { bsel = b0 + 3; cab = above; } else if (c2 >= 256) { bsel = b0 + 2; cab = c3; } else if (c1 >= 256) { bsel = b0 + 1; cab = c2; } else { bsel = b0; cab = c1; } }
    const unsigned long long fm = __ballot(found);
    const int src = (int)__builtin_ctzll(fm);
    const int bstar = __builtin_amdgcn_readlane(bsel, src), c_above = __builtin_amdgcn_readlane(cab, src);
    unsigned key[NJ];
#pragma unroll
    for (int j = 0; j < NJ; ++j) key[j] = ordkey(f[j]);
    int base = 0;
#pragma unroll
    for (int j = 0; j < NJ; ++j) { const bool isc = bn[j] == bstar; const unsigned long long cm = __ballot(isc); const int pos = base + mbcnt64(cm);
        clist[(isc && pos < 256) ? pos : 256 + lane] = key[j]; base += __popcll(cm); }
    LDS_WAIT();
    const int ncand = base, need = 256 - c_above;
    unsigned T = 0u; int cge;
    if (ncand <= 64) {
        const unsigned ck = lane < ncand ? clist[lane] : 0u;
        int g = 0, e = 0;
#pragma unroll 1
        for (int i = 0; i < ncand; ++i) { const unsigned sk = (unsigned)__builtin_amdgcn_readlane((int)ck, i); g += (sk > ck) ? 1 : 0; e += (sk == ck) ? 1 : 0; }
        const unsigned long long hit = __ballot(lane < ncand && g < need && need <= g + e);
        const int src2 = (int)__builtin_ctzll(hit);
        T = (unsigned)__builtin_amdgcn_readlane((int)ck, src2);
        cge = c_above + __builtin_amdgcn_readlane(g, src2) + __builtin_amdgcn_readlane(e, src2);
    } else if (ncand <= 256) {
        unsigned ck[4];
#pragma unroll
        for (int r = 0; r < 4; ++r) ck[r] = (r * 64 + lane < ncand) ? clist[r * 64 + lane] : 0u;
#pragma unroll 1
        for (int bit = 31; bit >= 0; --bit) { const unsigned cand = T | (1u << bit);
            const int cnt = __popcll(__ballot(ck[0] >= cand)) + __popcll(__ballot(ck[1] >= cand)) + __popcll(__ballot(ck[2] >= cand)) + __popcll(__ballot(ck[3] >= cand));
            if (cnt >= need) T = cand; }
        cge = c_above + __popcll(__ballot(ck[0] >= T)) + __popcll(__ballot(ck[1] >= T)) + __popcll(__ballot(ck[2] >= T)) + __popcll(__ballot(ck[3] >= T));
    } else {
#pragma unroll 1
        for (int bit = 31; bit >= 0; --bit) { const unsigned cand = T | (1u << bit); int cnt = 0;
#pragma unroll
            for (int j = 0; j < NJ; ++j) cnt += __popcll(__ballot(key[j] >= cand));
            if (cnt >= 256) T = cand; }
        cge = 0;
#pragma unroll
        for (int j = 0; j < NJ; ++j) cge += __popcll(__ballot(key[j] >= T));
    }
    unsigned w = 0u;
    if (cge == 256) {
#pragma unroll
        for (int j = NJ - 1; j >= 0; --j) w = w + w + (key[j] >= T ? 1u : 0u);
    } else {
        int cgt = 0;
#pragma unroll
        for (int j = 0; j < NJ; ++j) cgt += __popcll(__ballot(key[j] > T));
        const int need2 = 256 - cgt; int eqseen = 0;
#pragma unroll
        for (int j = 0; j < NJ; ++j) { const bool gt = key[j] > T, eq = key[j] == T; const unsigned long long em = __ballot(eq); const int er = eqseen + mbcnt64(em);
            w |= (gt || (eq && er < need2)) ? (1u << j) : 0u; eqseen += __popcll(em); }
    }
    return w;
}
constexpr int MB_K = 0, MB_V = 32768, MB_BM = 65536, MB_WQ = MB_BM + 64 * MA_BMS * 4, MB_SEL = MB_WQ + 1024, MB_END = MB_SEL + NWAVES * 2560;
static_assert(MB_END <= RING_BYTES, "mixer A (64-query units) LDS map");
template <int NJ> __device__ __forceinline__ void select8_t(const float* scr0, int t0, LAS unsigned* hist, LAS unsigned* clist, LAS unsigned* bmrow0, int lane) {
    float cur[NJ], nxt[NJ];
    select_load<NJ>(scr0, t0, lane, cur);
#pragma unroll 1
    for (int i = 0; i < 8; ++i) {
        const int t = t0 + i;
        if (i < 7) select_load<NJ>(scr0 + (size_t)(i + 1) * 2048, t + 1, lane, nxt);
        unsigned w;
        if (t < 256) { const int n = t + 1, nf = n >> 6; w = ((1u << nf) - 1u) | ((lane < (n & 63)) ? (1u << nf) : 0u); }
        else w = select_row_t<NJ>(cur, t, hist, clist, lane);
        bmrow0[i * MA_BMS + lane] = w;
#pragma unroll
        for (int j = 0; j < NJ; ++j) cur[j] = nxt[j];
    }
}
__device__ __forceinline__ void mixa_unit64(const bf16* Z, bf16* MIX, float* SCR, LAS unsigned char* L, int b, int qt64, int wave) {
    int lane = lane_now(), tid = wave * 64 + lane;
    int r32 = lane & 31, hi = lane >> 5; const int T0 = qt64 * 64;
    const bf16* zb = Z + (size_t)(b * SEQ) * ZC;
    LAS unsigned* bm = (LAS unsigned*)(L + MB_BM); LAS float* wq = (LAS float*)(L + MB_WQ);
    if (tid < 256) wq[tid] = bf1(zb[(size_t)(T0 + (tid >> 2)) * ZC + ZC_WI + (tid & 3)]);
    __syncthreads();
#ifndef REP_AIDX
#define REP_AIDX 1
#endif
#pragma unroll 1
    for (int half_ = 0; half_ < 2 * REP_AIDX; ++half_) { const int half = half_ & 1;
        const int Th = T0 + 32 * half;
        bf16x8v qi[4][4];
#pragma unroll
        for (int mt = 0; mt < 4; ++mt)
#pragma unroll
            for (int ks = 0; ks < 4; ++ks) qi[mt][ks] = *(const bf16x8v*)(zb + (size_t)(Th + 8 * mt + (r32 >> 2)) * ZC + ZC_QI + (r32 & 3) * 64 + ks * 16 + hi * 8);
        const int nkt = (Th >> 5) + 1;
        bf16x8v kn[4];
        if (wave < nkt) { const bf16* kr0 = zb + (size_t)(wave * 32 + r32) * ZC + ZC_KI + hi * 8;
#pragma unroll
            for (int ks = 0; ks < 4; ++ks) kn[ks] = *(const bf16x8v*)(kr0 + ks * 16); }
        for (int kt = wave; kt < nkt; kt += NWAVES) {
            const int key = kt * 32 + r32;
            bf16x8v kf[4];
#pragma unroll
            for (int ks = 0; ks < 4; ++ks) kf[ks] = kn[ks];
            if (kt + NWAVES < nkt) { const bf16* kr1 = zb + (size_t)((kt + NWAVES) * 32 + r32) * ZC + ZC_KI + hi * 8;
#pragma unroll
                for (int ks = 0; ks < 4; ++ks) kn[ks] = *(const bf16x8v*)(kr1 + ks * 16); }
#pragma unroll
            for (int mt = 0; mt < 4; ++mt) {
                f32x16 d;
#pragma unroll
                for (int r = 0; r < 16; ++r) d[r] = 0.f;
#pragma unroll
                for (int ks = 0; ks < 4; ++ks) d = __builtin_amdgcn_mfma_f32_32x32x16_bf16(qi[mt][ks], kf[ks], d, 0, 0, 0);
#pragma unroll
                for (int g = 0; g < 4; ++g) { const int q = 32 * half + 8 * mt + 2 * g + hi; const f32x4 w = *(const LAS f32x4*)(wq + 4 * q);
                    float s = fmaxf(d[4 * g + 0], 0.f) * w.x + fmaxf(d[4 * g + 1], 0.f) * w.y + fmaxf(d[4 * g + 2], 0.f) * w.z + fmaxf(d[4 * g + 3], 0.f) * w.w;
                    if (key > T0 + q) s = -INFINITY;
                    SCR[(size_t)q * 2048 + key] = s; }
            }
        }
    }
    asm volatile("s_waitcnt vmcnt(0)" ::: "memory");
    __syncthreads();
#ifndef REP_ASEL
#define REP_ASEL 1
#endif
#pragma unroll 1
    for (int rs_ = 0; rs_ < REP_ASEL; ++rs_) {
        lane = lane_now();
        const int q0 = wave * 8, tl = __builtin_amdgcn_readfirstlane(T0 + q0 + 7);
        LAS unsigned* hs = (LAS unsigned*)(L + MB_SEL + wave * 2560);
        if (tl + 1 <= 512) select8_t<8>(SCR + (size_t)q0 * 2048, T0 + q0, hs, hs + 256, bm + q0 * MA_BMS, lane);
        else if (tl + 1 <= 768) select8_t<12>(SCR + (size_t)q0 * 2048, T0 + q0, hs, hs + 256, bm + q0 * MA_BMS, lane);
        else if (tl + 1 <= 1024) select8_t<16>(SCR + (size_t)q0 * 2048, T0 + q0, hs, hs + 256, bm + q0 * MA_BMS, lane);
        else if (tl + 1 <= 1280) select8_t<20>(SCR + (size_t)q0 * 2048, T0 + q0, hs, hs + 256, bm + q0 * MA_BMS, lane);
        else if (tl + 1 <= 1536) select8_t<24>(SCR + (size_t)q0 * 2048, T0 + q0, hs, hs + 256, bm + q0 * MA_BMS, lane);
        else if (tl + 1 <= 1792) select8_t<28>(SCR + (size_t)q0 * 2048, T0 + q0, hs, hs + 256, bm + q0 * MA_BMS, lane);
        else select8_t<32>(SCR + (size_t)q0 * 2048, T0 + q0, hs, hs + 256, bm + q0 * MA_BMS, lane);
    }
#ifndef REP_AATT
#define REP_AATT 1
#endif
#pragma unroll 1
    for (int ra_ = 0; ra_ < REP_AATT; ++ra_) {
    lane = lane_now(); tid = wave * 64 + lane; r32 = lane & 31; hi = lane >> 5;
    int wv = wave; asm volatile("" : "+s"(wv));
    const int h = wv & 3, qh = wv >> 2, tq0 = T0 + 32 * qh, t = tq0 + r32;
    const float sl = __builtin_amdgcn_exp2f(-2.f * (float)(h + 1)) * LOG2E;
    bf16x8v qf[4];
#pragma unroll
    for (int ks = 0; ks < 4; ++ks) qf[ks] = *(const bf16x8v*)(zb + (size_t)t * ZC + ZC_QA + h * 64 + ks * 16 + hi * 8);
    float m = -1e30f, l = 0.f; f32x16 o[2];
    f32x16 cinA;
#pragma unroll
    for (int r = 0; r < 16; ++r) cinA[r] = sl * (float)((r & 3) + 8 * (r >> 2) + 4 * hi);
#pragma unroll
    for (int r = 0; r < 16; ++r) { o[0][r] = 0.f; o[1][r] = 0.f; }
    LAS unsigned char* Kb = L + MB_K; LAS unsigned char* Vb = L + MB_V;
    const int skey = tid >> 3, sc = tid & 7;
    const bf16* ksrc = zb + (size_t)skey * ZC + ZC_KA + sc * 8;
    const bf16* vsrc = zb + (size_t)skey * ZC + ZC_VA + sc * 8;
    const int kdst = (sc >> 1) * 2048 + (sc & 1) * 1024 + (skey >> 5) * 512 + (skey & 31) * 16;
    const int vdst = (sc >> 2) * 4096 + (skey >> 3) * 512 + (skey & 7) * 64 + (sc & 3) * 16;
    const int krd = hi * 1024 + r32 * 16;
    const int vrd = ((lane >> 4) & 1) * 32 + (lane & 3) * 8 + (4 * hi + ((lane & 15) >> 2)) * 64;
    const LAS v4u* wrow = (const LAS v4u*)(bm + (32 * qh + r32) * MA_BMS + 4 * hi);
    int jp = (T0 + 63) >> 7;
    int stg_ = 128 * ZC, til_ = 64 * ZC; asm volatile("" : "+s"(stg_), "+s"(til_));
    const size_t stg = (size_t)stg_, til = (size_t)til_;
    v4u kA0 = *(const v4u*)(ksrc + jp * stg), vA0 = *(const v4u*)(vsrc + jp * stg), kA1 = *(const v4u*)(ksrc + jp * stg + til), vA1 = *(const v4u*)(vsrc + jp * stg + til);
    { LAS unsigned char* kb = Kb + (jp & 1) * 16384; LAS unsigned char* vb = Vb + (jp & 1) * 16384;
      *(LAS v4u*)(kb + kdst) = kA0; *(LAS v4u*)(vb + vdst) = vA0; *(LAS v4u*)(kb + 8192 + kdst) = kA1; *(LAS v4u*)(vb + 8192 + vdst) = vA1; }
    v4u kB0 = kA0, vB0 = vA0, kB1 = kA1, vB1 = vA1;
    if (jp >= 1) { kB0 = *(const v4u*)(ksrc + (jp - 1) * stg); vB0 = *(const v4u*)(vsrc + (jp - 1) * stg); kB1 = *(const v4u*)(ksrc + (jp - 1) * stg + til); vB1 = *(const v4u*)(vsrc + (jp - 1) * stg + til); }
    __syncthreads();
    v4u wsel[8];
#pragma unroll
    for (int g = 0; g < 4; ++g) { wsel[g] = wrow[2 * g]; wsel[4 + g] = wrow[8 + 2 * g]; }
#define MB_STAGE(JP, KW0, VW0, KW1, VW1, KL0, VL0, KL1, VL1) do { const int jp_ = (JP); \
        if (jp_ >= 2) { KL0 = *(const v4u*)(ksrc + (jp_ - 2) * stg); VL0 = *(const v4u*)(vsrc + (jp_ - 2) * stg); KL1 = *(const v4u*)(ksrc + (jp_ - 2) * stg + til); VL1 = *(const v4u*)(vsrc + (jp_ - 2) * stg + til); } \
        _Pragma("unroll") for (int kp = 1; kp >= 0; --kp) { \
            const int tile = 2 * jp_ + kp, s0 = 64 * tile; \
            if (s0 <= tq0 + 31) {                                          \
                const LAS unsigned char* Kc = Kb + (jp_ & 1) * 16384 + kp * 8192; const LAS unsigned char* Vc = Vb + (jp_ & 1) * 16384 + kp * 8192; \
                const float sha = sl * (float)(s0 - t), shb = sha + 32.f * sl; \
                f32x16 p0 = cinA, p1 = cinA; \
                _Pragma("unroll") for (int ks = 0; ks < 4; ++ks) { const bf16x8v kf0 = *(const LAS bf16x8v*)(Kc + ks * 2048 + krd), kf1 = *(const LAS bf16x8v*)(Kc + ks * 2048 + 512 + krd); \
                    p0 = __builtin_amdgcn_mfma_f32_32x32x16_bf16(kf0, qf[ks], p0, 0, 0, 0); p1 = __builtin_amdgcn_mfma_f32_32x32x16_bf16(kf1, qf[ks], p1, 0, 0, 0); } \
                const unsigned sbit = (unsigned)tile; \
                _Pragma("unroll") for (int g = 0; g < 4; ++g) { const v4u wa = wsel[g], wb = wsel[4 + g]; \
                    _Pragma("unroll") for (int e = 0; e < 4; ++e) { const int r = 4 * g + e; \
                        const unsigned ma = (unsigned)(-(int)((wa[e] >> sbit) & 1u)), mb = (unsigned)(-(int)((wb[e] >> sbit) & 1u)); \
                        p0[r] = __uint_as_float((__float_as_uint(p0[r]) & ma) | (~ma & 0xff800000u)); p1[r] = __uint_as_float((__float_as_uint(p1[r]) & mb) | (~mb & 0xff800000u)); } } \
                bf16x8v pf[4]; \
                fl_softmax3(p0, p1, sha, shb, m, l, o, pf); \
                _Pragma("unroll") for (int s4 = 0; s4 < 4; ++s4) _Pragma("unroll") for (int db = 0; db < 2; ++db) { const LAS unsigned char* vp = Vc + db * 4096 + s4 * 1024 + vrd; \
                        const s16x4 lo = lds_tr(vp), hh = lds_tr(vp + 512); \
                        const bf16x8v vf = (bf16x8v){lo[0], lo[1], lo[2], lo[3], hh[0], hh[1], hh[2], hh[3]}; \
                        o[db] = __builtin_amdgcn_mfma_f32_32x32x16_bf16(vf, pf[s4], o[db], 0, 0, 0); } \
            } } \
        if (jp_ >= 1) { LAS unsigned char* kb = Kb + ((jp_ - 1) & 1) * 16384; LAS unsigned char* vb = Vb + ((jp_ - 1) & 1) * 16384; \
            *(LAS v4u*)(kb + kdst) = KW0; *(LAS v4u*)(vb + vdst) = VW0; *(LAS v4u*)(kb + 8192 + kdst) = KW1; *(LAS v4u*)(vb + 8192 + vdst) = VW1; } \
        __syncthreads(); } while (0)
    for (; jp >= 0; jp -= 2) { MB_STAGE(jp, kB0, vB0, kB1, vB1, kA0, vA0, kA1, vA1); if (jp >= 1) MB_STAGE(jp - 1, kA0, vA0, kA1, vA1, kB0, vB0, kB1, vB1); }
#undef MB_STAGE
    { const float inv = 1.f / swap_sum(l);
      const size_t orow = (size_t)(b * SEQ + t) * DM + h * 64 + 4 * hi;
      o[0] *= inv; o[1] *= inv; mix_store_head(MIX, orow, hi, o[0], o[1]); }
    if (REP_AATT > 1) __syncthreads();
    }
}
__device__ __forceinline__ void mixa_phase64(const bf16* Z, bf16* MIX, float* SCR, LAS unsigned char* L, int vcu, int G, int wave) {
    float* scr = SCR + (size_t)blockIdx.x * (64 * 2048);
    for (int p = vcu; p < BATCH * 16; p += G) {
        const int b = p >> 4, x = p & 15;
#pragma unroll 1
        for (int k = 0; k < 2; ++k) { mixa_unit64(Z, MIX, scr, L, b, k == 0 ? 31 - x : x, wave); __syncthreads(); }
    }
}
#ifndef REP_A
#define REP_A 1
#endif
#ifndef REP_B
#define REP_B 1
#endif
#ifndef REP_C
#define REP_C 1
#endif
#ifndef REP_G
#define REP_G 1
#endif
#ifndef REP_P1A
#define REP_P1A 1
#endif
#ifndef REP_P1B
#define REP_P1B 1
#endif
#ifndef REP_P3
#define REP_P3 1
#endif
#ifndef REP_P4
#define REP_P4 1
#endif
#ifndef REP_P5
#define REP_P5 1
#endif
#ifndef REP_BAR
#define REP_BAR 1
#endif
#ifndef FLASH2
#define FLASH2 1
#endif
#if FLASH2
#define FLASHP flash_phase2
#else
#define FLASHP flash_phase
#endif
#ifndef GM_ALIGN
#define GM_ALIGN true
#endif
#ifndef GM_ALIGN_RES
#define GM_ALIGN_RES true
#endif
#ifndef GM_ALIGN_F8
#define GM_ALIGN_F8 true
#endif
#ifndef GM_SP2_F8
#define GM_SP2_F8 true
#endif
#ifndef GM_SP2
#define GM_SP2 true
#endif
#ifndef MIXA64
#define MIXA64 1
#endif
#ifndef FFN_FP8
#define FFN_FP8 1
#endif
#ifndef FFN_FP8_P5
#define FFN_FP8_P5 FFN_FP8
#endif
#ifndef P1_FP8
#define P1_FP8 0
#endif
#ifndef CSUB
#define CSUB 0
#endif
#ifndef MIX_PRIO
#define MIX_PRIO 0
#endif
#ifndef LNFUSE
#define LNFUSE 0
#endif
#ifndef P1_MIX
#define P1_MIX 0
#endif
#ifndef BSTREAM
#define BSTREAM 0
#endif
#ifndef B3
#define B3 0
#endif
#if P1_FP8 && !MIX_FP8
#error P1_FP8 keeps its e4m3 input copy in the half of R1 that MIX_FP8 frees
#endif
#define H8_OFF (FFN_FP8_P5 ? (size_t)0 : 352 * MiB)
#define ACT_OFF (FFN_FP8 && FFN_FP8_P5 ? 64 * MiB : (size_t)0)
struct Args { const float* in[12]; float* out; unsigned char* ws; };
__global__ void __launch_bounds__(NWAVES * 64, 2) hybrid_fwd(Args args) {
    extern __shared__ __attribute__((aligned(16))) unsigned char lds[];
    LAS unsigned char* L = (LAS unsigned char*)lds;
    volatile LAS unsigned* MISC = (volatile LAS unsigned*)(L + MISC_OFF);
    const int wave = __builtin_amdgcn_readfirstlane((int)threadIdx.x >> 6);
#define LANE_NOW lane_now()
#define TID_NOW (wave * 64 + lane_now())
    const int G = gridDim.x, bx = blockIdx.x;
    const int vcu = (G % 8 == 0) ? (bx % 8) * (G / 8) + bx / 8 : bx;
    const int gw = vcu * NWAVES + wave, NGW = G * NWAVES;
    unsigned char* ws = args.ws;
    gu32* ctl = (gu32*)(ws + WS_CTL);
    for (int u = TID_NOW; u < (LDS_BYTES - LDSCTL_OFF) / 4; u += NWAVES * 64) ((LAS unsigned*)(L + LDSCTL_OFF))[u] = 0u;
    __syncthreads();
    XcdBarrier bar = xcd_barrier_post((unsigned*)(ctl + CW_BAR), MISC + 8);
    const float* x = args.in[0];
    bf16* R0 = (bf16*)(ws + WS_R0); bf16* R1 = (bf16*)(ws + WS_R1); bf16* R2 = (bf16*)(ws + WS_R2); bf16* BIG = (bf16*)(ws + WS_BIG);

    {
        const int tid_ = TID_NOW;
        const size_t n8 = (size_t)M * DM / 8; const size_t gt = (size_t)bx * (NWAVES * 64) + tid_, nth = (size_t)G * NWAVES * 64;
#ifndef REP_X
#define REP_X 1
#endif
#ifndef REP_T
#define REP_T 1
#endif
        const int half_ = wave >> 2;
        const size_t xh = n8 / 2, xgt = (size_t)bx * 256 + (tid_ & 255), xnth = (size_t)G * 256;
        LAS float* scr = (LAS float*)(L + RING_OFF + wave * 16384);
        for (int pass_ = 0; pass_ < 2; ++pass_) {
        if ((pass_ == 0) == (half_ == 0)) {
        for (int rx_ = 0; rx_ < REP_X; ++rx_)
        for (size_t i = xgt + half_ * xh, n8 = (half_ + 1) * xh, nth = xnth; i < n8; i += 4 * nth) {
            f32x4 a[4], b[4];
#pragma unroll
            for (int u = 0; u < 4; ++u) { size_t j = i + u * nth; j = j < n8 ? j : n8 - 1; a[u] = ((const f32x4*)x)[2 * j]; b[u] = ((const f32x4*)x)[2 * j + 1]; }
#pragma unroll
            for (int u = 0; u < 4; ++u) { const size_t j = i + u * nth; if (j < n8) { v4u o; o.x = pk2(a[u].x, a[u].y); o.y = pk2(a[u].z, a[u].w); o.z = pk2(b[u].x, b[u].y); o.w = pk2(b[u].z, b[u].w); ((v4u*)R0)[j] = o;
#if P1_FP8
                int w0 = __builtin_amdgcn_cvt_pk_fp8_f32(a[u].x, a[u].y, 0, false); w0 = __builtin_amdgcn_cvt_pk_fp8_f32(a[u].z, a[u].w, w0, true);
                int w1 = __builtin_amdgcn_cvt_pk_fp8_f32(b[u].x, b[u].y, 0, false); w1 = __builtin_amdgcn_cvt_pk_fp8_f32(b[u].z, b[u].w, w1, true);
                v2u o8; o8.x = (unsigned)w0; o8.y = (unsigned)w1; ((v2u*)(ws + WS_X8))[j] = o8;
#endif
                } }
        }
        } else {
        constexpr int I_IN = (DM / 64) * (ZC / 32), I_O = (DM / 64) * (DM / 32), I_GU = (DM / 64) * (GU / 32), I_D = (FF / 64) * (DM / 32), I_L = I_IN + I_O + I_GU + I_D;
        for (int rt_ = 0; rt_ < REP_T; ++rt_)
        for (int it = vcu * NWAVES + (wave & 3) * 2 + half_; it < DEPTH * I_L; it += NGW) {
            const int l = it / I_L; int r = it % I_L;
            unsigned char* wl = ws + WS_W + (size_t)l * W_LAYER_B;
            float* cv = (float*)(ws + WS_CVP) + (size_t)l * 16 * CV_LAYER; const bool acc_ = rt_ == 0;
            const float* g2p = (l > 0 && !LNFUSE) ? args.in[10] + (l - 1) * DM : nullptr; const float* b2p = (l > 0 && !LNFUSE) ? args.in[11] + (l - 1) * DM : nullptr;
            const float* g1 = LNFUSE ? nullptr : args.in[5] + l * DM; const float* b1 = LNFUSE ? nullptr : args.in[6] + l * DM;
            if (r < I_IN) { transpose_item<0, P1_FP8 ? 8 : 0>(args.in[1] + (size_t)l * DM * INC, nullptr, g2p, b2p, acc_ ? cv : nullptr, cv + ZC, DM, INC, ZC, (bf16*)wl, scr, r, LANE_NOW); continue; } r -= I_IN;
            if (r < I_O) { transpose_item<1, MIX_FP8 ? 6 : 0>(args.in[2] + (size_t)l * DM * DM, nullptr, nullptr, nullptr, nullptr, nullptr, DM, DM, DM, (bf16*)(wl + W_IN_B), scr, r, LANE_NOW); continue; } r -= I_O;
            if (r < I_GU) { transpose_item<2, FFN_FP8 ? 6 : 0>(args.in[7] + (size_t)l * DM * FF, args.in[8] + (size_t)l * DM * FF, g1, b1, acc_ ? cv + 2 * ZC : nullptr, cv + 2 * ZC + GU, DM, FF, GU, (bf16*)(wl + W_IN_B + W_O_B), scr, r, LANE_NOW); continue; } r -= I_GU;
            transpose_item<1, FFN_FP8_P5 ? 8 : 0>(args.in[9] + (size_t)l * FF * DM, nullptr, nullptr, nullptr, nullptr, nullptr, FF, DM, DM, (bf16*)(wl + W_IN_B + W_O_B + W_GU_B), scr, r, LANE_NOW);
        }
        } }
    }
    xcd_barrier(bar);

#pragma unroll
    for (int l = 0; l < DEPTH; ++l) {
#define WS_NOW ({ unsigned char* w_ = args.ws; asm volatile("" : "+s"(w_)); w_; })
#define OPQ_S(x) ({ int x_ = (x); asm volatile("" : "+s"(x_)); x_; })
#define P_WL(w) ((w) + WS_W + (size_t)l * W_LAYER_B)
#define P_ST(w, ll, which) ((float*)((w) + WS_STAT) + (size_t)(((ll) * 2 + (which)) * 2) * M)
#define P_CV(w) ((const float*)((w) + WS_CV) + (size_t)l * CV_LAYER)
        const float lambda_init = (l == 0) ? 0.2f : 0.35550906759f;
        const bool last = (l + 1 == DEPTH);

        { unsigned char* w = WS_NOW; const float* sP = (l > 0 && !LNFUSE) ? P_ST(w, l - 1, 1) : nullptr; const float* cv = P_CV(w);
#if P1_FP8
#if P1_MIX
          const int pop_ = (OPQ_S(bx) >> 3) & 1;
#pragma unroll 1
          for (int part_ = 0; part_ < 4; ++part_) { const bool isb_ = ((part_ & 1) == pop_); const int hf_ = part_ >> 1;
          if (!isb_)
#endif
          { pg8::Gemm g{(const pg8::bf16_t*)(w + WS_X8), (const pg8::bf16_t*)(P_WL(w) + W_IN8_OFF), M, ZC - 512, DM / 2, 0}; pg8::StaticOrder S; S.init(M, ZC - 512, OPQ_S(G), OPQ_S(bx), 1, 2);
#if P1_MIX
            S.i0 = 5 * hf_; S.iN = 5;
#endif
            pg8::EpiStoreLN E{(pg8::bf16_t*)(w + WS_BIG), ZC, sP, sP ? sP + M : nullptr, cv, cv + ZC, 1.f / 256.f};
            for (int rep = 0; rep < REP_G * REP_P1A; ++rep) {
            pg8::gemm_phase<pg8::EpiStoreLN, pg8::StaticOrder, GM_ALIGN_F8, GM_SP2_F8, true>(L + RING_OFF, g, S, E, OPQ_S(wave)); } }
#if P1_MIX
          else
#endif
          { pg8::Gemm g{(const pg8::bf16_t*)(w + WS_R0), (const pg8::bf16_t*)P_WL(w), M, 512, DM, 0}; pg8::StaticOrder S; S.init(M, 512, OPQ_S(G), OPQ_S(bx), 0, 1);
#if P1_MIX
            S.i0 = hf_; S.iN = 1;
#endif
            pg8::EpiStoreLN E{(pg8::bf16_t*)(w + WS_BIG), ZC, sP, sP ? sP + M : nullptr, cv, cv + ZC, 1.f};
            for (int rep = 0; rep < REP_G * REP_P1B; ++rep) {
            pg8::gemm_phase<pg8::EpiStoreLN, pg8::StaticOrder, GM_ALIGN, GM_SP2>(L + RING_OFF, g, S, E, OPQ_S(wave)); } }
#if P1_MIX
          }
#endif
          }
#else
          pg8::Gemm g{(const pg8::bf16_t*)(w + WS_R0), (const pg8::bf16_t*)P_WL(w), M, ZC, DM, 0}; pg8::StaticOrder S; S.init(M, ZC, OPQ_S(G), OPQ_S(bx));
          pg8::EpiStoreLN E{(pg8::bf16_t*)(w + WS_BIG), ZC, sP, sP ? sP + M : nullptr, cv, cv + ZC, 1.f};
          for (int rep = 0; rep < REP_G * REP_P1A; ++rep) {
          pg8::gemm_phase<pg8::EpiStoreLN, pg8::StaticOrder, GM_ALIGN, GM_SP2>(L + RING_OFF, g, S, E, OPQ_S(wave)); } }
#endif
        for (int rb_ = 0; rb_ < REP_BAR; ++rb_) xcd_barrier(bar);
#if MIX_PRIO
        if (OPQ_S(wave) >= 4) __builtin_amdgcn_s_setprio(1);
#endif
        if (l == 0 && !LNFUSE) { unsigned char* w = WS_NOW; cv_reduce((const float*)(w + WS_CVP), (float*)(w + WS_CV), (size_t)OPQ_S(bx) * (NWAVES * 64) + TID_NOW, (size_t)OPQ_S(G) * NWAVES * 64); }
        { unsigned char* w = WS_NOW; for (int rep = 0; rep < REP_A; ++rep) mixa_phase64((const bf16*)(w + WS_BIG), (bf16*)(w + WS_R1), (float*)(w + WS_R2), L + RING_OFF, OPQ_S(vcu), OPQ_S(G), OPQ_S(wave)); }
#if B3
        { unsigned char* w = WS_NOW; for (int rep = 0; rep < REP_B; ++rep) flash_phase_b3((const bf16*)(w + WS_BIG), (bf16*)(w + WS_R1), L + RING_OFF, args.in[3] + l * 128, args.in[4] + l * 64, lambda_init, OPQ_S(vcu), OPQ_S(G), OPQ_S(wave)); }
#elif BSTREAM
        { unsigned char* w = WS_NOW; for (int rep = 0; rep < REP_B; ++rep) flash_phase_b((const bf16*)(w + WS_BIG), (bf16*)(w + WS_R1), L + RING_OFF, args.in[3] + l * 128, args.in[4] + l * 64, lambda_init, OPQ_S(vcu), OPQ_S(G), OPQ_S(wave)); }
#else
        { unsigned char* w = WS_NOW; for (int rep = 0; rep < REP_B; ++rep) FLASHP<0>((const bf16*)(w + WS_BIG), (bf16*)(w + WS_R1), L + RING_OFF, args.in[3] + l * 128, args.in[4] + l * 64, lambda_init, OPQ_S(vcu), OPQ_S(G), TID_NOW, OPQ_S(wave), LANE_NOW); }
#endif
#if CSUB
        { unsigned char* w = WS_NOW; for (int rep = 0; rep < REP_C; ++rep) flash_phase_sub((const bf16*)(w + WS_BIG), (bf16*)(w + WS_R1), L + RING_OFF, OPQ_S(vcu), OPQ_S(G), OPQ_S(wave)); }
#else
        { unsigned char* w = WS_NOW; for (int rep = 0; rep < REP_C; ++rep) FLASHP<1>((const bf16*)(w + WS_BIG), (bf16*)(w + WS_R1), L + RING_OFF, nullptr, nullptr, 0.f, OPQ_S(vcu), OPQ_S(G), TID_NOW, OPQ_S(wave), LANE_NOW); }
#endif
#if MIX_PRIO
        __builtin_amdgcn_s_setprio(0);
#endif
        for (int rb_ = 0; rb_ < REP_BAR; ++rb_) xcd_barrier(bar);
#if LNFUSE
        { unsigned char* w = WS_NOW;
          pg8::Gemm g{(const pg8::bf16_t*)(w + WS_R1), (const pg8::bf16_t*)(P_WL(w) + W_IN_B), M, DM, MIX_FP8 ? DM / 2 : DM, 0}; pg8::StaticOrder S; S.init(M, DM, OPQ_S(G), OPQ_S(bx));
          pg8::EpiResLN E{(const pg8::bf16_t*)(w + WS_R0), args.in[5] + l * DM, args.in[6] + l * DM, (pg8::bf16_t*)(w + WS_R2), (unsigned char*)(w + WS_BIG + H8_OFF), nullptr, DM, ALPHA, MIX_FP8 ? 1.f / 64.f : 1.f,
                          (unsigned long long*)(w + WS_SP) + (size_t)(2 * l) * M * 4, (unsigned*)(w + XCNT_OFF) + (2 * l) * 256 * 16, (unsigned*)(w + WS_CTL) + 32, (PG8_LAS unsigned char*)(L + XT_OFF)};
          pg8::gemm_phase<pg8::EpiResLN, pg8::StaticOrder, true, GM_SP2, MIX_FP8 != 0>(L + RING_OFF, g, S, E, OPQ_S(wave)); }
        xcd_barrier(bar);
        { unsigned char* w = WS_NOW;
          pg8::StaticOrder S; S.init(M, GU, OPQ_S(G), OPQ_S(bx));
          pg8::Gemm g{(const pg8::bf16_t*)(w + WS_BIG + H8_OFF), (const pg8::bf16_t*)(P_WL(w) + W_IN_B + W_O_B), M, GU, DM / 2, 0};
          pg8::EpiSwiglu8 E{w + WS_BIG + ACT_OFF, FF, 1.f / 64.f};
          pg8::gemm_phase<pg8::EpiSwiglu8, pg8::StaticOrder, GM_ALIGN_F8, GM_SP2_F8, true>(L + RING_OFF, g, S, E, OPQ_S(wave)); }
        xcd_barrier(bar);
        { unsigned char* w = WS_NOW;
          pg8::Gemm g{(const pg8::bf16_t*)(w + WS_BIG + ACT_OFF), (const pg8::bf16_t*)(P_WL(w) + W_IN_B + W_O_B + W_GU_B), M, DM, FF / 2, 0};
          pg8::StaticOrder S; S.init(M, DM, OPQ_S(G), OPQ_S(bx));
          pg8::EpiResLN E{(const pg8::bf16_t*)(w + WS_R2), args.in[10] + l * DM, args.in[11] + l * DM, last ? nullptr : (pg8::bf16_t*)(w + WS_R0), last ? nullptr : (unsigned char*)(w + WS_X8), last ? args.out : nullptr, DM, ALPHA, 1.f / 256.f,
                          (unsigned long long*)(w + WS_SP) + (size_t)(2 * l + 1) * M * 4, (unsigned*)(w + XCNT_OFF) + (2 * l + 1) * 256 * 16, (unsigned*)(w + WS_CTL) + 32, (PG8_LAS unsigned char*)(L + XT_OFF)};
          pg8::gemm_phase<pg8::EpiResLN, pg8::StaticOrder, true, GM_SP2, true>(L + RING_OFF, g, S, E, OPQ_S(wave)); }
        if (!last) xcd_barrier(bar);
#else
        { unsigned char* w = WS_NOW; const float* sP = l > 0 ? P_ST(w, l - 1, 1) : nullptr; float* sA = P_ST(w, l, 0);
          pg8::Gemm g{(const pg8::bf16_t*)(w + WS_R1), (const pg8::bf16_t*)(P_WL(w) + W_IN_B), M, DM, MIX_FP8 ? DM / 2 : DM, 0}; pg8::StaticOrder S; S.init(M, DM, OPQ_S(G), OPQ_S(bx));
          pg8::EpiResStat E{(const pg8::bf16_t*)(w + WS_R0), sP, sP ? sP + M : nullptr, l > 0 ? args.in[10] + (l - 1) * DM : nullptr, l > 0 ? args.in[11] + (l - 1) * DM : nullptr, (pg8::bf16_t*)(w + WS_R2), nullptr, (float*)(w + WS_SP), (float*)(w + WS_SP) + (size_t)16 * M, DM, ALPHA, FFN_FP8 ? (unsigned char*)(w + WS_BIG + H8_OFF) : nullptr, MIX_FP8 ? 1.f / 64.f : 1.f, M};
          for (int rep = 0; rep < REP_G * REP_P3; ++rep) { if (rep > 0) { E.osum = nullptr; }
          pg8::gemm_phase<pg8::EpiResStat, pg8::StaticOrder, GM_ALIGN_RES, GM_SP2, MIX_FP8 != 0>(L + RING_OFF, g, S, E, OPQ_S(wave)); } }
        for (int rb_ = 0; rb_ < REP_BAR; ++rb_) xcd_barrier(bar);
        { unsigned char* w = WS_NOW; float* sA = P_ST(w, l, 0); stats_reduce((const float*)(w + WS_SP), sA, sA + M, (size_t)OPQ_S(bx) * (NWAVES * 64) + TID_NOW, (size_t)OPQ_S(G) * NWAVES * 64); }
        xcd_barrier(bar);
        { unsigned char* w = WS_NOW; float* sA = P_ST(w, l, 0); const float* cv = P_CV(w);
          pg8::StaticOrder S; S.init(M, GU, OPQ_S(G), OPQ_S(bx));
#if FFN_FP8
          pg8::Gemm g{(const pg8::bf16_t*)(w + WS_BIG + H8_OFF), (const pg8::bf16_t*)(P_WL(w) + W_IN_B + W_O_B), M, GU, DM / 2, 0};
#if FFN_FP8_P5
          pg8::EpiSwigluLN8 E{w + WS_BIG + ACT_OFF, FF, sA, sA + M, cv + 2 * ZC, cv + 2 * ZC + GU, 1.f / 64.f};
          for (int rep = 0; rep < REP_G * REP_P4; ++rep) {
          pg8::gemm_phase<pg8::EpiSwigluLN8, pg8::StaticOrder, GM_ALIGN_F8, GM_SP2_F8, true>(L + RING_OFF, g, S, E, OPQ_S(wave)); }
#ifdef PROBE_K
          { pg8::Gemm g2{g.A, g.Bt, M, GU, DM / 2, PROBE_K == 2 ? 777 : 0}; pg8::EpiSwigluLN8 E2{w + WS_BIG + 256 * MiB, FF, sA, sA + M, cv + 2 * ZC, cv + 2 * ZC + GU, 1.f / 64.f};
            pg8::gemm_phase<pg8::EpiSwigluLN8, pg8::StaticOrder, GM_ALIGN_F8, GM_SP2_F8, true>(L + RING_OFF, g2, S, E2, OPQ_S(wave)); }
#endif
#else
          pg8::EpiSwigluLN E{(pg8::bf16_t*)(w + WS_BIG + ACT_OFF), FF, sA, sA + M, cv + 2 * ZC, cv + 2 * ZC + GU, 1.f / 64.f};
          for (int rep = 0; rep < REP_G * REP_P4; ++rep) {
          pg8::gemm_phase<pg8::EpiSwigluLN, pg8::StaticOrder, GM_ALIGN, GM_SP2, true>(L + RING_OFF, g, S, E, OPQ_S(wave)); }
#endif
#else
          pg8::Gemm g{(const pg8::bf16_t*)(w + WS_R2), (const pg8::bf16_t*)(P_WL(w) + W_IN_B + W_O_B), M, GU, DM, 0};
          pg8::EpiSwigluLN E{(pg8::bf16_t*)(w + WS_BIG), FF, sA, sA + M, cv + 2 * ZC, cv + 2 * ZC + GU, 1.f};
          for (int rep = 0; rep < REP_G * REP_P4; ++rep) {
          pg8::gemm_phase<pg8::EpiSwigluLN, pg8::StaticOrder, GM_ALIGN, GM_SP2>(L + RING_OFF, g, S, E, OPQ_S(wave)); }
#endif
        }
        for (int rb_ = 0; rb_ < REP_BAR; ++rb_) xcd_barrier(bar);
        { unsigned char* w = WS_NOW; float* sA = P_ST(w, l, 0); float* sB = P_ST(w, l, 1);
#if FFN_FP8_P5
          pg8::Gemm g{(const pg8::bf16_t*)(w + WS_BIG + ACT_OFF), (const pg8::bf16_t*)(P_WL(w) + W_IN_B + W_O_B + W_GU_B), M, DM, FF / 2, 0};
#else
          pg8::Gemm g{(const pg8::bf16_t*)(w + WS_BIG + ACT_OFF), (const pg8::bf16_t*)(P_WL(w) + W_IN_B + W_O_B + W_GU_B), M, DM, FF, 0};
#endif
          pg8::StaticOrder S; S.init(M, DM, OPQ_S(G), OPQ_S(bx));
          pg8::EpiResStat E{(const pg8::bf16_t*)(w + WS_R2), sA, sA + M, args.in[5] + l * DM, args.in[6] + l * DM, (pg8::bf16_t*)(w + WS_R0), nullptr, (float*)(w + WS_SP), (float*)(w + WS_SP) + (size_t)16 * M, DM, ALPHA, (P1_FP8 && !last) ? w + WS_X8 : nullptr, FFN_FP8_P5 ? 1.f / 256.f : 1.f, M};
          for (int rep = 0; rep < REP_G * REP_P5; ++rep) { if (rep > 0) { E.osum = nullptr; }
          pg8::gemm_phase<pg8::EpiResStat, pg8::StaticOrder, GM_ALIGN_RES, GM_SP2, FFN_FP8_P5 != 0>(L + RING_OFF, g, S, E, OPQ_S(wave)); } }
        for (int rb_ = 0; rb_ < REP_BAR; ++rb_) xcd_barrier(bar);
        { unsigned char* w = WS_NOW; float* sB = P_ST(w, l, 1); stats_reduce((const float*)(w + WS_SP), sB, sB + M, (size_t)OPQ_S(bx) * (NWAVES * 64) + TID_NOW, (size_t)OPQ_S(G) * NWAVES * 64); }
        xcd_barrier(bar);
        if (last) {
            unsigned char* w = WS_NOW; const bf16* R0 = (const bf16*)(w + WS_R0); const float* sB = P_ST(w, l, 1);
            const int tid_ = TID_NOW;
            const size_t gt = (size_t)bx * (NWAVES * 64) + tid_, nth = (size_t)G * NWAVES * 64;
            if (nth % 128 == 0) {
                const int cc = (int)(gt & 127) * 8; const float* g2 = args.in[10] + l * DM + cc; const float* b2 = args.in[11] + l * DM + cc;
                const f32x4 ga = *(const f32x4*)g2, gb = *(const f32x4*)(g2 + 4), ba = *(const f32x4*)b2, bb = *(const f32x4*)(b2 + 4);
                const size_t rstep = nth / 128;
                for (size_t row = gt >> 7; row < (size_t)M; row += 4 * rstep) {
                    v4u hv[4]; float mu[4], rs[4];
#pragma unroll
                    for (int u = 0; u < 4; ++u) { size_t r = row + u * rstep; r = r < (size_t)M ? r : (size_t)M - 1; hv[u] = *(const v4u*)(R0 + r * DM + cc); mu[u] = sB[r]; rs[u] = sB[M + r]; }
#pragma unroll
                    for (int u = 0; u < 4; ++u) { const size_t r = row + u * rstep; if (r < (size_t)M) {
                        f32x4 ya, yb; ya.x = bflo(hv[u].x); ya.y = bfhi(hv[u].x); ya.z = bflo(hv[u].y); ya.w = bfhi(hv[u].y); yb.x = bflo(hv[u].z); yb.y = bfhi(hv[u].z); yb.z = bflo(hv[u].w); yb.w = bfhi(hv[u].w);
                        ya = (ya - mu[u]) * rs[u] * ga + ba; yb = (yb - mu[u]) * rs[u] * gb + bb;
                        float* op = args.out + r * DM + cc; *(f32x4*)op = ya; *(f32x4*)(op + 4) = yb; } }
                }
            }
        }
#endif
    }
}

extern "C" void kernel_launch(void* const* d_in, const int* in_sizes, int n_in, void* d_out, int out_size, void* d_ws, size_t ws_size, hipStream_t stream) {
    static int grid = 0;
    if (grid == 0) {
        if (n_in != 12 || in_sizes[0] != M * DM || out_size != M * DM || ws_size < WS_END) { fprintf(stderr, "kernel_launch: unexpected shapes / workspace (n_in %d, in0 %d, out %d, ws %zu < %zu)\n", n_in, n_in > 0 ? in_sizes[0] : -1, out_size, ws_size, (size_t)WS_END); grid = -1; return; }
        int dev = 0, cus = 0, per_cu = 0;
        if (hipGetDevice(&dev) != hipSuccess || hipDeviceGetAttribute(&cus, hipDeviceAttributeMultiprocessorCount, dev) != hipSuccess) { grid = -1; return; }
        if (hipFuncSetAttribute((const void*)hybrid_fwd, hipFuncAttributeMaxDynamicSharedMemorySize, LDS_BYTES) != hipSuccess) { fprintf(stderr, "kernel_launch: hipFuncSetAttribute failed\n"); grid = -1; return; }
        if (hipOccupancyMaxActiveBlocksPerMultiprocessor(&per_cu, (const void*)hybrid_fwd, NWAVES * 64, LDS_BYTES) != hipSuccess || per_cu < 1) { fprintf(stderr, "kernel_launch: occupancy query reports %d\n", per_cu); }
        (void)hipGetLastError();
        grid = cus < 256 ? cus : 256;
    }
    if (grid < 0) return;
    if (hipMemsetAsync((char*)d_ws + WS_CTL, 0, CTL_ZERO_BYTES, stream) != hipSuccess) return;
    Args a{};
    for (int i = 0; i < 12; ++i) a.in[i] = (const float*)d_in[i];
    a.out = (float*)d_out; a.ws = (unsigned char*)d_ws;
    hipLaunchKernelGGL(hybrid_fwd, dim3(grid), dim3(NWAVES * 64), LDS_BYTES, stream, a);
}
```

```cpp
#include <hip/hip_runtime.h>
#include <cstdio>
#include <cstdint>
#include <cmath>
#define FL_CLASS 0
#define FLASH2 0
#define MIX_FP8 1
#define P1_FP8 1
#define CSUB 1
#define LNFUSE 1
#ifndef REP_EPI
#define REP_EPI 1
#endif
#ifndef REP_EPI_MASK
#define REP_EPI_MASK 0xff
#endif
namespace pg8 {
#define PG8_LAS __attribute__((address_space(3)))
typedef unsigned short bf16_t;
typedef short bf16x8 __attribute__((ext_vector_type(8)));
typedef float f32x4 __attribute__((ext_vector_type(4)));
typedef unsigned u32x4 __attribute__((ext_vector_type(4)));
constexpr int BM = 256, BK = 64, HALF = 128, HTB = HALF * BK * 2  , STAGE_BYTES = 8 * HTB, NXCD = 8, WGM = 8;

__host__ __device__ __forceinline__ int lds_byte(int r, int c) { const int st = (r >> 4) * 2 + (c >> 5), rr = r & 15, cc = c & 31, ob = rr * 64 + cc * 2; return st * 1024 + (ob ^ (((ob >> 9) & 1) << 5)); }
__host__ __device__ __forceinline__ void stage_rc(int b, int& R, int& C) { const int st = b / 1024, sb = b % 1024, swz = sb ^ (((sb >> 9) & 1) << 5); R = (st >> 1) * 16 + swz / 64; C = (st & 1) * 32 + (swz % 64) / 2; }
__host__ __device__ __forceinline__ int perm32(int rho) { const int n = rho >> 4, i = rho & 15; return 8 * (i >> 2) + 4 * n + (i & 3); }

struct Unit { int pm, pn; };
struct Gemm { const bf16_t* A; const bf16_t* Bt; int M, N, K; int scale_w; };
typedef int v4i_t __attribute__((ext_vector_type(4)));
typedef int v8i_t __attribute__((ext_vector_type(8)));

struct StaticOrder {
    int nM, nN, nwg, G, c, skip_at, skip_n, i0 = 0, iN = 1 << 30;
    __host__ __device__ void init(int M, int N, int G_, int c_, int skip_at_ = 1 << 20, int skip_n_ = 0) { nM = M / BM; nN = N / BM; nwg = nM * nN; G = G_; c = c_; skip_at = skip_at_; skip_n = skip_n_; }
    __host__ __device__ bool next(int i, Unit& u) const {
        if (i >= iN) return false; i += i0;
        const long L = (long)i * G + c; if (L >= nwg) return false;
        int wgid = (int)L; { const int q = nwg / NXCD, r = nwg % NXCD, xcd = wgid % NXCD, off = wgid / NXCD; wgid = (xcd < r ? xcd * (q + 1) : r * (q + 1) + (xcd - r) * q) + off; }
        const int nig = WGM * nN, gid = wgid / nig, fm = gid * WGM, gsz = (nM - fm) < WGM ? (nM - fm) : WGM;
        u.pm = fm + ((wgid % nig) % gsz); u.pn = (wgid % nig) / gsz; if (u.pn >= skip_at) u.pn += skip_n; return true;
    }
    __device__ __forceinline__ void a_ready(const Unit&) const {}
    __device__ __forceinline__ void done(const Unit&) const {}
};
__device__ __forceinline__ unsigned cvt_pk_bf16(float lo, float hi) { unsigned r; asm volatile("v_cvt_pk_bf16_f32 %0, %1, %2" : "=v"(r) : "v"(lo), "v"(hi)); return r; }
typedef float f32x2 __attribute__((ext_vector_type(2)));
typedef unsigned u32x2 __attribute__((ext_vector_type(2)));
struct EpiStore {
    static constexpr int ID = 4;
    static constexpr bool PERM = true, AFTER_DRAIN = false;
    bf16_t* O; int ldc;
    __device__ __forceinline__ void operator()(const f32x4 (&acc)[2][2][4][2], const Unit& u, int wr, int wc, int fr, int fq) const {
        const int row0 = u.pm * BM + wr * 64 + fr, col0 = u.pn * BM + wc * 32 + 8 * fq;
#pragma unroll
        for (int ai = 0; ai < 2; ++ai)
#pragma unroll
            for (int m = 0; m < 4; ++m) { bf16_t* rowp = O + (size_t)(row0 + ai * HALF + m * 16) * ldc + col0;
#pragma unroll
                for (int bj = 0; bj < 2; ++bj) { const f32x4 v0 = acc[ai][bj][m][0], v1 = acc[ai][bj][m][1];
                    u32x4 w; w.x = cvt_pk_bf16(v0[0], v0[1]); w.y = cvt_pk_bf16(v0[2], v0[3]); w.z = cvt_pk_bf16(v1[0], v1[1]); w.w = cvt_pk_bf16(v1[2], v1[3]);
                    *(u32x4*)(rowp + bj * HALF) = w; } }
    }
};
struct EpiSwiglu {
    static constexpr int ID = 5;
    static constexpr bool PERM = true, AFTER_DRAIN = false;
    bf16_t* O; int ldc;
    __device__ __forceinline__ float act(float g, float u) const { const float e = __builtin_amdgcn_exp2f(g * -1.4426950408889634f); return g * __builtin_amdgcn_rcpf(1.0f + e) * u; }
    __device__ __forceinline__ void operator()(const f32x4 (&acc)[2][2][4][2], const Unit& u, int wr, int wc, int fr, int fq) const {
        const int row0 = u.pm * BM + wr * 64 + fr, col0 = u.pn * HALF + wc * 32 + 8 * fq;
#pragma unroll
        for (int ai = 0; ai < 2; ++ai)
#pragma unroll
            for (int m = 0; m < 4; ++m) { bf16_t* rowp = O + (size_t)(row0 + ai * HALF + m * 16) * ldc + col0;
                const f32x4 g0 = acc[ai][0][m][0], g1 = acc[ai][0][m][1], u0 = acc[ai][1][m][0], u1 = acc[ai][1][m][1];
                u32x4 w; w.x = cvt_pk_bf16(act(g0[0], u0[0]), act(g0[1], u0[1])); w.y = cvt_pk_bf16(act(g0[2], u0[2]), act(g0[3], u0[3]));
                w.z = cvt_pk_bf16(act(g1[0], u1[0]), act(g1[1], u1[1])); w.w = cvt_pk_bf16(act(g1[2], u1[2]), act(g1[3], u1[3]));
                *(u32x4*)rowp = w; }
    }
};
struct EpiRes {
    static constexpr int ID = 6;
    static constexpr bool PERM = false, AFTER_DRAIN = false;
    const bf16_t* X; float* H; int ldc; float alpha;
    __device__ __forceinline__ void operator()(const f32x4 (&acc)[2][2][4][2], const Unit& u, int wr, int wc, int fr, int fq) const {
        const int row0 = u.pm * BM + wr * 64 + fr, col0 = u.pn * BM + wc * 32 + 4 * fq;
#pragma unroll
        for (int ai = 0; ai < 2; ++ai)
#pragma unroll
            for (int m = 0; m < 4; ++m) { const size_t off = (size_t)(row0 + ai * HALF + m * 16) * ldc + col0;
#pragma unroll
                for (int bj = 0; bj < 2; ++bj)
#pragma unroll
                    for (int n = 0; n < 2; ++n) { const size_t c = off + bj * HALF + n * 16; const u32x2 xb = *(const u32x2*)(X + c);
                        f32x4 x; x[0] = __uint_as_float(xb.x << 16); x[1] = __uint_as_float(xb.x & 0xffff0000u); x[2] = __uint_as_float(xb.y << 16); x[3] = __uint_as_float(xb.y & 0xffff0000u);
                        *(f32x4*)(H + c) = acc[ai][bj][m][n] + x * alpha; } }
    }
};

__device__ __forceinline__ float sum16x(float v) { auto rr = __builtin_amdgcn_permlane16_swap(__float_as_uint(v), __float_as_uint(v), false, false); return __uint_as_float(rr[0]) + __uint_as_float(rr[1]); }
__device__ __forceinline__ float sum32x(float v) { auto rr = __builtin_amdgcn_permlane32_swap(__float_as_uint(v), __float_as_uint(v), false, false); return __uint_as_float(rr[0]) + __uint_as_float(rr[1]); }
__device__ __forceinline__ void row_stats(const float* ssum, const float* ssq, int row, float& mu, float& rs) {
    mu = 0.f; rs = 1.f;
    if (ssum) { mu = ssum[row]; rs = ssq[row]; }
}
struct EpiStoreLN {
    static constexpr int ID = 0;
    static constexpr bool PERM = true, AFTER_DRAIN = false;
    bf16_t* O; int ldc; const float* ssum; const float* ssq; const float* c1; const float* c0; float ascale;
    __device__ __forceinline__ void operator()(const f32x4 (&acc)[2][2][4][2], const Unit& u, int wr, int wc, int fr, int fq) const {
        const int row0 = u.pm * BM + wr * 64 + fr, col0 = u.pn * BM + wc * 32 + 8 * fq;
        f32x4 c1v[2][2], c0v[2][2]; float z_ = 0.f; asm volatile("" : "+v"(z_));
#pragma unroll
        for (int bj = 0; bj < 2; ++bj)
#pragma unroll
            for (int n = 0; n < 2; ++n) { c1v[bj][n] = ssum ? *(const f32x4*)(c1 + col0 + bj * HALF + 4 * n) : (f32x4){z_, z_, z_, z_}; c0v[bj][n] = ssum ? *(const f32x4*)(c0 + col0 + bj * HALF + 4 * n) : (f32x4){z_, z_, z_, z_}; }
        float ra_[2][4], rb_[2][4];
#pragma unroll
        for (int ai = 0; ai < 2; ++ai)
#pragma unroll
            for (int m = 0; m < 4; ++m) { float mu, rs; row_stats(ssum, ssq, row0 + ai * HALF + m * 16, mu, rs); ra_[ai][m] = ascale * rs; rb_[ai][m] = -mu * rs; }
#pragma unroll
        for (int ai = 0; ai < 2; ++ai)
#pragma unroll
            for (int m = 0; m < 4; ++m) { const int row = row0 + ai * HALF + m * 16; const float ra = ra_[ai][m], rb = rb_[ai][m];
                bf16_t* rowp = O + (size_t)row * ldc + col0;
#pragma unroll
                for (int bj = 0; bj < 2; ++bj) { const f32x4 v0 = acc[ai][bj][m][0] * ra + (c1v[bj][0] * rb + c0v[bj][0]), v1 = acc[ai][bj][m][1] * ra + (c1v[bj][1] * rb + c0v[bj][1]);
                    u32x4 w; w.x = cvt_pk_bf16(v0[0], v0[1]); w.y = cvt_pk_bf16(v0[2], v0[3]); w.z = cvt_pk_bf16(v1[0], v1[1]); w.w = cvt_pk_bf16(v1[2], v1[3]);
                    *(u32x4*)(rowp + bj * HALF) = w; } }
    }
};
struct EpiSwigluLN {
    static constexpr int ID = 3;
    static constexpr bool PERM = true, AFTER_DRAIN = false;
    bf16_t* O; int ldc; const float* ssum; const float* ssq; const float* c1; const float* c0; float ascale;
    __device__ __forceinline__ float act(float g, float u) const { const float e = __builtin_amdgcn_exp2f(g * -1.4426950408889634f); return g * __builtin_amdgcn_rcpf(1.0f + e) * u; }
    __device__ __forceinline__ void operator()(const f32x4 (&acc)[2][2][4][2], const Unit& u, int wr, int wc, int fr, int fq) const {
        const int row0 = u.pm * BM + wr * 64 + fr, col0 = u.pn * HALF + wc * 32 + 8 * fq, wrow0 = u.pn * BM + wc * 32 + 8 * fq;
        f32x4 c1v[2][2], c0v[2][2];
#pragma unroll
        for (int bj = 0; bj < 2; ++bj)
#pragma unroll
            for (int n = 0; n < 2; ++n) { c1v[bj][n] = *(const f32x4*)(c1 + wrow0 + bj * HALF + 4 * n); c0v[bj][n] = *(const f32x4*)(c0 + wrow0 + bj * HALF + 4 * n); }
#pragma unroll
        for (int ai = 0; ai < 2; ++ai)
#pragma unroll
            for (int m = 0; m < 4; ++m) { const int row = row0 + ai * HALF + m * 16; float mu, rs; row_stats(ssum, ssq, row, mu, rs);
                bf16_t* rowp = O + (size_t)row * ldc + col0;
                const f32x4 g0 = (acc[ai][0][m][0] * ascale - c1v[0][0] * mu) * rs + c0v[0][0], g1 = (acc[ai][0][m][1] * ascale - c1v[0][1] * mu) * rs + c0v[0][1];
                const f32x4 u0 = (acc[ai][1][m][0] * ascale - c1v[1][0] * mu) * rs + c0v[1][0], u1 = (acc[ai][1][m][1] * ascale - c1v[1][1] * mu) * rs + c0v[1][1];
                u32x4 w; w.x = cvt_pk_bf16(act(g0[0], u0[0]), act(g0[1], u0[1])); w.y = cvt_pk_bf16(act(g0[2], u0[2]), act(g0[3], u0[3]));
                w.z = cvt_pk_bf16(act(g1[0], u1[0]), act(g1[1], u1[1])); w.w = cvt_pk_bf16(act(g1[2], u1[2]), act(g1[3], u1[3]));
                *(u32x4*)rowp = w; }
    }
};
struct EpiSwigluLN8 {
    static constexpr int ID = 1;
    static constexpr bool PERM = true, AFTER_DRAIN = false;
    unsigned char* O; int ldc; const float* ssum; const float* ssq; const float* c1; const float* c0; float ascale;
    __device__ __forceinline__ float act(float g, float u) const { const float e = __builtin_amdgcn_exp2f(g); return g * __builtin_amdgcn_rcpf(1.0f + e) * u; }
    __device__ __forceinline__ void operator()(const f32x4 (&acc)[2][2][4][2], const Unit& u, int wr, int wc, int fr, int fq) const {
        const int row0 = u.pm * BM + wr * 64 + fr, col0 = u.pn * HALF + wc * 32 + 8 * fq, wrow0 = u.pn * BM + wc * 32 + 8 * fq;
        f32x4 c1v[2][2], c0v[2][2];
#pragma unroll
        for (int bj = 0; bj < 2; ++bj)
#pragma unroll
            for (int n = 0; n < 2; ++n) { const float k_ = bj == 0 ? -1.4426950408889634f : -0.6931471805599453f; c1v[bj][n] = *(const f32x4*)(c1 + wrow0 + bj * HALF + 4 * n) * k_; c0v[bj][n] = *(const f32x4*)(c0 + wrow0 + bj * HALF + 4 * n) * k_; }
        float ra_[2][4], rb_[2][4];
#pragma unroll
        for (int ai = 0; ai < 2; ++ai)
#pragma unroll
            for (int m = 0; m < 4; ++m) { float mu, rs; row_stats(ssum, ssq, row0 + ai * HALF + m * 16, mu, rs); ra_[ai][m] = ascale * rs; rb_[ai][m] = -mu * rs; }
#pragma unroll
        for (int ai = 0; ai < 2; ++ai)
#pragma unroll
            for (int m = 0; m < 4; ++m) { const int row = row0 + ai * HALF + m * 16;
                const float rb = rb_[ai][m], rg = ra_[ai][m] * -1.4426950408889634f, ru = ra_[ai][m] * -0.6931471805599453f;
                unsigned char* rowp = O + (size_t)row * ldc + col0;
                const f32x4 g0 = acc[ai][0][m][0] * rg + (c1v[0][0] * rb + c0v[0][0]), g1 = acc[ai][0][m][1] * rg + (c1v[0][1] * rb + c0v[0][1]);
                const f32x4 u0 = acc[ai][1][m][0] * ru + (c1v[1][0] * rb + c0v[1][0]), u1 = acc[ai][1][m][1] * ru + (c1v[1][1] * rb + c0v[1][1]);
                int w0 = __builtin_amdgcn_cvt_pk_fp8_f32(act(g0[0], u0[0]), act(g0[1], u0[1]), 0, false); w0 = __builtin_amdgcn_cvt_pk_fp8_f32(act(g0[2], u0[2]), act(g0[3], u0[3]), w0, true);
                int w1 = __builtin_amdgcn_cvt_pk_fp8_f32(act(g1[0], u1[0]), act(g1[1], u1[1]), 0, false); w1 = __builtin_amdgcn_cvt_pk_fp8_f32(act(g1[2], u1[2]), act(g1[3], u1[3]), w1, true);
                u32x2 w; w.x = (unsigned)w0; w.y = (unsigned)w1; *(u32x2*)rowp = w; }
    }
};
struct EpiSwiglu8 {
    static constexpr int ID = 8;
    static constexpr bool PERM = true, AFTER_DRAIN = false;
    unsigned char* O; int ldc; float ascale;
    __device__ __forceinline__ float act(float g, float u) const { const float e = __builtin_amdgcn_exp2f(g); return g * __builtin_amdgcn_rcpf(1.0f + e) * u; }
    __device__ __forceinline__ void operator()(const f32x4 (&acc)[2][2][4][2], const Unit& u, int wr, int wc, int fr, int fq) const {
        const int row0 = u.pm * BM + wr * 64 + fr, col0 = u.pn * HALF + wc * 32 + 8 * fq;
        const float kg = ascale * -1.4426950408889634f, ku = ascale * -0.6931471805599453f;
#pragma unroll
        for (int ai = 0; ai < 2; ++ai)
#pragma unroll
            for (int m = 0; m < 4; ++m) { const int row = row0 + ai * HALF + m * 16;
                unsigned char* rowp = O + (size_t)row * ldc + col0;
                const f32x4 g0 = acc[ai][0][m][0] * kg, g1 = acc[ai][0][m][1] * kg, u0 = acc[ai][1][m][0] * ku, u1 = acc[ai][1][m][1] * ku;
                int w0 = __builtin_amdgcn_cvt_pk_fp8_f32(act(g0[0], u0[0]), act(g0[1], u0[1]), 0, false); w0 = __builtin_amdgcn_cvt_pk_fp8_f32(act(g0[2], u0[2]), act(g0[3], u0[3]), w0, true);
                int w1 = __builtin_amdgcn_cvt_pk_fp8_f32(act(g1[0], u1[0]), act(g1[1], u1[1]), 0, false); w1 = __builtin_amdgcn_cvt_pk_fp8_f32(act(g1[2], u1[2]), act(g1[3], u1[3]), w1, true);
                u32x2 w; w.x = (unsigned)w0; w.y = (unsigned)w1; *(u32x2*)rowp = w; }
    }
};
struct EpiResLN {
    static constexpr int ID = 7;
    static constexpr bool PERM = true, AFTER_DRAIN = false;
    const bf16_t* R; const float* g; const float* b; bf16_t* Yb; unsigned char* Y8; float* Yf; int ldc; float alpha; float ascale;
    unsigned long long* xbuf; unsigned* cnt; unsigned* tmo; PG8_LAS unsigned char* xl;
    __device__ __forceinline__ void operator()(f32x4 (&acc)[2][2][4][2], const Unit& u, int wr, int wc, int fr, int fq) const {
        typedef float f32x2v __attribute__((ext_vector_type(2)));
        const int row0 = u.pm * BM + wr * 64 + fr, col0 = u.pn * BM + wc * 32 + 8 * fq;
        float alpha_ = alpha, ascale_ = ascale; asm volatile("" : "+s"(alpha_), "+s"(ascale_));
        PG8_LAS f32x2v* P = (PG8_LAS f32x2v*)xl;
        PG8_LAS f32x2v* S = (PG8_LAS f32x2v*)(xl + 8192);
#pragma unroll
        for (int ai = 0; ai < 2; ++ai) {
            u32x4 xr[4][2];
#pragma unroll
            for (int m = 0; m < 4; ++m)
#pragma unroll
                for (int bj = 0; bj < 2; ++bj) xr[m][bj] = *(const u32x4*)(R + (size_t)(row0 + ai * HALF + m * 16) * ldc + col0 + bj * HALF);
            float ss[4], qq[4];
#pragma unroll
            for (int m = 0; m < 4; ++m) { float s = 0.f, q = 0.f;
#pragma unroll
                for (int bj = 0; bj < 2; ++bj) { const u32x4 xb = xr[m][bj];
                    f32x4 x0, x1; x0[0] = __uint_as_float(xb.x << 16); x0[1] = __uint_as_float(xb.x & 0xffff0000u); x0[2] = __uint_as_float(xb.y << 16); x0[3] = __uint_as_float(xb.y & 0xffff0000u);
                    x1[0] = __uint_as_float(xb.z << 16); x1[1] = __uint_as_float(xb.z & 0xffff0000u); x1[2] = __uint_as_float(xb.w << 16); x1[3] = __uint_as_float(xb.w & 0xffff0000u);
                    const f32x4 v0 = acc[ai][bj][m][0] * ascale_ + x0 * alpha_, v1 = acc[ai][bj][m][1] * ascale_ + x1 * alpha_;
                    acc[ai][bj][m][0] = v0; acc[ai][bj][m][1] = v1;
                    s += ((v0[0] + v0[1]) + (v0[2] + v0[3])) + ((v1[0] + v1[1]) + (v1[2] + v1[3]));
                    q += ((v0[0] * v0[0] + v0[1] * v0[1]) + (v0[2] * v0[2] + v0[3] * v0[3])) + ((v1[0] * v1[0] + v1[1] * v1[1]) + (v1[2] * v1[2] + v1[3] * v1[3])); }
                ss[m] = sum32x(sum16x(s)); qq[m] = sum32x(sum16x(q)); }
            const float sv = fq == 0 ? ss[0] : (fq == 1 ? ss[1] : (fq == 2 ? ss[2] : ss[3])), qv = fq == 0 ? qq[0] : (fq == 1 ? qq[1] : (fq == 2 ? qq[2] : qq[3]));
            P[(ai * HALF + wr * 64 + fq * 16 + fr) * 4 + wc] = (f32x2v){sv, qv}; }
        asm volatile("s_waitcnt lgkmcnt(0)" ::: "memory"); __builtin_amdgcn_s_barrier(); asm volatile("" ::: "memory");
        const int wid_ = wr * 4 + wc; int ln_; asm volatile("v_mbcnt_lo_u32_b32 %0, -1, 0\n\tv_mbcnt_hi_u32_b32 %0, -1, %0" : "=v"(ln_));
        const int row = wid_ * 64 + ln_;
        unsigned* cn = cnt + 16 * u.pm;
        if (wid_ < 4) {
            const f32x2v a = P[row * 4 + 0], b_ = P[row * 4 + 1], c = P[row * 4 + 2], d = P[row * 4 + 3];
            const float s4 = (a.x + b_.x) + (c.x + d.x), q4 = (a.y + b_.y) + (c.y + d.y);
            __hip_atomic_store(xbuf + ((size_t)(u.pm * BM + row) * 4 + u.pn), ((unsigned long long)__float_as_uint(q4) << 32) | __float_as_uint(s4), __ATOMIC_RELAXED, __HIP_MEMORY_SCOPE_AGENT);
            asm volatile("s_waitcnt vmcnt(0)" ::: "memory");
            if (ln_ == 0) __hip_atomic_fetch_add(cn, 1u, __ATOMIC_RELAXED, __HIP_MEMORY_SCOPE_AGENT);
        }
        if (wid_ == 0) { unsigned sp = 0;
            while ((unsigned)__builtin_amdgcn_readfirstlane((int)__hip_atomic_load(cn, __ATOMIC_RELAXED, __HIP_MEMORY_SCOPE_AGENT)) < 16u) {
                __builtin_amdgcn_s_sleep(1);
                if (++sp > (1u << 22)) { if (ln_ == 0) __hip_atomic_store(tmo, 1u, __ATOMIC_RELAXED, __HIP_MEMORY_SCOPE_AGENT); break; } }
            __builtin_amdgcn_fence(__ATOMIC_ACQUIRE, "agent"); asm volatile("s_waitcnt vmcnt(0)" ::: "memory"); }
        __builtin_amdgcn_s_barrier(); asm volatile("" ::: "memory");
        if (wid_ < 4) { float s = 0.f, q = 0.f;
#pragma unroll
            for (int j = 0; j < 4; ++j) { const unsigned long long w = __hip_atomic_load(xbuf + ((size_t)(u.pm * BM + row) * 4 + j), __ATOMIC_RELAXED, __HIP_MEMORY_SCOPE_AGENT); s += __uint_as_float((unsigned)w); q += __uint_as_float((unsigned)(w >> 32)); }
            const float mu = s * (1.f / 1024.f); S[row] = (f32x2v){mu, __builtin_amdgcn_rsqf(fmaxf(q * (1.f / 1024.f) - mu * mu, 0.f) + 1e-5f)}; }
        asm volatile("s_waitcnt lgkmcnt(0)" ::: "memory"); __builtin_amdgcn_s_barrier(); asm volatile("" ::: "memory");
        f32x4 gv[2][2], bv[2][2];
#pragma unroll
        for (int bj = 0; bj < 2; ++bj)
#pragma unroll
            for (int n = 0; n < 2; ++n) { gv[bj][n] = *(const f32x4*)(g + col0 + bj * HALF + 4 * n); bv[bj][n] = *(const f32x4*)(b + col0 + bj * HALF + 4 * n); }
#pragma unroll
        for (int ai = 0; ai < 2; ++ai)
#pragma unroll
            for (int m = 0; m < 4; ++m) { const int rl = ai * HALF + wr * 64 + m * 16 + fr; const f32x2v st = S[rl]; const float rs = st.y, rb = -st.x * st.y;
                const size_t off = (size_t)(u.pm * BM + rl) * ldc + col0;
#pragma unroll
                for (int bj = 0; bj < 2; ++bj) { const size_t c = off + bj * HALF;
                    const f32x4 y0 = (acc[ai][bj][m][0] * rs + rb) * gv[bj][0] + bv[bj][0], y1 = (acc[ai][bj][m][1] * rs + rb) * gv[bj][1] + bv[bj][1];
                    if (Yf) { *(f32x4*)(Yf + c) = y0; *(f32x4*)(Yf + c + 4) = y1; }
                    if (Yb) { u32x4 w; w.x = cvt_pk_bf16(y0[0], y0[1]); w.y = cvt_pk_bf16(y0[2], y0[3]); w.z = cvt_pk_bf16(y1[0], y1[1]); w.w = cvt_pk_bf16(y1[2], y1[3]); *(u32x4*)(Yb + c) = w; }
                    if (Y8) { int w0 = __builtin_amdgcn_cvt_pk_fp8_f32(y0[0], y0[1], 0, false); w0 = __builtin_amdgcn_cvt_pk_fp8_f32(y0[2], y0[3], w0, true);
                              int w1 = __builtin_amdgcn_cvt_pk_fp8_f32(y1[0], y1[1], 0, false); w1 = __builtin_amdgcn_cvt_pk_fp8_f32(y1[2], y1[3], w1, true);
                              u32x2 w8; w8.x = (unsigned)w0; w8.y = (unsigned)w1; *(u32x2*)(Y8 + c) = w8; } } }
    }
};
struct EpiResStat {
    static constexpr int ID = 2;
    static constexpr bool PERM = true, AFTER_DRAIN = false;
    const bf16_t* R; const float* rsum; const float* rsq; const float* g; const float* b; bf16_t* Hb; float* Hf; float* osum; float* osq; int ldc; float alpha; unsigned char* H8; float ascale; int pM;
    __device__ __forceinline__ void operator()(const f32x4 (&acc)[2][2][4][2], const Unit& u, int wr, int wc, int fr, int fq) const {
        const int row0 = u.pm * BM + wr * 64 + fr, col0 = u.pn * BM + wc * 32 + 8 * fq;
        float alpha_ = alpha, ascale_ = ascale; unsigned char* H8_ = H8; asm volatile("" : "+s"(alpha_), "+s"(ascale_), "+s"(H8_));
        f32x4 gv[2][2], bv[2][2];
#pragma unroll
        for (int bj = 0; bj < 2; ++bj)
#pragma unroll
            for (int n = 0; n < 2; ++n) { float z_ = 0.f, o_ = 1.f; asm volatile("" : "+v"(z_), "+v"(o_)); gv[bj][n] = rsum ? *(const f32x4*)(g + col0 + bj * HALF + 4 * n) : (f32x4){o_, o_, o_, o_}; bv[bj][n] = rsum ? *(const f32x4*)(b + col0 + bj * HALF + 4 * n) : (f32x4){z_, z_, z_, z_}; }
        float ss[2][4], qq[2][4];
#pragma unroll
        for (int ai = 0; ai < 2; ++ai) {
            u32x4 xr[4][2];
#pragma unroll
            for (int m = 0; m < 4; ++m)
#pragma unroll
                for (int bj = 0; bj < 2; ++bj) xr[m][bj] = *(const u32x4*)(R + (size_t)(row0 + ai * HALF + m * 16) * ldc + col0 + bj * HALF);
            float rs_[4], rb_[4];
#pragma unroll
            for (int m = 0; m < 4; ++m) { float mu, rs; row_stats(rsum, rsq, row0 + ai * HALF + m * 16, mu, rs); rs_[m] = rs; rb_[m] = -mu * rs; }
#pragma unroll
            for (int m = 0; m < 4; ++m) { const int row = row0 + ai * HALF + m * 16; const float rs = rs_[m], rb = rb_[m];
                const size_t off = (size_t)row * ldc + col0; float s = 0.f, q = 0.f;
#pragma unroll
                for (int bj = 0; bj < 2; ++bj) { const size_t c = off + bj * HALF; const u32x4 xb = xr[m][bj];
                    f32x4 x0, x1; x0[0] = __uint_as_float(xb.x << 16); x0[1] = __uint_as_float(xb.x & 0xffff0000u); x0[2] = __uint_as_float(xb.y << 16); x0[3] = __uint_as_float(xb.y & 0xffff0000u);
                    x1[0] = __uint_as_float(xb.z << 16); x1[1] = __uint_as_float(xb.z & 0xffff0000u); x1[2] = __uint_as_float(xb.w << 16); x1[3] = __uint_as_float(xb.w & 0xffff0000u);
                    x0 = (x0 * rs + rb) * gv[bj][0] + bv[bj][0]; x1 = (x1 * rs + rb) * gv[bj][1] + bv[bj][1];
                    const f32x4 v0 = acc[ai][bj][m][0] * ascale_ + x0 * alpha_, v1 = acc[ai][bj][m][1] * ascale_ + x1 * alpha_;
                    u32x4 w; w.x = cvt_pk_bf16(v0[0], v0[1]); w.y = cvt_pk_bf16(v0[2], v0[3]); w.z = cvt_pk_bf16(v1[0], v1[1]); w.w = cvt_pk_bf16(v1[2], v1[3]); *(u32x4*)(Hb + c) = w;
                    s += ((v0[0] + v0[1]) + (v0[2] + v0[3])) + ((v1[0] + v1[1]) + (v1[2] + v1[3]));
                    q += ((v0[0] * v0[0] + v0[1] * v0[1]) + (v0[2] * v0[2] + v0[3] * v0[3])) + ((v1[0] * v1[0] + v1[1] * v1[1]) + (v1[2] * v1[2] + v1[3] * v1[3]));
                    if (H8_) { int w0 = __builtin_amdgcn_cvt_pk_fp8_f32(v0[0], v0[1], 0, false); w0 = __builtin_amdgcn_cvt_pk_fp8_f32(v0[2], v0[3], w0, true);
                              int w1 = __builtin_amdgcn_cvt_pk_fp8_f32(v1[0], v1[1], 0, false); w1 = __builtin_amdgcn_cvt_pk_fp8_f32(v1[2], v1[3], w1, true);
                              u32x2 w8; w8.x = (unsigned)w0; w8.y = (unsigned)w1; *(u32x2*)(H8_ + c) = w8; } }
                ss[ai][m] = sum32x(sum16x(s)); qq[ai][m] = sum32x(sum16x(q)); } }
        if (!Hf && osum) { int l2_; asm volatile("v_mbcnt_lo_u32_b32 %0, -1, 0\n\tv_mbcnt_hi_u32_b32 %0, -1, %0" : "=v"(l2_)); const int fr = l2_ & 15, fq = l2_ >> 4, row0 = u.pm * BM + wr * 64 + fr;
            const size_t slot = (size_t)(u.pn * 4 + wc) * (size_t)pM;
#pragma unroll
            for (int ai = 0; ai < 2; ++ai) { const float sv = fq == 0 ? ss[ai][0] : (fq == 1 ? ss[ai][1] : (fq == 2 ? ss[ai][2] : ss[ai][3])), qv = fq == 0 ? qq[ai][0] : (fq == 1 ? qq[ai][1] : (fq == 2 ? qq[ai][2] : qq[ai][3]));
                const int row = row0 + ai * HALF + fq * 16;
                osum[slot + row] = sv; osq[slot + row] = qv; } }
    }
};
template <class Epi, class Sched, bool ALIGN_EPI = false, bool SP2 = false, bool FP8 = false>
__device__ __forceinline__ void gemm_phase(PG8_LAS unsigned char* lds, const Gemm g, const Sched& S, const Epi& E, int wave_in) {
    int lane_; asm volatile("v_mbcnt_lo_u32_b32 %0, -1, 0\n\tv_mbcnt_hi_u32_b32 %0, -1, %0" : "=v"(lane_)); const int tid_ = wave_in * 64 + lane_;
    const int tid = tid_, wid = __builtin_amdgcn_readfirstlane(tid >> 6), lane = tid & 63, wr = wid >> 2, wc = wid & 3, fr = lane & 15, fq = lane >> 4;
    const int K = g.K, nt = K / BK;
    unsigned voffA[2], voffB[2];
#pragma unroll
    for (int i = 0; i < 2; ++i) { int R, C; stage_rc(tid * 16 + i * 8192, R, C); const int Rb = Epi::PERM ? ((R & ~31) + perm32(R & 31)) : R;
        voffA[i] = (unsigned)(R * K + C) * 2u; voffB[i] = (unsigned)(Rb * K + C) * 2u; }
    const size_t kstep = g.scale_w == 777 ? (size_t)0 : (size_t)(BK * 2);
    const size_t hstep = (size_t)HALF * K * 2;
    const size_t tstep = 2 * hstep;
    const unsigned ldsw = (unsigned)wid * 1024u;
    const int aoff = lds_byte(wr * 64 + fr, fq * 8), boff = lds_byte(wc * 32 + fr, fq * 8);
#define PG8_SA(b, h) (((b) * 2 + (h)) * HTB)
#define PG8_SB(b, h) ((4 + (b) * 2 + (h)) * HTB)
#define PG8_STAGE(bufoff, gbase, voff) do { _Pragma("unroll") for (int _i = 0; _i < 2; ++_i) \
        __builtin_amdgcn_global_load_lds((const unsigned*)((const char*)(gbase) + (voff)[_i]), (PG8_LAS unsigned*)(lds + (bufoff) + ldsw + _i * 8192), 16, 0, 0); } while (0)
#define PG8_LDA16(dst, b, h) do { _Pragma("unroll") for (int m = 0; m < 4; ++m) _Pragma("unroll") for (int k = 0; k < 2; ++k) dst[m][k] = *(const PG8_LAS bf16x8*)(lds + PG8_SA(b, h) + aoff + m * 2048 + k * 1024); } while (0)
#define PG8_LDA8(dst, b, h) do { _Pragma("unroll") for (int m = 0; m < 4; ++m) { const v4i_t lo_ = *(const PG8_LAS v4i_t*)(lds + PG8_SA(b, h) + aoff + m * 2048), hi_ = *(const PG8_LAS v4i_t*)(lds + PG8_SA(b, h) + aoff + m * 2048 + 1024); dst[m] = __builtin_shufflevector(lo_, hi_, 0, 1, 2, 3, 4, 5, 6, 7); } } while (0)
#define PG8_LDA(dst, b, h) do { if constexpr (FP8) PG8_LDA8(dst##8, b, h); else PG8_LDA16(dst, b, h); } while (0)
#define PG8_LDB16(dst, b, h) do { _Pragma("unroll") for (int n = 0; n < 2; ++n) _Pragma("unroll") for (int k = 0; k < 2; ++k) dst[n][k] = *(const PG8_LAS bf16x8*)(lds + PG8_SB(b, h) + boff + n * 2048 + k * 1024); } while (0)
#define PG8_LDB8(dst, b, h) do { _Pragma("unroll") for (int n = 0; n < 2; ++n) { const v4i_t lo_ = *(const PG8_LAS v4i_t*)(lds + PG8_SB(b, h) + boff + n * 2048), hi_ = *(const PG8_LAS v4i_t*)(lds + PG8_SB(b, h) + boff + n * 2048 + 1024); dst[n] = __builtin_shufflevector(lo_, hi_, 0, 1, 2, 3, 4, 5, 6, 7); } } while (0)
#define PG8_LDB(dst, b, h) do { if constexpr (FP8) PG8_LDB8(dst##8, b, h); else PG8_LDB16(dst, b, h); } while (0)
#define PG8_MMA(ai, bj, At, Bt) do { __builtin_amdgcn_s_setprio(1); _Pragma("unroll") for (int m = 0; m < 4; ++m) _Pragma("unroll") for (int n = 0; n < 2; ++n) _Pragma("unroll") for (int k = 0; k < 2; ++k) \
        acc[ai][bj][m][n] = __builtin_amdgcn_mfma_f32_16x16x32_bf16(Bt[n][k], At[m][k], acc[ai][bj][m][n], 0, 0, 0); __builtin_amdgcn_s_setprio(0); } while (0)
#define PG8_MMA8(ai, bj, At, Bt) do { __builtin_amdgcn_s_setprio(1); _Pragma("unroll") for (int m = 0; m < 4; ++m) _Pragma("unroll") for (int n = 0; n < 2; ++n) \
        asm("v_mfma_f32_16x16x128_f8f6f4 %0, %1, %2, %0" : "+v"(acc[ai][bj][m][n]) : "v"(Bt[n]), "v"(At[m])); __builtin_amdgcn_s_setprio(0); } while (0)
#define PG8_MM(ai, bj, At, Bt) do { if constexpr (FP8) PG8_MMA8(ai, bj, At##8, Bt##8); else PG8_MMA(ai, bj, At, Bt); } while (0)
#define PG8_WAIT_V(n) asm volatile("s_waitcnt vmcnt(" #n ")" ::: "memory")
#define PG8_WAIT_L(n) asm volatile("s_waitcnt lgkmcnt(" #n ")" ::: "memory")
#define PG8_BAR __builtin_amdgcn_s_barrier()
#define PG8_SCHED __builtin_amdgcn_sched_barrier(0)
    Unit cur, nxt; int ui = 0;
    if (!S.next(0, cur)) return;
    f32x4 acc[2][2][4][2];
#pragma unroll
    for (int a = 0; a < 2; ++a)
#pragma unroll
        for (int b = 0; b < 2; ++b)
#pragma unroll
            for (int m = 0; m < 4; ++m)
#pragma unroll
                for (int n = 0; n < 2; ++n) acc[a][b][m][n] = (f32x4){0.f, 0.f, 0.f, 0.f};
    bf16x8 At[4][2], B0[2][2], B1[2][2]; v8i_t At8[4], B08[2], B18[2];
    const char* cA = (const char*)g.A + (size_t)cur.pm * tstep; const char* cB = (const char*)g.Bt + (size_t)cur.pn * tstep;
    S.a_ready(cur);
    if constexpr (SP2) {
        PG8_STAGE(PG8_SB(0, 0), cB, voffB); PG8_STAGE(PG8_SB(0, 1), cB + hstep, voffB); PG8_STAGE(PG8_SA(0, 0), cA, voffA); PG8_STAGE(PG8_SA(0, 1), cA + hstep, voffA);
        if (wr == 1) PG8_BAR;
        PG8_WAIT_V(2); PG8_BAR;
        PG8_STAGE(PG8_SB(1, 0), cB + kstep, voffB); PG8_STAGE(PG8_SA(1, 0), cA + kstep, voffA); PG8_STAGE(PG8_SB(1, 1), cB + hstep + kstep, voffB);
        PG8_WAIT_V(6); PG8_BAR;
    } else {
        PG8_STAGE(PG8_SB(0, 0), cB, voffB); PG8_STAGE(PG8_SA(0, 0), cA, voffA); PG8_STAGE(PG8_SB(0, 1), cB + hstep, voffB); PG8_STAGE(PG8_SA(0, 1), cA + hstep, voffA);
        if (wr == 1) PG8_BAR;
        PG8_WAIT_V(4); PG8_BAR;
        PG8_STAGE(PG8_SB(1, 0), cB + kstep, voffB); PG8_STAGE(PG8_SA(1, 0), cA + kstep, voffA); PG8_STAGE(PG8_SB(1, 1), cB + hstep + kstep, voffB);
        PG8_WAIT_V(6); PG8_BAR;
    }
    for (;;) {
        const bool has_next = S.next(ui + 1, nxt);
        const char* nA = has_next ? (const char*)g.A + (size_t)nxt.pm * tstep : cA; const char* nB = has_next ? (const char*)g.Bt + (size_t)nxt.pn * tstep : cB;
#pragma unroll 1
        for (int t = 0; t < nt; t += 2) {
            const bool last = (t == nt - 2);
            const char* a1 = cA + (size_t)(t + 1) * kstep;
            const char* a2 = last ? nA : cA + (size_t)(t + 2) * kstep; const char* b2 = last ? nB : cB + (size_t)(t + 2) * kstep;
            const char* a3 = a2 + kstep; const char* b3 = b2 + kstep;
            if (last && has_next) S.a_ready(nxt);
            if constexpr (SP2) {
            PG8_LDB(B0, 0, 0); PG8_LDB(B1, 0, 1); PG8_SCHED; PG8_LDA(At, 0, 0); PG8_STAGE(PG8_SA(1, 1), a1 + hstep, voffA);
            PG8_WAIT_V(8); PG8_WAIT_L(0); PG8_BAR; PG8_MM(0, 0, At, B0); PG8_MM(0, 1, At, B1); PG8_BAR; PG8_SCHED;
            PG8_LDA(At, 0, 1); PG8_STAGE(PG8_SB(0, 0), b2, voffB); PG8_STAGE(PG8_SB(0, 1), b2 + hstep, voffB); PG8_STAGE(PG8_SA(0, 0), a2, voffA);
            PG8_WAIT_V(8); PG8_WAIT_L(0); PG8_BAR; PG8_MM(1, 0, At, B0); PG8_MM(1, 1, At, B1); PG8_BAR; PG8_SCHED;
            PG8_LDB(B0, 1, 0); PG8_LDB(B1, 1, 1); PG8_SCHED; PG8_LDA(At, 1, 0); PG8_STAGE(PG8_SA(0, 1), a2 + hstep, voffA);
            PG8_WAIT_V(8); PG8_WAIT_L(0); PG8_BAR; PG8_MM(0, 0, At, B0); PG8_MM(0, 1, At, B1); PG8_BAR; PG8_SCHED;
            PG8_LDA(At, 1, 1); PG8_STAGE(PG8_SB(1, 0), b3, voffB); PG8_STAGE(PG8_SB(1, 1), b3 + hstep, voffB); PG8_STAGE(PG8_SA(1, 0), a3, voffA);
            PG8_WAIT_V(8); PG8_WAIT_L(0); PG8_BAR; PG8_MM(1, 0, At, B0); PG8_MM(1, 1, At, B1); PG8_BAR; PG8_SCHED;
            } else {
            PG8_LDB(B0, 0, 0); PG8_SCHED; PG8_LDA(At, 0, 0); PG8_STAGE(PG8_SA(1, 1), a1 + hstep, voffA);
            PG8_WAIT_L(8); PG8_BAR; PG8_WAIT_L(0); PG8_MM(0, 0, At, B0); PG8_BAR; PG8_SCHED;
            PG8_LDB(B1, 0, 1); PG8_STAGE(PG8_SB(0, 0), b2, voffB);
            PG8_BAR; PG8_WAIT_L(0); PG8_MM(0, 1, At, B1); PG8_BAR;
            PG8_LDA(At, 0, 1); PG8_STAGE(PG8_SA(0, 0), a2, voffA);
            PG8_BAR; PG8_WAIT_L(0); PG8_MM(1, 0, At, B0); PG8_BAR; PG8_SCHED;
            PG8_STAGE(PG8_SB(0, 1), b2 + hstep, voffB);
            PG8_WAIT_V(6); PG8_BAR; PG8_MM(1, 1, At, B1); PG8_BAR;
            PG8_LDB(B0, 1, 0); PG8_SCHED; PG8_LDA(At, 1, 0); PG8_STAGE(PG8_SA(0, 1), a2 + hstep, voffA);
            PG8_WAIT_L(8); PG8_BAR; PG8_WAIT_L(0); PG8_MM(0, 0, At, B0); PG8_BAR; PG8_SCHED;
            PG8_LDB(B1, 1, 1); PG8_STAGE(PG8_SB(1, 0), b3, voffB);
            PG8_BAR; PG8_WAIT_L(0); PG8_MM(0, 1, At, B1); PG8_BAR;
            PG8_LDA(At, 1, 1); PG8_STAGE(PG8_SA(1, 0), a3, voffA);
            PG8_BAR; PG8_WAIT_L(0); PG8_MM(1, 0, At, B0); PG8_BAR; PG8_SCHED;
            PG8_STAGE(PG8_SB(1, 1), b3 + hstep, voffB);
            PG8_WAIT_V(6); PG8_BAR; PG8_MM(1, 1, At, B1); PG8_BAR;
            }
        }
        if constexpr (ALIGN_EPI) { if (wr == 0) PG8_BAR; }
        if constexpr (FP8) asm volatile("s_nop 15\n\ts_nop 15" ::: "memory");
        if constexpr (!Epi::AFTER_DRAIN) { int le_; asm volatile("v_mbcnt_lo_u32_b32 %0, -1, 0\n\tv_mbcnt_hi_u32_b32 %0, -1, %0" : "=v"(le_)); E(acc, cur, wr, wc, le_ & 15, le_ >> 4);
#if REP_EPI > 1
            if constexpr ((REP_EPI_MASK >> Epi::ID) & 1) { for (int rr_ = 1; rr_ < REP_EPI; ++rr_) { asm volatile("" ::: "memory"); asm volatile("v_mbcnt_lo_u32_b32 %0, -1, 0\n\tv_mbcnt_hi_u32_b32 %0, -1, %0" : "=v"(le_)); E(acc, cur, wr, wc, le_ & 15, le_ >> 4); } }
#endif
            S.done(cur); }
        if (!has_next) break;
#pragma unroll
        for (int a = 0; a < 2; ++a)
#pragma unroll
            for (int b = 0; b < 2; ++b)
#pragma unroll
                for (int m = 0; m < 4; ++m)
#pragma unroll
                    for (int n = 0; n < 2; ++n) acc[a][b][m][n] = (f32x4){0.f, 0.f, 0.f, 0.f};
        cur = nxt; cA = nA; cB = nB; ++ui;
        if constexpr (ALIGN_EPI) { if (wr == 1) PG8_BAR; }
    }
    PG8_WAIT_V(0);
    if constexpr (!ALIGN_EPI) { if (wr == 0) PG8_BAR; }
    PG8_BAR;
    if constexpr (Epi::AFTER_DRAIN) { E.fused(acc, cur, wr, wc, fr, fq, lds, wid, lane); S.done(cur); }
#undef PG8_SA
#undef PG8_SB
#undef PG8_STAGE
#undef PG8_LDA
#undef PG8_LDA8
#undef PG8_LDA16
#undef PG8_LDB
#undef PG8_LDB8
#undef PG8_LDB16
#undef PG8_MMA
#undef PG8_MMA8
#undef PG8_MM
#undef PG8_WAIT_V
#undef PG8_WAIT_L
#undef PG8_BAR
#undef PG8_SCHED
}
}
constexpr int NWAVES = 8;
constexpr int BATCH = 32, SEQ = 2048, DM = 1024, M = BATCH * SEQ, ZC = 3072, FF = 2816, GU = 2 * FF, DEPTH = 2, INC = 3012;
constexpr float LN_EPS = 1e-5f, LOG2E = 1.4426950408889634f, ALPHA = 1.4142135623730951f;
constexpr int ZC_QA = 0, ZC_KA = 256, ZC_VA = 320, ZC_QI = 384, ZC_KI = 640, ZC_WI = 704, ZC_QB = 768, ZC_KB = 1024, ZC_VB = 1280, ZC_QC = 1536, ZC_KC = 2048, ZC_VC = 2560;
constexpr size_t MiB = 1u << 20;
constexpr size_t XCNT_OFF = 128 * 1024;
constexpr size_t WS_CTL = 0, CTL_ZERO_BYTES = 256 * 1024;
constexpr size_t WS_STAT = 1 * MiB;
constexpr size_t WS_CV = 3 * MiB;
constexpr size_t CV_LAYER = 2 * (3072 + 5632);
constexpr size_t WS_W = 4 * MiB;
constexpr size_t W_IN_B = (size_t)ZC * DM * 2, W_O_B = (size_t)DM * DM * 2, W_GU_B = (size_t)GU * DM * 2, W_D_B = (size_t)DM * FF * 2;
constexpr size_t W_LAYER_B = W_IN_B + W_O_B + W_GU_B + W_D_B;
constexpr size_t W_IN8_OFF = 3 * MiB;
constexpr size_t WS_X8 = 256 * MiB;
constexpr size_t WS_R0 = 64 * MiB, WS_R1 = 192 * MiB, WS_R2 = 320 * MiB, WS_BIG = 448 * MiB, WS_SP = 896 * MiB  , WS_CVP = 904 * MiB  , WS_END = 908 * MiB;
static_assert(WS_W + DEPTH * W_LAYER_B <= WS_R0, "weights fit below R0");
static_assert((size_t)M * ZC * 2 <= WS_END - WS_BIG && (size_t)M * DM * 4 <= WS_END - WS_BIG && (size_t)M * DM * 2 <= WS_R1 - WS_R0, "activation map");
constexpr int CW_TMO = 0, CW_BAR = 4096;
constexpr int RING_OFF = 0, RING_BYTES = 131072;
constexpr int LDSCTL_OFF = RING_BYTES, MISC_OFF = LDSCTL_OFF + 320;
constexpr int XT_OFF = RING_BYTES + 2048;
constexpr int LDS_BYTES = 147456;

typedef unsigned short bf16;
typedef unsigned v4u __attribute__((ext_vector_type(4)));
typedef unsigned v2u __attribute__((ext_vector_type(2)));
typedef float f32x4 __attribute__((ext_vector_type(4)));
#define LDS_WAIT() asm volatile("s_waitcnt lgkmcnt(0)" ::: "memory")
__device__ __forceinline__ unsigned f2bf(float f) { unsigned u = __builtin_bit_cast(unsigned, f); return (u + 0x7fffu + ((u >> 16) & 1u)) >> 16; }
__device__ __forceinline__ unsigned pk2(float lo, float hi) { return f2bf(lo) | (f2bf(hi) << 16); }
__device__ __forceinline__ float bflo(unsigned w) { return __uint_as_float(w << 16); }
__device__ __forceinline__ float bfhi(unsigned w) { return __uint_as_float(w & 0xffff0000u); }
__device__ __forceinline__ float bf1(bf16 b) { return __uint_as_float((unsigned)b << 16); }
__device__ __forceinline__ void unpack8(const v4u w, float (&f)[8]) { f[0] = bflo(w.x); f[1] = bfhi(w.x); f[2] = bflo(w.y); f[3] = bfhi(w.y); f[4] = bflo(w.z); f[5] = bfhi(w.z); f[6] = bflo(w.w); f[7] = bfhi(w.w); }
__device__ __forceinline__ float wave_sum(float v, int lane) {
#pragma unroll
    for (int o = 1; o < 64; o <<= 1) v += __int_as_float(__builtin_amdgcn_ds_bpermute((lane ^ o) << 2, __float_as_int(v)));
    return v;
}
__device__ __forceinline__ int mbcnt64(unsigned long long m) { return (int)__builtin_amdgcn_mbcnt_hi((unsigned)(m >> 32), __builtin_amdgcn_mbcnt_lo((unsigned)m, 0u)); }
#define GAS __attribute__((address_space(1)))
#define LAS __attribute__((address_space(3)))
typedef GAS unsigned gu32;
#define RLX_AGENT __ATOMIC_RELAXED, __HIP_MEMORY_SCOPE_AGENT
#define VM_WAIT() asm volatile("s_waitcnt vmcnt(0)" ::: "memory")
__device__ __forceinline__ int lane_now() { int l; asm volatile("v_mbcnt_lo_u32_b32 %0, -1, 0\n\tv_mbcnt_hi_u32_b32 %0, -1, %0" : "=v"(l)); return l; }
#define XB_TMO      128
#define XB_XCNT(j)  (256  + 64 * (j))
#define XB_XSUB(j)  (1280 + 64 * (j))
#define XB_XGEN(j)  (2304 + 64 * (j))
#define XB_TOP      3328
#define XB_TOPGEN   3392
#define XCD_BAR_WORDS 3456
#define XB_SPIN_CAP (1u << 24)

__device__ __forceinline__ unsigned xb_ld(unsigned* p)              { return __hip_atomic_load(p, __ATOMIC_RELAXED, __HIP_MEMORY_SCOPE_AGENT); }
__device__ __forceinline__ unsigned xb_add(unsigned* p, unsigned v) { return __hip_atomic_fetch_add(p, v, __ATOMIC_RELAXED, __HIP_MEMORY_SCOPE_AGENT); }
__device__ __forceinline__ unsigned xb_xcc_id() { return (unsigned)__builtin_amdgcn_s_getreg((3 << 11) | 20) & 0xFu; }
#define XB_SPIN(cond, bar) do { unsigned _sp = 0; while (cond) { __builtin_amdgcn_s_sleep(1); \
    if ((++_sp & 255u) == 0u) { if (xb_ld(&(bar)[XB_TMO])) break; if (_sp > XB_SPIN_CAP) { atomicAdd(&(bar)[XB_TMO], 1u); break; } } } } while (0)

struct XcdBarrier {
    unsigned* bar; unsigned x;
    volatile LAS unsigned* st;
};

__device__ __forceinline__ XcdBarrier xcd_barrier_post(unsigned* bar, volatile LAS unsigned* st) {
    XcdBarrier b; b.bar = bar; b.x = (unsigned)__builtin_amdgcn_readfirstlane((int)xb_xcc_id()); b.st = st;
    if (threadIdx.x == 0) (void)xb_add(&bar[XB_XCNT(b.x)], 1u);
    return b;
}
__device__ __forceinline__ void xcd_barrier_complete(unsigned* bar, unsigned x, unsigned& nloc, unsigned& nx) {
    const unsigned G = gridDim.x * gridDim.y * gridDim.z;
    unsigned sum, cnt, mine, sp = 0u;
    for (;;) {
        sum = 0u; cnt = 0u; mine = 0u;
#pragma unroll
        for (unsigned j = 0; j < 16; ++j) { const unsigned c = xb_ld(&bar[XB_XCNT(j)]); sum += c; cnt += (c > 0u) ? 1u : 0u; mine = (j == x) ? c : mine; }
        if (sum == G) break;
        __builtin_amdgcn_s_sleep(1);
        if ((++sp & 255u) == 0u) { if (xb_ld(&bar[XB_TMO])) break; if (sp > XB_SPIN_CAP) { atomicAdd(&bar[XB_TMO], 1u); break; } }
    }
    nloc = mine > 0u ? mine : 1u; nx = cnt > 0u ? cnt : 1u;
}

__device__ __forceinline__ void xcd_barrier(const XcdBarrier& b) {
    asm volatile("s_waitcnt vmcnt(0)" ::: "memory");
    __syncthreads();
    if (threadIdx.x == 0) {
        unsigned* bar = b.bar; asm volatile("" : "+s"(bar));
        const unsigned bx_ = (unsigned)__builtin_amdgcn_readfirstlane((int)xb_xcc_id());
        __builtin_amdgcn_s_waitcnt(0);
        unsigned nloc = b.st[0], nx = b.st[1];
        if (nloc == 0u) { xcd_barrier_complete(bar, bx_, nloc, nx); b.st[0] = nloc; b.st[1] = nx; }
        const unsigned old = xb_add(&bar[XB_XSUB(bx_)], 1u);
        const unsigned gen = old / nloc;
        if (old + 1u == (gen + 1u) * nloc) {
            __builtin_amdgcn_fence(__ATOMIC_RELEASE, "agent");
            asm volatile("s_waitcnt vmcnt(0)" ::: "memory");
            const unsigned og = xb_add(&bar[XB_TOP], 1u);
            const unsigned tg = og / nx;
            if (og + 1u == (tg + 1u) * nx) xb_add(&bar[XB_TOPGEN], 1u);
            else XB_SPIN(xb_ld(&bar[XB_TOPGEN]) == tg, bar);
            __builtin_amdgcn_fence(__ATOMIC_ACQUIRE, "agent");
            xb_add(&bar[XB_XGEN(bx_)], 1u);
            asm volatile("s_waitcnt vmcnt(0)" ::: "memory");
        } else {
            XB_SPIN(xb_ld(&bar[XB_XGEN(bx_)]) == gen, bar);
            __builtin_amdgcn_fence(__ATOMIC_ACQUIRE, "agent");
            asm volatile("s_waitcnt vmcnt(0)" ::: "memory");
        }
    }
    __syncthreads();
}
template <int TYPE, int FP8S = 0> __device__ __forceinline__ void transpose_item(const float* W0, const float* W1, const float* gk, const float* bk, float* c1o, float* c0o, int K, int Nsrc, int Ndst, bf16* WT, LAS float* scr, int item, int lane) {
    const int nblk = Ndst / 32, kb = item / nblk, nb = item % nblk, k0 = 64 * kb, n0 = 32 * nb;
    const int nd = n0 + (lane & 31);
    const float* src = W0; int c = nd; float sc = 1.f; bool pad = false;
    if (TYPE == 0) {
        if (nd < 708) c = nd; else if (nd < 768) { pad = true; c = 0; } else c = nd - 60;
        if (nd < 256) sc = 0.125f * LOG2E; else if (nd >= ZC_QB && nd < ZC_KB) sc = 0.17677669529663687f * LOG2E; else if (nd >= ZC_QC && nd < ZC_KC) sc = 0.125f * LOG2E;
    } else if (TYPE == 2) {
        const int tile = nd >> 8, w = nd & 255;
        if (w < 128) { src = W0; c = tile * 128 + w; } else { src = W1; c = tile * 128 + (w - 128); }
    }
    const bool f8 = FP8S && (TYPE != 0 || n0 < 256 || n0 >= 768);
    float s1 = 0.f, s0 = 0.f;
#pragma unroll
    for (int i = 0; i < 32; ++i) { const int kk = 2 * i + (lane >> 5); float v = pad ? 0.f : src[(size_t)(k0 + kk) * Nsrc + c] * sc;
        if (gk) { s0 += bk[k0 + kk] * v; v *= gk[k0 + kk];
            if (f8) s1 += __builtin_amdgcn_cvt_f32_fp8(__builtin_amdgcn_cvt_pk_fp8_f32(v * (float)(1 << FP8S), 0.f, 0, false), 0) * (1.f / (float)(1 << FP8S));
            else s1 += __uint_as_float(f2bf(v) << 16); }
        scr[kk * 33 + (lane & 31)] = v; }
    if (gk) { s1 += __int_as_float(__builtin_amdgcn_ds_bpermute((lane ^ 32) << 2, __float_as_int(s1))); s0 += __int_as_float(__builtin_amdgcn_ds_bpermute((lane ^ 32) << 2, __float_as_int(s0)));
        if (lane < 32 && c1o) { c1o[(size_t)kb * CV_LAYER + nd] = s1; c0o[(size_t)kb * CV_LAYER + nd] = s0; } }
    LDS_WAIT();
    const int c8 = lane & 7;
#pragma unroll
    for (int j = 0; j < 4; ++j) { const int n = (lane >> 3) + 8 * j; const LAS float* s = scr + (8 * c8) * 33 + n;
        if (f8) {
            const float S = (float)(1 << FP8S);
            int w0 = __builtin_amdgcn_cvt_pk_fp8_f32(s[0 * 33] * S, s[1 * 33] * S, 0, false); w0 = __builtin_amdgcn_cvt_pk_fp8_f32(s[2 * 33] * S, s[3 * 33] * S, w0, true);
            int w1 = __builtin_amdgcn_cvt_pk_fp8_f32(s[4 * 33] * S, s[5 * 33] * S, 0, false); w1 = __builtin_amdgcn_cvt_pk_fp8_f32(s[6 * 33] * S, s[7 * 33] * S, w1, true);
            v2u o; o.x = (unsigned)w0; o.y = (unsigned)w1; *(v2u*)((unsigned char*)WT + (TYPE == 0 ? W_IN8_OFF : 0) + (size_t)(n0 + n) * K + k0 + 8 * c8) = o;
        } else {
        v4u o; o.x = pk2(s[0 * 33], s[1 * 33]); o.y = pk2(s[2 * 33], s[3 * 33]); o.z = pk2(s[4 * 33], s[5 * 33]); o.w = pk2(s[6 * 33], s[7 * 33]);
        *(v4u*)(WT + (size_t)(n0 + n) * K + k0 + 8 * c8) = o; } }
    LDS_WAIT();
}

template <bool OUT_F32> __device__ __forceinline__ void ln_phase(const float* H, const float* g, const float* b, bf16* ob, float* of, int gw, int NGW, int lane) {
    asm volatile("" : "+v"(lane));
    f32x4 gv[4], bv[4];
#pragma unroll
    for (int j = 0; j < 4; ++j) { gv[j] = ((const f32x4*)g)[lane + 64 * j]; bv[j] = ((const f32x4*)b)[lane + 64 * j]; }
    for (int m = gw; m < M; m += NGW) {
        const f32x4* xr = (const f32x4*)(H + (size_t)m * DM) + lane;
        f32x4 v[4]; float s = 0.f;
#pragma unroll
        for (int j = 0; j < 4; ++j) { v[j] = xr[64 * j]; s += (v[j].x + v[j].y) + (v[j].z + v[j].w); }
        const float mean = wave_sum(s, lane) * (1.f / DM); float s2 = 0.f;
#pragma unroll
        for (int j = 0; j < 4; ++j) { v[j] = v[j] - mean; s2 += (v[j].x * v[j].x + v[j].y * v[j].y) + (v[j].z * v[j].z + v[j].w * v[j].w); }
        const float rstd = 1.f / sqrtf(wave_sum(s2, lane) * (1.f / DM) + LN_EPS);
#pragma unroll
        for (int j = 0; j < 4; ++j) { const f32x4 y = v[j] * rstd * gv[j] + bv[j];
            if (OUT_F32) ((f32x4*)(of + (size_t)m * DM))[lane + 64 * j] = y;
            else { v2u o; o.x = pk2(y.x, y.y); o.y = pk2(y.z, y.w); ((v2u*)(ob + (size_t)m * DM))[lane + 64 * j] = o; } }
    }
}


__device__ __forceinline__ void stats_reduce(const float* part, float* ssum, float* ssq, size_t gt, size_t nth) {
    for (size_t row = gt; row < (size_t)M; row += nth) { float s = 0.f, q = 0.f;
#pragma unroll
        for (int sl = 0; sl < 16; ++sl) { s += part[(size_t)sl * M + row]; q += part[(size_t)(16 + sl) * M + row]; }
        const float mu = s * (1.f / DM); ssum[row] = mu; ssq[row] = __builtin_amdgcn_rsqf(fmaxf(q * (1.f / DM) - mu * mu, 0.f) + LN_EPS); }
}
__device__ __forceinline__ void cv_reduce(const float* cvp, float* cv, size_t gt, size_t nth) {
    for (size_t i = gt; i < (size_t)DEPTH * CV_LAYER; i += nth) { const size_t l = i / CV_LAYER, j = i % CV_LAYER;
        if (l == 0 && j < 2 * (size_t)ZC) continue;
        float s = 0.f;
#pragma unroll
        for (int kb = 0; kb < 16; ++kb) s += cvp[(l * 16 + kb) * CV_LAYER + j];
        cv[i] = s; }
}
typedef short bf16x8v __attribute__((ext_vector_type(8)));
typedef float f32x16 __attribute__((ext_vector_type(16)));
typedef short s16x4 __attribute__((ext_vector_type(4)));
typedef short v4i16_t __attribute__((ext_vector_type(4)));
typedef float f32x2_t __attribute__((ext_vector_type(2)));
typedef __bf16 bf16x2_t __attribute__((ext_vector_type(2)));
__device__ __forceinline__ unsigned cvtpk(float lo, float hi) { f32x2_t v = {lo, hi}; bf16x2_t b = __builtin_convertvector(v, bf16x2_t); return __builtin_bit_cast(unsigned, b); }
__device__ __forceinline__ s16x4 lds_tr(LAS const unsigned char* p) { return __builtin_bit_cast(s16x4, __builtin_amdgcn_ds_read_tr16_b64_v4i16((LAS v4i16_t*)p)); }
__device__ __forceinline__ float swap_max(float v) { auto rr = __builtin_amdgcn_permlane32_swap(__float_as_uint(v), __float_as_uint(v), false, false); return fmaxf(__uint_as_float(rr[0]), __uint_as_float(rr[1])); }
__device__ __forceinline__ float swap_sum(float v) { auto rr = __builtin_amdgcn_permlane32_swap(__float_as_uint(v), __float_as_uint(v), false, false); return __uint_as_float(rr[0]) + __uint_as_float(rr[1]); }
#ifndef FL_MFMA_SUM
#define FL_MFMA_SUM 1
#endif
#ifndef FL_CLASS
#define FL_CLASS 1
#endif
#ifndef MIX_FP8
#define MIX_FP8 0
#endif
__device__ __forceinline__ void mix_store4(bf16* MIX, size_t idx, float a, float b, float c, float d) {
#if MIX_FP8
    int w8 = __builtin_amdgcn_cvt_pk_fp8_f32(a, b, 0, false); w8 = __builtin_amdgcn_cvt_pk_fp8_f32(c, d, w8, true); *(int*)((unsigned char*)MIX + idx) = w8;
#else
    v2u w; w.x = cvtpk(a, b); w.y = cvtpk(c, d); *(v2u*)(MIX + idx) = w;
#endif
}
__device__ __forceinline__ void mix_store_head(bf16* MIX, size_t orow  , int hi, const f32x16& a, const f32x16& b) {
#if MIX_FP8
    unsigned wa[4], wb[4];
#pragma unroll
    for (int rg = 0; rg < 4; ++rg) {
        int x = __builtin_amdgcn_cvt_pk_fp8_f32(a[4 * rg + 0], a[4 * rg + 1], 0, false); x = __builtin_amdgcn_cvt_pk_fp8_f32(a[4 * rg + 2], a[4 * rg + 3], x, true);
        int y = __builtin_amdgcn_cvt_pk_fp8_f32(b[4 * rg + 0], b[4 * rg + 1], 0, false); y = __builtin_amdgcn_cvt_pk_fp8_f32(b[4 * rg + 2], b[4 * rg + 3], y, true);
        auto rr = __builtin_amdgcn_permlane32_swap((unsigned)x, (unsigned)y, false, false);
        wa[rg] = rr[0]; wb[rg] = rr[1]; }
    unsigned char* p = (unsigned char*)MIX + (orow - 4 * hi) + 32 * hi;
    v4u w0, w1; w0.x = wa[0]; w0.y = wb[0]; w0.z = wa[1]; w0.w = wb[1]; w1.x = wa[2]; w1.y = wb[2]; w1.z = wa[3]; w1.w = wb[3];
    *(v4u*)p = w0; *(v4u*)(p + 16) = w1;
#else
#pragma unroll
    for (int rg = 0; rg < 4; ++rg) { mix_store4(MIX, orow + 8 * rg, a[4 * rg + 0], a[4 * rg + 1], a[4 * rg + 2], a[4 * rg + 3]); mix_store4(MIX, orow + 32 + 8 * rg, b[4 * rg + 0], b[4 * rg + 1], b[4 * rg + 2], b[4 * rg + 3]); }
#endif
}
#ifndef RAWBAR
#define RAWBAR 1
#endif
#if RAWBAR
#define FL_RAW_BAR() asm volatile("s_waitcnt lgkmcnt(0)\n\ts_barrier" ::: "memory")
#else
#define FL_RAW_BAR() __syncthreads()
#endif
constexpr float FL_THR = 4.0f;
constexpr int FL_K = 0, FL_V = 16384, FL_TAB = 32768, FL_TABN = 2112;
__device__ __forceinline__ void fl_glds16(const void* g, unsigned lds_base) {
    unsigned sv; asm volatile("s_mov_b32 %0, m0\n\ts_mov_b32 m0, %2\n\ts_nop 0\n\tglobal_load_lds_dwordx4 %1, off\n\ts_mov_b32 m0, %0" : "=&s"(sv) : "v"(g), "s"(lds_base) : "memory"); }
constexpr int FL_QS = 45056;
constexpr int FL_SUBG = FL_TAB + FL_TABN * 4;

__device__ __forceinline__ void fl_softmax(f32x16& p, float& m, float& l, f32x16 (&o)[2], bf16x8v (&pa)[2]) {
    const bool first = m < -1e29f;
    const float mref = first ? 0.f : m;
#pragma unroll
    for (int r = 0; r < 16; ++r) p[r] -= mref;
    float rm = fmaxf(fmaxf(p[0], p[1]), fmaxf(p[2], p[3]));
#pragma unroll
    for (int r = 4; r < 16; r += 4) rm = fmaxf(rm, fmaxf(fmaxf(p[r], p[r + 1]), fmaxf(p[r + 2], p[r + 3])));
    rm = swap_max(rm);
    const float dl = first ? ((rm > -1e29f) ? rm : 0.f) : ((rm > FL_THR) ? rm : 0.f);
    if (__any(dl != 0.f)) { const float al = first ? 1.f : __builtin_amdgcn_exp2f(-dl); l *= al;     o[0] *= al; o[1] *= al;
#pragma unroll
        for (int r = 0; r < 16; ++r) p[r] -= dl; }
    m = first ? ((rm > -1e29f) ? rm : m) : m + dl;
    float ls = 0.f;
#pragma unroll
    for (int r = 0; r < 16; ++r) { p[r] = __builtin_amdgcn_exp2f(p[r]); ls += p[r]; }
    l += ls;
    typedef unsigned u4 __attribute__((ext_vector_type(4)));
    u4 w0, w1; w0.x = cvtpk(p[0], p[1]); w0.y = cvtpk(p[2], p[3]); w0.z = cvtpk(p[4], p[5]); w0.w = cvtpk(p[6], p[7]);
    w1.x = cvtpk(p[8], p[9]); w1.y = cvtpk(p[10], p[11]); w1.z = cvtpk(p[12], p[13]); w1.w = cvtpk(p[14], p[15]);
    pa[0] = __builtin_bit_cast(bf16x8v, w0); pa[1] = __builtin_bit_cast(bf16x8v, w1);
}

__device__ __forceinline__ void fl_softmax2(f32x16& pa_, f32x16& pb_, float& m, float& l, f32x16 (&o)[2], bf16x8v (&pf)[4]) {
    const bool first = m < -1e29f;
    const float mref = first ? 0.f : m;
#pragma unroll
    for (int r = 0; r < 16; ++r) { pa_[r] -= mref; pb_[r] -= mref; }
    float rm = fmaxf(fmaxf(pa_[0], pa_[1]), fmaxf(pb_[0], pb_[1]));
#pragma unroll
    for (int r = 2; r < 16; r += 2) rm = fmaxf(rm, fmaxf(fmaxf(pa_[r], pa_[r + 1]), fmaxf(pb_[r], pb_[r + 1])));
    rm = swap_max(rm);
    const float dl = first ? ((rm > -1e29f) ? rm : 0.f) : ((rm > FL_THR) ? rm : 0.f);
    if (__any(dl != 0.f)) { const float al = first ? 1.f : __builtin_amdgcn_exp2f(-dl); l *= al; o[0] *= al; o[1] *= al;
#pragma unroll
        for (int r = 0; r < 16; ++r) { pa_[r] -= dl; pb_[r] -= dl; } }
    m = first ? ((rm > -1e29f) ? rm : m) : m + dl;
    float ls0 = 0.f, ls1 = 0.f;
#pragma unroll
    for (int r = 0; r < 16; ++r) { pa_[r] = __builtin_amdgcn_exp2f(pa_[r]); ls0 += pa_[r]; pb_[r] = __builtin_amdgcn_exp2f(pb_[r]); ls1 += pb_[r]; }
    l += ls0 + ls1;
    typedef unsigned u4 __attribute__((ext_vector_type(4)));
    u4 w;
    w.x = cvtpk(pa_[0], pa_[1]); w.y = cvtpk(pa_[2], pa_[3]); w.z = cvtpk(pa_[4], pa_[5]); w.w = cvtpk(pa_[6], pa_[7]); pf[0] = __builtin_bit_cast(bf16x8v, w);
    w.x = cvtpk(pa_[8], pa_[9]); w.y = cvtpk(pa_[10], pa_[11]); w.z = cvtpk(pa_[12], pa_[13]); w.w = cvtpk(pa_[14], pa_[15]); pf[1] = __builtin_bit_cast(bf16x8v, w);
    w.x = cvtpk(pb_[0], pb_[1]); w.y = cvtpk(pb_[2], pb_[3]); w.z = cvtpk(pb_[4], pb_[5]); w.w = cvtpk(pb_[6], pb_[7]); pf[2] = __builtin_bit_cast(bf16x8v, w);
    w.x = cvtpk(pb_[8], pb_[9]); w.y = cvtpk(pb_[10], pb_[11]); w.z = cvtpk(pb_[12], pb_[13]); w.w = cvtpk(pb_[14], pb_[15]); pf[3] = __builtin_bit_cast(bf16x8v, w);
}

__device__ __forceinline__ void fl_softmax3(f32x16& pa_, f32x16& pb_, float sha, float shb, float& m, float& l, f32x16 (&o)[2], bf16x8v (&pf)[4]) {
    const bool first = m < -1e29f;
    const float mref = first ? 0.f : m, ca = sha - mref, cb = shb - mref;
#pragma unroll
    for (int r = 0; r < 16; ++r) { pa_[r] += ca; pb_[r] += cb; }
    float rm = fmaxf(fmaxf(pa_[0], pa_[1]), fmaxf(pb_[0], pb_[1]));
#pragma unroll
    for (int r = 2; r < 16; r += 2) rm = fmaxf(rm, fmaxf(fmaxf(pa_[r], pa_[r + 1]), fmaxf(pb_[r], pb_[r + 1])));
    rm = swap_max(rm);
    const float dl = first ? ((rm > -1e29f) ? rm : 0.f) : ((rm > FL_THR) ? rm : 0.f);
    if (__any(dl != 0.f)) { const float al = first ? 1.f : __builtin_amdgcn_exp2f(-dl); l *= al; o[0] *= al; o[1] *= al;
#pragma unroll
        for (int r = 0; r < 16; ++r) { pa_[r] -= dl; pb_[r] -= dl; } }
    m = first ? ((rm > -1e29f) ? rm : m) : m + dl;
    float ls0 = 0.f, ls1 = 0.f;
#pragma unroll
    for (int r = 0; r < 16; ++r) { pa_[r] = __builtin_amdgcn_exp2f(pa_[r]); ls0 += pa_[r]; pb_[r] = __builtin_amdgcn_exp2f(pb_[r]); ls1 += pb_[r]; }
    l += ls0 + ls1;
    typedef unsigned u4 __attribute__((ext_vector_type(4)));
    u4 w;
    w.x = cvtpk(pa_[0], pa_[1]); w.y = cvtpk(pa_[2], pa_[3]); w.z = cvtpk(pa_[4], pa_[5]); w.w = cvtpk(pa_[6], pa_[7]); pf[0] = __builtin_bit_cast(bf16x8v, w);
    w.x = cvtpk(pa_[8], pa_[9]); w.y = cvtpk(pa_[10], pa_[11]); w.z = cvtpk(pa_[12], pa_[13]); w.w = cvtpk(pa_[14], pa_[15]); pf[1] = __builtin_bit_cast(bf16x8v, w);
    w.x = cvtpk(pb_[0], pb_[1]); w.y = cvtpk(pb_[2], pb_[3]); w.z = cvtpk(pb_[4], pb_[5]); w.w = cvtpk(pb_[6], pb_[7]); pf[2] = __builtin_bit_cast(bf16x8v, w);
    w.x = cvtpk(pb_[8], pb_[9]); w.y = cvtpk(pb_[10], pb_[11]); w.z = cvtpk(pb_[12], pb_[13]); w.w = cvtpk(pb_[14], pb_[15]); pf[3] = __builtin_bit_cast(bf16x8v, w);
}
__device__ __forceinline__ float fl_rowsum(const bf16x8v (&pf)[4]) {
    const bf16x8v ones = (bf16x8v){0x3f80, 0x3f80, 0x3f80, 0x3f80, 0x3f80, 0x3f80, 0x3f80, 0x3f80};
    f32x16 z;
#pragma unroll
    for (int r = 0; r < 16; ++r) z[r] = 0.f;
    z = __builtin_amdgcn_mfma_f32_32x32x16_bf16(ones, pf[0], z, 0, 0, 0); z = __builtin_amdgcn_mfma_f32_32x32x16_bf16(ones, pf[1], z, 0, 0, 0);
    z = __builtin_amdgcn_mfma_f32_32x32x16_bf16(ones, pf[2], z, 0, 0, 0); z = __builtin_amdgcn_mfma_f32_32x32x16_bf16(ones, pf[3], z, 0, 0, 0);
    return z[0];
}

template <int MODE> __device__ __forceinline__ void flash_unit(const bf16* Z, bf16* MIX, LAS unsigned char* L, int b, int h, int qb, float lam_full, float lambda_init, const float* subg, int tid, int wave, int lane,
        v4u& kA, v4u& vA, v4u& kB, v4u& vB  , int nb, int nh, int nqb  , bool newtab) {
    lane = lane_now(); tid = wave * 64 + lane;
    constexpr int NMAP = MODE == 0 ? 2 : 1, KS = 4 / NMAP;
    constexpr int CQ = MODE == 0 ? ZC_QB : ZC_QC, CK = MODE == 0 ? ZC_KB : ZC_KC, CV = MODE == 0 ? ZC_VB : ZC_VC;
    const int r32 = lane & 31, hi = lane >> 5;
    LAS unsigned char* Kb = L + FL_K; LAS unsigned char* Vb = L + FL_V; LAS float* tab = (LAS float*)(L + FL_TAB);
    const int Q0 = qb * 256, tq0 = Q0 + wave * 32, t = tq0 + r32;
    const bf16* zb = Z + (size_t)(b * SEQ) * ZC;
    const float sl = (MODE == 0 ? __builtin_amdgcn_exp2f(-2.f * (float)(h + 1)) : __builtin_amdgcn_exp2f(-(float)(h + 1))) * LOG2E;
    if (newtab)
    for (int j = tid; j < FL_TABN; j += NWAVES * 64) { const int d = 2047 - j; float v;
        if (MODE == 0) v = d < 0 ? -INFINITY : -sl * (float)d;
        else { const int mult = (d <= 128 ? 1 : 0) + (((d & 3) == 0 && d <= 512) ? 1 : 0) + ((d & 15) == 0 ? 1 : 0);
               v = (d < 0 || mult == 0) ? -INFINITY : -sl * (float)d + (mult == 1 ? 0.f : (mult == 2 ? 1.f : 1.5849625007211562f)); }
        tab[j] = v; }
    bf16x8v qf[NMAP][KS];
    if (MODE == 0) {
        asm volatile("s_waitcnt vmcnt(0)" ::: "memory");
#pragma unroll
        for (int mp = 0; mp < NMAP; ++mp)
#pragma unroll
            for (int ks = 0; ks < KS; ++ks) qf[mp][ks] = *(const LAS bf16x8v*)(L + FL_QS + wave * 4096 + (mp * KS + ks) * 1024 + lane * 16);
        asm volatile("s_waitcnt lgkmcnt(0)" ::: "memory");
        if (nqb >= 0) { const bf16* nq_ = Z + (size_t)(nb * SEQ + nqb * 256 + wave * 32 + r32) * ZC + CQ + nh * 64 + hi * 8;
            const unsigned qd_ = (unsigned)(size_t)L + FL_QS + wave * 4096;
#pragma unroll
            for (int f = 0; f < 4; ++f) fl_glds16(nq_ + f * 16, (unsigned)__builtin_amdgcn_readfirstlane(qd_ + f * 1024)); }
    } else {
#pragma unroll
    for (int mp = 0; mp < NMAP; ++mp)
#pragma unroll
        for (int ks = 0; ks < KS; ++ks) qf[mp][ks] = *(const bf16x8v*)(zb + (size_t)t * ZC + CQ + h * 64 + (mp * KS + ks) * 16 + hi * 8);
    }
    constexpr int NCLS = MODE == 0 ? 1 : 3;
    f32x16 cin[NCLS];
#pragma unroll
    for (int r = 0; r < 16; ++r) { const int cr = (r & 3) + 8 * (r >> 2) + 4 * hi; const float a = sl * (float)cr;
        if (MODE == 0) cin[0][r] = a;
        else { const bool m4 = ((t - cr) & 3) == 0, m16 = ((t - cr) & 15) == 0;
            cin[0][r] = a + (m16 ? 1.5849625007211562f : (m4 ? 1.f : 0.f)); cin[NCLS - 2][r] = m4 ? a + (m16 ? 1.f : 0.f) : -INFINITY; cin[NCLS - 1][r] = m16 ? a : -INFINITY; } }
    float m[NMAP], l[NMAP]; f32x16 o[NMAP][2];
#pragma unroll
    for (int mp = 0; mp < NMAP; ++mp) { m[mp] = -1e30f; l[mp] = 0.f;
#pragma unroll
        for (int r = 0; r < 16; ++r) { o[mp][0][r] = 0.f; o[mp][1][r] = 0.f; } }
    const int skey = tid >> 3, sc = tid & 7;
    const bf16* ksrc = zb + (size_t)skey * ZC + CK + h * 64 + sc * 8;
    const bf16* vsrc = zb + (size_t)skey * ZC + CV + h * 64 + sc * 8;
    const int kdst = (sc >> 1) * 2048 + (sc & 1) * 1024 + (skey >> 5) * 512 + (skey & 31) * 16;
    const int vdst = (sc >> 2) * 4096 + (skey >> 3) * 512 + (skey & 7) * 64 + (sc & 3) * 16;
    const int krd = hi * 1024 + r32 * 16;
    const int vrd = ((lane >> 4) & 1) * 32 + (lane & 3) * 8 + (4 * hi + ((lane & 15) >> 2)) * 64;
    int tilz = 64 * ZC; asm volatile("" : "+s"(tilz));
    int jt = Q0 / 64 + 3;
    const ptrdiff_t nxo = ((ptrdiff_t)(nb - b) * SEQ) * ZC + (nh - h) * 64 + (ptrdiff_t)(4 * nqb + 2) * tilz;
    *(LAS v4u*)(Kb + (jt & 1) * 8192 + kdst) = kA; *(LAS v4u*)(Vb + (jt & 1) * 8192 + vdst) = vA;
    FL_RAW_BAR();
#define FL_TILE(JT, KW, VW, KL, VL) do { const int jt_ = (JT); \
        if (jt_ >= 2) { KL = *(const v4u*)(ksrc + (size_t)((jt_ - 2) * tilz)); VL = *(const v4u*)(vsrc + (size_t)((jt_ - 2) * tilz)); } \
        else if (nqb >= 0) { const ptrdiff_t no_ = nxo + (ptrdiff_t)(jt_ * tilz); KL = *(const v4u*)(ksrc + no_); VL = *(const v4u*)(vsrc + no_); }     \
        const LAS unsigned char* Kc = Kb + (jt_ & 1) * 8192; const LAS unsigned char* Vc = Vb + (jt_ & 1) * 8192; \
        if (jt_ * 64 <= tq0) {                                            \
              \
            const LAS float* tp = tab + (2047 - t + jt_ * 64 + 4 * hi); \
            f32x16 bias0, bias1; \
            _Pragma("unroll") for (int r = 0; r < 16; ++r) { bias0[r] = tp[(r & 3) + 8 * (r >> 2)]; bias1[r] = tp[32 + (r & 3) + 8 * (r >> 2)]; } \
            _Pragma("unroll") for (int mp = 0; mp < NMAP; ++mp) { \
                f32x16 p0 = bias0, p1 = bias1; \
                _Pragma("unroll") for (int ks = 0; ks < KS; ++ks) { const bf16x8v kf0 = *(const LAS bf16x8v*)(Kc + (mp * KS + ks) * 2048 + krd), kf1 = *(const LAS bf16x8v*)(Kc + (mp * KS + ks) * 2048 + 512 + krd); \
                    p0 = __builtin_amdgcn_mfma_f32_32x32x16_bf16(kf0, qf[mp][ks], p0, 0, 0, 0); p1 = __builtin_amdgcn_mfma_f32_32x32x16_bf16(kf1, qf[mp][ks], p1, 0, 0, 0); } \
                bf16x8v pf[4]; \
                fl_softmax3(p0, p1, 0.f, 0.f, m[mp], l[mp], o[mp], pf); \
                _Pragma("unroll") for (int s4 = 0; s4 < 4; ++s4) _Pragma("unroll") for (int db = 0; db < 2; ++db) { const LAS unsigned char* vp = Vc + db * 4096 + s4 * 1024 + vrd; \
                        const s16x4 lo = lds_tr(vp), hh = lds_tr(vp + 512); \
                        const bf16x8v vf = (bf16x8v){lo[0], lo[1], lo[2], lo[3], hh[0], hh[1], hh[2], hh[3]}; \
                        o[mp][db] = __builtin_amdgcn_mfma_f32_32x32x16_bf16(vf, pf[s4], o[mp][db], 0, 0, 0); } } \
        } \
        if (jt_ >= 1) { *(LAS v4u*)(Kb + ((jt_ - 1) & 1) * 8192 + kdst) = KW; *(LAS v4u*)(Vb + ((jt_ - 1) & 1) * 8192 + vdst) = VW; } \
        FL_RAW_BAR(); } while (0)
    for (; jt >= 0; jt -= 2) { FL_TILE(jt, kB, vB, kA, vA); FL_TILE(jt - 1, kA, vA, kB, vB); }
#undef FL_TILE
    const size_t orow = (size_t)(b * SEQ + t) * DM + (MODE == 0 ? 256 : 512) + h * 64 + 4 * hi;
    if (MODE == 0) {
        const float i0 = 1.f / swap_sum(l[0]), i1 = lam_full / swap_sum(l[NMAP - 1]); float ss = 0.f;
#pragma unroll
        for (int db = 0; db < 2; ++db)
#pragma unroll
            for (int r = 0; r < 16; ++r) { const float v = o[0][db][r] * i0 - o[NMAP - 1][db][r] * i1; o[0][db][r] = v; ss += v * v; }
        const float rs = (1.f / sqrtf(swap_sum(ss) * (1.f / 64.f) + LN_EPS)) * lambda_init;
#pragma unroll
        for (int db = 0; db < 2; ++db)
#pragma unroll
            for (int rg = 0; rg < 4; ++rg) { const f32x4 g = *(const LAS f32x4*)(L + FL_SUBG + (32 * db + 8 * rg + 4 * hi) * 4);
                o[0][db][4 * rg + 0] *= rs * g.x; o[0][db][4 * rg + 1] *= rs * g.y; o[0][db][4 * rg + 2] *= rs * g.z; o[0][db][4 * rg + 3] *= rs * g.w; }
        mix_store_head(MIX, orow, hi, o[0][0], o[0][1]);
    } else {
        const float i0 = 1.f / swap_sum(l[0]);
        o[0][0] *= i0; o[0][1] *= i0; mix_store_head(MIX, orow, hi, o[0][0], o[0][1]);
    }
}
template <int MODE> __device__ __forceinline__ void flash_phase(const bf16* Z, bf16* MIX, LAS unsigned char* L, const float* lam, const float* subg, float lambda_init, int vcu, int G, int tid, int wave, int lane) {
    asm volatile("" : "+v"(tid), "+v"(lane));
    constexpr int NH = MODE == 0 ? 4 : 8, NPAIR = BATCH * NH * 4;
    float lam_full = 0.f;
    if (MODE == 0) { const int li = lane & 31; const float s01 = wave_sum(lam[li] * lam[32 + li], lane) * 0.5f, s23 = wave_sum(lam[64 + li] * lam[96 + li], lane) * 0.5f; lam_full = __int_as_float(__builtin_amdgcn_readfirstlane(__float_as_int(expf(s01) - expf(s23) + lambda_init))); }
    const float oml = __int_as_float(__builtin_amdgcn_readfirstlane(__float_as_int(1.f - lambda_init)));
    constexpr int CK = MODE == 0 ? ZC_KB : ZC_KC, CV = MODE == 0 ? ZC_VB : ZC_VC;
    if (MODE == 0) { const int t_ = wave * 64 + lane_now(); if (t_ < 64) ((LAS float*)(L + FL_SUBG))[t_] = subg[t_]; }
    v4u kA = {0u, 0u, 0u, 0u}, vA = kA, kB = kA, vB = kA;
    if (vcu < NPAIR) {
        const int b = vcu / (NH * 4), h = (vcu >> 2) % NH, x = vcu & 3, t_ = wave * 64 + lane_now();
        const bf16* s_ = Z + (size_t)(b * SEQ + (t_ >> 3)) * ZC + h * 64 + (t_ & 7) * 8 + (size_t)(4 * (7 - x) + 2) * (64 * ZC);
        kB = *(const v4u*)(s_ + CK); vB = *(const v4u*)(s_ + CV); kA = *(const v4u*)(s_ + CK + 64 * ZC); vA = *(const v4u*)(s_ + CV + 64 * ZC);
        if (MODE == 0) { const int ln_ = t_ & 63;
            const bf16* nq_ = Z + (size_t)(b * SEQ + (7 - x) * 256 + wave * 32 + (ln_ & 31)) * ZC + ZC_QB + h * 64 + (ln_ >> 5) * 8;
            const unsigned qd_ = (unsigned)(size_t)L + FL_QS + wave * 4096;
#pragma unroll
            for (int f = 0; f < 4; ++f) fl_glds16(nq_ + f * 16, (unsigned)__builtin_amdgcn_readfirstlane(qd_ + f * 1024));
            asm volatile("s_waitcnt vmcnt(0)" ::: "memory"); } }
    for (int p = vcu; p < NPAIR; p += G) {
        const int b = p / (NH * 4), h = (p >> 2) % NH, x = p & 3;
        const int pn = p + G, bn = pn / (NH * 4), hn = (pn >> 2) % NH, xn = pn < NPAIR ? 7 - (pn & 3) : -1;
#pragma unroll 1
        for (int k = 0; k < 2; ++k) { flash_unit<MODE>(Z, MIX, L, b, h, k == 0 ? 7 - x : x, lam_full, oml, subg, tid, wave, lane, kA, vA, kB, vB, k == 0 ? b : bn, k == 0 ? h : hn, k == 0 ? x : xn, k == 0); __syncthreads(); }
    }
}
constexpr int F2_K = 0, F2_V = 24576, F2_TAB = 40960;
#define F2_QK(S, KSLOT, MP, JT) do { const LAS float* tp_ = tab + (2047 - t + (JT) * 64 + 4 * hi); const LAS unsigned char* kc_ = Kb + (KSLOT) * 8192; \
        _Pragma("unroll") for (int r = 0; r < 16; ++r) { S[0][r] = tp_[(r & 3) + 8 * (r >> 2)]; S[1][r] = tp_[32 + (r & 3) + 8 * (r >> 2)]; } \
        _Pragma("unroll") for (int ks = 0; ks < KS; ++ks) { const bf16x8v k0_ = *(const LAS bf16x8v*)(kc_ + ((MP) * KS + ks) * 2048 + krd), k1_ = *(const LAS bf16x8v*)(kc_ + ((MP) * KS + ks) * 2048 + 512 + krd); \
            S[0] = __builtin_amdgcn_mfma_f32_32x32x16_bf16(k0_, qf[MP][ks], S[0], 0, 0, 0); S[1] = __builtin_amdgcn_mfma_f32_32x32x16_bf16(k1_, qf[MP][ks], S[1], 0, 0, 0); } } while (0)
#define F2_BD(S, MP) do { float rm_ = fmaxf(fmaxf(S[0][0], S[0][1]), fmaxf(S[1][0], S[1][1])); \
        _Pragma("unroll") for (int r = 2; r < 16; r += 2) rm_ = fmaxf(rm_, fmaxf(fmaxf(S[0][r], S[0][r + 1]), fmaxf(S[1][r], S[1][r + 1]))); \
        rm_ = swap_max(rm_); const bool first_ = m[MP] < -1e29f; \
        const bool up_ = first_ ? (rm_ > -1e29f) : (rm_ > m[MP] + FL_THR); \
        if (__any(up_)) { const float nm_ = up_ ? rm_ : m[MP], al_ = (first_ || !up_) ? 1.f : __builtin_amdgcn_exp2f(m[MP] - nm_); l[MP] *= al_; o[MP][0] *= al_; o[MP][1] *= al_; m[MP] = nm_; } } while (0)
#define F2_SM(S, MP, PF) do { const float nm_ = -m[MP]; float ls0_ = 0.f, ls1_ = 0.f; \
        _Pragma("unroll") for (int r = 0; r < 16; ++r) { S[0][r] = __builtin_amdgcn_exp2f(S[0][r] + nm_); ls0_ += S[0][r]; S[1][r] = __builtin_amdgcn_exp2f(S[1][r] + nm_); ls1_ += S[1][r]; } \
        l[MP] += ls0_ + ls1_; \
        { typedef unsigned u4_ __attribute__((ext_vector_type(4))); u4_ w_; \
          w_.x = cvtpk(S[0][0], S[0][1]); w_.y = cvtpk(S[0][2], S[0][3]); w_.z = cvtpk(S[0][4], S[0][5]); w_.w = cvtpk(S[0][6], S[0][7]); PF[0] = __builtin_bit_cast(bf16x8v, w_); \
          w_.x = cvtpk(S[0][8], S[0][9]); w_.y = cvtpk(S[0][10], S[0][11]); w_.z = cvtpk(S[0][12], S[0][13]); w_.w = cvtpk(S[0][14], S[0][15]); PF[1] = __builtin_bit_cast(bf16x8v, w_); \
          w_.x = cvtpk(S[1][0], S[1][1]); w_.y = cvtpk(S[1][2], S[1][3]); w_.z = cvtpk(S[1][4], S[1][5]); w_.w = cvtpk(S[1][6], S[1][7]); PF[2] = __builtin_bit_cast(bf16x8v, w_); \
          w_.x = cvtpk(S[1][8], S[1][9]); w_.y = cvtpk(S[1][10], S[1][11]); w_.z = cvtpk(S[1][12], S[1][13]); w_.w = cvtpk(S[1][14], S[1][15]); PF[3] = __builtin_bit_cast(bf16x8v, w_); } } while (0)
#define F2_PV(MP, VSLOT, PF) do { const LAS unsigned char* vc_ = Vb + (VSLOT) * 8192; \
        _Pragma("unroll") for (int s4 = 0; s4 < 4; ++s4) _Pragma("unroll") for (int db = 0; db < 2; ++db) { const LAS unsigned char* vp_ = vc_ + db * 4096 + s4 * 1024 + vrd; \
            const s16x4 lo_ = lds_tr(vp_), hh_ = lds_tr(vp_ + 512); const bf16x8v vf_ = (bf16x8v){lo_[0], lo_[1], lo_[2], lo_[3], hh_[0], hh_[1], hh_[2], hh_[3]}; \
            o[MP][db] = __builtin_amdgcn_mfma_f32_32x32x16_bf16(vf_, PF[s4], o[MP][db], 0, 0, 0); } } while (0)

template <int MODE> __device__ __forceinline__ void flash_unit2(const bf16* Z, bf16* MIX, LAS unsigned char* L, int b, int h, int qb, float lam_full, float lambda_init, const float* subg, int wave) {
    const int lane = lane_now(), tid = wave * 64 + lane;
    constexpr int NMAP = MODE == 0 ? 2 : 1, KS = 4 / NMAP;
    constexpr int CQ = MODE == 0 ? ZC_QB : ZC_QC, CK = MODE == 0 ? ZC_KB : ZC_KC, CV = MODE == 0 ? ZC_VB : ZC_VC;
    const int r32 = lane & 31, hi = lane >> 5;
    LAS unsigned char* Kb = L + F2_K; LAS unsigned char* Vb = L + F2_V; LAS float* tab = (LAS float*)(L + F2_TAB);
    const int Q0 = qb * 256, tq0 = Q0 + wave * 32, t = tq0 + r32, Jw = tq0 >> 6;
    const bf16* zb = Z + (size_t)(b * SEQ) * ZC;
    const float sl = (MODE == 0 ? __builtin_amdgcn_exp2f(-2.f * (float)(h + 1)) : __builtin_amdgcn_exp2f(-(float)(h + 1))) * LOG2E;
    for (int j = tid; j < FL_TABN; j += NWAVES * 64) { const int d = 2047 - j; float v;
        if (MODE == 0) v = d < 0 ? -INFINITY : -sl * (float)d;
        else { const int mult = (d <= 128 ? 1 : 0) + (((d & 3) == 0 && d <= 512) ? 1 : 0) + ((d & 15) == 0 ? 1 : 0);
               v = (d < 0 || mult == 0) ? -INFINITY : -sl * (float)d + (mult == 1 ? 0.f : (mult == 2 ? 1.f : 1.5849625007211562f)); }
        tab[j] = v; }
    bf16x8v qf[NMAP][KS];
#pragma unroll
    for (int mp = 0; mp < NMAP; ++mp)
#pragma unroll
        for (int ks = 0; ks < KS; ++ks) qf[mp][ks] = *(const bf16x8v*)(zb + (size_t)t * ZC + CQ + h * 64 + (mp * KS + ks) * 16 + hi * 8);
    float m[NMAP], l[NMAP]; f32x16 o[NMAP][2];
#pragma unroll
    for (int mp = 0; mp < NMAP; ++mp) { m[mp] = -1e30f; l[mp] = 0.f;
#pragma unroll
        for (int r = 0; r < 16; ++r) { o[mp][0][r] = 0.f; o[mp][1][r] = 0.f; } }
    const int skey = tid >> 3, sc = tid & 7;
    const bf16* ksrc = zb + (size_t)skey * ZC + CK + h * 64 + sc * 8;
    const bf16* vsrc = zb + (size_t)skey * ZC + CV + h * 64 + sc * 8;
    const int kdst = (sc >> 1) * 2048 + (sc & 1) * 1024 + (skey >> 5) * 512 + (skey & 31) * 16;
    const int vdst = (sc >> 2) * 4096 + (skey >> 3) * 512 + (skey & 7) * 64 + (sc & 3) * 16;
    const int krd = hi * 1024 + r32 * 16;
    const int vrd = ((lane >> 4) & 1) * 32 + (lane & 3) * 8 + (4 * hi + ((lane & 15) >> 2)) * 64;
    const size_t til = (size_t)64 * ZC;
    const int J = Q0 / 64 + 3;
    int k0s = J % 3, k1s = (J + 2) % 3, k2s = (J + 1) % 3;
    { const v4u a = *(const v4u*)(ksrc + J * til), bq = *(const v4u*)(ksrc + (J - 1) * til), c = *(const v4u*)(vsrc + J * til);
      *(LAS v4u*)(Kb + k0s * 8192 + kdst) = a; *(LAS v4u*)(Kb + k1s * 8192 + kdst) = bq; *(LAS v4u*)(Vb + (J & 1) * 8192 + vdst) = c; }
    v4u kA = *(const v4u*)(ksrc + (J - 2) * til), vA = *(const v4u*)(vsrc + (J - 1) * til);
    v4u kB = kA, vB = vA;
    __syncthreads();
    f32x16 Sa[2], Sb[2];
    if (J <= Jw) { F2_QK(Sa, k0s, 0, J); F2_BD(Sa, 0); }
#define F2_TILE(JT, KW, VW, KL, VL, SC, SN) do { const int jt_ = (JT); \
        if (jt_ >= 3) KL = *(const v4u*)(ksrc + (jt_ - 3) * til); if (jt_ >= 2) VL = *(const v4u*)(vsrc + (jt_ - 2) * til); \
        if (MODE == 1) { \
            if (jt_ <= Jw && jt_ >= 1) { bf16x8v pf_[4]; if (wave >= 4) { F2_SM(SC, 0, pf_); F2_PV(0, jt_ & 1, pf_); F2_QK(SN, k1s, 0, jt_ - 1); F2_BD(SN, 0); } else { F2_QK(SN, k1s, 0, jt_ - 1); F2_SM(SC, 0, pf_); F2_PV(0, jt_ & 1, pf_); F2_BD(SN, 0); } } \
            else if (jt_ == Jw + 1) { F2_QK(SN, k1s, 0, jt_ - 1); F2_BD(SN, 0); } \
            else if (jt_ <= Jw) { bf16x8v pf_[4]; F2_SM(SC, 0, pf_); F2_PV(0, jt_ & 1, pf_); } \
        } else { \
            if (jt_ <= Jw) { bf16x8v pf_[4]; F2_QK(Sb, k0s, NMAP - 1, jt_); F2_SM(Sa, 0, pf_); F2_PV(0, jt_ & 1, pf_); F2_BD(Sb, NMAP - 1); } \
            if (jt_ <= Jw + 1 && jt_ >= 1) { F2_QK(Sa, k1s, 0, jt_ - 1); } \
            if (jt_ <= Jw) { bf16x8v pf_[4]; F2_SM(Sb, NMAP - 1, pf_); F2_PV(NMAP - 1, jt_ & 1, pf_); } \
            if (jt_ <= Jw + 1 && jt_ >= 1) { F2_BD(Sa, 0); } \
        } \
        if (jt_ >= 2) *(LAS v4u*)(Kb + k2s * 8192 + kdst) = KW; if (jt_ >= 1) *(LAS v4u*)(Vb + ((jt_ - 1) & 1) * 8192 + vdst) = VW; \
        { const int t_ = k0s; k0s = k1s; k1s = k2s; k2s = t_; } \
        __syncthreads(); } while (0)
    for (int jt = J; jt >= 0; jt -= 2) { F2_TILE(jt, kA, vA, kB, vB, Sa, Sb); F2_TILE(jt - 1, kB, vB, kA, vA, Sb, Sa); }
#undef F2_TILE
    bf16* orow = MIX + (size_t)(b * SEQ + t) * DM + (MODE == 0 ? 256 : 512) + h * 64 + 4 * hi;
    if (MODE == 0) {
        const float i0 = 1.f / swap_sum(l[0]), i1 = lam_full / swap_sum(l[NMAP - 1]); float ss = 0.f;
#pragma unroll
        for (int db = 0; db < 2; ++db)
#pragma unroll
            for (int r = 0; r < 16; ++r) { const float v = o[0][db][r] * i0 - o[NMAP - 1][db][r] * i1; o[0][db][r] = v; ss += v * v; }
        const float rs = (1.f / sqrtf(swap_sum(ss) * (1.f / 64.f) + LN_EPS)) * (1.f - lambda_init);
#pragma unroll
        for (int db = 0; db < 2; ++db)
#pragma unroll
            for (int rg = 0; rg < 4; ++rg) { const f32x4 g = *(const f32x4*)(subg + 32 * db + 8 * rg + 4 * hi);
                v2u w; w.x = cvtpk(o[0][db][4 * rg + 0] * rs * g.x, o[0][db][4 * rg + 1] * rs * g.y); w.y = cvtpk(o[0][db][4 * rg + 2] * rs * g.z, o[0][db][4 * rg + 3] * rs * g.w);
                *(v2u*)(orow + 32 * db + 8 * rg) = w; }
    } else {
        const float i0 = 1.f / swap_sum(l[0]);
#pragma unroll
        for (int db = 0; db < 2; ++db)
#pragma unroll
            for (int rg = 0; rg < 4; ++rg) { v2u w; w.x = cvtpk(o[0][db][4 * rg + 0] * i0, o[0][db][4 * rg + 1] * i0); w.y = cvtpk(o[0][db][4 * rg + 2] * i0, o[0][db][4 * rg + 3] * i0);
                *(v2u*)(orow + 32 * db + 8 * rg) = w; }
    }
}
template <int MODE> __device__ __forceinline__ void flash_phase2(const bf16* Z, bf16* MIX, LAS unsigned char* L, const float* lam, const float* subg, float lambda_init, int vcu, int G, int tid, int wave, int lane) {
    constexpr int NH = MODE == 0 ? 4 : 8, NPAIR = BATCH * NH * 4;
    float lam_full = 0.f;
    if (MODE == 0) { const int li = lane & 31; const float s01 = wave_sum(lam[li] * lam[32 + li], lane) * 0.5f, s23 = wave_sum(lam[64 + li] * lam[96 + li], lane) * 0.5f; lam_full = expf(s01) - expf(s23) + lambda_init; }
    for (int p = vcu; p < NPAIR; p += G) {
        const int b = p / (NH * 4), h = (p >> 2) % NH, x = p & 3;
#pragma unroll 1
        for (int k = 0; k < 2; ++k) { flash_unit2<MODE>(Z, MIX, L, b, h, k == 0 ? 7 - x : x, lam_full, lambda_init, subg, wave); __syncthreads(); }
    }
}
#ifndef FSUB_STREAM
#define FSUB_STREAM 1
#endif
constexpr int FLS_TABN = 2304;
constexpr int FLS_TABW = FL_TAB + FLS_TABN * 4;
constexpr int FLS_WK = 44032, FLS_WV = FLS_WK + 9 * 4096;
static_assert(FLS_TABW + 3 * 96 * 4 <= FLS_WK && FLS_WV + 9 * 4096 <= RING_BYTES, "sub-lattice LDS map");

#define FS_SBAR() __builtin_amdgcn_sched_barrier(0)
#define FS_PIN(x) asm volatile("" : "+v"(x))
#define FS_MFMA(a, b, c) __builtin_amdgcn_mfma_f32_32x32x16_bf16(a, b, c, 0, 0, 0)
#define FS_WAIT_BAR(N) asm volatile("s_waitcnt vmcnt(" #N ") lgkmcnt(0)\n\ts_barrier" ::: "memory")
#define FS_MX3(a, b, c) __builtin_fmaxf(__builtin_fmaxf((a), (b)), (c))
#ifndef FS_THR_V
#define FS_THR_V 8.0f
#endif
constexpr float FS_THR = FS_THR_V;
__device__ __forceinline__ void fs_glds16(const void* g, unsigned lds_base) {
    unsigned sv; asm volatile("s_mov_b32 %0, m0\n\ts_mov_b32 m0, %2\n\ts_nop 0\n\tglobal_load_lds_dwordx4 %1, off\n\ts_mov_b32 m0, %0" : "=&s"(sv) : "v"(g), "s"(lds_base) : "memory"); }
__device__ __forceinline__ void fs_kload2(bf16x8v* kf, const LAS unsigned char* kp, int d0) { kf[2 * d0] = *(const LAS bf16x8v*)(kp + d0 * 2048); kf[2 * d0 + 1] = *(const LAS bf16x8v*)(kp + d0 * 2048 + 512); }
__device__ __forceinline__ float fs_rowmax(const f32x16& p0, const f32x16& p1) {
    float a = FS_MX3(p0[0], p0[1], p1[0]), b = FS_MX3(p0[2], p0[3], p1[1]); a = FS_MX3(a, p1[2], p1[3]);
#pragma unroll
    for (int r = 4; r < 16; r += 4) { a = FS_MX3(a, p0[r], p0[r + 1]); b = FS_MX3(b, p0[r + 2], p0[r + 3]); a = FS_MX3(a, p1[r], p1[r + 1]); b = FS_MX3(b, p1[r + 2], p1[r + 3]); }
    return swap_max(__builtin_fmaxf(a, b)); }
__device__ __forceinline__ void fsub_stream(const bf16* zb, int zs4, int h, int Q0, int wid, int lane, LAS unsigned char* L, const bf16x8v (&qr)[4], float& m_io, float& l_io, f32x16 (&o)[2]) {
    const int r32 = lane & 31, hi = lane >> 5; const int NT = Q0 / 64 + 4, t = Q0 + wid * 32 + r32;
    constexpr int SLOTB = 8192, RK = FLS_WK, RV = FLS_WK + 3 * SLOTB;
    const unsigned lds0 = (unsigned)(size_t)L;
    size_t tilz = (size_t)64 * (size_t)zs4;
    const bf16* ksrc = zb + (size_t)lane * zs4 + ZC_KC + h * 64 + wid * 8;
    const bf16* vsrc = zb + (size_t)(16 * (wid & 3) + (lane >> 2)) * zs4 + ZC_VC + h * 64 + (wid >> 2) * 32 + (lane & 3) * 8;
    const unsigned kdst = lds0 + RK + wid * 1024, vdst = lds0 + RV + wid * 1024;
#define DMA_K(s_, slot) fs_glds16(ksrc + (size_t)(NT - 1 - (s_)) * tilz, (unsigned)__builtin_amdgcn_readfirstlane(kdst + (slot)))
#define DMA_V(s_, slot) fs_glds16(vsrc + (size_t)(NT - 1 - (s_)) * tilz, (unsigned)__builtin_amdgcn_readfirstlane(vdst + (slot)))
    const LAS unsigned char* vp0 = L + RV + ((lane >> 4) & 1) * 32 + (lane & 3) * 8 + (4 * hi + ((lane & 15) >> 2)) * 64;
    const LAS unsigned char* kp0 = L + RK + hi * 1024 + r32 * 16;
    const LAS float* tp = (const LAS float*)(L + FL_TAB) + (2047 - t + (NT - 1) * 64 + 4 * hi);
    DMA_K(0, 0); DMA_V(0, 0); DMA_K(1, SLOTB); DMA_K(2, 2 * SLOTB);
    float mhat = m_io, l_reg = l_io; bool resc = false; float fsc = 1.f;
    f32x16 pA0, pA1, pB0, pB1; bf16x8v kf[8]; s16x4 vlo[8], vhi[8]; v4u pw0, pw1, pw2, pw3;
    int sl_prev = 0, sl_cur = 0, sl_next = SLOTB;
#define ROT() do { sl_prev = sl_cur; sl_cur = sl_next; sl_next = (sl_next == 2 * SLOTB) ? 0 : sl_next + SLOTB; } while (0)
#define EX(v) __builtin_amdgcn_exp2f((v) + nmh)
#define RESC() do { if (resc) { o[0] *= fsc; o[1] *= fsc; } } while (0)
#define DECIDE(C0, C1) do { const float rm = fs_rowmax(C0, C1); const bool first = mhat < -1e29f; const bool cond = first ? (rm > -1e29f) : (rm - mhat > FS_THR); resc = false; \
        if (__builtin_expect(__any(cond), 0)) { const float nm = cond ? rm : mhat; fsc = (first || !cond) ? 1.f : __builtin_amdgcn_exp2f(mhat - nm); l_reg *= fsc; mhat = nm; resc = true; } } while (0)
#pragma unroll
    for (int r = 0; r < 16; ++r) { pA0[r] = tp[(r & 3) + 8 * (r >> 2)]; pA1[r] = tp[32 + (r & 3) + 8 * (r >> 2)]; }
    FS_WAIT_BAR(3);
#pragma unroll
    for (int d0 = 0; d0 < 4; ++d0) fs_kload2(kf, kp0, d0);
    pA0 = FS_MFMA(kf[0], qr[0], pA0); pA1 = FS_MFMA(kf[1], qr[0], pA1); pA0 = FS_MFMA(kf[2], qr[1], pA0); pA1 = FS_MFMA(kf[3], qr[1], pA1);
    pA0 = FS_MFMA(kf[4], qr[2], pA0); pA1 = FS_MFMA(kf[5], qr[2], pA1); pA0 = FS_MFMA(kf[6], qr[3], pA0); pA1 = FS_MFMA(kf[7], qr[3], pA1);
    { DECIDE(pA0, pA1); RESC(); const float nmh = -mhat;
#pragma unroll
      for (int r = 0; r < 16; ++r) { pA0[r] = EX(pA0[r]); pA1[r] = EX(pA1[r]); } }
    { const LAS float* tq = tp - 64;
#pragma unroll
      for (int r = 0; r < 16; ++r) { pB0[r] = tq[(r & 3) + 8 * (r >> 2)]; pB1[r] = tq[32 + (r & 3) + 8 * (r >> 2)]; } }
    FS_WAIT_BAR(0);
    DMA_K(3, 0); DMA_V(1, SLOTB); ROT();
#pragma unroll
    for (int d0 = 0; d0 < 4; ++d0) fs_kload2(kf, kp0 + sl_cur, d0);
    FS_WAIT_BAR(2);
#define PKW(P, i) cvtpk(P[i], P[i + 1])
#define PAF(k) __builtin_bit_cast(bf16x8v, pw##k)
#define VFR(i) (bf16x8v){vlo[i][0], vlo[i][1], vlo[i][2], vlo[i][3], vhi[i][0], vhi[i][1], vhi[i][2], vhi[i][3]}
#define VRD(i) do { vlo[i] = lds_tr(vp_ + (((i) >> 2) * 4096 + ((i) & 3) * 1024)); vhi[i] = lds_tr(vp_ + (((i) >> 2) * 4096 + ((i) & 3) * 1024 + 512)); } while (0)
#define KRD(G, d0) do { if (G) { fs_kload2(kf, kp0 + sl_next, d0); FS_SBAR(); } } while (0)
#define GAPA(MF, a0, a1, a2, a3, W0, W1, PW) do { MF; sacc += a0; sacc += a1; sacc += a2; sacc += a3; W0; W1; FS_PIN(PW); FS_PIN(sacc); FS_SBAR(); } while (0)
#define GAPB(MF, X, i, Y, j) do { MF; X[i] = EX(X[i]); X[i + 1] = EX(X[i + 1]); X[i + 2] = EX(X[i + 2]); X[i + 3] = EX(X[i + 3]); \
        Y[j] = tn_[((j) & 3) + 8 * ((j) >> 2)]; Y[j + 1] = tn_[((j + 1) & 3) + 8 * ((j + 1) >> 2)]; Y[j + 2] = tn_[((j + 2) & 3) + 8 * ((j + 2) >> 2)]; Y[j + 3] = tn_[((j + 3) & 3) + 8 * ((j + 3) >> 2)]; FS_PIN(X); FS_SBAR(); } while (0)
#define GAPB1(MF, X, i, Y, j) do { MF; X[i] = EX(X[i]); X[i + 1] = EX(X[i + 1]); X[i + 2] = EX(X[i + 2]); X[i + 3] = EX(X[i + 3]); \
        Y[j] = tn_[32 + ((j) & 3) + 8 * ((j) >> 2)]; Y[j + 1] = tn_[32 + ((j + 1) & 3) + 8 * ((j + 1) >> 2)]; Y[j + 2] = tn_[32 + ((j + 2) & 3) + 8 * ((j + 2) >> 2)]; Y[j + 3] = tn_[32 + ((j + 3) & 3) + 8 * ((j + 3) >> 2)]; FS_PIN(X); FS_SBAR(); } while (0)
#define STEP(C0, C1, P0, P1, s_, GK, GV, GL) do { FS_SBAR(); \
    const LAS unsigned char* vp_ = vp0 + sl_prev; const LAS float* tn_ = tp - 64 * ((s_) + 1); \
    VRD(0); FS_SBAR(); float sacc = P0[0] + P0[1]; \
                       GAPA(C0 = FS_MFMA(kf[0], qr[0], C0), P0[2], P0[3], P0[4], P0[5],     pw0[0] = PKW(P0, 0),  pw0[1] = PKW(P0, 2),  pw0); \
    VRD(4); FS_SBAR(); GAPA(C1 = FS_MFMA(kf[1], qr[0], C1), P0[6], P0[7], P0[8], P0[9],     pw0[2] = PKW(P0, 4),  pw0[3] = PKW(P0, 6),  pw0); \
    VRD(1); FS_SBAR(); GAPA(C0 = FS_MFMA(kf[2], qr[1], C0), P0[10], P0[11], P0[12], P0[13], pw1[0] = PKW(P0, 8),  pw1[1] = PKW(P0, 10), pw1); \
    VRD(5); FS_SBAR(); GAPA(C1 = FS_MFMA(kf[3], qr[1], C1), P0[14], P0[15], P1[0], P1[1],   pw1[2] = PKW(P0, 12), pw1[3] = PKW(P0, 14), pw1); \
    VRD(2); FS_SBAR(); GAPA(C0 = FS_MFMA(kf[4], qr[2], C0), P1[2], P1[3], P1[4], P1[5],     pw2[0] = PKW(P1, 0),  pw2[1] = PKW(P1, 2),  pw2); \
    VRD(6); FS_SBAR(); GAPA(C1 = FS_MFMA(kf[5], qr[2], C1), P1[6], P1[7], P1[8], P1[9],     pw2[2] = PKW(P1, 4),  pw2[3] = PKW(P1, 6),  pw2); \
    VRD(3); FS_SBAR(); GAPA(C0 = FS_MFMA(kf[6], qr[3], C0), P1[10], P1[11], P1[12], P1[13], pw3[0] = PKW(P1, 8),  pw3[1] = PKW(P1, 10), pw3); \
    VRD(7); FS_SBAR(); GAPA(C1 = FS_MFMA(kf[7], qr[3], C1), P1[14], P1[15], 0.f, 0.f,       pw3[2] = PKW(P1, 12), pw3[3] = PKW(P1, 14), pw3); \
    l_reg += sacc; \
    if (GK) DMA_K((s_) + 3, sl_cur); if (GV) DMA_V((s_) + 1, sl_next); \
    DECIDE(C0, C1); \
    const float nmh = -mhat; FS_SBAR(); \
    GAPB(o[0] = FS_MFMA(VFR(0), PAF(0), o[0]), C0, 0, P0, 0);               GAPB(o[1] = FS_MFMA(VFR(4), PAF(0), o[1]), C0, 4, P0, 4); \
    KRD(GL, 0); GAPB(o[0] = FS_MFMA(VFR(1), PAF(1), o[0]), C0, 8, P0, 8);   KRD(GL, 1); GAPB(o[1] = FS_MFMA(VFR(5), PAF(1), o[1]), C0, 12, P0, 12); \
    KRD(GL, 2); GAPB1(o[0] = FS_MFMA(VFR(2), PAF(2), o[0]), C1, 0, P1, 0);  KRD(GL, 3); GAPB1(o[1] = FS_MFMA(VFR(6), PAF(2), o[1]), C1, 4, P1, 4); \
    GAPB1(o[0] = FS_MFMA(VFR(3), PAF(3), o[0]), C1, 8, P1, 8);              GAPB1(o[1] = FS_MFMA(VFR(7), PAF(3), o[1]), C1, 12, P1, 12); \
    } while (0)
    int s = 1;
    for (; s + 5 < NT; s += 2) {
        STEP(pB0, pB1, pA0, pA1, s, true, true, true);     FS_WAIT_BAR(2); RESC(); ROT();
        STEP(pA0, pA1, pB0, pB1, s + 1, true, true, true); FS_WAIT_BAR(2); RESC(); ROT();
    }
#define ENDW(tt) do { if ((tt) + 3 < NT) { FS_WAIT_BAR(2); } else if ((tt) + 2 < NT) { FS_WAIT_BAR(1); } else { FS_WAIT_BAR(0); } } while (0)
    for (; s + 1 < NT; s += 2) {
        STEP(pB0, pB1, pA0, pA1, s, (s + 3 < NT), (s + 1 < NT), (s + 1 < NT));         ENDW(s);     RESC(); ROT();
        STEP(pA0, pA1, pB0, pB1, s + 1, (s + 4 < NT), (s + 2 < NT), (s + 2 < NT));     ENDW(s + 1); RESC(); ROT();
    }
    STEP(pB0, pB1, pA0, pA1, NT - 1, false, false, false); RESC();
    { float sacc = pB0[0] + pB0[1];
#pragma unroll
      for (int r = 2; r < 16; ++r) sacc += pB0[r];
#pragma unroll
      for (int r = 0; r < 16; ++r) sacc += pB1[r];
      l_reg += sacc;
      pw0 = (v4u){PKW(pB0, 0), PKW(pB0, 2), PKW(pB0, 4), PKW(pB0, 6)}; pw1 = (v4u){PKW(pB0, 8), PKW(pB0, 10), PKW(pB0, 12), PKW(pB0, 14)};
      pw2 = (v4u){PKW(pB1, 0), PKW(pB1, 2), PKW(pB1, 4), PKW(pB1, 6)}; pw3 = (v4u){PKW(pB1, 8), PKW(pB1, 10), PKW(pB1, 12), PKW(pB1, 14)};
      const LAS unsigned char* vp_ = vp0 + sl_cur;
#pragma unroll
      for (int i = 0; i < 8; ++i) VRD(i);
      o[0] = FS_MFMA(VFR(0), PAF(0), o[0]); o[1] = FS_MFMA(VFR(4), PAF(0), o[1]); o[0] = FS_MFMA(VFR(1), PAF(1), o[0]); o[1] = FS_MFMA(VFR(5), PAF(1), o[1]);
      o[0] = FS_MFMA(VFR(2), PAF(2), o[0]); o[1] = FS_MFMA(VFR(6), PAF(2), o[1]); o[0] = FS_MFMA(VFR(3), PAF(3), o[0]); o[1] = FS_MFMA(VFR(7), PAF(3), o[1]); }
    m_io = mhat; l_io = l_reg;
    asm volatile("s_waitcnt lgkmcnt(0)\n\ts_barrier" ::: "memory");
#undef DMA_K
#undef DMA_V
#undef ROT
#undef EX
#undef RESC
#undef DECIDE
#undef PKW
#undef PAF
#undef VFR
#undef VRD
#undef KRD
#undef ENDW
#undef GAPA
#undef GAPB
#undef GAPB1
#undef STEP
}

__device__ __forceinline__ void flash_unit_sub(const bf16* Z, bf16* MIX, LAS unsigned char* L, int b, int h, int res, int qb, int wave, bool newtab) {
    const int lane = lane_now(), tid = wave * 64 + lane;
    constexpr int KS = 4, CQ = ZC_QC, CK = ZC_KC, CV = ZC_VC;
    const int r32 = lane & 31, hi = lane >> 5;
    LAS unsigned char* Kb = L + FL_K; LAS unsigned char* Vb = L + FL_V; LAS float* tab = (LAS float*)(L + FL_TAB); LAS float* tabw = (LAS float*)(L + FLS_TABW);
    const int Q0 = qb * 256, tq0 = Q0 + wave * 32, t = tq0 + r32;
    const bf16* zb = Z + (size_t)(b * SEQ + res) * ZC;
    int zs4 = 4 * ZC; asm volatile("" : "+s"(zs4));
    const float sl = __builtin_amdgcn_exp2f(-(float)(h + 1)) * LOG2E;
    v4u wk[5], wv[5];
#define FLS_WLOAD(RES2) do { const bf16* zw = Z + (size_t)(b * SEQ + (RES2)) * ZC + h * 64; \
        _Pragma("unroll") for (int i = 0; i < 5; ++i) { int idx = tid + 512 * i; idx = idx < 2304 ? idx : 2303; const int rho = idx >> 3, c = idx & 7, k = Q0 - 32 + rho, kc = k < 0 ? 0 : k; \
            const bf16* p = zw + (size_t)kc * zs4 + c * 8; const v4u a = *(const v4u*)(p + CK), bq = *(const v4u*)(p + CV); const unsigned msk = k < 0 ? 0u : 0xffffffffu; \
            wk[i].x = a.x & msk; wk[i].y = a.y & msk; wk[i].z = a.z & msk; wk[i].w = a.w & msk; wv[i].x = bq.x & msk; wv[i].y = bq.y & msk; wv[i].z = bq.z & msk; wv[i].w = bq.w & msk; } } while (0)
#define FLS_WSTORE() do { \
        _Pragma("unroll") for (int i = 0; i < 5; ++i) { int idx = tid + 512 * i; idx = idx < 2304 ? idx : 2303; const int rho = idx >> 3, c = idx & 7, blk = rho >> 5, kk = rho & 31; \
            *(LAS v4u*)(L + FLS_WK + blk * 4096 + (c >> 1) * 1024 + (c & 1) * 512 + kk * 16) = wk[i]; \
            *(LAS v4u*)(L + FLS_WV + blk * 4096 + (c >> 2) * 2048 + (kk >> 3) * 512 + (kk & 7) * 64 + (c & 3) * 16) = wv[i]; } } while (0)
    FLS_WLOAD((res + 1) & 3);
    if (newtab)
    for (int j = tid; j < FLS_TABN; j += NWAVES * 64) { const int e = 2047 - j; const int mult = (e <= 32 ? 1 : 0) + (e <= 128 ? 1 : 0) + ((e & 3) == 0 ? 1 : 0);
        tab[j] = (e < 0 || mult == 0) ? -INFINITY : -sl * (float)(4 * e) + (mult == 1 ? 0.f : (mult == 2 ? 1.f : 1.5849625007211562f)); }
    if (newtab && tid < 3 * 96) { const int w3 = tid / 96, i = tid % 96, res2 = (res + 1 + w3) & 3, d = 4 * (63 - i) + (res - res2);
        tabw[tid] = (d >= 0 && d <= 128) ? -sl * (float)d : -INFINITY; }
    bf16x8v qf[KS];
#pragma unroll
    for (int ks = 0; ks < KS; ++ks) qf[ks] = *(const bf16x8v*)(zb + (size_t)t * zs4 + CQ + h * 64 + ks * 16 + hi * 8);
    float m = -1e30f, l = 0.f; f32x16 o[2];
#pragma unroll
    for (int r = 0; r < 16; ++r) { o[0][r] = 0.f; o[1][r] = 0.f; }
    const int krd = hi * 1024 + r32 * 16;
    const int vrd = ((lane >> 4) & 1) * 32 + (lane & 3) * 8 + (4 * hi + ((lane & 15) >> 2)) * 64;
#pragma unroll
    for (int w3 = 0; w3 < 3; ++w3) {
        FLS_WSTORE();
        __syncthreads();
        if (w3 < 2) FLS_WLOAD((res + 2 + w3) & 3);
        { const LAS float* tp = tabw + w3 * 96 + (31 - r32 + 4 * hi);
          const LAS float* tp0 = tq0 == 0 ? (const LAS float*)tab + 2048 + 4 * hi : tp;
          f32x16 p0, p1;
#pragma unroll
          for (int r = 0; r < 16; ++r) { p0[r] = tp0[(r & 3) + 8 * (r >> 2)]; p1[r] = tp[32 + (r & 3) + 8 * (r >> 2)]; }
          const LAS unsigned char* K0 = L + FLS_WK + wave * 4096 + hi * 512 + r32 * 16;
#pragma unroll
          for (int ks = 0; ks < KS; ++ks) { const bf16x8v kf0 = *(const LAS bf16x8v*)(K0 + ks * 1024), kf1 = *(const LAS bf16x8v*)(K0 + 4096 + ks * 1024);
              p0 = __builtin_amdgcn_mfma_f32_32x32x16_bf16(kf0, qf[ks], p0, 0, 0, 0); p1 = __builtin_amdgcn_mfma_f32_32x32x16_bf16(kf1, qf[ks], p1, 0, 0, 0); }
          bf16x8v pf[4];
          fl_softmax3(p0, p1, 0.f, 0.f, m, l, o, pf);
#pragma unroll
          for (int s4 = 0; s4 < 4; ++s4)
#pragma unroll
              for (int db = 0; db < 2; ++db) { const LAS unsigned char* vp = L + FLS_WV + (wave + (s4 >> 1)) * 4096 + db * 2048 + (s4 & 1) * 1024 + vrd;
                  const s16x4 lo = lds_tr(vp), hh = lds_tr(vp + 512);
                  const bf16x8v vf = (bf16x8v){lo[0], lo[1], lo[2], lo[3], hh[0], hh[1], hh[2], hh[3]};
                  o[db] = __builtin_amdgcn_mfma_f32_32x32x16_bf16(vf, pf[s4], o[db], 0, 0, 0); } }
        __syncthreads();
    }
#undef FLS_WLOAD
#undef FLS_WSTORE
#if FSUB_STREAM
    fsub_stream(zb, zs4, h, Q0, wave, lane, L, qf, m, l, o);
#else
    const int skey = tid >> 3, sc = tid & 7;
    const bf16* ksrc = zb + (size_t)skey * zs4 + CK + h * 64 + sc * 8;
    const bf16* vsrc = zb + (size_t)skey * zs4 + CV + h * 64 + sc * 8;
    const int kdst = (sc >> 1) * 2048 + (sc & 1) * 1024 + (skey >> 5) * 512 + (skey & 31) * 16;
    const int vdst = (sc >> 2) * 4096 + (skey >> 3) * 512 + (skey & 7) * 64 + (sc & 3) * 16;
    int tilz = 64 * 4 * ZC; asm volatile("" : "+s"(tilz));
    int jt = Q0 / 64 + 3;
    v4u kA = *(const v4u*)(ksrc + (size_t)jt * tilz), vA = *(const v4u*)(vsrc + (size_t)jt * tilz);
    v4u kB = *(const v4u*)(ksrc + (size_t)(jt - 1) * tilz), vB = *(const v4u*)(vsrc + (size_t)(jt - 1) * tilz);
    *(LAS v4u*)(Kb + (jt & 1) * 8192 + kdst) = kA; *(LAS v4u*)(Vb + (jt & 1) * 8192 + vdst) = vA;
    __syncthreads();
#define FLS_TILE(JT, KW, VW, KL, VL) do { const int jt_ = (JT); \
        if (jt_ >= 2) { KL = *(const v4u*)(ksrc + (size_t)(jt_ - 2) * tilz); VL = *(const v4u*)(vsrc + (size_t)(jt_ - 2) * tilz); } \
        const LAS unsigned char* Kc = Kb + (jt_ & 1) * 8192; const LAS unsigned char* Vc = Vb + (jt_ & 1) * 8192; \
        if (jt_ * 64 <= tq0) { \
            const LAS float* tp = tab + (2047 - t + jt_ * 64 + 4 * hi); \
            f32x16 p0, p1; \
            _Pragma("unroll") for (int r = 0; r < 16; ++r) { p0[r] = tp[(r & 3) + 8 * (r >> 2)]; p1[r] = tp[32 + (r & 3) + 8 * (r >> 2)]; } \
            _Pragma("unroll") for (int ks = 0; ks < KS; ++ks) { const bf16x8v kf0 = *(const LAS bf16x8v*)(Kc + ks * 2048 + krd), kf1 = *(const LAS bf16x8v*)(Kc + ks * 2048 + 512 + krd); \
                p0 = __builtin_amdgcn_mfma_f32_32x32x16_bf16(kf0, qf[ks], p0, 0, 0, 0); p1 = __builtin_amdgcn_mfma_f32_32x32x16_bf16(kf1, qf[ks], p1, 0, 0, 0); } \
            bf16x8v pf[4]; \
            fl_softmax3(p0, p1, 0.f, 0.f, m, l, o, pf); \
            _Pragma("unroll") for (int s4 = 0; s4 < 4; ++s4) _Pragma("unroll") for (int db = 0; db < 2; ++db) { const LAS unsigned char* vp = Vc + db * 4096 + s4 * 1024 + vrd; \
                    const s16x4 lo = lds_tr(vp), hh = lds_tr(vp + 512); \
                    const bf16x8v vf = (bf16x8v){lo[0], lo[1], lo[2], lo[3], hh[0], hh[1], hh[2], hh[3]}; \
                    o[db] = __builtin_amdgcn_mfma_f32_32x32x16_bf16(vf, pf[s4], o[db], 0, 0, 0); } \
        } \
        if (jt_ >= 1) { *(LAS v4u*)(Kb + ((jt_ - 1) & 1) * 8192 + kdst) = KW; *(LAS v4u*)(Vb + ((jt_ - 1) & 1) * 8192 + vdst) = VW; } \
        __syncthreads(); } while (0)
    for (; jt >= 0; jt -= 2) { FLS_TILE(jt, kB, vB, kA, vA); FLS_TILE(jt - 1, kA, vA, kB, vB); }
#undef FLS_TILE
#endif
    const size_t orow = (size_t)(b * SEQ + 4 * t + res) * DM + 512 + h * 64 + 4 * hi;
    const float i0 = 1.f / swap_sum(l);
    o[0] *= i0; o[1] *= i0; mix_store_head(MIX, orow, hi, o[0], o[1]);
}
__device__ __forceinline__ void flash_phase_sub(const bf16* Z, bf16* MIX, LAS unsigned char* L, int vcu, int G, int wave) {
    constexpr int NITEM = BATCH * 8 * 4;
    for (int p = vcu; p < NITEM; p += G) {
        const int b = p >> 5, h = (p >> 2) & 7, res = p & 3;
#pragma unroll 1
        for (int k = 0; k < 2; ++k) { flash_unit_sub(Z, MIX, L, b, h, res, 1 - k, wave, k == 0); __syncthreads(); }
    }
}
constexpr int MA_K = 0, MA_V = 32768, MA_BM = 65536, MA_BMS = 68  , MA_WQ = MA_BM + 32 * MA_BMS * 4, MA_MG = MA_WQ + 512, MA_SEL = MA_MG + 4 * 34 * 64 * 4, MA_END = MA_SEL + NWAVES * 2560;
static_assert(MA_END <= RING_BYTES, "mixer A LDS map");

__device__ __forceinline__ unsigned ordkey(float f) { const unsigned u = __float_as_uint(f); return u ^ ((unsigned)((int)u >> 31) | 0x80000000u); }
#define DPP_I(v, ctrl) __builtin_amdgcn_update_dpp(0, (v), (ctrl), 0xf, 0xf, false)
__device__ __forceinline__ float wave_max_dpp(float v) {
    v = fmaxf(v, __int_as_float(DPP_I(__float_as_int(v), 0xB1))); v = fmaxf(v, __int_as_float(DPP_I(__float_as_int(v), 0x4E)));
    v = fmaxf(v, __int_as_float(DPP_I(__float_as_int(v), 0x141))); v = fmaxf(v, __int_as_float(DPP_I(__float_as_int(v), 0x140)));
    const int i = __float_as_int(v);
    return fmaxf(fmaxf(__int_as_float(__builtin_amdgcn_readlane(i, 0)), __int_as_float(__builtin_amdgcn_readlane(i, 16))), fmaxf(__int_as_float(__builtin_amdgcn_readlane(i, 32)), __int_as_float(__builtin_amdgcn_readlane(i, 48))));
}
__device__ __forceinline__ float wave_min_dpp(float v) {
    v = fminf(v, __int_as_float(DPP_I(__float_as_int(v), 0xB1))); v = fminf(v, __int_as_float(DPP_I(__float_as_int(v), 0x4E)));
    v = fminf(v, __int_as_float(DPP_I(__float_as_int(v), 0x141))); v = fminf(v, __int_as_float(DPP_I(__float_as_int(v), 0x140)));
    const int i = __float_as_int(v);
    return fminf(fminf(__int_as_float(__builtin_amdgcn_readlane(i, 0)), __int_as_float(__builtin_amdgcn_readlane(i, 16))), fminf(__int_as_float(__builtin_amdgcn_readlane(i, 32)), __int_as_float(__builtin_amdgcn_readlane(i, 48))));
}
__device__ __forceinline__ int wave_prefix_dpp(int x, int lane) {
    x += DPP_I(x, 0x111); x += DPP_I(x, 0x112); x += DPP_I(x, 0x114); x += DPP_I(x, 0x118);
    const int t0 = __builtin_amdgcn_readlane(x, 15), t1 = __builtin_amdgcn_readlane(x, 31), t2 = __builtin_amdgcn_readlane(x, 47);
    return x + (lane >= 16 ? t0 : 0) + (lane >= 32 ? t1 : 0) + (lane >= 48 ? t2 : 0);
}
template <int NJ> __device__ __forceinline__ void select_load(const float* srow, int t, int lane, float (&raw)[NJ]) {
#pragma unroll
    for (int j = 0; j < NJ; ++j) { const int kx = 64 * j + lane; raw[j] = srow[kx < t ? kx : t]; }
}
template <int NJ> __device__ __forceinline__ unsigned select_row_t(const float (&raw)[NJ], int t, LAS unsigned* hist, LAS unsigned* clist, int lane) {
    float f[NJ]; int bn[NJ];
    float NINF = -INFINITY, PINF = INFINITY; int C255 = 255; asm volatile("" : "+v"(NINF), "+v"(PINF), "+v"(C255));
    float vmax = NINF, vmin = PINF;
#pragma unroll
    for (int j = 0; j < NJ; ++j) { const int kx = 64 * j + lane; const float v = raw[j] + 0.0f; const bool ok = kx <= t; f[j] = ok ? v : NINF; vmax = fmaxf(vmax, f[j]); vmin = fminf(vmin, ok ? v : PINF); }
    vmax = wave_max_dpp(vmax); vmin = wave_min_dpp(vmin);
    const float scale = 255.99f / (vmax - vmin);
    { unsigned z_ = 0u; asm volatile("" : "+v"(z_)); ((LAS v4u*)hist)[lane] = (v4u){z_, z_, z_, z_}; }
#pragma unroll
    for (int j = 0; j < NJ; ++j) { int bi = (int)((f[j] - vmin) * scale); bi = bi > C255 ? C255 : bi; bi = bi < 0 ? 0 : bi; bn[j] = (64 * j + lane <= t) ? bi : -1;
        if (bn[j] >= 0) __hip_atomic_fetch_add(hist + bn[j], 1u, __ATOMIC_RELAXED, __HIP_MEMORY_SCOPE_WAVEFRONT); }
    LDS_WAIT();
    const v4u hv = ((const LAS v4u*)hist)[63 - lane];
    const int ssum = (int)(hv.x + hv.y + hv.z + hv.w);
    const int x = wave_prefix_dpp(ssum, lane);
    const int above = x - ssum; const bool found = above < 256 && x >= 256;
    int bsel, cab;
    { const int c3 = above + (int)hv.w, c2 = c3 + (int)hv.z, c1 = c2 + (int)hv.y; const int b0 = 4 * (63 - lane);
      if (c3 >= 256) { bsel = b0 + 3; cab = above; } else if (c2 >= 256) { bsel = b0 + 2; cab = c3; } else if (c1 >= 256) { bsel = b0 + 1; cab = c2; } else { bsel = b0; cab = c1; } }
    const unsigned long long fm = __ballot(found);
    const int src = (int)__builtin_ctzll(fm);
    const int bstar = __builtin_amdgcn_readlane(bsel, src), c_above = __builtin_amdgcn_readlane(cab, src);
    unsigned key[NJ];
#pragma unroll
    for (int j = 0; j < NJ; ++j) key[j] = ordkey(f[j]);
    int base = 0;
#pragma unroll
    for (int j = 0; j < NJ; ++j) { const bool isc = bn[j] == bstar; const unsigned long long cm = __ballot(isc); const int pos = base + mbcnt64(cm);
        clist[(isc && pos < 256) ? pos : 256 + lane] = key[j]; base += __popcll(cm); }
    LDS_WAIT();
    const int ncand = base, need = 256 - c_above;
    unsigned T = 0u; int cge;
    if (ncand <= 64) {
        const unsigned ck = lane < ncand ? clist[lane] : 0u;
        int g = 0, e = 0;
#pragma unroll 1
        for (int i = 0; i < ncand; ++i) { const unsigned sk = (unsigned)__builtin_amdgcn_readlane((int)ck, i); g += (sk > ck) ? 1 : 0; e += (sk == ck) ? 1 : 0; }
        const unsigned long long hit = __ballot(lane < ncand && g < need && need <= g + e);
        const int src2 = (int)__builtin_ctzll(hit);
        T = (unsigned)__builtin_amdgcn_readlane((int)ck, src2);
        cge = c_above + __builtin_amdgcn_readlane(g, src2) + __builtin_amdgcn_readlane(e, src2);
    } else if (ncand <= 256) {
        unsigned ck[4];
#pragma unroll
        for (int r = 0; r < 4; ++r) ck[r] = (r * 64 + lane < ncand) ? clist[r * 64 + lane] : 0u;
#pragma unroll 1
        for (int bit = 31; bit >= 0; --bit) { const unsigned cand = T | (1u << bit);
            const int cnt = __popcll(__ballot(ck[0] >= cand)) + __popcll(__ballot(ck[1] >= cand)) + __popcll(__ballot(ck[2] >= cand)) + __popcll(__ballot(ck[3] >= cand));
            if (cnt >= need) T = cand; }
        cge = c_above + __popcll(__ballot(ck[0] >= T)) + __popcll(__ballot(ck[1] >= T)) + __popcll(__ballot(ck[2] >= T)) + __popcll(__ballot(ck[3] >= T));
    } else {
#pragma unroll 1
        for (int bit = 31; bit >= 0; --bit) { const unsigned cand = T | (1u << bit); int cnt = 0;
#pragma unroll
            for (int j = 0; j < NJ; ++j) cnt += __popcll(__ballot(key[j] >= cand));
            if (cnt >= 256) T = cand; }
        cge = 0;
#pragma unroll
        for (int j = 0; j < NJ; ++j) cge += __popcll(__ballot(key[j] >= T));
    }
    unsigned w = 0u;
    if (cge == 256) {
#pragma unroll
        for (int j = NJ - 1; j >= 0; --j) w = w + w + (key[j] >= T ? 1u : 0u);
    } else {
        int cgt = 0;
#pragma unroll
        for (int j = 0; j < NJ; ++j) cgt += __popcll(__ballot(key[j] > T));
        const int need2 = 256 - cgt; int eqseen = 0;
#pragma unroll
        for (int j = 0; j < NJ; ++j) { const bool gt = key[j] > T, eq = key[j] == T; const unsigned long long em = __ballot(eq); const int er = eqseen + mbcnt64(em);
            w |= (gt || (eq && er < need2)) ? (1u << j) : 0u; eqseen += __popcll(em); }
    }
    return w;
}
constexpr int MB_K = 0, MB_V = 32768, MB_BM = 65536, MB_WQ = MB_BM + 64 * MA_BMS * 4, MB_SEL = MB_WQ + 1024, MB_END = MB_SEL + NWAVES * 2560;
static_assert(MB_END <= RING_BYTES, "mixer A (64-query units) LDS map");
template <int NJ> __device__ __forceinline__ void select8_t(const float* scr0, int t0, LAS unsigned* hist, LAS unsigned* clist, LAS unsigned* bmrow0, int lane) {
    float cur[NJ], nxt[NJ];
    select_load<NJ>(scr0, t0, lane, cur);
#pragma unroll 1
    for (int i = 0; i < 8; ++i) {
        const int t = t0 + i;
        if (i < 7) select_load<NJ>(scr0 + (size_t)(i + 1) * 2048, t + 1, lane, nxt);
        unsigned w;
        if (t < 256) { const int n = t + 1, nf = n >> 6; w = ((1u << nf) - 1u) | ((lane < (n & 63)) ? (1u << nf) : 0u); }
        else w = select_row_t<NJ>(cur, t, hist, clist, lane);
        bmrow0[i * MA_BMS + lane] = w;
#pragma unroll
        for (int j = 0; j < NJ; ++j) cur[j] = nxt[j];
    }
}
__device__ __forceinline__ void mixa_unit64(const bf16* Z, bf16* MIX, float* SCR, LAS unsigned char* L, int b, int qt64, int wave) {
    int lane = lane_now(), tid = wave * 64 + lane;
    int r32 = lane & 31, hi = lane >> 5; const int T0 = qt64 * 64;
    const bf16* zb = Z + (size_t)(b * SEQ) * ZC;
    LAS unsigned* bm = (LAS unsigned*)(L + MB_BM); LAS float* wq = (LAS float*)(L + MB_WQ);
    { int wv_ = wave; asm volatile("" : "+s"(wv_));
#pragma unroll
      for (int i = 0; i < 4; ++i) { const int j = wv_ * 4 + i, hf = j >> 4, mt = (j >> 2) & 3, ks = j & 3;
          fs_glds16(zb + (size_t)(T0 + 32 * hf + 8 * mt + (r32 >> 2)) * ZC + ZC_QI + (r32 & 3) * 64 + ks * 16 + hi * 8, (unsigned)__builtin_amdgcn_readfirstlane((unsigned)(size_t)(L + MB_K) + j * 1024)); } }
    if (tid < 256) wq[tid] = bf1(zb[(size_t)(T0 + (tid >> 2)) * ZC + ZC_WI + (tid & 3)]);
    asm volatile("s_waitcnt vmcnt(0)" ::: "memory");
    __syncthreads();
#ifndef REP_AIDX
#define REP_AIDX 1
#endif
#pragma unroll 1
    for (int half_ = 0; half_ < 2 * REP_AIDX; ++half_) { const int half = half_ & 1;
        const int Th = T0 + 32 * half;
        bf16x8v qi[4][4];
#pragma unroll
        for (int mt = 0; mt < 4; ++mt)
#pragma unroll
            for (int ks = 0; ks < 4; ++ks) qi[mt][ks] = *(const LAS bf16x8v*)(L + MB_K + (half * 16 + mt * 4 + ks) * 1024 + lane * 16);
        const int nkt = (Th >> 5) + 1;
        bf16x8v kn[4];
        if (wave < nkt) { const bf16* kr0 = zb + (size_t)(wave * 32 + r32) * ZC + ZC_KI + hi * 8;
#pragma unroll
            for (int ks = 0; ks < 4; ++ks) kn[ks] = *(const bf16x8v*)(kr0 + ks * 16); }
        for (int kt = wave; kt < nkt; kt += NWAVES) {
            const int key = kt * 32 + r32;
            bf16x8v kf[4];
#pragma unroll
            for (int ks = 0; ks < 4; ++ks) kf[ks] = kn[ks];
            if (kt + NWAVES < nkt) { const bf16* kr1 = zb + (size_t)((kt + NWAVES) * 32 + r32) * ZC + ZC_KI + hi * 8;
#pragma unroll
                for (int ks = 0; ks < 4; ++ks) kn[ks] = *(const bf16x8v*)(kr1 + ks * 16); }
#pragma unroll
            for (int mt = 0; mt < 4; ++mt) {
                f32x16 d;
#pragma unroll
                for (int r = 0; r < 16; ++r) d[r] = 0.f;
#pragma unroll
                for (int ks = 0; ks < 4; ++ks) d = __builtin_amdgcn_mfma_f32_32x32x16_bf16(qi[mt][ks], kf[ks], d, 0, 0, 0);
#pragma unroll
                for (int g = 0; g < 4; ++g) { const int q = 32 * half + 8 * mt + 2 * g + hi; const f32x4 w = *(const LAS f32x4*)(wq + 4 * q);
                    float s = fmaxf(d[4 * g + 0], 0.f) * w.x + fmaxf(d[4 * g + 1], 0.f) * w.y + fmaxf(d[4 * g + 2], 0.f) * w.z + fmaxf(d[4 * g + 3], 0.f) * w.w;
                    if (key > T0 + q) s = -INFINITY;
                    SCR[(size_t)q * 2048 + key] = s; }
            }
        }
    }
    asm volatile("s_waitcnt vmcnt(0)" ::: "memory");
    __syncthreads();
    { const int ln_ = lane_now();
      const bf16* ks_ = zb + (size_t)ln_ * ZC + ZC_KA + wave * 8;
      const bf16* vs_ = zb + (size_t)(16 * (wave & 3) + (ln_ >> 2)) * ZC + ZC_VA + (wave >> 2) * 32 + (ln_ & 3) * 8;
      const int j0_ = (T0 + 63) >> 7; const unsigned bo_ = (unsigned)((j0_ & 1) * 16384);
      const unsigned kd_ = (unsigned)(size_t)(L + MB_K) + wave * 1024 + bo_, vd_ = (unsigned)(size_t)(L + MB_V) + wave * 1024 + bo_;
      const size_t so_ = (size_t)j0_ * (size_t)(128 * ZC);
      fs_glds16(ks_ + so_, (unsigned)__builtin_amdgcn_readfirstlane(kd_)); fs_glds16(ks_ + so_ + 64 * ZC, (unsigned)__builtin_amdgcn_readfirstlane(kd_ + 8192));
      fs_glds16(vs_ + so_, (unsigned)__builtin_amdgcn_readfirstlane(vd_)); fs_glds16(vs_ + so_ + 64 * ZC, (unsigned)__builtin_amdgcn_readfirstlane(vd_ + 8192)); }
#ifndef REP_ASEL
#define REP_ASEL 1
#endif
#pragma unroll 1
    for (int rs_ = 0; rs_ < REP_ASEL; ++rs_) {
        lane = lane_now();
        const int q0 = wave * 8, tl = __builtin_amdgcn_readfirstlane(T0 + q0 + 7);
        LAS unsigned* hs = (LAS unsigned*)(L + MB_SEL + wave * 2560);
        if (tl + 1 <= 512) select8_t<8>(SCR + (size_t)q0 * 2048, T0 + q0, hs, hs + 256, bm + q0 * MA_BMS, lane);
        else if (tl + 1 <= 768) select8_t<12>(SCR + (size_t)q0 * 2048, T0 + q0, hs, hs + 256, bm + q0 * MA_BMS, lane);
        else if (tl + 1 <= 1024) select8_t<16>(SCR + (size_t)q0 * 2048, T0 + q0, hs, hs + 256, bm + q0 * MA_BMS, lane);
        else if (tl + 1 <= 1280) select8_t<20>(SCR + (size_t)q0 * 2048, T0 + q0, hs, hs + 256, bm + q0 * MA_BMS, lane);
        else if (tl + 1 <= 1536) select8_t<24>(SCR + (size_t)q0 * 2048, T0 + q0, hs, hs + 256, bm + q0 * MA_BMS, lane);
        else if (tl + 1 <= 1792) select8_t<28>(SCR + (size_t)q0 * 2048, T0 + q0, hs, hs + 256, bm + q0 * MA_BMS, lane);
        else select8_t<32>(SCR + (size_t)q0 * 2048, T0 + q0, hs, hs + 256, bm + q0 * MA_BMS, lane);
    }
#ifndef REP_AATT
#define REP_AATT 1
#endif
#ifndef RAWBAR
#define RAWBAR 1
#endif
#if RAWBAR
#define RAW_BAR() asm volatile("s_waitcnt lgkmcnt(0)\n\ts_barrier" ::: "memory")
#else
#define RAW_BAR() __syncthreads()
#endif
#pragma unroll 1
    for (int ra_ = 0; ra_ < REP_AATT; ++ra_) {
    lane = lane_now(); tid = wave * 64 + lane; r32 = lane & 31; hi = lane >> 5;
    int wv = wave; asm volatile("" : "+s"(wv));
    const int h = wv & 3, qh = wv >> 2, tq0 = T0 + 32 * qh, t = tq0 + r32;
    const float sl = __builtin_amdgcn_exp2f(-2.f * (float)(h + 1)) * LOG2E;
    bf16x8v qf[4];
#pragma unroll
    for (int ks = 0; ks < 4; ++ks) qf[ks] = *(const bf16x8v*)(zb + (size_t)t * ZC + ZC_QA + h * 64 + ks * 16 + hi * 8);
    float m = -1e30f, l = 0.f; f32x16 o[2];
    f32x16 cinA;
#pragma unroll
    for (int r = 0; r < 16; ++r) cinA[r] = sl * (float)((r & 3) + 8 * (r >> 2) + 4 * hi);
#pragma unroll
    for (int r = 0; r < 16; ++r) { o[0][r] = 0.f; o[1][r] = 0.f; }
    LAS unsigned char* Kb = L + MB_K; LAS unsigned char* Vb = L + MB_V;
    const bf16* ksrc = zb + (size_t)lane * ZC + ZC_KA + wave * 8;
    const bf16* vsrc = zb + (size_t)(16 * (wave & 3) + (lane >> 2)) * ZC + ZC_VA + (wave >> 2) * 32 + (lane & 3) * 8;
    const unsigned kdma = (unsigned)(size_t)(L + MB_K) + wave * 1024, vdma = (unsigned)(size_t)(L + MB_V) + wave * 1024;
    const int krd = hi * 1024 + r32 * 16;
    const int vrd = ((lane >> 4) & 1) * 32 + (lane & 3) * 8 + (4 * hi + ((lane & 15) >> 2)) * 64;
    const LAS v4u* wrow = (const LAS v4u*)(bm + (32 * qh + r32) * MA_BMS + 4 * hi);
    int jp = (T0 + 63) >> 7;
    int stg_ = 128 * ZC, til_ = 64 * ZC; asm volatile("" : "+s"(stg_), "+s"(til_));
    const size_t stg = (size_t)stg_, til = (size_t)til_;
#define MB_DMA(JP) do { const unsigned bo_ = (unsigned)(((JP) & 1) * 16384); \
        fs_glds16(ksrc + (JP) * stg, (unsigned)__builtin_amdgcn_readfirstlane(kdma + bo_)); fs_glds16(ksrc + (JP) * stg + til, (unsigned)__builtin_amdgcn_readfirstlane(kdma + bo_ + 8192)); \
        fs_glds16(vsrc + (JP) * stg, (unsigned)__builtin_amdgcn_readfirstlane(vdma + bo_)); fs_glds16(vsrc + (JP) * stg + til, (unsigned)__builtin_amdgcn_readfirstlane(vdma + bo_ + 8192)); } while (0)
    asm volatile("s_waitcnt vmcnt(0)" ::: "memory");
    __syncthreads();
    v4u wsel[8];
#pragma unroll
    for (int g = 0; g < 4; ++g) { wsel[g] = wrow[2 * g]; wsel[4 + g] = wrow[8 + 2 * g]; }
#define MB_STAGE(JP) do { const int jp_ = (JP); \
        if (jp_ >= 1) MB_DMA(jp_ - 1);                                     \
        _Pragma("unroll") for (int kp = 1; kp >= 0; --kp) { \
            const int tile = 2 * jp_ + kp, s0 = 64 * tile; \
            if (s0 <= tq0 + 31) {                                          \
                const LAS unsigned char* Kc = Kb + (jp_ & 1) * 16384 + kp * 8192; const LAS unsigned char* Vc = Vb + (jp_ & 1) * 16384 + kp * 8192; \
                const float sha = sl * (float)(s0 - t), shb = sha + 32.f * sl; \
                f32x16 p0 = cinA, p1 = cinA; \
                _Pragma("unroll") for (int ks = 0; ks < 4; ++ks) { const bf16x8v kf0 = *(const LAS bf16x8v*)(Kc + ks * 2048 + krd), kf1 = *(const LAS bf16x8v*)(Kc + ks * 2048 + 512 + krd); \
                    p0 = __builtin_amdgcn_mfma_f32_32x32x16_bf16(kf0, qf[ks], p0, 0, 0, 0); p1 = __builtin_amdgcn_mfma_f32_32x32x16_bf16(kf1, qf[ks], p1, 0, 0, 0); } \
                const unsigned sbit = (unsigned)tile; \
                _Pragma("unroll") for (int g = 0; g < 4; ++g) { const v4u wa = wsel[g], wb = wsel[4 + g]; \
                    _Pragma("unroll") for (int e = 0; e < 4; ++e) { const int r = 4 * g + e; \
                        const unsigned ma = (unsigned)(-(int)((wa[e] >> sbit) & 1u)), mb = (unsigned)(-(int)((wb[e] >> sbit) & 1u)); \
                        p0[r] = __uint_as_float((__float_as_uint(p0[r]) & ma) | (~ma & 0xff800000u)); p1[r] = __uint_as_float((__float_as_uint(p1[r]) & mb) | (~mb & 0xff800000u)); } } \
                bf16x8v pf[4]; \
                fl_softmax3(p0, p1, sha, shb, m, l, o, pf); \
                _Pragma("unroll") for (int s4 = 0; s4 < 4; ++s4) _Pragma("unroll") for (int db = 0; db < 2; ++db) { const LAS unsigned char* vp = Vc + db * 4096 + s4 * 1024 + vrd; \
                        const s16x4 lo = lds_tr(vp), hh = lds_tr(vp + 512); \
                        const bf16x8v vf = (bf16x8v){lo[0], lo[1], lo[2], lo[3], hh[0], hh[1], hh[2], hh[3]}; \
                        o[db] = __builtin_amdgcn_mfma_f32_32x32x16_bf16(vf, pf[s4], o[db], 0, 0, 0); } \
            } } \
        asm volatile("s_waitcnt vmcnt(0) lgkmcnt(0)\n\ts_barrier" ::: "memory"); } while (0)
    for (; jp >= 0; --jp) MB_STAGE(jp);
#undef MB_DMA
#undef MB_STAGE
    { const float inv = 1.f / swap_sum(l);
      const size_t orow = (size_t)(b * SEQ + t) * DM + h * 64 + 4 * hi;
      o[0] *= inv; o[1] *= inv; mix_store_head(MIX, orow, hi, o[0], o[1]); }
    if (REP_AATT > 1) __syncthreads();
    }
}
__device__ __forceinline__ void mixa_phase64(const bf16* Z, bf16* MIX, float* SCR, LAS unsigned char* L, int vcu, int G, int wave) {
    float* scr = SCR + (size_t)blockIdx.x * (64 * 2048);
    for (int p = vcu; p < BATCH * 16; p += G) {
        const int b = p >> 4, x = p & 15;
#pragma unroll 1
        for (int k = 0; k < 2; ++k) { mixa_unit64(Z, MIX, scr, L, b, k == 0 ? 31 - x : x, wave); __syncthreads(); }
    }
}
#ifndef REP_A
#define REP_A 1
#endif
#ifndef REP_B
#define REP_B 1
#endif
#ifndef REP_C
#define REP_C 1
#endif
#ifndef REP_G
#define REP_G 1
#endif
#ifndef REP_P1A
#define REP_P1A 1
#endif
#ifndef REP_P1B
#define REP_P1B 1
#endif
#ifndef REP_P3
#define REP_P3 1
#endif
#ifndef REP_P4
#define REP_P4 1
#endif
#ifndef REP_P5
#define REP_P5 1
#endif
#ifndef REP_BAR
#define REP_BAR 1
#endif
#ifndef FLASH2
#define FLASH2 1
#endif
#if FLASH2
#define FLASHP flash_phase2
#else
#define FLASHP flash_phase
#endif
#ifndef GM_ALIGN
#define GM_ALIGN true
#endif
#ifndef GM_ALIGN_RES
#define GM_ALIGN_RES true
#endif
#ifndef GM_ALIGN_F8
#define GM_ALIGN_F8 true
#endif
#ifndef GM_SP2_F8
#define GM_SP2_F8 true
#endif
#ifndef GM_SP2
#define GM_SP2 true
#endif
#ifndef MIXA64
#define MIXA64 1
#endif
#ifndef FFN_FP8
#define FFN_FP8 1
#endif
#ifndef FFN_FP8_P5
#define FFN_FP8_P5 FFN_FP8
#endif
#ifndef P1_FP8
#define P1_FP8 0
#endif
#ifndef CSUB
#define CSUB 0
#endif
#ifndef MIX_PRIO
#define MIX_PRIO 0
#endif
#ifndef LNFUSE
#define LNFUSE 0
#endif
#ifndef P1_MIX
#define P1_MIX 0
#endif
#ifndef BSTREAM
#define BSTREAM 0
#endif
#if P1_FP8 && !MIX_FP8
#error P1_FP8 keeps its e4m3 input copy in the half of R1 that MIX_FP8 frees
#endif
#define H8_OFF (FFN_FP8_P5 ? (size_t)0 : 352 * MiB)
#define ACT_OFF (FFN_FP8 && FFN_FP8_P5 ? 64 * MiB : (size_t)0)
struct Args { const float* in[12]; float* out; unsigned char* ws; };
__global__ void __launch_bounds__(NWAVES * 64, 2) hybrid_fwd(Args args) {
    extern __shared__ __attribute__((aligned(16))) unsigned char lds[];
    LAS unsigned char* L = (LAS unsigned char*)lds;
    volatile LAS unsigned* MISC = (volatile LAS unsigned*)(L + MISC_OFF);
    const int wave = __builtin_amdgcn_readfirstlane((int)threadIdx.x >> 6);
#define LANE_NOW lane_now()
#define TID_NOW (wave * 64 + lane_now())
    const int G = gridDim.x, bx = blockIdx.x;
    const int vcu = (G % 8 == 0) ? (bx % 8) * (G / 8) + bx / 8 : bx;
    const int gw = vcu * NWAVES + wave, NGW = G * NWAVES;
    unsigned char* ws = args.ws;
    gu32* ctl = (gu32*)(ws + WS_CTL);
    for (int u = TID_NOW; u < (LDS_BYTES - LDSCTL_OFF) / 4; u += NWAVES * 64) ((LAS unsigned*)(L + LDSCTL_OFF))[u] = 0u;
    __syncthreads();
    XcdBarrier bar = xcd_barrier_post((unsigned*)(ctl + CW_BAR), MISC + 8);
    const float* x = args.in[0];
    bf16* R0 = (bf16*)(ws + WS_R0); bf16* R1 = (bf16*)(ws + WS_R1); bf16* R2 = (bf16*)(ws + WS_R2); bf16* BIG = (bf16*)(ws + WS_BIG);

    {
        const int tid_ = TID_NOW;
        const size_t n8 = (size_t)M * DM / 8; const size_t gt = (size_t)bx * (NWAVES * 64) + tid_, nth = (size_t)G * NWAVES * 64;
#ifndef REP_X
#define REP_X 1
#endif
#ifndef REP_T
#define REP_T 1
#endif
        const int half_ = wave >> 2;
        const size_t xh = n8 / 2, xgt = (size_t)bx * 256 + (tid_ & 255), xnth = (size_t)G * 256;
        LAS float* scr = (LAS float*)(L + RING_OFF + wave * 16384);
        for (int pass_ = 0; pass_ < 2; ++pass_) {
        if ((pass_ == 0) == (half_ == 0)) {
        for (int rx_ = 0; rx_ < REP_X; ++rx_)
        for (size_t i = xgt + half_ * xh, n8 = (half_ + 1) * xh, nth = xnth; i < n8; i += 4 * nth) {
            f32x4 a[4], b[4];
#pragma unroll
            for (int u = 0; u < 4; ++u) { size_t j = i + u * nth; j = j < n8 ? j : n8 - 1; a[u] = ((const f32x4*)x)[2 * j]; b[u] = ((const f32x4*)x)[2 * j + 1]; }
#pragma unroll
            for (int u = 0; u < 4; ++u) { const size_t j = i + u * nth; if (j < n8) { v4u o; o.x = pk2(a[u].x, a[u].y); o.y = pk2(a[u].z, a[u].w); o.z = pk2(b[u].x, b[u].y); o.w = pk2(b[u].z, b[u].w); ((v4u*)R0)[j] = o;
#if P1_FP8
                int w0 = __builtin_amdgcn_cvt_pk_fp8_f32(a[u].x, a[u].y, 0, false); w0 = __builtin_amdgcn_cvt_pk_fp8_f32(a[u].z, a[u].w, w0, true);
                int w1 = __builtin_amdgcn_cvt_pk_fp8_f32(b[u].x, b[u].y, 0, false); w1 = __builtin_amdgcn_cvt_pk_fp8_f32(b[u].z, b[u].w, w1, true);
                v2u o8; o8.x = (unsigned)w0; o8.y = (unsigned)w1; ((v2u*)(ws + WS_X8))[j] = o8;
#endif
                } }
        }
        } else {
        constexpr int I_IN = (DM / 64) * (ZC / 32), I_O = (DM / 64) * (DM / 32), I_GU = (DM / 64) * (GU / 32), I_D = (FF / 64) * (DM / 32), I_L = I_IN + I_O + I_GU + I_D;
        for (int rt_ = 0; rt_ < REP_T; ++rt_)
        for (int it = vcu * NWAVES + (wave & 3) * 2 + half_; it < DEPTH * I_L; it += NGW) {
            const int l = it / I_L; int r = it % I_L;
            unsigned char* wl = ws + WS_W + (size_t)l * W_LAYER_B;
            float* cv = (float*)(ws + WS_CVP) + (size_t)l * 16 * CV_LAYER; const bool acc_ = rt_ == 0;
            const float* g2p = (l > 0 && !LNFUSE) ? args.in[10] + (l - 1) * DM : nullptr; const float* b2p = (l > 0 && !LNFUSE) ? args.in[11] + (l - 1) * DM : nullptr;
            const float* g1 = LNFUSE ? nullptr : args.in[5] + l * DM; const float* b1 = LNFUSE ? nullptr : args.in[6] + l * DM;
            if (r < I_IN) { transpose_item<0, P1_FP8 ? 8 : 0>(args.in[1] + (size_t)l * DM * INC, nullptr, g2p, b2p, acc_ ? cv : nullptr, cv + ZC, DM, INC, ZC, (bf16*)wl, scr, r, LANE_NOW); continue; } r -= I_IN;
            if (r < I_O) { transpose_item<1, MIX_FP8 ? 6 : 0>(args.in[2] + (size_t)l * DM * DM, nullptr, nullptr, nullptr, nullptr, nullptr, DM, DM, DM, (bf16*)(wl + W_IN_B), scr, r, LANE_NOW); continue; } r -= I_O;
            if (r < I_GU) { transpose_item<2, FFN_FP8 ? 6 : 0>(args.in[7] + (size_t)l * DM * FF, args.in[8] + (size_t)l * DM * FF, g1, b1, acc_ ? cv + 2 * ZC : nullptr, cv + 2 * ZC + GU, DM, FF, GU, (bf16*)(wl + W_IN_B + W_O_B), scr, r, LANE_NOW); continue; } r -= I_GU;
            transpose_item<1, FFN_FP8_P5 ? 8 : 0>(args.in[9] + (size_t)l * FF * DM, nullptr, nullptr, nullptr, nullptr, nullptr, FF, DM, DM, (bf16*)(wl + W_IN_B + W_O_B + W_GU_B), scr, r, LANE_NOW);
        }
        } }
    }
    xcd_barrier(bar);

#pragma unroll
    for (int l = 0; l < DEPTH; ++l) {
#define WS_NOW ({ unsigned char* w_ = args.ws; asm volatile("" : "+s"(w_)); w_; })
#define OPQ_S(x) ({ int x_ = (x); asm volatile("" : "+s"(x_)); x_; })
#define P_WL(w) ((w) + WS_W + (size_t)l * W_LAYER_B)
#define P_ST(w, ll, which) ((float*)((w) + WS_STAT) + (size_t)(((ll) * 2 + (which)) * 2) * M)
#define P_CV(w) ((const float*)((w) + WS_CV) + (size_t)l * CV_LAYER)
        const float lambda_init = (l == 0) ? 0.2f : 0.35550906759f;
        const bool last = (l + 1 == DEPTH);

#ifndef STAG_P1
#define STAG_P1 3
#endif
#ifndef STAG_P4
#define STAG_P4 2
#endif
#ifndef STAG_P5
#define STAG_P5 0
#endif
#define PHASE_STAGGER(N) do { if ((N) > 0 && (OPQ_S(bx) & 1)) { for (int i_ = 0; i_ < (N); ++i_) __builtin_amdgcn_s_sleep(127); } } while (0)
        PHASE_STAGGER(STAG_P1);
        { unsigned char* w = WS_NOW; const float* sP = (l > 0 && !LNFUSE) ? P_ST(w, l - 1, 1) : nullptr; const float* cv = P_CV(w);
#if P1_FP8
#if P1_MIX
          const int pop_ = OPQ_S(bx) & 1;
#pragma unroll 1
          for (int part_ = 0; part_ < 4; ++part_) { const bool isb_ = ((part_ & 1) == pop_); const int hf_ = part_ >> 1;
          if (!isb_)
#endif
          { pg8::Gemm g{(const pg8::bf16_t*)(w + WS_X8), (const pg8::bf16_t*)(P_WL(w) + W_IN8_OFF), M, ZC - 512, DM / 2, 0}; pg8::StaticOrder S; S.init(M, ZC - 512, OPQ_S(G), OPQ_S(bx), 1, 2);
#if P1_MIX
            S.i0 = 5 * hf_; S.iN = 5;
#endif
            pg8::EpiStoreLN E{(pg8::bf16_t*)(w + WS_BIG), ZC, sP, sP ? sP + M : nullptr, cv, cv + ZC, 1.f / 256.f};
            for (int rep = 0; rep < REP_G * REP_P1A; ++rep) {
            pg8::gemm_phase<pg8::EpiStoreLN, pg8::StaticOrder, GM_ALIGN_F8, GM_SP2_F8, true>(L + RING_OFF, g, S, E, OPQ_S(wave)); } }
#if P1_MIX
          else
#endif
          { pg8::Gemm g{(const pg8::bf16_t*)(w + WS_R0), (const pg8::bf16_t*)P_WL(w), M, 512, DM, 0}; pg8::StaticOrder S; S.init(M, 512, OPQ_S(G), OPQ_S(bx), 0, 1);
#if P1_MIX
            S.i0 = hf_; S.iN = 1;
#endif
            pg8::EpiStoreLN E{(pg8::bf16_t*)(w + WS_BIG), ZC, sP, sP ? sP + M : nullptr, cv, cv + ZC, 1.f};
            for (int rep = 0; rep < REP_G * REP_P1B; ++rep) {
            pg8::gemm_phase<pg8::EpiStoreLN, pg8::StaticOrder, GM_ALIGN, GM_SP2>(L + RING_OFF, g, S, E, OPQ_S(wave)); } }
#if P1_MIX
          }
#endif
          }
#else
          pg8::Gemm g{(const pg8::bf16_t*)(w + WS_R0), (const pg8::bf16_t*)P_WL(w), M, ZC, DM, 0}; pg8::StaticOrder S; S.init(M, ZC, OPQ_S(G), OPQ_S(bx));
          pg8::EpiStoreLN E{(pg8::bf16_t*)(w + WS_BIG), ZC, sP, sP ? sP + M : nullptr, cv, cv + ZC, 1.f};
          for (int rep = 0; rep < REP_G * REP_P1A; ++rep) {
          pg8::gemm_phase<pg8::EpiStoreLN, pg8::StaticOrder, GM_ALIGN, GM_SP2>(L + RING_OFF, g, S, E, OPQ_S(wave)); } }
#endif
        for (int rb_ = 0; rb_ < REP_BAR; ++rb_) xcd_barrier(bar);
#if MIX_PRIO
        if (OPQ_S(wave) >= 4) __builtin_amdgcn_s_setprio(1);
#endif
        if (l == 0 && !LNFUSE) { unsigned char* w = WS_NOW; cv_reduce((const float*)(w + WS_CVP), (float*)(w + WS_CV), (size_t)OPQ_S(bx) * (NWAVES * 64) + TID_NOW, (size_t)OPQ_S(G) * NWAVES * 64); }
        { unsigned char* w = WS_NOW; for (int rep = 0; rep < REP_A; ++rep) mixa_phase64((const bf16*)(w + WS_BIG), (bf16*)(w + WS_R1), (float*)(w + WS_R2), L + RING_OFF, OPQ_S(vcu), OPQ_S(G), OPQ_S(wave)); }
#if BSTREAM
        { unsigned char* w = WS_NOW; for (int rep = 0; rep < REP_B; ++rep) flash_phase_b((const bf16*)(w + WS_BIG), (bf16*)(w + WS_R1), L + RING_OFF, args.in[3] + l * 128, args.in[4] + l * 64, lambda_init, OPQ_S(vcu), OPQ_S(G), OPQ_S(wave)); }
#else
        { unsigned char* w = WS_NOW; for (int rep = 0; rep < REP_B; ++rep) FLASHP<0>((const bf16*)(w + WS_BIG), (bf16*)(w + WS_R1), L + RING_OFF, args.in[3] + l * 128, args.in[4] + l * 64, lambda_init, OPQ_S(vcu), OPQ_S(G), TID_NOW, OPQ_S(wave), LANE_NOW); }
#endif
#if CSUB
        { unsigned char* w = WS_NOW; for (int rep = 0; rep < REP_C; ++rep) flash_phase_sub((const bf16*)(w + WS_BIG), (bf16*)(w + WS_R1), L + RING_OFF, OPQ_S(vcu), OPQ_S(G), OPQ_S(wave)); }
#else
        { unsigned char* w = WS_NOW; for (int rep = 0; rep < REP_C; ++rep) FLASHP<1>((const bf16*)(w + WS_BIG), (bf16*)(w + WS_R1), L + RING_OFF, nullptr, nullptr, 0.f, OPQ_S(vcu), OPQ_S(G), TID_NOW, OPQ_S(wave), LANE_NOW); }
#endif
#if MIX_PRIO
        __builtin_amdgcn_s_setprio(0);
#endif
        for (int rb_ = 0; rb_ < REP_BAR; ++rb_) xcd_barrier(bar);
#if LNFUSE
        { unsigned char* w = WS_NOW;
          pg8::Gemm g{(const pg8::bf16_t*)(w + WS_R1), (const pg8::bf16_t*)(P_WL(w) + W_IN_B), M, DM, MIX_FP8 ? DM / 2 : DM, 0}; pg8::StaticOrder S; S.init(M, DM, OPQ_S(G), OPQ_S(bx));
          pg8::EpiResLN E{(const pg8::bf16_t*)(w + WS_R0), args.in[5] + l * DM, args.in[6] + l * DM, (pg8::bf16_t*)(w + WS_R2), (unsigned char*)(w + WS_BIG + H8_OFF), nullptr, DM, ALPHA, MIX_FP8 ? 1.f / 64.f : 1.f,
                          (unsigned long long*)(w + WS_SP) + (size_t)(2 * l) * M * 4, (unsigned*)(w + XCNT_OFF) + (2 * l) * 256 * 16, (unsigned*)(w + WS_CTL) + 32, (PG8_LAS unsigned char*)(L + XT_OFF)};
          pg8::gemm_phase<pg8::EpiResLN, pg8::StaticOrder, true, GM_SP2, MIX_FP8 != 0>(L + RING_OFF, g, S, E, OPQ_S(wave)); }
        xcd_barrier(bar);
        PHASE_STAGGER(STAG_P4);
        { unsigned char* w = WS_NOW;
          pg8::StaticOrder S; S.init(M, GU, OPQ_S(G), OPQ_S(bx));
          pg8::Gemm g{(const pg8::bf16_t*)(w + WS_BIG + H8_OFF), (const pg8::bf16_t*)(P_WL(w) + W_IN_B + W_O_B), M, GU, DM / 2, 0};
          pg8::EpiSwiglu8 E{w + WS_BIG + ACT_OFF, FF, 1.f / 64.f};
          pg8::gemm_phase<pg8::EpiSwiglu8, pg8::StaticOrder, GM_ALIGN_F8, GM_SP2_F8, true>(L + RING_OFF, g, S, E, OPQ_S(wave)); }
        xcd_barrier(bar);
        { unsigned char* w = WS_NOW;
          pg8::Gemm g{(const pg8::bf16_t*)(w + WS_BIG + ACT_OFF), (const pg8::bf16_t*)(P_WL(w) + W_IN_B + W_O_B + W_GU_B), M, DM, FF / 2, 0};
          pg8::StaticOrder S; S.init(M, DM, OPQ_S(G), OPQ_S(bx));
          pg8::EpiResLN E{(const pg8::bf16_t*)(w + WS_R2), args.in[10] + l * DM, args.in[11] + l * DM, last ? nullptr : (pg8::bf16_t*)(w + WS_R0), last ? nullptr : (unsigned char*)(w + WS_X8), last ? args.out : nullptr, DM, ALPHA, 1.f / 256.f,
                          (unsigned long long*)(w + WS_SP) + (size_t)(2 * l + 1) * M * 4, (unsigned*)(w + XCNT_OFF) + (2 * l + 1) * 256 * 16, (unsigned*)(w + WS_CTL) + 32, (PG8_LAS unsigned char*)(L + XT_OFF)};
          pg8::gemm_phase<pg8::EpiResLN, pg8::StaticOrder, true, GM_SP2, true>(L + RING_OFF, g, S, E, OPQ_S(wave)); }
        if (!last) xcd_barrier(bar);
#else
        { unsigned char* w = WS_NOW; const float* sP = l > 0 ? P_ST(w, l - 1, 1) : nullptr; float* sA = P_ST(w, l, 0);
          pg8::Gemm g{(const pg8::bf16_t*)(w + WS_R1), (const pg8::bf16_t*)(P_WL(w) + W_IN_B), M, DM, MIX_FP8 ? DM / 2 : DM, 0}; pg8::StaticOrder S; S.init(M, DM, OPQ_S(G), OPQ_S(bx));
          pg8::EpiResStat E{(const pg8::bf16_t*)(w + WS_R0), sP, sP ? sP + M : nullptr, l > 0 ? args.in[10] + (l - 1) * DM : nullptr, l > 0 ? args.in[11] + (l - 1) * DM : nullptr, (pg8::bf16_t*)(w + WS_R2), nullptr, (float*)(w + WS_SP), (float*)(w + WS_SP) + (size_t)16 * M, DM, ALPHA, FFN_FP8 ? (unsigned char*)(w + WS_BIG + H8_OFF) : nullptr, MIX_FP8 ? 1.f / 64.f : 1.f, M};
          for (int rep = 0; rep < REP_G * REP_P3; ++rep) { if (rep > 0) { E.osum = nullptr; }
          pg8::gemm_phase<pg8::EpiResStat, pg8::StaticOrder, GM_ALIGN_RES, GM_SP2, MIX_FP8 != 0>(L + RING_OFF, g, S, E, OPQ_S(wave)); } }
        for (int rb_ = 0; rb_ < REP_BAR; ++rb_) xcd_barrier(bar);
        { unsigned char* w = WS_NOW; float* sA = P_ST(w, l, 0); stats_reduce((const float*)(w + WS_SP), sA, sA + M, (size_t)OPQ_S(bx) * (NWAVES * 64) + TID_NOW, (size_t)OPQ_S(G) * NWAVES * 64); }
        xcd_barrier(bar);
        { unsigned char* w = WS_NOW; float* sA = P_ST(w, l, 0); const float* cv = P_CV(w);
          pg8::StaticOrder S; S.init(M, GU, OPQ_S(G), OPQ_S(bx));
#if FFN_FP8
          pg8::Gemm g{(const pg8::bf16_t*)(w + WS_BIG + H8_OFF), (const pg8::bf16_t*)(P_WL(w) + W_IN_B + W_O_B), M, GU, DM / 2, 0};
#if FFN_FP8_P5
          pg8::EpiSwigluLN8 E{w + WS_BIG + ACT_OFF, FF, sA, sA + M, cv + 2 * ZC, cv + 2 * ZC + GU, 1.f / 64.f};
          for (int rep = 0; rep < REP_G * REP_P4; ++rep) {
          pg8::gemm_phase<pg8::EpiSwigluLN8, pg8::StaticOrder, GM_ALIGN_F8, GM_SP2_F8, true>(L + RING_OFF, g, S, E, OPQ_S(wave)); }
#ifdef PROBE_K
          { pg8::Gemm g2{g.A, g.Bt, M, GU, DM / 2, PROBE_K == 2 ? 777 : 0}; pg8::EpiSwigluLN8 E2{w + WS_BIG + 256 * MiB, FF, sA, sA + M, cv + 2 * ZC, cv + 2 * ZC + GU, 1.f / 64.f};
            pg8::gemm_phase<pg8::EpiSwigluLN8, pg8::StaticOrder, GM_ALIGN_F8, GM_SP2_F8, true>(L + RING_OFF, g2, S, E2, OPQ_S(wave)); }
#endif
#else
          pg8::EpiSwigluLN E{(pg8::bf16_t*)(w + WS_BIG + ACT_OFF), FF, sA, sA + M, cv + 2 * ZC, cv + 2 * ZC + GU, 1.f / 64.f};
          for (int rep = 0; rep < REP_G * REP_P4; ++rep) {
          pg8::gemm_phase<pg8::EpiSwigluLN, pg8::StaticOrder, GM_ALIGN, GM_SP2, true>(L + RING_OFF, g, S, E, OPQ_S(wave)); }
#endif
#else
          pg8::Gemm g{(const pg8::bf16_t*)(w + WS_R2), (const pg8::bf16_t*)(P_WL(w) + W_IN_B + W_O_B), M, GU, DM, 0};
          pg8::EpiSwigluLN E{(pg8::bf16_t*)(w + WS_BIG), FF, sA, sA + M, cv + 2 * ZC, cv + 2 * ZC + GU, 1.f};
          for (int rep = 0; rep < REP_G * REP_P4; ++rep) {
          pg8::gemm_phase<pg8::EpiSwigluLN, pg8::StaticOrder, GM_ALIGN, GM_SP2>(L + RING_OFF, g, S, E, OPQ_S(wave)); }
#endif
        }
        for (int rb_ = 0; rb_ < REP_BAR; ++rb_) xcd_barrier(bar);
        { unsigned char* w = WS_NOW; float* sA = P_ST(w, l, 0); float* sB = P_ST(w, l, 1);
#if FFN_FP8_P5
          pg8::Gemm g{(const pg8::bf16_t*)(w + WS_BIG + ACT_OFF), (const pg8::bf16_t*)(P_WL(w) + W_IN_B + W_O_B + W_GU_B), M, DM, FF / 2, 0};
#else
          pg8::Gemm g{(const pg8::bf16_t*)(w + WS_BIG + ACT_OFF), (const pg8::bf16_t*)(P_WL(w) + W_IN_B + W_O_B + W_GU_B), M, DM, FF, 0};
#endif
          pg8::StaticOrder S; S.init(M, DM, OPQ_S(G), OPQ_S(bx));
          pg8::EpiResStat E{(const pg8::bf16_t*)(w + WS_R2), sA, sA + M, args.in[5] + l * DM, args.in[6] + l * DM, (pg8::bf16_t*)(w + WS_R0), nullptr, (float*)(w + WS_SP), (float*)(w + WS_SP) + (size_t)16 * M, DM, ALPHA, (P1_FP8 && !last) ? w + WS_X8 : nullptr, FFN_FP8_P5 ? 1.f / 256.f : 1.f, M};
          for (int rep = 0; rep < REP_G * REP_P5; ++rep) { if (rep > 0) { E.osum = nullptr; }
          pg8::gemm_phase<pg8::EpiResStat, pg8::StaticOrder, GM_ALIGN_RES, GM_SP2, FFN_FP8_P5 != 0>(L + RING_OFF, g, S, E, OPQ_S(wave)); } }
        for (int rb_ = 0; rb_ < REP_BAR; ++rb_) xcd_barrier(bar);
        { unsigned char* w = WS_NOW; float* sB = P_ST(w, l, 1); stats_reduce((const float*)(w + WS_SP), sB, sB + M, (size_t)OPQ_S(bx) * (NWAVES * 64) + TID_NOW, (size_t)OPQ_S(G) * NWAVES * 64); }
        xcd_barrier(bar);
        if (last) {
            unsigned char* w = WS_NOW; const bf16* R0 = (const bf16*)(w + WS_R0); const float* sB = P_ST(w, l, 1);
            const int tid_ = TID_NOW;
            const size_t gt = (size_t)bx * (NWAVES * 64) + tid_, nth = (size_t)G * NWAVES * 64;
            if (nth % 128 == 0) {
                const int cc = (int)(gt & 127) * 8; const float* g2 = args.in[10] + l * DM + cc; const float* b2 = args.in[11] + l * DM + cc;
                const f32x4 ga = *(const f32x4*)g2, gb = *(const f32x4*)(g2 + 4), ba = *(const f32x4*)b2, bb = *(const f32x4*)(b2 + 4);
                const size_t rstep = nth / 128;
                for (size_t row = gt >> 7; row < (size_t)M; row += 4 * rstep) {
                    v4u hv[4]; float mu[4], rs[4];
#pragma unroll
                    for (int u = 0; u < 4; ++u) { size_t r = row + u * rstep; r = r < (size_t)M ? r : (size_t)M - 1; hv[u] = *(const v4u*)(R0 + r * DM + cc); mu[u] = sB[r]; rs[u] = sB[M + r]; }
#pragma unroll
                    for (int u = 0; u < 4; ++u) { const size_t r = row + u * rstep; if (r < (size_t)M) {
                        f32x4 ya, yb; ya.x = bflo(hv[u].x); ya.y = bfhi(hv[u].x); ya.z = bflo(hv[u].y); ya.w = bfhi(hv[u].y); yb.x = bflo(hv[u].z); yb.y = bfhi(hv[u].z); yb.z = bflo(hv[u].w); yb.w = bfhi(hv[u].w);
                        ya = (ya - mu[u]) * rs[u] * ga + ba; yb = (yb - mu[u]) * rs[u] * gb + bb;
                        float* op = args.out + r * DM + cc; *(f32x4*)op = ya; *(f32x4*)(op + 4) = yb; } }
                }
            }
        }
#endif
    }
}

extern "C" void kernel_launch(void* const* d_in, const int* in_sizes, int n_in, void* d_out, int out_size, void* d_ws, size_t ws_size, hipStream_t stream) {
    static int grid = 0;
    if (grid == 0) {
        if (n_in != 12 || in_sizes[0] != M * DM || out_size != M * DM || ws_size < WS_END) { fprintf(stderr, "kernel_launch: unexpected shapes / workspace (n_in %d, in0 %d, out %d, ws %zu < %zu)\n", n_in, n_in > 0 ? in_sizes[0] : -1, out_size, ws_size, (size_t)WS_END); grid = -1; return; }
        int dev = 0, cus = 0, per_cu = 0;
        if (hipGetDevice(&dev) != hipSuccess || hipDeviceGetAttribute(&cus, hipDeviceAttributeMultiprocessorCount, dev) != hipSuccess) { grid = -1; return; }
        if (hipFuncSetAttribute((const void*)hybrid_fwd, hipFuncAttributeMaxDynamicSharedMemorySize, LDS_BYTES) != hipSuccess) { fprintf(stderr, "kernel_launch: hipFuncSetAttribute failed\n"); grid = -1; return; }
        if (hipOccupancyMaxActiveBlocksPerMultiprocessor(&per_cu, (const void*)hybrid_fwd, NWAVES * 64, LDS_BYTES) != hipSuccess || per_cu < 1) { fprintf(stderr, "kernel_launch: occupancy query reports %d\n", per_cu); }
        (void)hipGetLastError();
        grid = cus < 256 ? cus : 256;
    }
    if (grid < 0) return;
    if (hipMemsetAsync((char*)d_ws + WS_CTL, 0, CTL_ZERO_BYTES, stream) != hipSuccess) return;
    Args a{};
    for (int i = 0; i < 12; ++i) a.in[i] = (const float*)d_in[i];
    a.out = (float*)d_out; a.ws = (unsigned char*)d_ws;
    hipLaunchKernelGGL(hybrid_fwd, dim3(grid), dim3(NWAVES * 64), LDS_BYTES, stream, a);
}
```
